# Optimizing an MI355X kernel written in HIP

```python
import jax, jax.numpy as jnp
from jax import lax
import numpy as np

D_MODEL = 2048
BATCH = 4
SEQ = 2048
DEPTH = 1

W_CONV = D_MODEL // 2
CONV_GROUPS = 8
W_MLSTM = D_MODEL - W_CONV
N_HEADS_M = 4
HEAD_DIM_M = W_MLSTM // N_HEADS_M
CONV_WIDTH = 3
CHUNK = 64
D_FF = 5632
LN_EPS = 1e-5
HEAD_NORM_EPS = 1e-6
N_IN = 3 * W_CONV + 4 * W_MLSTM + 2 * N_HEADS_M

kernel_name = "hybrid_shortconv_mlstm_convffn_deepnorm"


def causal_dwconv(u, w, b=None):
    s = u.shape[1]
    up = jnp.pad(u, ((0, 0), (CONV_WIDTH - 1, 0), (0, 0)))
    y = w[0] * up[:, 0:s]
    for j in range(1, CONV_WIDTH):
        y = y + w[j] * up[:, j:j + s]
    return y if b is None else y + b


def layer_norm(x, g, b):
    xf = x.astype(jnp.float32)
    mu = jnp.mean(xf, axis=-1, keepdims=True)
    var = jnp.mean(jnp.square(xf - mu), axis=-1, keepdims=True)
    y = (xf - mu) * lax.rsqrt(var + LN_EPS) * g.astype(jnp.float32) + b.astype(jnp.float32)
    return y.astype(x.dtype)


def head_layer_norm(h, g):
    mu = jnp.mean(h, axis=-1, keepdims=True)
    var = jnp.mean(jnp.square(h - mu), axis=-1, keepdims=True)
    return (h - mu) * lax.rsqrt(var + HEAD_NORM_EPS) * g.astype(jnp.float32)


def mlstm_chunkwise(q, k, v, i_pre, f_pre):
    f32 = jnp.float32
    bsz, s, nh, dh = q.shape
    nc = s // CHUNK

    def to_chunks(t):
        return t.astype(f32).reshape(bsz, nc, CHUNK, nh, dh).transpose(1, 0, 3, 2, 4)

    def gate_chunks(t):
        return t.astype(f32).reshape(bsz, nc, CHUNK, nh).transpose(1, 0, 3, 2)

    qc = to_chunks(q) * (dh ** -0.5)
    kc = to_chunks(k)
    vc = to_chunks(v)
    ic = gate_chunks(i_pre)
    lfc = gate_chunks(jax.nn.log_sigmoid(f_pre.astype(f32)))
    causal = jnp.tril(jnp.ones((CHUNK, CHUNK), dtype=bool))

    def step(carry, xs):
        c_state, n_state, m_state = carry
        qb, kb, vb, ib, lfb = xs
        bcum = jnp.cumsum(lfb, axis=-1)
        g_tot = bcum[..., -1]
        log_d = bcum[..., :, None] - bcum[..., None, :] + ib[..., None, :]
        log_d = jnp.where(causal, log_d, -jnp.inf)
        inter_log = bcum + m_state[..., None]
        m_t = jnp.maximum(inter_log, jnp.max(log_d, axis=-1))
        d_w = jnp.exp(log_d - m_t[..., None])
        scores = jnp.einsum('bhtd,bhsd->bhts', qb, kb) * d_w
        inter_w = jnp.exp(inter_log - m_t)
        num = (jnp.einsum('bhts,bhse->bhte', scores, vb)
               + inter_w[..., None] * jnp.einsum('bhtd,bhde->bhte', qb, c_state))
        den = jnp.sum(scores, axis=-1) + inter_w * jnp.einsum('bhtd,bhd->bht', qb, n_state)
        h = num / jnp.maximum(jnp.abs(den), jnp.exp(-m_t))[..., None]
        w_log = g_tot[..., None] - bcum + ib
        m_new = jnp.maximum(g_tot + m_state, jnp.max(w_log, axis=-1))
        w = jnp.exp(w_log - m_new[..., None])
        decay = jnp.exp(g_tot + m_state - m_new)
        c_new = decay[..., None, None] * c_state + jnp.einsum('bhs,bhsd,bhse->bhde', w, kb, vb)
        n_new = decay[..., None] * n_state + jnp.einsum('bhs,bhsd->bhd', w, kb)
        return (c_new, n_new, m_new), h

    init = (jnp.zeros((bsz, nh, dh, dh), f32),
            jnp.zeros((bsz, nh, dh), f32),
            jnp.zeros((bsz, nh), f32))
    _, h = lax.scan(step, init, (qc, kc, vc, ic, lfc))
    return h.transpose(1, 0, 3, 2, 4).reshape(bsz, s, nh, dh)


def hybrid_mixer(x, w_in, b_gates, w_sc_conv, mh_gain, w_out):
    bsz, s, _ = x.shape
    proj = jnp.einsum('bsd,dn->bsn', x, w_in)
    splits = [W_CONV, 2 * W_CONV, 3 * W_CONV,
              3 * W_CONV + W_MLSTM, 3 * W_CONV + 2 * W_MLSTM,
              3 * W_CONV + 3 * W_MLSTM, 3 * W_CONV + 4 * W_MLSTM]
    c_b, c_c, c_h, q, k, v, o, gates = jnp.split(proj, splits, axis=-1)
    y_conv = c_b * causal_dwconv(c_c * c_h, w_sc_conv)
    gates = gates + b_gates
    i_pre, f_pre = gates[..., :N_HEADS_M], gates[..., N_HEADS_M:]
    hd = (bsz, s, N_HEADS_M, HEAD_DIM_M)
    h = mlstm_chunkwise(q.reshape(hd), k.reshape(hd), v.reshape(hd), i_pre, f_pre)
    h = head_layer_norm(h, mh_gain.reshape(N_HEADS_M, HEAD_DIM_M))
    h = jax.nn.sigmoid(o.astype(jnp.float32)).reshape(hd) * h
    y_mlstm = h.reshape(bsz, s, W_MLSTM).astype(x.dtype)
    y = jnp.concatenate([y_conv, y_mlstm], axis=-1)
    return jnp.einsum('bsd,de->bse', y, w_out)


def conv_ffn(x, w_up, w_ffn_conv, b_ffn_conv, w_down):
    hid = jnp.einsum('bsd,df->bsf', x, w_up)
    hid = causal_dwconv(hid, w_ffn_conv, b_ffn_conv)
    val, gate = hid[..., :D_FF], hid[..., D_FF:]
    return jnp.einsum('bsf,fd->bsd', jax.nn.silu(gate) * val, w_down)


def setup_inputs(seed: int = 0) -> dict:
    key = jax.random.key(seed)
    ks = jax.random.split(key, 16)
    beta = (8 * DEPTH) ** -0.25
    nrm = jax.random.normal
    x = nrm(ks[0], (BATCH, SEQ, D_MODEL), jnp.float32)
    col_scale = jnp.ones((N_IN,), jnp.float32)
    col_scale = col_scale.at[2 * W_CONV:3 * W_CONV].set(beta)
    col_scale = col_scale.at[3 * W_CONV + 2 * W_MLSTM:3 * W_CONV + 3 * W_MLSTM].set(beta)
    w_in = nrm(ks[1], (DEPTH, D_MODEL, N_IN), jnp.float32) * (D_MODEL ** -0.5) * col_scale
    b_i = 0.1 * nrm(ks[2], (DEPTH, N_HEADS_M), jnp.float32)
    b_f = jnp.linspace(3.0, 6.0, N_HEADS_M, dtype=jnp.float32) + 0.1 * nrm(ks[3], (DEPTH, N_HEADS_M), jnp.float32)
    b_gates = jnp.concatenate([b_i, b_f], axis=-1)
    w_sc_conv = nrm(ks[4], (DEPTH, CONV_WIDTH, W_CONV), jnp.float32) * (CONV_WIDTH ** -0.5)
    mh_gain = 1.0 + 0.02 * nrm(ks[5], (DEPTH, W_MLSTM), jnp.float32)
    w_out = nrm(ks[6], (DEPTH, D_MODEL, D_MODEL), jnp.float32) * (D_MODEL ** -0.5) * beta
    ln1_g = 1.0 + 0.02 * nrm(ks[7], (DEPTH, D_MODEL), jnp.float32)
    ln1_b = 0.02 * nrm(ks[8], (DEPTH, D_MODEL), jnp.float32)
    w_up = nrm(ks[9], (DEPTH, D_MODEL, 2 * D_FF), jnp.float32) * (D_MODEL ** -0.5)
    w_ffn_conv = nrm(ks[10], (DEPTH, CONV_WIDTH, 2 * D_FF), jnp.float32) * (CONV_WIDTH ** -0.5)
    b_ffn_conv = 0.02 * nrm(ks[11], (DEPTH, 2 * D_FF), jnp.float32)
    w_down = nrm(ks[12], (DEPTH, D_FF, D_MODEL), jnp.float32) * (D_FF ** -0.5) * beta
    ln2_g = 1.0 + 0.02 * nrm(ks[13], (DEPTH, D_MODEL), jnp.float32)
    ln2_b = 0.02 * nrm(ks[14], (DEPTH, D_MODEL), jnp.float32)
    return {"x": x, "w_in": w_in, "b_gates": b_gates, "w_sc_conv": w_sc_conv,
            "mh_gain": mh_gain, "w_out": w_out, "ln1_g": ln1_g, "ln1_b": ln1_b,
            "w_up": w_up, "w_ffn_conv": w_ffn_conv, "b_ffn_conv": b_ffn_conv,
            "w_down": w_down, "ln2_g": ln2_g, "ln2_b": ln2_b}


def reference(x, w_in, b_gates, w_sc_conv, mh_gain, w_out, ln1_g, ln1_b,
              w_up, w_ffn_conv, b_ffn_conv, w_down, ln2_g, ln2_b):
    alpha = (2 * DEPTH) ** 0.25
    for l in range(DEPTH):
        mix = hybrid_mixer(x, w_in[l], b_gates[l], w_sc_conv[l], mh_gain[l], w_out[l])
        x = layer_norm(alpha * x + mix, ln1_g[l], ln1_b[l])
        ff = conv_ffn(x, w_up[l], w_ffn_conv[l], b_ffn_conv[l], w_down[l])
        x = layer_norm(alpha * x + ff, ln2_g[l], ln2_b[l])
    return x
```

```cpp
#include <hip/hip_runtime.h>
#include <hip/hip_cooperative_groups.h>
#include <cstdio>
#include <cstdint>
namespace cg = cooperative_groups;

#ifndef MK_SINGLE
#define MK_SINGLE 1
#endif

#define LAS __attribute__((address_space(3)))
typedef unsigned short bf16_t;
typedef short bf16x8 __attribute__((ext_vector_type(8)));
typedef float f32x4 __attribute__((ext_vector_type(4)));
typedef unsigned u32x4 __attribute__((ext_vector_type(4)));
typedef unsigned u32x2 __attribute__((ext_vector_type(2)));

constexpr int MT = 8192, DM = 2048, SEQ = 2048, NIN = 7176, NP = 7168, DFF = 5632, NUP = 11264, WCONV = 1024;
constexpr float ALPHA = 1.189207115002721f;
constexpr size_t WS_WIN = 0;
constexpr size_t WS_WOUT = WS_WIN + (size_t)NP * DM * 2;
constexpr size_t WS_WUP = WS_WOUT + (size_t)DM * DM * 2;
constexpr size_t WS_WDN = WS_WUP + (size_t)NUP * DM * 2;
constexpr size_t WS_X1B = WS_WDN + (size_t)DM * DFF * 2;
constexpr size_t WS_GATES = WS_X1B + (size_t)MT * DM * 2;
constexpr size_t WS_C = WS_GATES + (size_t)MT * 8 * 4;
constexpr size_t WS_PROJ = WS_C;
constexpr size_t WS_Y = WS_PROJ + (size_t)MT * NP * 2;
constexpr size_t WS_XB = WS_Y + (size_t)MT * DM * 2;
constexpr size_t WS_ACT = WS_C;
constexpr size_t WS_HALO = WS_ACT + (size_t)MT * DFF * 2;
constexpr size_t WS_BAR = WS_XB + (size_t)MT * DM * 2;
constexpr size_t WS_END = WS_BAR + 4096;
constexpr int LDS_BYTES = 131072;

struct Args {
    const float* x; const float* w_in; const float* b_gates; const float* w_sc; const float* mh_gain; const float* w_out;
    const float* ln1_g; const float* ln1_b; const float* w_up; const float* w_fc; const float* b_fc; const float* w_down;
    const float* ln2_g; const float* ln2_b;
    float* out; unsigned char* ws; int ph_lo, ph_hi;
};

typedef __bf16 bf16v2 __attribute__((ext_vector_type(2)));
typedef float f32x2 __attribute__((ext_vector_type(2)));
__device__ __forceinline__ unsigned cvt_pk_bf16(float lo, float hi) { const f32x2 v = {lo, hi}; const bf16v2 r = __builtin_convertvector(v, bf16v2); return __builtin_bit_cast(unsigned, r); }
__device__ __forceinline__ unsigned cvt_pk_bf16_asm(float lo, float hi) { unsigned r; asm volatile("v_cvt_pk_bf16_f32 %0, %1, %2" : "=v"(r) : "v"(lo), "v"(hi)); return r; }
__device__ __forceinline__ float bflo(unsigned u) { return __uint_as_float(u << 16); }
__device__ __forceinline__ float bfhi(unsigned u) { return __uint_as_float(u & 0xffff0000u); }
__device__ __forceinline__ bf16_t f2bf(float f) { unsigned u = __float_as_uint(f); u += 0x7FFFu + ((u >> 16) & 1u); return (bf16_t)(u >> 16); }

namespace pg8 {
constexpr int BM = 256, BK = 64, HALF = 128, HTB = HALF * BK * 2, STAGE_BYTES = 8 * HTB, NXCD = 8, WGM = 8;
__host__ __device__ __forceinline__ int lds_byte(int r, int c) { const int st = (r >> 4) * 2 + (c >> 5), rr = r & 15, cc = c & 31, ob = rr * 64 + cc * 2; return st * 1024 + (ob ^ (((ob >> 9) & 1) << 5)); }
__host__ __device__ __forceinline__ void stage_rc(int b, int& R, int& C) { const int st = b / 1024, sb = b % 1024, swz = sb ^ (((sb >> 9) & 1) << 5); R = (st >> 1) * 16 + swz / 64; C = (st & 1) * 32 + (swz % 64) / 2; }
__host__ __device__ __forceinline__ int perm32(int rho) { const int n = rho >> 4, i = rho & 15; return 8 * (i >> 2) + 4 * n + (i & 3); }
struct Unit { int pm, pn; };
struct Gemm { const bf16_t* A; const bf16_t* Bt; int M, N, K; };
struct StaticOrder {
    int nM, nN, nwg, G, c;
    __device__ void init(int M, int N, int G_, int c_) { nM = M / BM; nN = N / BM; nwg = nM * nN; G = G_; c = c_; }
    __device__ bool next(int i, Unit& u) const {
        const long L = (long)i * G + c; if (L >= nwg) return false;
        int wgid = (int)L; { const int q = nwg / NXCD, r = nwg % NXCD, xcd = wgid % NXCD, off = wgid / NXCD; wgid = (xcd < r ? xcd * (q + 1) : r * (q + 1) + (xcd - r) * q) + off; }
        const int nig = WGM * nN, gid = wgid / nig, fm = gid * WGM, gsz = (nM - fm) < WGM ? (nM - fm) : WGM;
        u.pm = fm + ((wgid % nig) % gsz); u.pn = (wgid % nig) / gsz; return true;
    }
};

template <class Epi>
__device__ __forceinline__ void gemm_phase(LAS unsigned char* lds, const Gemm g, const StaticOrder& S, const Epi& E) {
    const int tid = threadIdx.x, wid = __builtin_amdgcn_readfirstlane(tid >> 6), lane = tid & 63, wr = wid >> 2, wc = wid & 3, fr = lane & 15, fq = lane >> 4;
    const int K = g.K, nt = K / BK;
    unsigned voffA[2], voffB[2];
#pragma unroll
    for (int i = 0; i < 2; ++i) { int R, C; stage_rc(tid * 16 + i * 8192, R, C); const int Rb = Epi::PERM ? ((R & ~31) + perm32(R & 31)) : R;
        voffA[i] = (unsigned)(R * K + C) * 2u; voffB[i] = (unsigned)(Rb * K + C) * 2u; }
    const size_t kstep = (size_t)(BK * 2);
    const size_t hstep = (size_t)HALF * K * 2;
    const size_t tstep = 2 * hstep;
    const unsigned ldsw = (unsigned)wid * 1024u;
    const int aoff = lds_byte(wr * 64 + fr, fq * 8), boff = lds_byte(wc * 32 + fr, fq * 8);
#define PG8_SA(b, h) (((b) * 2 + (h)) * HTB)
#define PG8_SB(b, h) ((4 + (b) * 2 + (h)) * HTB)
#define PG8_STAGE(bufoff, gbase, voff) do { _Pragma("unroll") for (int _i = 0; _i < 2; ++_i) \
        __builtin_amdgcn_global_load_lds((const unsigned*)((const char*)(gbase) + (voff)[_i]), (LAS unsigned*)(lds + (bufoff) + ldsw + _i * 8192), 16, 0, 0); } while (0)
#define PG8_LDA(dst, b, h) do { _Pragma("unroll") for (int m = 0; m < 4; ++m) _Pragma("unroll") for (int k = 0; k < 2; ++k) dst[m][k] = *(const LAS bf16x8*)(lds + PG8_SA(b, h) + aoff + m * 2048 + k * 1024); } while (0)
#define PG8_LDB(dst, b, h) do { _Pragma("unroll") for (int n = 0; n < 2; ++n) _Pragma("unroll") for (int k = 0; k < 2; ++k) dst[n][k] = *(const LAS bf16x8*)(lds + PG8_SB(b, h) + boff + n * 2048 + k * 1024); } while (0)
#define PG8_MMA(ai, bj, At, Bt) do { __builtin_amdgcn_s_setprio(1); _Pragma("unroll") for (int m = 0; m < 4; ++m) _Pragma("unroll") for (int n = 0; n < 2; ++n) _Pragma("unroll") for (int k = 0; k < 2; ++k) \
        acc[ai][bj][m][n] = __builtin_amdgcn_mfma_f32_16x16x32_bf16(Bt[n][k], At[m][k], acc[ai][bj][m][n], 0, 0, 0); __builtin_amdgcn_s_setprio(0); } while (0)
#define PG8_WAIT_V(n) asm volatile("s_waitcnt vmcnt(" #n ")" ::: "memory")
#define PG8_WAIT_L(n) asm volatile("s_waitcnt lgkmcnt(" #n ")" ::: "memory")
#define PG8_BAR __builtin_amdgcn_s_barrier()
#define PG8_SCHED __builtin_amdgcn_sched_barrier(0)
    Unit cur, nxt; int ui = 0;
    if (!S.next(0, cur)) return;
    f32x4 acc[2][2][4][2];
#pragma unroll
    for (int a = 0; a < 2; ++a)
#pragma unroll
        for (int b = 0; b < 2; ++b)
#pragma unroll
            for (int m = 0; m < 4; ++m)
#pragma unroll
                for (int n = 0; n < 2; ++n) acc[a][b][m][n] = (f32x4){0.f, 0.f, 0.f, 0.f};
    bf16x8 At[4][2], B0[2][2], B1[2][2];
    const char* cA = (const char*)g.A + (size_t)cur.pm * tstep; const char* cB = (const char*)g.Bt + (size_t)cur.pn * tstep;
    PG8_STAGE(PG8_SB(0, 0), cB, voffB); PG8_STAGE(PG8_SA(0, 0), cA, voffA); PG8_STAGE(PG8_SB(0, 1), cB + hstep, voffB); PG8_STAGE(PG8_SA(0, 1), cA + hstep, voffA);
    if (wr == 1) PG8_BAR;
    PG8_WAIT_V(4); PG8_BAR;
    PG8_STAGE(PG8_SB(1, 0), cB + kstep, voffB); PG8_STAGE(PG8_SA(1, 0), cA + kstep, voffA); PG8_STAGE(PG8_SB(1, 1), cB + hstep + kstep, voffB);
    PG8_WAIT_V(6); PG8_BAR;
    for (;;) {
        const bool has_next = S.next(ui + 1, nxt);
        const char* nA = has_next ? (const char*)g.A + (size_t)nxt.pm * tstep : cA; const char* nB = has_next ? (const char*)g.Bt + (size_t)nxt.pn * tstep : cB;
        for (int t = 0; t < nt; t += 2) {
            const bool last = (t == nt - 2);
            const char* a1 = cA + (size_t)(t + 1) * kstep;
            const char* a2 = last ? nA : cA + (size_t)(t + 2) * kstep; const char* b2 = last ? nB : cB + (size_t)(t + 2) * kstep;
            const char* a3 = a2 + kstep; const char* b3 = b2 + kstep;
            PG8_LDB(B0, 0, 0); PG8_SCHED; PG8_LDA(At, 0, 0); PG8_STAGE(PG8_SA(1, 1), a1 + hstep, voffA);
            PG8_WAIT_L(8); PG8_BAR; PG8_WAIT_L(0); PG8_MMA(0, 0, At, B0); PG8_BAR; PG8_SCHED;
            PG8_LDB(B1, 0, 1); PG8_STAGE(PG8_SB(0, 0), b2, voffB);
            PG8_BAR; PG8_WAIT_L(0); PG8_MMA(0, 1, At, B1); PG8_BAR;
            PG8_LDA(At, 0, 1); PG8_STAGE(PG8_SA(0, 0), a2, voffA);
            PG8_BAR; PG8_WAIT_L(0); PG8_MMA(1, 0, At, B0); PG8_BAR; PG8_SCHED;
            PG8_STAGE(PG8_SB(0, 1), b2 + hstep, voffB);
            PG8_WAIT_V(6); PG8_BAR; PG8_MMA(1, 1, At, B1); PG8_BAR;
            PG8_LDB(B0, 1, 0); PG8_SCHED; PG8_LDA(At, 1, 0); PG8_STAGE(PG8_SA(0, 1), a2 + hstep, voffA);
            PG8_WAIT_L(8); PG8_BAR; PG8_WAIT_L(0); PG8_MMA(0, 0, At, B0); PG8_BAR; PG8_SCHED;
            PG8_LDB(B1, 1, 1); PG8_STAGE(PG8_SB(1, 0), b3, voffB);
            PG8_BAR; PG8_WAIT_L(0); PG8_MMA(0, 1, At, B1); PG8_BAR;
            PG8_LDA(At, 1, 1); PG8_STAGE(PG8_SA(1, 0), a3, voffA);
            PG8_BAR; PG8_WAIT_L(0); PG8_MMA(1, 0, At, B0); PG8_BAR; PG8_SCHED;
            PG8_STAGE(PG8_SB(1, 1), b3 + hstep, voffB);
            PG8_WAIT_V(6); PG8_BAR; PG8_MMA(1, 1, At, B1); PG8_BAR;
        }
        E(acc, cur, wr, wc, fr, fq);
        if (!has_next) break;
#pragma unroll
        for (int a = 0; a < 2; ++a)
#pragma unroll
            for (int b = 0; b < 2; ++b)
#pragma unroll
                for (int m = 0; m < 4; ++m)
#pragma unroll
                    for (int n = 0; n < 2; ++n) acc[a][b][m][n] = (f32x4){0.f, 0.f, 0.f, 0.f};
        cur = nxt; cA = nA; cB = nB; ++ui;
    }
    PG8_WAIT_V(0);
    if (wr == 0) PG8_BAR;
    PG8_BAR;
#undef PG8_SA
#undef PG8_SB
#undef PG8_STAGE
#undef PG8_LDA
#undef PG8_LDB
#undef PG8_MMA
#undef PG8_WAIT_V
#undef PG8_WAIT_L
#undef PG8_BAR
#undef PG8_SCHED
}

struct EpiBf16 {
    static constexpr bool PERM = true;
    bf16_t* O; int ldc;
    __device__ __forceinline__ void operator()(const f32x4 (&acc)[2][2][4][2], const Unit& u, int wr, int wc, int fr, int fq) const {
        const int row0 = u.pm * BM + wr * 64 + fr, col0 = u.pn * BM + wc * 32 + 8 * fq;
#pragma unroll
        for (int ai = 0; ai < 2; ++ai)
#pragma unroll
            for (int m = 0; m < 4; ++m) { bf16_t* rowp = O + (size_t)(row0 + ai * HALF + m * 16) * ldc + col0;
#pragma unroll
                for (int bj = 0; bj < 2; ++bj) { const f32x4 v0 = acc[ai][bj][m][0], v1 = acc[ai][bj][m][1];
                    u32x4 w; w.x = cvt_pk_bf16_asm(v0[0], v0[1]); w.y = cvt_pk_bf16_asm(v0[2], v0[3]); w.z = cvt_pk_bf16_asm(v1[0], v1[1]); w.w = cvt_pk_bf16_asm(v1[2], v1[3]);
                    *(u32x4*)(rowp + bj * HALF) = w; } }
    }
};
struct EpiResF32 {
    static constexpr bool PERM = false;
    const float* X; float* O; int ldc;
    __device__ __forceinline__ void operator()(const f32x4 (&acc)[2][2][4][2], const Unit& u, int wr, int wc, int fr, int fq) const {
        const int row0 = u.pm * BM + wr * 64 + fr, col0 = u.pn * BM + wc * 32 + 4 * fq;
#pragma unroll
        for (int ai = 0; ai < 2; ++ai)
#pragma unroll
            for (int m = 0; m < 4; ++m) { const size_t ro = (size_t)(row0 + ai * HALF + m * 16) * ldc + col0;
#pragma unroll
                for (int bj = 0; bj < 2; ++bj)
#pragma unroll
                    for (int n = 0; n < 2; ++n) { const f32x4 xv = *(const f32x4*)(X + ro + bj * HALF + n * 16);
                        *(f32x4*)(O + ro + bj * HALF + n * 16) = xv * ALPHA + acc[ai][bj][m][n]; } }
    }
};
#define DPP_SHR1(x) __builtin_bit_cast(float, __builtin_amdgcn_update_dpp(0, __builtin_bit_cast(int, (x)), 0x111, 0xf, 0xf, true))
#define DPP_SHR2(x) __builtin_bit_cast(float, __builtin_amdgcn_update_dpp(0, __builtin_bit_cast(int, (x)), 0x112, 0xf, 0xf, true))
#define DPP_SHL15(o, x) __builtin_bit_cast(float, __builtin_amdgcn_update_dpp(__builtin_bit_cast(int, (o)), __builtin_bit_cast(int, (x)), 0x10F, 0xf, 0xf, false))
#define DPP_SHL14(o, x) __builtin_bit_cast(float, __builtin_amdgcn_update_dpp(__builtin_bit_cast(int, (o)), __builtin_bit_cast(int, (x)), 0x10E, 0xf, 0xf, false))
struct EpiConvFfn {
    static constexpr bool PERM = true;
    bf16_t* act; float* halo; const float* cw; const float* cb;
    __device__ __forceinline__ void operator()(const f32x4 (&acc)[2][2][4][2], const Unit& u, int wr, int wc, int fr, int fq) const {
        const int fcol = u.pn * 128 + wc * 32 + 8 * fq;
#pragma unroll
        for (int ai = 0; ai < 2; ++ai) {
            float* hb = halo + (size_t)((u.pm * BM + ai * HALF + wr * 64) >> 6) * 4 * NUP + fcol;
            if (fr < 2) {
#pragma unroll
                for (int bj = 0; bj < 2; ++bj)
#pragma unroll
                    for (int n = 0; n < 2; ++n) *(f32x4*)(hb + (size_t)(2 + fr) * NUP + bj * DFF + 4 * n) = acc[ai][bj][0][n];
            }
            if (fr >= 14) {
#pragma unroll
                for (int bj = 0; bj < 2; ++bj)
#pragma unroll
                    for (int n = 0; n < 2; ++n) *(f32x4*)(hb + (size_t)(fr - 14) * NUP + bj * DFF + 4 * n) = acc[ai][bj][3][n];
            }
        }
        u32x2 pk0[2][4];
#pragma unroll
        for (int n = 0; n < 2; ++n) {
            f32x4 W0[2], W1[2], W2[2], Bb[2];
#pragma unroll
            for (int bj = 0; bj < 2; ++bj) { const int hc = bj * DFF + fcol + 4 * n;
                W0[bj] = *(const f32x4*)(cw + hc); W1[bj] = *(const f32x4*)(cw + NUP + hc); W2[bj] = *(const f32x4*)(cw + 2 * NUP + hc); Bb[bj] = *(const f32x4*)(cb + hc); }
#pragma unroll
            for (int ai = 0; ai < 2; ++ai) {
                const int rbase = u.pm * BM + ai * HALF + wr * 64;
#pragma unroll
                for (int m = 0; m < 4; ++m) {
                    float av[4];
#pragma unroll
                    for (int j = 0; j < 4; ++j) {
                        float hc[2];
#pragma unroll
                        for (int bj = 0; bj < 2; ++bj) {
                            const float cur = acc[ai][bj][m][n][j];
                            float p1 = DPP_SHR1(cur), p2 = DPP_SHR2(cur);
                            if (m > 0) { const float pv = acc[ai][bj][m > 0 ? m - 1 : 0][n][j]; p1 = DPP_SHL15(p1, pv); p2 = DPP_SHL14(p2, pv); }
                            hc[bj] = W2[bj][j] * cur + W1[bj][j] * p1 + W0[bj][j] * p2 + Bb[bj][j];
                        }
                        const float gt = hc[1];
                        av[j] = hc[0] * gt * __builtin_amdgcn_rcpf(1.0f + __expf(-gt));
                    }
                    u32x2 pk; pk.x = cvt_pk_bf16_asm(av[0], av[1]); pk.y = cvt_pk_bf16_asm(av[2], av[3]);
                    if (n == 0) pk0[ai][m] = pk;
                    else if (m > 0 || fr >= 2) { u32x4 w; w.x = pk0[ai][m].x; w.y = pk0[ai][m].y; w.z = pk.x; w.w = pk.y;
                        *(u32x4*)(act + (size_t)(rbase + m * 16 + fr) * DFF + fcol) = w; }
                }
            }
            asm volatile("" ::: "memory");
        }
    }
};
}

__device__ __forceinline__ void transpose_tile(const float* W, int ldw, int k0, int n0, bf16_t* Wt, int ldt, int nrow0, unsigned char* lds) {
    bf16_t* sT = (bf16_t*)lds; const int tid = threadIdx.x;
#pragma unroll
    for (int i = 0; i < 2; ++i) { const int k = (tid >> 4) + 32 * i, n4 = (tid & 15) * 4;
        const float4 v = *(const float4*)(W + (size_t)(k0 + k) * ldw + n0 + n4);
        sT[(n4 + 0) * 66 + k] = f2bf(v.x); sT[(n4 + 1) * 66 + k] = f2bf(v.y); sT[(n4 + 2) * 66 + k] = f2bf(v.z); sT[(n4 + 3) * 66 + k] = f2bf(v.w); }
    __syncthreads();
    { const int n = tid >> 3, ks = (tid & 7) * 8; const unsigned* p = (const unsigned*)(sT + n * 66 + ks);
      u32x4 o; o.x = p[0]; o.y = p[1]; o.z = p[2]; o.w = p[3];
      *(u32x4*)(Wt + (size_t)(nrow0 + n) * ldt + k0 + ks) = o; }
    __syncthreads();
}
__device__ __forceinline__ void phase_prologue(const Args& A, unsigned char* lds) {
    unsigned char* ws = A.ws;
    constexpr int T_IN = 32 * 112, T_OUT = 32 * 32, T_UP = 32 * 176, T_DN = 88 * 32;
    for (int g = blockIdx.x; g < T_IN + T_OUT + T_UP + T_DN; g += gridDim.x) {
        if (g < T_IN) { const int tk = g / 112, tn = g % 112; transpose_tile(A.w_in, NIN, tk * 64, tn * 64, (bf16_t*)(ws + WS_WIN), DM, tn * 64, lds); }
        else if (g < T_IN + T_OUT) { const int h = g - T_IN, tk = h / 32, tn = h % 32; transpose_tile(A.w_out, DM, tk * 64, tn * 64, (bf16_t*)(ws + WS_WOUT), DM, tn * 64, lds); }
        else if (g < T_IN + T_OUT + T_UP) { const int h = g - T_IN - T_OUT, tk = h / 176, tn = h % 176; const int n0 = tn * 64;
            const int f = (n0 < DFF) ? n0 : n0 - DFF; const int nrow0 = 256 * (f >> 7) + (f & 127) + ((n0 < DFF) ? 0 : 128);
            transpose_tile(A.w_up, NUP, tk * 64, n0, (bf16_t*)(ws + WS_WUP), DM, nrow0, lds); }
        else { const int h = g - T_IN - T_OUT - T_UP, tk = h / 32, tn = h % 32; transpose_tile(A.w_down, DM, tk * 64, tn * 64, (bf16_t*)(ws + WS_WDN), DFF, tn * 64, lds); }
    }
    const int lane = threadIdx.x & 63, gw = blockIdx.x * 8 + (threadIdx.x >> 6), nw = gridDim.x * 8;
    bf16_t* xb = (bf16_t*)(ws + WS_XB); float* gates = (float*)(ws + WS_GATES);
    for (int it = gw; it < MT / 4; it += nw) {
        const int r0 = it * 4;
        float acc[4][8];
#pragma unroll
        for (int r = 0; r < 4; ++r)
#pragma unroll
            for (int q = 0; q < 8; ++q) acc[r][q] = 0.f;
#pragma unroll 1
        for (int i = 0; i < 8; ++i) {
            const int kb = i * 256 + lane * 4;
            f32x4 xv[4];
#pragma unroll
            for (int r = 0; r < 4; ++r) { xv[r] = *(const f32x4*)(A.x + (size_t)(r0 + r) * DM + kb);
                u32x2 o; o.x = cvt_pk_bf16(xv[r][0], xv[r][1]); o.y = cvt_pk_bf16(xv[r][2], xv[r][3]); *(u32x2*)(xb + (size_t)(r0 + r) * DM + kb) = o; }
#pragma unroll
            for (int j = 0; j < 4; ++j) {
                const f32x4* wp = (const f32x4*)(A.w_in + (size_t)(kb + j) * NIN + NP);
                const f32x4 w0 = wp[0], w1 = wp[1];
#pragma unroll
                for (int r = 0; r < 4; ++r) { const float xs = xv[r][j];
                    acc[r][0] += xs * w0[0]; acc[r][1] += xs * w0[1]; acc[r][2] += xs * w0[2]; acc[r][3] += xs * w0[3];
                    acc[r][4] += xs * w1[0]; acc[r][5] += xs * w1[1]; acc[r][6] += xs * w1[2]; acc[r][7] += xs * w1[3]; }
            }
        }
#pragma unroll
        for (int r = 0; r < 4; ++r)
#pragma unroll
            for (int q = 0; q < 8; ++q) { float v = acc[r][q];
#pragma unroll
                for (int off = 32; off >= 1; off >>= 1) v += __shfl_xor(v, off);
                acc[r][q] = v; }
        if (lane == 0) {
            const f32x4 b0 = *(const f32x4*)(A.b_gates), b1 = *(const f32x4*)(A.b_gates + 4);
#pragma unroll
            for (int r = 0; r < 4; ++r) {
                *(f32x4*)(gates + (size_t)(r0 + r) * 8) = (f32x4){acc[r][0] + b0[0], acc[r][1] + b0[1], acc[r][2] + b0[2], acc[r][3] + b0[3]};
                *(f32x4*)(gates + (size_t)(r0 + r) * 8 + 4) = (f32x4){acc[r][4] + b1[0], acc[r][5] + b1[1], acc[r][6] + b1[2], acc[r][7] + b1[3]}; }
        }
    }
}

__device__ __forceinline__ void phase_yconv(const Args& A) {
    const bf16_t* proj = (const bf16_t*)(A.ws + WS_PROJ); bf16_t* y = (bf16_t*)(A.ws + WS_Y);
    for (int idx = blockIdx.x * 512 + threadIdx.x; idx < MT * 128; idx += gridDim.x * 512) {
        const int row = idx >> 7, c = (idx & 127) * 8, t = row & (SEQ - 1);
        const bf16_t* pr = proj + (size_t)row * NP + c;
        const u32x4 bv = *(const u32x4*)pr;
        float cv[8];
#pragma unroll
        for (int i = 0; i < 8; ++i) cv[i] = 0.f;
#pragma unroll
        for (int j = 0; j < 3; ++j) {
            const int dt = 2 - j;
            if (t - dt >= 0) {
                const u32x4 cc = *(const u32x4*)(pr - (size_t)dt * NP + WCONV), hh = *(const u32x4*)(pr - (size_t)dt * NP + 2 * WCONV);
                const f32x4 w0 = *(const f32x4*)(A.w_sc + j * WCONV + c), w1 = *(const f32x4*)(A.w_sc + j * WCONV + c + 4);
                const float wv[8] = {w0[0], w0[1], w0[2], w0[3], w1[0], w1[1], w1[2], w1[3]};
#pragma unroll
                for (int q = 0; q < 4; ++q) { cv[2 * q] += wv[2 * q] * bflo(cc[q]) * bflo(hh[q]); cv[2 * q + 1] += wv[2 * q + 1] * bfhi(cc[q]) * bfhi(hh[q]); }
            }
        }
        u32x4 o;
#pragma unroll
        for (int q = 0; q < 4; ++q) o[q] = cvt_pk_bf16(bflo(bv[q]) * cv[2 * q], bfhi(bv[q]) * cv[2 * q + 1]);
        *(u32x4*)(y + (size_t)row * DM + c) = o;
    }
}

__device__ __forceinline__ void phase_mlstm(const Args& A, unsigned char* lds, float* hbuf) {
    const int tid = threadIdx.x, lane = tid & 63, w = tid >> 6, g = lane >> 4, l15 = lane & 15;
    const int a = w >> 2, ti = w & 3;
    unsigned char* QS = lds; unsigned char* KS = lds + 33792; unsigned char* VT = lds + 67584; unsigned char* WVT = VT + 4608; unsigned char* CT = WVT + 4608; unsigned char* XCH = CT + 33792;
    const bf16_t* proj = (const bf16_t*)(A.ws + WS_PROJ); const float* gates = (const float*)(A.ws + WS_GATES);
    for (int item = blockIdx.x; item < 256; item += gridDim.x) {
        const int xcd = item & 7, idx = item >> 3; const int bh = xcd * 2 + (idx >> 4), es = idx & 15;
        const int b = bh >> 2, hh = bh & 3, e0 = es * 16;
        const size_t row0 = (size_t)b * SEQ;
        __syncthreads();
        for (int i = tid; i < 16896 / 4; i += 512) ((unsigned*)CT)[i] = 0u;
        for (int i = tid; i < 16 * 72; i += 512) { const int r = 16 + i / 72, ci = i % 72; ((bf16_t*)VT)[r * 72 + ci] = (r == 16) ? (bf16_t)0x3F80 : (bf16_t)0; ((bf16_t*)WVT)[r * 72 + ci] = 0; }
        f32x4 Cst[2][2];
#pragma unroll
        for (int x = 0; x < 2; ++x)
#pragma unroll
            for (int et = 0; et < 2; ++et) Cst[x][et] = (f32x4){0.f, 0.f, 0.f, 0.f};
        float m_state = 0.f;
        u32x4 qr[4], kr[4], vr = (u32x4){0u, 0u, 0u, 0u}; float gi, gf;
        const bf16_t* qbase = proj + row0 * NP + 3072 + hh * 256;
#define ML_LOAD(c) do { _Pragma("unroll") for (int i = 0; i < 4; ++i) { const int p = tid + 512 * i, r = p >> 5, c16 = p & 31; const bf16_t* rp = qbase + (size_t)((c) * 64 + r) * NP + c16 * 8; \
            qr[i] = *(const u32x4*)rp; kr[i] = *(const u32x4*)(rp + 1024); } \
            if (tid < 128) vr = *(const u32x4*)(qbase + (size_t)((c) * 64 + (tid >> 1)) * NP + 2048 + e0 + (tid & 1) * 8); \
            { const float* gp = gates + (row0 + (c) * 64 + lane) * 8 + hh; gi = gp[0]; gf = gp[4]; } } while (0)
        ML_LOAD(0);
#pragma unroll 1
        for (int c = 0; c < 32; ++c) {
            const float lf = fminf(gf, 0.f) - log1pf(__expf(-fabsf(gf)));
            float bc = lf;
#pragma unroll
            for (int off = 1; off < 64; off <<= 1) { const float t = __shfl_up(bc, off); if (lane >= off) bc += t; }
            const float uv = gi - bc;
            float cm = uv;
#pragma unroll
            for (int off = 1; off < 64; off <<= 1) { const float t = __shfl_up(cm, off); if (lane >= off) cm = fmaxf(cm, t); }
            const float g_tot = __shfl(bc, 63), cm63 = __shfl(cm, 63);
            const float Mv = fmaxf(m_state, cm), M63 = fmaxf(m_state, cm63);
            const float w_s = __expf(uv - M63), decay = __expf(m_state - M63);
            const float interw = __expf(m_state - Mv) * 0.0625f, floorv = __expf(-(bc + Mv));
            m_state = g_tot + M63;
#pragma unroll
            for (int i = 0; i < 4; ++i) { const int p = tid + 512 * i, r = p >> 5, c16 = p & 31; *(u32x4*)(QS + r * 528 + c16 * 16) = qr[i]; *(u32x4*)(KS + r * 528 + c16 * 16) = kr[i]; }
            { const float wv = __shfl(w_s, (tid >> 1) & 63);
              if (tid < 128) { const int s = tid >> 1, hf = tid & 1;
#pragma unroll
                  for (int q = 0; q < 4; ++q) { const float v0 = bflo(vr[q]), v1 = bfhi(vr[q]);
                      ((bf16_t*)VT)[(8 * hf + 2 * q) * 72 + s] = (bf16_t)(vr[q] & 0xffffu); ((bf16_t*)VT)[(8 * hf + 2 * q + 1) * 72 + s] = (bf16_t)(vr[q] >> 16);
                      ((bf16_t*)WVT)[(8 * hf + 2 * q) * 72 + s] = f2bf(v0 * wv); ((bf16_t*)WVT)[(8 * hf + 2 * q + 1) * 72 + s] = f2bf(v1 * wv); } }
              if (w == 2) ((bf16_t*)WVT)[16 * 72 + lane] = f2bf(w_s); }
            if (c + 1 < 32) ML_LOAD(c + 1);
            __syncthreads();
            bf16x8 qf[8]; f32x4 S0 = (f32x4){0.f, 0.f, 0.f, 0.f}, S1 = S0;
#pragma unroll
            for (int kk = 0; kk < 8; ++kk) {
                qf[kk] = *(const bf16x8*)(QS + (16 * ti + l15) * 528 + kk * 64 + g * 16);
                const bf16x8 kf0 = *(const bf16x8*)(KS + (32 * a + l15) * 528 + kk * 64 + g * 16), kf1 = *(const bf16x8*)(KS + (32 * a + 16 + l15) * 528 + kk * 64 + g * 16);
                S0 = __builtin_amdgcn_mfma_f32_16x16x32_bf16(kf0, qf[kk], S0, 0, 0, 0); S1 = __builtin_amdgcn_mfma_f32_16x16x32_bf16(kf1, qf[kk], S1, 0, 0, 0);
            }
            const int tcol = 16 * ti + l15;
            const float Mt = __shfl(Mv, tcol);
            float p[8];
#pragma unroll
            for (int r = 0; r < 4; ++r) { const int s0 = 32 * a + 4 * g + r, s1 = s0 + 16; const float u0 = __shfl(uv, s0), u1 = __shfl(uv, s1);
                p[r] = (s0 <= tcol) ? S0[r] * 0.0625f * __expf(u0 - Mt) : 0.f; p[4 + r] = (s1 <= tcol) ? S1[r] * 0.0625f * __expf(u1 - Mt) : 0.f; }
            u32x4 pau; pau.x = cvt_pk_bf16(p[0], p[1]); pau.y = cvt_pk_bf16(p[2], p[3]); pau.z = cvt_pk_bf16(p[4], p[5]); pau.w = cvt_pk_bf16(p[6], p[7]);
            const bf16x8 pa = __builtin_bit_cast(bf16x8, pau);
            f32x4 rr[2];
#pragma unroll
            for (int et = 0; et < 2; ++et) { const unsigned char* vp = VT + (16 * et + l15) * 144 + (32 * a + 4 * g) * 2;
                const u32x2 lo = *(const u32x2*)vp, hi = *(const u32x2*)(vp + 32);
                u32x4 vbu; vbu.x = lo.x; vbu.y = lo.y; vbu.z = hi.x; vbu.w = hi.y;
                rr[et] = __builtin_amdgcn_mfma_f32_16x16x32_bf16(pa, __builtin_bit_cast(bf16x8, vbu), (f32x4){0.f, 0.f, 0.f, 0.f}, 0, 0, 0); }
            {
                const unsigned char* CTc = CT + (c & 1) * 16896;
                f32x4 in0 = (f32x4){0.f, 0.f, 0.f, 0.f}, in1 = in0;
#pragma unroll
                for (int k2 = 0; k2 < 4; ++k2) {
                    const bf16x8 qa = a ? qf[4 + k2] : qf[k2];
                    const bf16x8 c0 = *(const bf16x8*)(CTc + (l15) * 528 + (128 * a + 32 * k2 + 8 * g) * 2), c1 = *(const bf16x8*)(CTc + (16 + l15) * 528 + (128 * a + 32 * k2 + 8 * g) * 2);
                    in0 = __builtin_amdgcn_mfma_f32_16x16x32_bf16(qa, c0, in0, 0, 0, 0); in1 = __builtin_amdgcn_mfma_f32_16x16x32_bf16(qa, c1, in1, 0, 0, 0);
                }
#pragma unroll
                for (int r = 0; r < 4; ++r) { const float iw = __shfl(interw, 16 * ti + 4 * g + r); rr[0][r] += in0[r] * iw; rr[1][r] += in1[r] * iw; }
            }
            if (a == 1) { *(f32x4*)(XCH + ((ti * 2 + 0) * 64 + lane) * 16) = rr[0]; *(f32x4*)(XCH + ((ti * 2 + 1) * 64 + lane) * 16) = rr[1]; }
            {
                unsigned char* CTn = CT + ((c + 1) & 1) * 16896;
#pragma unroll
                for (int x = 0; x < 2; ++x) {
                    const int dt = 2 * w + x;
#pragma unroll
                    for (int et = 0; et < 2; ++et) Cst[x][et] *= decay;
#pragma unroll
                    for (int ks = 0; ks < 2; ++ks) {
                        bf16x8 ka;
#pragma unroll
                        for (int jj = 0; jj < 8; ++jj) ka[jj] = (short)*(const bf16_t*)(KS + (32 * ks + 8 * g + jj) * 528 + (16 * dt + l15) * 2);
#pragma unroll
                        for (int et = 0; et < 2; ++et) { const bf16x8 wvb = *(const bf16x8*)(WVT + (16 * et + l15) * 144 + (32 * ks + 8 * g) * 2);
                            Cst[x][et] = __builtin_amdgcn_mfma_f32_16x16x32_bf16(ka, wvb, Cst[x][et], 0, 0, 0); }
                    }
#pragma unroll
                    for (int et = 0; et < 2; ++et) { u32x2 o; o.x = cvt_pk_bf16(Cst[x][et][0], Cst[x][et][1]); o.y = cvt_pk_bf16(Cst[x][et][2], Cst[x][et][3]);
                        *(u32x2*)(CTn + (16 * et + l15) * 528 + (16 * dt + 4 * g) * 2) = o; }
                }
            }
            __syncthreads();
            if (a == 0) {
                const f32x4 o0 = *(const f32x4*)(XCH + ((ti * 2 + 0) * 64 + lane) * 16), o1 = *(const f32x4*)(XCH + ((ti * 2 + 1) * 64 + lane) * 16);
#pragma unroll
                for (int r = 0; r < 4; ++r) {
                    const float den = __shfl(rr[1][r] + o1[r], lane & 48), fl = __shfl(floorv, 16 * ti + 4 * g + r);
                    const float hv = (rr[0][r] + o0[r]) / fmaxf(fabsf(den), fl);
                    hbuf[(row0 + c * 64 + 16 * ti + 4 * g + r) * 1024 + hh * 256 + e0 + l15] = hv;
                }
            }
        }
#undef ML_LOAD
    }
}

__device__ __forceinline__ void phase_headnorm(const Args& A, const float* hbuf) {
    const bf16_t* proj = (const bf16_t*)(A.ws + WS_PROJ); bf16_t* y = (bf16_t*)(A.ws + WS_Y);
    const int lane = threadIdx.x & 63, gw = blockIdx.x * 8 + (threadIdx.x >> 6), nw = gridDim.x * 8;
    for (int it = gw; it < MT * 4; it += nw) {
        const int row = it >> 2, hh = it & 3;
        const f32x4 hv = *(const f32x4*)(hbuf + (size_t)row * 1024 + hh * 256 + lane * 4);
        float s = (hv[0] + hv[1]) + (hv[2] + hv[3]);
#pragma unroll
        for (int off = 32; off >= 1; off >>= 1) s += __shfl_xor(s, off);
        const float mu = s * (1.0f / 256.0f);
        const f32x4 d = hv - mu;
        float q = (d[0] * d[0] + d[1] * d[1]) + (d[2] * d[2] + d[3] * d[3]);
#pragma unroll
        for (int off = 32; off >= 1; off >>= 1) q += __shfl_xor(q, off);
        const float rstd = rsqrtf(q * (1.0f / 256.0f) + 1e-6f);
        const f32x4 gn = *(const f32x4*)(A.mh_gain + hh * 256 + lane * 4);
        const u32x2 ov = *(const u32x2*)(proj + (size_t)row * NP + 6144 + hh * 256 + lane * 4);
        const float o0 = bflo(ov.x), o1 = bfhi(ov.x), o2 = bflo(ov.y), o3 = bfhi(ov.y);
        const float y0 = d[0] * rstd * gn[0] / (1.0f + __expf(-o0)), y1 = d[1] * rstd * gn[1] / (1.0f + __expf(-o1));
        const float y2 = d[2] * rstd * gn[2] / (1.0f + __expf(-o2)), y3 = d[3] * rstd * gn[3] / (1.0f + __expf(-o3));
        u32x2 o; o.x = cvt_pk_bf16(y0, y1); o.y = cvt_pk_bf16(y2, y3);
        *(u32x2*)(y + (size_t)row * DM + WCONV + hh * 256 + lane * 4) = o;
    }
}

__device__ __forceinline__ void phase_ln(float* io, const float* gam, const float* bet, bf16_t* ob) {
    const int lane = threadIdx.x & 63, gw = blockIdx.x * 8 + (threadIdx.x >> 6), nw = gridDim.x * 8;
    for (int row = gw; row < MT; row += nw) {
        float* rp = io + (size_t)row * DM;
        f32x4 v[8]; float s = 0.f;
#pragma unroll
        for (int i = 0; i < 8; ++i) { v[i] = *(const f32x4*)(rp + i * 256 + lane * 4); s += (v[i][0] + v[i][1]) + (v[i][2] + v[i][3]); }
#pragma unroll
        for (int off = 32; off >= 1; off >>= 1) s += __shfl_xor(s, off);
        const float mu = s * (1.0f / DM);
        float q = 0.f;
#pragma unroll
        for (int i = 0; i < 8; ++i) { v[i] = v[i] - mu; q += (v[i][0] * v[i][0] + v[i][1] * v[i][1]) + (v[i][2] * v[i][2] + v[i][3] * v[i][3]); }
#pragma unroll
        for (int off = 32; off >= 1; off >>= 1) q += __shfl_xor(q, off);
        const float rstd = rsqrtf(q * (1.0f / DM) + 1e-5f);
#pragma unroll
        for (int i = 0; i < 8; ++i) { const f32x4 gg = *(const f32x4*)(gam + i * 256 + lane * 4), bb = *(const f32x4*)(bet + i * 256 + lane * 4);
            const f32x4 o = v[i] * rstd * gg + bb;
            *(f32x4*)(rp + i * 256 + lane * 4) = o;
            if (ob) { u32x2 p; p.x = cvt_pk_bf16(o[0], o[1]); p.y = cvt_pk_bf16(o[2], o[3]); *(u32x2*)(ob + (size_t)row * DM + i * 256 + lane * 4) = p; } }
    }
}

__device__ __forceinline__ void phase_fixup(const Args& A) {
    const float* halo = (const float*)(A.ws + WS_HALO); bf16_t* act = (bf16_t*)(A.ws + WS_ACT);
    for (int idx = blockIdx.x * 512 + threadIdx.x; idx < 128 * 2 * (DFF / 4); idx += gridDim.x * 512) {
        const int f = (idx % (DFF / 4)) * 4, br = idx / (DFF / 4), rr = br & 1, B = br >> 1;
        const bool first = (B & 31) == 0;
        const float* hc = halo + (size_t)B * 4 * NUP; const float* hp = hc - 4 * NUP;
        f32x4 hv[2];
#pragma unroll
        for (int bj = 0; bj < 2; ++bj) {
            const int col = bj * DFF + f;
            const f32x4 cur = *(const f32x4*)(hc + (size_t)(2 + rr) * NUP + col);
            f32x4 p1, p2; const f32x4 z = (f32x4){0.f, 0.f, 0.f, 0.f};
            if (rr == 0) { p1 = first ? z : *(const f32x4*)(hp + (size_t)1 * NUP + col); p2 = first ? z : *(const f32x4*)(hp + col); }
            else { p1 = *(const f32x4*)(hc + (size_t)2 * NUP + col); p2 = first ? z : *(const f32x4*)(hp + (size_t)1 * NUP + col); }
            const f32x4 w0 = *(const f32x4*)(A.w_fc + col), w1 = *(const f32x4*)(A.w_fc + NUP + col), w2 = *(const f32x4*)(A.w_fc + 2 * NUP + col), bb = *(const f32x4*)(A.b_fc + col);
            hv[bj] = w2 * cur + w1 * p1 + w0 * p2 + bb;
        }
        float av[4];
#pragma unroll
        for (int j = 0; j < 4; ++j) { const float gt = hv[1][j]; av[j] = hv[0][j] * gt / (1.0f + __expf(-gt)); }
        u32x2 o; o.x = cvt_pk_bf16(av[0], av[1]); o.y = cvt_pk_bf16(av[2], av[3]);
        *(u32x2*)(act + (size_t)(B * 64 + rr) * DFF + f) = o;
    }
}

__device__ __forceinline__ void phase_dump(const bf16_t* src, int ld, int c0, float* out) {
    for (size_t idx = (size_t)blockIdx.x * 512 + threadIdx.x; idx < (size_t)MT * DM; idx += (size_t)gridDim.x * 512) {
        const size_t row = idx / DM, col = idx % DM; out[idx] = bflo((unsigned)src[row * ld + c0 + col]); }
}
#ifndef DBG_STOP
#define DBG_STOP -1
#endif
constexpr int N_PHASES = 10;
#ifndef ONLY_PH
#define ONLY_PH -1
#endif
#define PH_ON(x) (ONLY_PH < 0 || ONLY_PH == (x))
__global__ void __launch_bounds__(512, 2) mega(Args a) {
    extern __shared__ __attribute__((aligned(16))) unsigned char lds[];
    cg::grid_group grid = cg::this_grid();
    unsigned char* ws = a.ws;
#define PH_RUN(x) (PH_ON(x) && a.ph_lo <= (x) && (x) < a.ph_hi)
#define PH_SYNC(x) do { if (a.ph_lo <= (x) && (x) + 1 < a.ph_hi) grid.sync(); } while (0)
    if (PH_RUN(0)) phase_prologue(a, lds);
    PH_SYNC(0);
    if (PH_RUN(1)) { pg8::Gemm g{(const bf16_t*)(ws + WS_XB), (const bf16_t*)(ws + WS_WIN), MT, NP, DM}; pg8::StaticOrder S; S.init(MT, NP, gridDim.x, blockIdx.x);
        pg8::EpiBf16 E{(bf16_t*)(ws + WS_PROJ), NP}; pg8::gemm_phase((LAS unsigned char*)lds, g, S, E); }
    PH_SYNC(1);
    if (PH_RUN(2)) { phase_yconv(a); phase_mlstm(a, lds, a.out); }
    PH_SYNC(2);
    if (PH_RUN(3)) phase_headnorm(a, a.out);
    PH_SYNC(3);
    if (PH_RUN(4)) { pg8::Gemm g{(const bf16_t*)(ws + WS_Y), (const bf16_t*)(ws + WS_WOUT), MT, DM, DM}; pg8::StaticOrder S; S.init(MT, DM, gridDim.x, blockIdx.x);
        pg8::EpiResF32 E{a.x, a.out, DM}; pg8::gemm_phase((LAS unsigned char*)lds, g, S, E); }
    PH_SYNC(4);
    if (PH_RUN(5)) phase_ln(a.out, a.ln1_g, a.ln1_b, (bf16_t*)(ws + WS_X1B));
    PH_SYNC(5);
    if (PH_RUN(6)) { pg8::Gemm g{(const bf16_t*)(ws + WS_X1B), (const bf16_t*)(ws + WS_WUP), MT, NUP, DM}; pg8::StaticOrder S; S.init(MT, NUP, gridDim.x, blockIdx.x);
        pg8::EpiConvFfn E{(bf16_t*)(ws + WS_ACT), (float*)(ws + WS_HALO), a.w_fc, a.b_fc}; pg8::gemm_phase((LAS unsigned char*)lds, g, S, E); }
    PH_SYNC(6);
    if (PH_RUN(7)) phase_fixup(a);
    PH_SYNC(7);
    if (PH_RUN(8)) { pg8::Gemm g{(const bf16_t*)(ws + WS_ACT), (const bf16_t*)(ws + WS_WDN), MT, DM, DFF}; pg8::StaticOrder S; S.init(MT, DM, gridDim.x, blockIdx.x);
        pg8::EpiResF32 E{a.out, a.out, DM}; pg8::gemm_phase((LAS unsigned char*)lds, g, S, E); }
    PH_SYNC(8);
    if (PH_RUN(9)) phase_ln(a.out, a.ln2_g, a.ln2_b, nullptr);
    if (DBG_STOP == 1 && a.ph_lo == 101) phase_dump((const bf16_t*)(ws + WS_PROJ), NP, 3072, a.out);
    if (DBG_STOP == 3 && a.ph_lo == 103) phase_dump((const bf16_t*)(ws + WS_Y), DM, 0, a.out);
    if (DBG_STOP == 7 && a.ph_lo == 107) phase_dump((const bf16_t*)(ws + WS_ACT), DFF, 0, a.out);
}

extern "C" void kernel_launch(void* const* d_in, const int* in_sizes, int n_in, void* d_out, int out_size, void* d_ws, size_t ws_size, hipStream_t stream) {
    static int grid = 0;
    if (grid == 0) {
        if (n_in != 14 || ws_size < WS_END) { fprintf(stderr, "kernel_launch: unexpected n_in %d / ws_size %zu (need %zu)\n", n_in, ws_size, (size_t)WS_END); grid = -1; return; }
        int dev = 0, cus = 0, per_cu = 0;
        hipGetDevice(&dev); hipDeviceGetAttribute(&cus, hipDeviceAttributeMultiprocessorCount, dev);
        if (hipFuncSetAttribute((const void*)mega, hipFuncAttributeMaxDynamicSharedMemorySize, LDS_BYTES) != hipSuccess) { fprintf(stderr, "kernel_launch: hipFuncSetAttribute failed\n"); grid = -1; return; }
        if (hipOccupancyMaxActiveBlocksPerMultiprocessor(&per_cu, (const void*)mega, 512, LDS_BYTES) != hipSuccess || per_cu < 1) { fprintf(stderr, "kernel_launch: occupancy query failed (%d)\n", per_cu); (void)hipGetLastError(); per_cu = 1; }
        grid = cus * 1;
        fprintf(stderr, "kernel_launch: cus %d per_cu %d grid %d\n", cus, per_cu, grid);
    }
    if (grid < 0) return;
    Args a{};
    a.x = (const float*)d_in[0]; a.w_in = (const float*)d_in[1]; a.b_gates = (const float*)d_in[2]; a.w_sc = (const float*)d_in[3]; a.mh_gain = (const float*)d_in[4]; a.w_out = (const float*)d_in[5];
    a.ln1_g = (const float*)d_in[6]; a.ln1_b = (const float*)d_in[7]; a.w_up = (const float*)d_in[8]; a.w_fc = (const float*)d_in[9]; a.b_fc = (const float*)d_in[10]; a.w_down = (const float*)d_in[11];
    a.ln2_g = (const float*)d_in[12]; a.ln2_b = (const float*)d_in[13];
    a.out = (float*)d_out; a.ws = (unsigned char*)d_ws;
#if MK_SINGLE
    a.ph_lo = 0; a.ph_hi = N_PHASES;
    void* args[] = {&a};
    hipError_t e = hipLaunchCooperativeKernel((const void*)mega, dim3(grid), dim3(512), args, LDS_BYTES, stream);
    if (e != hipSuccess) fprintf(stderr, "cooperative launch failed: %s (grid %d)\n", hipGetErrorString(e), grid);
#else
    for (int ph = 0; ph < N_PHASES; ++ph) { if (DBG_STOP >= 0 && ph > DBG_STOP) break; a.ph_lo = ph; a.ph_hi = ph + 1; hipLaunchKernelGGL(mega, dim3(grid), dim3(512), LDS_BYTES, stream, a); }
    if (DBG_STOP >= 0) { a.ph_lo = 100 + DBG_STOP; a.ph_hi = 101 + DBG_STOP; hipLaunchKernelGGL(mega, dim3(grid), dim3(512), LDS_BYTES, stream, a); }
#endif
}
```

```cpp
#include <hip/hip_runtime.h>
#include <hip/hip_cooperative_groups.h>
#include <cstdio>
#include <cstdint>
namespace cg = cooperative_groups;

#ifndef MK_SINGLE
#define MK_SINGLE 1
#endif

#define LAS __attribute__((address_space(3)))
typedef unsigned short bf16_t;
typedef short bf16x8 __attribute__((ext_vector_type(8)));
typedef float f32x4 __attribute__((ext_vector_type(4)));
typedef unsigned u32x4 __attribute__((ext_vector_type(4)));
typedef unsigned u32x2 __attribute__((ext_vector_type(2)));

constexpr int MT = 8192, DM = 2048, SEQ = 2048, NIN = 7176, NP = 7168, DFF = 5632, NUP = 11264, WCONV = 1024;
constexpr float ALPHA = 1.189207115002721f;
constexpr size_t WS_WIN = 0;
constexpr size_t WS_WOUT = WS_WIN + (size_t)NP * DM * 2;
constexpr size_t WS_WUP = WS_WOUT + (size_t)DM * DM * 2;
constexpr size_t WS_WDN = WS_WUP + (size_t)NUP * DM * 2;
constexpr size_t WS_X1B = WS_WDN + (size_t)DM * DFF * 2;
constexpr size_t WS_GATES = WS_X1B + (size_t)MT * DM * 2;
constexpr size_t WS_C = WS_GATES + (size_t)MT * 8 * 4;
constexpr size_t WS_PROJ = WS_C;
constexpr size_t WS_Y = WS_PROJ + (size_t)MT * NP * 2;
constexpr size_t WS_XB = WS_Y + (size_t)MT * DM * 2;
constexpr size_t WS_ACT = WS_C;
constexpr size_t WS_HALO = WS_ACT + (size_t)MT * DFF * 2;
constexpr size_t WS_BAR = WS_XB + (size_t)MT * DM * 2;
constexpr size_t WS_END = WS_BAR + 16384;
constexpr int LDS_BYTES = 131072 + 16;

struct Args {
    const float* x; const float* w_in; const float* b_gates; const float* w_sc; const float* mh_gain; const float* w_out;
    const float* ln1_g; const float* ln1_b; const float* w_up; const float* w_fc; const float* b_fc; const float* w_down;
    const float* ln2_g; const float* ln2_b;
    float* out; unsigned char* ws; int ph_lo, ph_hi;
};

typedef __bf16 bf16v2 __attribute__((ext_vector_type(2)));
typedef float f32x2 __attribute__((ext_vector_type(2)));
__device__ __forceinline__ unsigned cvt_pk_bf16(float lo, float hi) { const f32x2 v = {lo, hi}; const bf16v2 r = __builtin_convertvector(v, bf16v2); return __builtin_bit_cast(unsigned, r); }
__device__ __forceinline__ unsigned cvt_pk_bf16_asm(float lo, float hi) { unsigned r; asm volatile("v_cvt_pk_bf16_f32 %0, %1, %2" : "=v"(r) : "v"(lo), "v"(hi)); return r; }
__device__ __forceinline__ float bflo(unsigned u) { return __uint_as_float(u << 16); }
__device__ __forceinline__ float bfhi(unsigned u) { return __uint_as_float(u & 0xffff0000u); }
__device__ __forceinline__ bf16_t f2bf(float f) { unsigned u = __float_as_uint(f); u += 0x7FFFu + ((u >> 16) & 1u); return (bf16_t)(u >> 16); }

namespace pg8 {
constexpr int BM = 256, BK = 64, HALF = 128, HTB = HALF * BK * 2, STAGE_BYTES = 8 * HTB, NXCD = 8, WGM = 8;
__host__ __device__ __forceinline__ int lds_byte(int r, int c) { const int st = (r >> 4) * 2 + (c >> 5), rr = r & 15, cc = c & 31, ob = rr * 64 + cc * 2; return st * 1024 + (ob ^ (((ob >> 9) & 1) << 5)); }
__host__ __device__ __forceinline__ void stage_rc(int b, int& R, int& C) { const int st = b / 1024, sb = b % 1024, swz = sb ^ (((sb >> 9) & 1) << 5); R = (st >> 1) * 16 + swz / 64; C = (st & 1) * 32 + (swz % 64) / 2; }
__host__ __device__ __forceinline__ int perm32(int rho) { const int n = rho >> 4, i = rho & 15; return 8 * (i >> 2) + 4 * n + (i & 3); }
struct Unit { int pm, pn; };
struct Gemm { const bf16_t* A; const bf16_t* Bt; int M, N, K; };
struct StaticOrder {
    int nM, nN, nwg, G, c;
    __device__ void init(int M, int N, int G_, int c_) { nM = M / BM; nN = N / BM; nwg = nM * nN; G = G_; c = c_; }
    __device__ bool next(int i, Unit& u) const {
        const long L = (long)i * G + c; if (L >= nwg) return false;
        int wgid = (int)L; { const int q = nwg / NXCD, r = nwg % NXCD, xcd = wgid % NXCD, off = wgid / NXCD; wgid = (xcd < r ? xcd * (q + 1) : r * (q + 1) + (xcd - r) * q) + off; }
        const int nig = WGM * nN, gid = wgid / nig, fm = gid * WGM, gsz = (nM - fm) < WGM ? (nM - fm) : WGM;
        u.pm = fm + ((wgid % nig) % gsz); u.pn = (wgid % nig) / gsz; return true;
    }
};

template <class Epi>
__device__ __forceinline__ void gemm_phase(LAS unsigned char* lds, const Gemm g, const StaticOrder& S, const Epi& E) {
    const int tid = threadIdx.x, wid = __builtin_amdgcn_readfirstlane(tid >> 6), lane = tid & 63, wr = wid >> 2, wc = wid & 3, fr = lane & 15, fq = lane >> 4;
    const int K = g.K, nt = K / BK;
    unsigned voffA[2], voffB[2];
#pragma unroll
    for (int i = 0; i < 2; ++i) { int R, C; stage_rc(tid * 16 + i * 8192, R, C); const int Rb = Epi::PERM ? ((R & ~31) + perm32(R & 31)) : R;
        voffA[i] = (unsigned)(R * K + C) * 2u; voffB[i] = (unsigned)(Rb * K + C) * 2u; }
    const size_t kstep = (size_t)(BK * 2);
    const size_t hstep = (size_t)HALF * K * 2;
    const size_t tstep = 2 * hstep;
    const unsigned ldsw = (unsigned)wid * 1024u;
    const int aoff = lds_byte(wr * 64 + fr, fq * 8), boff = lds_byte(wc * 32 + fr, fq * 8);
#define PG8_SA(b, h) (((b) * 2 + (h)) * HTB)
#define PG8_SB(b, h) ((4 + (b) * 2 + (h)) * HTB)
#define PG8_STAGE(bufoff, gbase, voff) do { _Pragma("unroll") for (int _i = 0; _i < 2; ++_i) \
        __builtin_amdgcn_global_load_lds((const unsigned*)((const char*)(gbase) + (voff)[_i]), (LAS unsigned*)(lds + (bufoff) + ldsw + _i * 8192), 16, 0, 0); } while (0)
#define PG8_LDA(dst, b, h) do { _Pragma("unroll") for (int m = 0; m < 4; ++m) _Pragma("unroll") for (int k = 0; k < 2; ++k) dst[m][k] = *(const LAS bf16x8*)(lds + PG8_SA(b, h) + aoff + m * 2048 + k * 1024); } while (0)
#define PG8_LDB(dst, b, h) do { _Pragma("unroll") for (int n = 0; n < 2; ++n) _Pragma("unroll") for (int k = 0; k < 2; ++k) dst[n][k] = *(const LAS bf16x8*)(lds + PG8_SB(b, h) + boff + n * 2048 + k * 1024); } while (0)
#define PG8_MMA(ai, bj, At, Bt) do { __builtin_amdgcn_s_setprio(1); _Pragma("unroll") for (int m = 0; m < 4; ++m) _Pragma("unroll") for (int n = 0; n < 2; ++n) _Pragma("unroll") for (int k = 0; k < 2; ++k) \
        acc[ai][bj][m][n] = __builtin_amdgcn_mfma_f32_16x16x32_bf16(Bt[n][k], At[m][k], acc[ai][bj][m][n], 0, 0, 0); __builtin_amdgcn_s_setprio(0); } while (0)
#define PG8_WAIT_V(n) asm volatile("s_waitcnt vmcnt(" #n ")" ::: "memory")
#define PG8_WAIT_L(n) asm volatile("s_waitcnt lgkmcnt(" #n ")" ::: "memory")
#define PG8_BAR __builtin_amdgcn_s_barrier()
#define PG8_SCHED __builtin_amdgcn_sched_barrier(0)
    Unit cur, nxt; int ui = 0;
    if (!S.next(0, cur)) return;
    f32x4 acc[2][2][4][2];
#pragma unroll
    for (int a = 0; a < 2; ++a)
#pragma unroll
        for (int b = 0; b < 2; ++b)
#pragma unroll
            for (int m = 0; m < 4; ++m)
#pragma unroll
                for (int n = 0; n < 2; ++n) acc[a][b][m][n] = (f32x4){0.f, 0.f, 0.f, 0.f};
    bf16x8 At[4][2], B0[2][2], B1[2][2];
    const char* cA = (const char*)g.A + (size_t)cur.pm * tstep; const char* cB = (const char*)g.Bt + (size_t)cur.pn * tstep;
    PG8_STAGE(PG8_SB(0, 0), cB, voffB); PG8_STAGE(PG8_SA(0, 0), cA, voffA); PG8_STAGE(PG8_SB(0, 1), cB + hstep, voffB); PG8_STAGE(PG8_SA(0, 1), cA + hstep, voffA);
    if (wr == 1) PG8_BAR;
    PG8_WAIT_V(4); PG8_BAR;
    PG8_STAGE(PG8_SB(1, 0), cB + kstep, voffB); PG8_STAGE(PG8_SA(1, 0), cA + kstep, voffA); PG8_STAGE(PG8_SB(1, 1), cB + hstep + kstep, voffB);
    PG8_WAIT_V(6); PG8_BAR;
    for (;;) {
        const bool has_next = S.next(ui + 1, nxt);
        const char* nA = has_next ? (const char*)g.A + (size_t)nxt.pm * tstep : cA; const char* nB = has_next ? (const char*)g.Bt + (size_t)nxt.pn * tstep : cB;
        for (int t = 0; t < nt; t += 2) {
            const bool last = (t == nt - 2);
            const char* a1 = cA + (size_t)(t + 1) * kstep;
            const char* a2 = last ? nA : cA + (size_t)(t + 2) * kstep; const char* b2 = last ? nB : cB + (size_t)(t + 2) * kstep;
            const char* a3 = a2 + kstep; const char* b3 = b2 + kstep;
            PG8_LDB(B0, 0, 0); PG8_SCHED; PG8_LDA(At, 0, 0); PG8_STAGE(PG8_SA(1, 1), a1 + hstep, voffA);
            PG8_WAIT_L(8); PG8_BAR; PG8_WAIT_L(0); PG8_MMA(0, 0, At, B0); PG8_BAR; PG8_SCHED;
            PG8_LDB(B1, 0, 1); PG8_STAGE(PG8_SB(0, 0), b2, voffB);
            PG8_BAR; PG8_WAIT_L(0); PG8_MMA(0, 1, At, B1); PG8_BAR;
            PG8_LDA(At, 0, 1); PG8_STAGE(PG8_SA(0, 0), a2, voffA);
            PG8_BAR; PG8_WAIT_L(0); PG8_MMA(1, 0, At, B0); PG8_BAR; PG8_SCHED;
            PG8_STAGE(PG8_SB(0, 1), b2 + hstep, voffB);
            PG8_WAIT_V(6); PG8_BAR; PG8_MMA(1, 1, At, B1); PG8_BAR;
            PG8_LDB(B0, 1, 0); PG8_SCHED; PG8_LDA(At, 1, 0); PG8_STAGE(PG8_SA(0, 1), a2 + hstep, voffA);
            PG8_WAIT_L(8); PG8_BAR; PG8_WAIT_L(0); PG8_MMA(0, 0, At, B0); PG8_BAR; PG8_SCHED;
            PG8_LDB(B1, 1, 1); PG8_STAGE(PG8_SB(1, 0), b3, voffB);
            PG8_BAR; PG8_WAIT_L(0); PG8_MMA(0, 1, At, B1); PG8_BAR;
            PG8_LDA(At, 1, 1); PG8_STAGE(PG8_SA(1, 0), a3, voffA);
            PG8_BAR; PG8_WAIT_L(0); PG8_MMA(1, 0, At, B0); PG8_BAR; PG8_SCHED;
            PG8_STAGE(PG8_SB(1, 1), b3 + hstep, voffB);
            PG8_WAIT_V(6); PG8_BAR; PG8_MMA(1, 1, At, B1); PG8_BAR;
        }
        E(acc, cur, wr, wc, fr, fq);
        if (!has_next) break;
#pragma unroll
        for (int a = 0; a < 2; ++a)
#pragma unroll
            for (int b = 0; b < 2; ++b)
#pragma unroll
                for (int m = 0; m < 4; ++m)
#pragma unroll
                    for (int n = 0; n < 2; ++n) acc[a][b][m][n] = (f32x4){0.f, 0.f, 0.f, 0.f};
        cur = nxt; cA = nA; cB = nB; ++ui;
    }
    PG8_WAIT_V(0);
    if (wr == 0) PG8_BAR;
    PG8_BAR;
#undef PG8_SA
#undef PG8_SB
#undef PG8_STAGE
#undef PG8_LDA
#undef PG8_LDB
#undef PG8_MMA
#undef PG8_WAIT_V
#undef PG8_WAIT_L
#undef PG8_BAR
#undef PG8_SCHED
}

struct EpiBf16 {
    static constexpr bool PERM = true;
    bf16_t* O; int ldc;
    __device__ __forceinline__ void operator()(const f32x4 (&acc)[2][2][4][2], const Unit& u, int wr, int wc, int fr, int fq) const {
        const int row0 = u.pm * BM + wr * 64 + fr, col0 = u.pn * BM + wc * 32 + 8 * fq;
#pragma unroll
        for (int ai = 0; ai < 2; ++ai)
#pragma unroll
            for (int m = 0; m < 4; ++m) { bf16_t* rowp = O + (size_t)(row0 + ai * HALF + m * 16) * ldc + col0;
#pragma unroll
                for (int bj = 0; bj < 2; ++bj) { const f32x4 v0 = acc[ai][bj][m][0], v1 = acc[ai][bj][m][1];
                    u32x4 w; w.x = cvt_pk_bf16_asm(v0[0], v0[1]); w.y = cvt_pk_bf16_asm(v0[2], v0[3]); w.z = cvt_pk_bf16_asm(v1[0], v1[1]); w.w = cvt_pk_bf16_asm(v1[2], v1[3]);
                    *(u32x4*)(rowp + bj * HALF) = w; } }
    }
};
struct EpiResF32 {
    static constexpr bool PERM = false;
    const float* X; float* O; int ldc;
    __device__ __forceinline__ void operator()(const f32x4 (&acc)[2][2][4][2], const Unit& u, int wr, int wc, int fr, int fq) const {
        const int row0 = u.pm * BM + wr * 64 + fr, col0 = u.pn * BM + wc * 32 + 4 * fq;
#pragma unroll
        for (int ai = 0; ai < 2; ++ai)
#pragma unroll
            for (int m = 0; m < 4; ++m) { const size_t ro = (size_t)(row0 + ai * HALF + m * 16) * ldc + col0;
#pragma unroll
                for (int bj = 0; bj < 2; ++bj)
#pragma unroll
                    for (int n = 0; n < 2; ++n) { const f32x4 xv = *(const f32x4*)(X + ro + bj * HALF + n * 16);
                        *(f32x4*)(O + ro + bj * HALF + n * 16) = xv * ALPHA + acc[ai][bj][m][n]; } }
    }
};
#define DPP_SHR1(x) __builtin_bit_cast(float, __builtin_amdgcn_update_dpp(0, __builtin_bit_cast(int, (x)), 0x111, 0xf, 0xf, true))
#define DPP_SHR2(x) __builtin_bit_cast(float, __builtin_amdgcn_update_dpp(0, __builtin_bit_cast(int, (x)), 0x112, 0xf, 0xf, true))
#define DPP_SHL15(o, x) __builtin_bit_cast(float, __builtin_amdgcn_update_dpp(__builtin_bit_cast(int, (o)), __builtin_bit_cast(int, (x)), 0x10F, 0xf, 0xf, false))
#define DPP_SHL14(o, x) __builtin_bit_cast(float, __builtin_amdgcn_update_dpp(__builtin_bit_cast(int, (o)), __builtin_bit_cast(int, (x)), 0x10E, 0xf, 0xf, false))
struct EpiConvFfn {
    static constexpr bool PERM = true;
    bf16_t* act; float* halo; const float* cw; const float* cb;
    __device__ __forceinline__ void operator()(const f32x4 (&acc)[2][2][4][2], const Unit& u, int wr, int wc, int fr, int fq) const {
        const int fcol = u.pn * 128 + wc * 32 + 8 * fq;
#pragma unroll
        for (int ai = 0; ai < 2; ++ai) {
            float* hb = halo + (size_t)((u.pm * BM + ai * HALF + wr * 64) >> 6) * 4 * NUP + fcol;
            if (fr < 2) {
#pragma unroll
                for (int bj = 0; bj < 2; ++bj)
#pragma unroll
                    for (int n = 0; n < 2; ++n) *(f32x4*)(hb + (size_t)(2 + fr) * NUP + bj * DFF + 4 * n) = acc[ai][bj][0][n];
            }
            if (fr >= 14) {
#pragma unroll
                for (int bj = 0; bj < 2; ++bj)
#pragma unroll
                    for (int n = 0; n < 2; ++n) *(f32x4*)(hb + (size_t)(fr - 14) * NUP + bj * DFF + 4 * n) = acc[ai][bj][3][n];
            }
        }
        u32x2 pk0[2][4];
#pragma unroll
        for (int n = 0; n < 2; ++n) {
            f32x4 W0[2], W1[2], W2[2], Bb[2];
#pragma unroll
            for (int bj = 0; bj < 2; ++bj) { const int hc = bj * DFF + fcol + 4 * n;
                W0[bj] = *(const f32x4*)(cw + hc); W1[bj] = *(const f32x4*)(cw + NUP + hc); W2[bj] = *(const f32x4*)(cw + 2 * NUP + hc); Bb[bj] = *(const f32x4*)(cb + hc); }
#pragma unroll
            for (int ai = 0; ai < 2; ++ai) {
                const int rbase = u.pm * BM + ai * HALF + wr * 64;
#pragma unroll
                for (int m = 0; m < 4; ++m) {
                    float av[4];
#pragma unroll
                    for (int j = 0; j < 4; ++j) {
                        float hc[2];
#pragma unroll
                        for (int bj = 0; bj < 2; ++bj) {
                            const float cur = acc[ai][bj][m][n][j];
                            float p1 = DPP_SHR1(cur), p2 = DPP_SHR2(cur);
                            if (m > 0) { const float pv = acc[ai][bj][m > 0 ? m - 1 : 0][n][j]; p1 = DPP_SHL15(p1, pv); p2 = DPP_SHL14(p2, pv); }
                            hc[bj] = W2[bj][j] * cur + W1[bj][j] * p1 + W0[bj][j] * p2 + Bb[bj][j];
                        }
                        const float gt = hc[1];
                        av[j] = hc[0] * gt * __builtin_amdgcn_rcpf(1.0f + __expf(-gt));
                    }
                    u32x2 pk; pk.x = cvt_pk_bf16_asm(av[0], av[1]); pk.y = cvt_pk_bf16_asm(av[2], av[3]);
                    if (n == 0) pk0[ai][m] = pk;
                    else if (m > 0 || fr >= 2) { u32x4 w; w.x = pk0[ai][m].x; w.y = pk0[ai][m].y; w.z = pk.x; w.w = pk.y;
                        *(u32x4*)(act + (size_t)(rbase + m * 16 + fr) * DFF + fcol) = w; }
                }
            }
            asm volatile("" ::: "memory");
        }
    }
};
}

__device__ __forceinline__ void transpose_tile(const float* W, int ldw, int k0, int n0, bf16_t* Wt, int ldt, int nrow0, unsigned char* lds) {
    bf16_t* sT = (bf16_t*)lds; const int tid = threadIdx.x;
#pragma unroll
    for (int i = 0; i < 2; ++i) { const int k = (tid >> 4) + 32 * i, n4 = (tid & 15) * 4;
        const float4 v = *(const float4*)(W + (size_t)(k0 + k) * ldw + n0 + n4);
        sT[(n4 + 0) * 66 + k] = f2bf(v.x); sT[(n4 + 1) * 66 + k] = f2bf(v.y); sT[(n4 + 2) * 66 + k] = f2bf(v.z); sT[(n4 + 3) * 66 + k] = f2bf(v.w); }
    __syncthreads();
    { const int n = tid >> 3, ks = (tid & 7) * 8; const unsigned* p = (const unsigned*)(sT + n * 66 + ks);
      u32x4 o; o.x = p[0]; o.y = p[1]; o.z = p[2]; o.w = p[3];
      *(u32x4*)(Wt + (size_t)(nrow0 + n) * ldt + k0 + ks) = o; }
    __syncthreads();
}
__device__ __forceinline__ void phase_prologue(const Args& A, unsigned char* lds) {
    unsigned char* ws = A.ws;
    constexpr int T_IN = 32 * 112, T_OUT = 32 * 32, T_UP = 32 * 176, T_DN = 88 * 32;
    for (int g = blockIdx.x; g < T_IN + T_OUT + T_UP + T_DN; g += gridDim.x) {
        if (g < T_IN) { const int tk = g / 112, tn = g % 112; transpose_tile(A.w_in, NIN, tk * 64, tn * 64, (bf16_t*)(ws + WS_WIN), DM, tn * 64, lds); }
        else if (g < T_IN + T_OUT) { const int h = g - T_IN, tk = h / 32, tn = h % 32; transpose_tile(A.w_out, DM, tk * 64, tn * 64, (bf16_t*)(ws + WS_WOUT), DM, tn * 64, lds); }
        else if (g < T_IN + T_OUT + T_UP) { const int h = g - T_IN - T_OUT, tk = h / 176, tn = h % 176; const int n0 = tn * 64;
            const int f = (n0 < DFF) ? n0 : n0 - DFF; const int nrow0 = 256 * (f >> 7) + (f & 127) + ((n0 < DFF) ? 0 : 128);
            transpose_tile(A.w_up, NUP, tk * 64, n0, (bf16_t*)(ws + WS_WUP), DM, nrow0, lds); }
        else { const int h = g - T_IN - T_OUT - T_UP, tk = h / 32, tn = h % 32; transpose_tile(A.w_down, DM, tk * 64, tn * 64, (bf16_t*)(ws + WS_WDN), DFF, tn * 64, lds); }
    }
    const int lane = threadIdx.x & 63, gw = blockIdx.x * 8 + (threadIdx.x >> 6), nw = gridDim.x * 8;
    bf16_t* xb = (bf16_t*)(ws + WS_XB); float* gates = (float*)(ws + WS_GATES);
    for (int it = gw; it < MT / 4; it += nw) {
        const int r0 = it * 4;
        float acc[4][8];
#pragma unroll
        for (int r = 0; r < 4; ++r)
#pragma unroll
            for (int q = 0; q < 8; ++q) acc[r][q] = 0.f;
#pragma unroll 1
        for (int i = 0; i < 8; ++i) {
            const int kb = i * 256 + lane * 4;
            f32x4 xv[4];
#pragma unroll
            for (int r = 0; r < 4; ++r) { xv[r] = *(const f32x4*)(A.x + (size_t)(r0 + r) * DM + kb);
                u32x2 o; o.x = cvt_pk_bf16(xv[r][0], xv[r][1]); o.y = cvt_pk_bf16(xv[r][2], xv[r][3]); *(u32x2*)(xb + (size_t)(r0 + r) * DM + kb) = o; }
#pragma unroll
            for (int j = 0; j < 4; ++j) {
                const f32x4* wp = (const f32x4*)(A.w_in + (size_t)(kb + j) * NIN + NP);
                const f32x4 w0 = wp[0], w1 = wp[1];
#pragma unroll
                for (int r = 0; r < 4; ++r) { const float xs = xv[r][j];
                    acc[r][0] += xs * w0[0]; acc[r][1] += xs * w0[1]; acc[r][2] += xs * w0[2]; acc[r][3] += xs * w0[3];
                    acc[r][4] += xs * w1[0]; acc[r][5] += xs * w1[1]; acc[r][6] += xs * w1[2]; acc[r][7] += xs * w1[3]; }
            }
        }
#pragma unroll
        for (int r = 0; r < 4; ++r)
#pragma unroll
            for (int q = 0; q < 8; ++q) { float v = acc[r][q];
#pragma unroll
                for (int off = 32; off >= 1; off >>= 1) v += __shfl_xor(v, off);
                acc[r][q] = v; }
        if (lane == 0) {
            const f32x4 b0 = *(const f32x4*)(A.b_gates), b1 = *(const f32x4*)(A.b_gates + 4);
#pragma unroll
            for (int r = 0; r < 4; ++r) {
                *(f32x4*)(gates + (size_t)(r0 + r) * 8) = (f32x4){acc[r][0] + b0[0], acc[r][1] + b0[1], acc[r][2] + b0[2], acc[r][3] + b0[3]};
                *(f32x4*)(gates + (size_t)(r0 + r) * 8 + 4) = (f32x4){acc[r][4] + b1[0], acc[r][5] + b1[1], acc[r][6] + b1[2], acc[r][7] + b1[3]}; }
        }
    }
}

__device__ __forceinline__ void phase_yconv(const Args& A) {
    const bf16_t* proj = (const bf16_t*)(A.ws + WS_PROJ); bf16_t* y = (bf16_t*)(A.ws + WS_Y);
    for (int idx = blockIdx.x * 512 + threadIdx.x; idx < MT * 128; idx += gridDim.x * 512) {
        const int row = idx >> 7, c = (idx & 127) * 8, t = row & (SEQ - 1);
        const bf16_t* pr = proj + (size_t)row * NP + c;
        const u32x4 bv = *(const u32x4*)pr;
        float cv[8];
#pragma unroll
        for (int i = 0; i < 8; ++i) cv[i] = 0.f;
#pragma unroll
        for (int j = 0; j < 3; ++j) {
            const int dt = 2 - j;
            if (t - dt >= 0) {
                const u32x4 cc = *(const u32x4*)(pr - (size_t)dt * NP + WCONV), hh = *(const u32x4*)(pr - (size_t)dt * NP + 2 * WCONV);
                const f32x4 w0 = *(const f32x4*)(A.w_sc + j * WCONV + c), w1 = *(const f32x4*)(A.w_sc + j * WCONV + c + 4);
                const float wv[8] = {w0[0], w0[1], w0[2], w0[3], w1[0], w1[1], w1[2], w1[3]};
#pragma unroll
                for (int q = 0; q < 4; ++q) { cv[2 * q] += wv[2 * q] * bflo(cc[q]) * bflo(hh[q]); cv[2 * q + 1] += wv[2 * q + 1] * bfhi(cc[q]) * bfhi(hh[q]); }
            }
        }
        u32x4 o;
#pragma unroll
        for (int q = 0; q < 4; ++q) o[q] = cvt_pk_bf16(bflo(bv[q]) * cv[2 * q], bfhi(bv[q]) * cv[2 * q + 1]);
        *(u32x4*)(y + (size_t)row * DM + c) = o;
    }
}

__device__ __forceinline__ void phase_mlstm(const Args& A, unsigned char* lds, float* hbuf) {
    const int tid = threadIdx.x, lane = tid & 63, w = tid >> 6, g = lane >> 4, l15 = lane & 15;
    const int a = w >> 2, ti = w & 3;
    unsigned char* QS = lds; unsigned char* KS = lds + 33792; unsigned char* VT = lds + 67584; unsigned char* WVT = VT + 4608; unsigned char* CT = WVT + 4608; unsigned char* XCH = CT + 33792;
    const bf16_t* proj = (const bf16_t*)(A.ws + WS_PROJ); const float* gates = (const float*)(A.ws + WS_GATES);
    for (int item = blockIdx.x; item < 256; item += gridDim.x) {
        const int xcd = item & 7, idx = item >> 3; const int bh = xcd * 2 + (idx >> 4), es = idx & 15;
        const int b = bh >> 2, hh = bh & 3, e0 = es * 16;
        const size_t row0 = (size_t)b * SEQ;
        __syncthreads();
        for (int i = tid; i < 16896 / 4; i += 512) ((unsigned*)CT)[i] = 0u;
        for (int i = tid; i < 16 * 72; i += 512) { const int r = 16 + i / 72, ci = i % 72; ((bf16_t*)VT)[r * 72 + ci] = (r == 16) ? (bf16_t)0x3F80 : (bf16_t)0; ((bf16_t*)WVT)[r * 72 + ci] = 0; }
        f32x4 Cst[2][2];
#pragma unroll
        for (int x = 0; x < 2; ++x)
#pragma unroll
            for (int et = 0; et < 2; ++et) Cst[x][et] = (f32x4){0.f, 0.f, 0.f, 0.f};
        float m_state = 0.f;
        u32x4 qr[4], kr[4], vr = (u32x4){0u, 0u, 0u, 0u}; float gi, gf;
        const bf16_t* qbase = proj + row0 * NP + 3072 + hh * 256;
#define ML_LOAD(c) do { _Pragma("unroll") for (int i = 0; i < 4; ++i) { const int p = tid + 512 * i, r = p >> 5, c16 = p & 31; const bf16_t* rp = qbase + (size_t)((c) * 64 + r) * NP + c16 * 8; \
            qr[i] = *(const u32x4*)rp; kr[i] = *(const u32x4*)(rp + 1024); } \
            if (tid < 128) vr = *(const u32x4*)(qbase + (size_t)((c) * 64 + (tid >> 1)) * NP + 2048 + e0 + (tid & 1) * 8); \
            { const float* gp = gates + (row0 + (c) * 64 + lane) * 8 + hh; gi = gp[0]; gf = gp[4]; } } while (0)
        ML_LOAD(0);
#pragma unroll 1
        for (int c = 0; c < 32; ++c) {
            const float lf = fminf(gf, 0.f) - log1pf(__expf(-fabsf(gf)));
            float bc = lf;
#pragma unroll
            for (int off = 1; off < 64; off <<= 1) { const float t = __shfl_up(bc, off); if (lane >= off) bc += t; }
            const float uv = gi - bc;
            float cm = uv;
#pragma unroll
            for (int off = 1; off < 64; off <<= 1) { const float t = __shfl_up(cm, off); if (lane >= off) cm = fmaxf(cm, t); }
            const float g_tot = __shfl(bc, 63), cm63 = __shfl(cm, 63);
            const float Mv = fmaxf(m_state, cm), M63 = fmaxf(m_state, cm63);
            const float w_s = __expf(uv - M63), decay = __expf(m_state - M63);
            const float interw = __expf(m_state - Mv) * 0.0625f, floorv = __expf(-(bc + Mv));
            m_state = g_tot + M63;
#pragma unroll
            for (int i = 0; i < 4; ++i) { const int p = tid + 512 * i, r = p >> 5, c16 = p & 31; *(u32x4*)(QS + r * 528 + c16 * 16) = qr[i]; *(u32x4*)(KS + r * 528 + c16 * 16) = kr[i]; }
            { const float wv = __shfl(w_s, (tid >> 1) & 63);
              if (tid < 128) { const int s = tid >> 1, hf = tid & 1;
#pragma unroll
                  for (int q = 0; q < 4; ++q) { const float v0 = bflo(vr[q]), v1 = bfhi(vr[q]);
                      ((bf16_t*)VT)[(8 * hf + 2 * q) * 72 + s] = (bf16_t)(vr[q] & 0xffffu); ((bf16_t*)VT)[(8 * hf + 2 * q + 1) * 72 + s] = (bf16_t)(vr[q] >> 16);
                      ((bf16_t*)WVT)[(8 * hf + 2 * q) * 72 + s] = f2bf(v0 * wv); ((bf16_t*)WVT)[(8 * hf + 2 * q + 1) * 72 + s] = f2bf(v1 * wv); } }
              if (w == 2) ((bf16_t*)WVT)[16 * 72 + lane] = f2bf(w_s); }
            if (c + 1 < 32) ML_LOAD(c + 1);
            __syncthreads();
            bf16x8 qf[8]; f32x4 S0 = (f32x4){0.f, 0.f, 0.f, 0.f}, S1 = S0;
#pragma unroll
            for (int kk = 0; kk < 8; ++kk) {
                qf[kk] = *(const bf16x8*)(QS + (16 * ti + l15) * 528 + kk * 64 + g * 16);
                const bf16x8 kf0 = *(const bf16x8*)(KS + (32 * a + l15) * 528 + kk * 64 + g * 16), kf1 = *(const bf16x8*)(KS + (32 * a + 16 + l15) * 528 + kk * 64 + g * 16);
                S0 = __builtin_amdgcn_mfma_f32_16x16x32_bf16(kf0, qf[kk], S0, 0, 0, 0); S1 = __builtin_amdgcn_mfma_f32_16x16x32_bf16(kf1, qf[kk], S1, 0, 0, 0);
            }
            const int tcol = 16 * ti + l15;
            const float Mt = __shfl(Mv, tcol);
            float p[8];
#pragma unroll
            for (int r = 0; r < 4; ++r) { const int s0 = 32 * a + 4 * g + r, s1 = s0 + 16; const float u0 = __shfl(uv, s0), u1 = __shfl(uv, s1);
                p[r] = (s0 <= tcol) ? S0[r] * 0.0625f * __expf(u0 - Mt) : 0.f; p[4 + r] = (s1 <= tcol) ? S1[r] * 0.0625f * __expf(u1 - Mt) : 0.f; }
            u32x4 pau; pau.x = cvt_pk_bf16(p[0], p[1]); pau.y = cvt_pk_bf16(p[2], p[3]); pau.z = cvt_pk_bf16(p[4], p[5]); pau.w = cvt_pk_bf16(p[6], p[7]);
            const bf16x8 pa = __builtin_bit_cast(bf16x8, pau);
            f32x4 rr[2];
#pragma unroll
            for (int et = 0; et < 2; ++et) { const unsigned char* vp = VT + (16 * et + l15) * 144 + (32 * a + 4 * g) * 2;
                const u32x2 lo = *(const u32x2*)vp, hi = *(const u32x2*)(vp + 32);
                u32x4 vbu; vbu.x = lo.x; vbu.y = lo.y; vbu.z = hi.x; vbu.w = hi.y;
                rr[et] = __builtin_amdgcn_mfma_f32_16x16x32_bf16(pa, __builtin_bit_cast(bf16x8, vbu), (f32x4){0.f, 0.f, 0.f, 0.f}, 0, 0, 0); }
            {
                const unsigned char* CTc = CT + (c & 1) * 16896;
                f32x4 in0 = (f32x4){0.f, 0.f, 0.f, 0.f}, in1 = in0;
#pragma unroll
                for (int k2 = 0; k2 < 4; ++k2) {
                    const bf16x8 qa = a ? qf[4 + k2] : qf[k2];
                    const bf16x8 c0 = *(const bf16x8*)(CTc + (l15) * 528 + (128 * a + 32 * k2 + 8 * g) * 2), c1 = *(const bf16x8*)(CTc + (16 + l15) * 528 + (128 * a + 32 * k2 + 8 * g) * 2);
                    in0 = __builtin_amdgcn_mfma_f32_16x16x32_bf16(qa, c0, in0, 0, 0, 0); in1 = __builtin_amdgcn_mfma_f32_16x16x32_bf16(qa, c1, in1, 0, 0, 0);
                }
#pragma unroll
                for (int r = 0; r < 4; ++r) { const float iw = __shfl(interw, 16 * ti + 4 * g + r); rr[0][r] += in0[r] * iw; rr[1][r] += in1[r] * iw; }
            }
            if (a == 1) { *(f32x4*)(XCH + ((ti * 2 + 0) * 64 + lane) * 16) = rr[0]; *(f32x4*)(XCH + ((ti * 2 + 1) * 64 + lane) * 16) = rr[1]; }
            {
                unsigned char* CTn = CT + ((c + 1) & 1) * 16896;
#pragma unroll
                for (int x = 0; x < 2; ++x) {
                    const int dt = 2 * w + x;
#pragma unroll
                    for (int et = 0; et < 2; ++et) Cst[x][et] *= decay;
#pragma unroll
                    for (int ks = 0; ks < 2; ++ks) {
                        bf16x8 ka;
#pragma unroll
                        for (int jj = 0; jj < 8; ++jj) ka[jj] = (short)*(const bf16_t*)(KS + (32 * ks + 8 * g + jj) * 528 + (16 * dt + l15) * 2);
#pragma unroll
                        for (int et = 0; et < 2; ++et) { const bf16x8 wvb = *(const bf16x8*)(WVT + (16 * et + l15) * 144 + (32 * ks + 8 * g) * 2);
                            Cst[x][et] = __builtin_amdgcn_mfma_f32_16x16x32_bf16(ka, wvb, Cst[x][et], 0, 0, 0); }
                    }
#pragma unroll
                    for (int et = 0; et < 2; ++et) { u32x2 o; o.x = cvt_pk_bf16(Cst[x][et][0], Cst[x][et][1]); o.y = cvt_pk_bf16(Cst[x][et][2], Cst[x][et][3]);
                        *(u32x2*)(CTn + (16 * et + l15) * 528 + (16 * dt + 4 * g) * 2) = o; }
                }
            }
            __syncthreads();
            if (a == 0) {
                const f32x4 o0 = *(const f32x4*)(XCH + ((ti * 2 + 0) * 64 + lane) * 16), o1 = *(const f32x4*)(XCH + ((ti * 2 + 1) * 64 + lane) * 16);
#pragma unroll
                for (int r = 0; r < 4; ++r) {
                    const float den = __shfl(rr[1][r] + o1[r], lane & 48), fl = __shfl(floorv, 16 * ti + 4 * g + r);
                    const float hv = (rr[0][r] + o0[r]) / fmaxf(fabsf(den), fl);
                    hbuf[(row0 + c * 64 + 16 * ti + 4 * g + r) * 1024 + hh * 256 + e0 + l15] = hv;
                }
            }
        }
#undef ML_LOAD
    }
}

__device__ __forceinline__ void phase_headnorm(const Args& A, const float* hbuf) {
    const bf16_t* proj = (const bf16_t*)(A.ws + WS_PROJ); bf16_t* y = (bf16_t*)(A.ws + WS_Y);
    const int lane = threadIdx.x & 63, gw = blockIdx.x * 8 + (threadIdx.x >> 6), nw = gridDim.x * 8;
    for (int it = gw; it < MT * 4; it += nw) {
        const int row = it >> 2, hh = it & 3;
        const f32x4 hv = *(const f32x4*)(hbuf + (size_t)row * 1024 + hh * 256 + lane * 4);
        float s = (hv[0] + hv[1]) + (hv[2] + hv[3]);
#pragma unroll
        for (int off = 32; off >= 1; off >>= 1) s += __shfl_xor(s, off);
        const float mu = s * (1.0f / 256.0f);
        const f32x4 d = hv - mu;
        float q = (d[0] * d[0] + d[1] * d[1]) + (d[2] * d[2] + d[3] * d[3]);
#pragma unroll
        for (int off = 32; off >= 1; off >>= 1) q += __shfl_xor(q, off);
        const float rstd = rsqrtf(q * (1.0f / 256.0f) + 1e-6f);
        const f32x4 gn = *(const f32x4*)(A.mh_gain + hh * 256 + lane * 4);
        const u32x2 ov = *(const u32x2*)(proj + (size_t)row * NP + 6144 + hh * 256 + lane * 4);
        const float o0 = bflo(ov.x), o1 = bfhi(ov.x), o2 = bflo(ov.y), o3 = bfhi(ov.y);
        const float y0 = d[0] * rstd * gn[0] / (1.0f + __expf(-o0)), y1 = d[1] * rstd * gn[1] / (1.0f + __expf(-o1));
        const float y2 = d[2] * rstd * gn[2] / (1.0f + __expf(-o2)), y3 = d[3] * rstd * gn[3] / (1.0f + __expf(-o3));
        u32x2 o; o.x = cvt_pk_bf16(y0, y1); o.y = cvt_pk_bf16(y2, y3);
        *(u32x2*)(y + (size_t)row * DM + WCONV + hh * 256 + lane * 4) = o;
    }
}

__device__ __forceinline__ void phase_ln(float* io, const float* gam, const float* bet, bf16_t* ob) {
    const int lane = threadIdx.x & 63, gw = blockIdx.x * 8 + (threadIdx.x >> 6), nw = gridDim.x * 8;
    for (int row = gw; row < MT; row += nw) {
        float* rp = io + (size_t)row * DM;
        f32x4 v[8]; float s = 0.f;
#pragma unroll
        for (int i = 0; i < 8; ++i) { v[i] = *(const f32x4*)(rp + i * 256 + lane * 4); s += (v[i][0] + v[i][1]) + (v[i][2] + v[i][3]); }
#pragma unroll
        for (int off = 32; off >= 1; off >>= 1) s += __shfl_xor(s, off);
        const float mu = s * (1.0f / DM);
        float q = 0.f;
#pragma unroll
        for (int i = 0; i < 8; ++i) { v[i] = v[i] - mu; q += (v[i][0] * v[i][0] + v[i][1] * v[i][1]) + (v[i][2] * v[i][2] + v[i][3] * v[i][3]); }
#pragma unroll
        for (int off = 32; off >= 1; off >>= 1) q += __shfl_xor(q, off);
        const float rstd = rsqrtf(q * (1.0f / DM) + 1e-5f);
#pragma unroll
        for (int i = 0; i < 8; ++i) { const f32x4 gg = *(const f32x4*)(gam + i * 256 + lane * 4), bb = *(const f32x4*)(bet + i * 256 + lane * 4);
            const f32x4 o = v[i] * rstd * gg + bb;
            *(f32x4*)(rp + i * 256 + lane * 4) = o;
            if (ob) { u32x2 p; p.x = cvt_pk_bf16(o[0], o[1]); p.y = cvt_pk_bf16(o[2], o[3]); *(u32x2*)(ob + (size_t)row * DM + i * 256 + lane * 4) = p; } }
    }
}

__device__ __forceinline__ void phase_fixup(const Args& A) {
    const float* halo = (const float*)(A.ws + WS_HALO); bf16_t* act = (bf16_t*)(A.ws + WS_ACT);
    for (int idx = blockIdx.x * 512 + threadIdx.x; idx < 128 * 2 * (DFF / 4); idx += gridDim.x * 512) {
        const int f = (idx % (DFF / 4)) * 4, br = idx / (DFF / 4), rr = br & 1, B = br >> 1;
        const bool first = (B & 31) == 0;
        const float* hc = halo + (size_t)B * 4 * NUP; const float* hp = hc - 4 * NUP;
        f32x4 hv[2];
#pragma unroll
        for (int bj = 0; bj < 2; ++bj) {
            const int col = bj * DFF + f;
            const f32x4 cur = *(const f32x4*)(hc + (size_t)(2 + rr) * NUP + col);
            f32x4 p1, p2; const f32x4 z = (f32x4){0.f, 0.f, 0.f, 0.f};
            if (rr == 0) { p1 = first ? z : *(const f32x4*)(hp + (size_t)1 * NUP + col); p2 = first ? z : *(const f32x4*)(hp + col); }
            else { p1 = *(const f32x4*)(hc + (size_t)2 * NUP + col); p2 = first ? z : *(const f32x4*)(hp + (size_t)1 * NUP + col); }
            const f32x4 w0 = *(const f32x4*)(A.w_fc + col), w1 = *(const f32x4*)(A.w_fc + NUP + col), w2 = *(const f32x4*)(A.w_fc + 2 * NUP + col), bb = *(const f32x4*)(A.b_fc + col);
            hv[bj] = w2 * cur + w1 * p1 + w0 * p2 + bb;
        }
        float av[4];
#pragma unroll
        for (int j = 0; j < 4; ++j) { const float gt = hv[1][j]; av[j] = hv[0][j] * gt / (1.0f + __expf(-gt)); }
        u32x2 o; o.x = cvt_pk_bf16(av[0], av[1]); o.y = cvt_pk_bf16(av[2], av[3]);
        *(u32x2*)(act + (size_t)(B * 64 + rr) * DFF + f) = o;
    }
}

__device__ __forceinline__ void phase_dump(const bf16_t* src, int ld, int c0, float* out) {
    for (size_t idx = (size_t)blockIdx.x * 512 + threadIdx.x; idx < (size_t)MT * DM; idx += (size_t)gridDim.x * 512) {
        const size_t row = idx / DM, col = idx % DM; out[idx] = bflo((unsigned)src[row * ld + c0 + col]); }
}
#ifndef DBG_STOP
#define DBG_STOP -1
#endif
#define XB_TMO      128
#define XB_XCNT(j)  (256  + 64 * (j))
#define XB_XSUB(j)  (1280 + 64 * (j))
#define XB_XGEN(j)  (2304 + 64 * (j))
#define XB_TOP      3328
#define XB_TOPGEN   3392
#define XCD_BAR_WORDS 3456
#define XB_SPIN_CAP (1u << 22)
__device__ __forceinline__ unsigned xb_ld(unsigned* p)              { return __hip_atomic_load(p, __ATOMIC_RELAXED, __HIP_MEMORY_SCOPE_AGENT); }
__device__ __forceinline__ unsigned xb_add(unsigned* p, unsigned v) { return __hip_atomic_fetch_add(p, v, __ATOMIC_RELAXED, __HIP_MEMORY_SCOPE_AGENT); }
__device__ __forceinline__ unsigned xb_xcc_id() { return (unsigned)__builtin_amdgcn_s_getreg((3 << 11) | 20) & 0xFu; }
#define XB_SPIN(cond, bar) do { unsigned _sp = 0; while (cond) { __builtin_amdgcn_s_sleep(1); \
    if ((++_sp & 255u) == 0u) { if (xb_ld(&(bar)[XB_TMO])) break; if (_sp > XB_SPIN_CAP) { atomicAdd(&(bar)[XB_TMO], 1u); break; } } } } while (0)
struct XcdBarrier { unsigned* bar; unsigned x; volatile LAS unsigned* st; };
__device__ __forceinline__ XcdBarrier xcd_barrier_post(unsigned* bar, volatile LAS unsigned* st) {
    XcdBarrier b; b.bar = bar; b.x = xb_xcc_id(); b.st = st;
    if (threadIdx.x == 0) (void)xb_add(&bar[XB_XCNT(b.x)], 1u);
    return b;
}
__device__ __forceinline__ void xcd_barrier_complete(unsigned* bar, unsigned x, unsigned& nloc, unsigned& nx) {
    const unsigned G = gridDim.x * gridDim.y * gridDim.z;
    unsigned sum, cnt, mine, sp = 0u;
    for (;;) {
        sum = 0u; cnt = 0u; mine = 0u;
#pragma unroll
        for (unsigned j = 0; j < 16; ++j) { const unsigned c = xb_ld(&bar[XB_XCNT(j)]); sum += c; cnt += (c > 0u) ? 1u : 0u; mine = (j == x) ? c : mine; }
        if (sum == G) break;
        __builtin_amdgcn_s_sleep(1);
        if ((++sp & 255u) == 0u) { if (xb_ld(&bar[XB_TMO])) break; if (sp > XB_SPIN_CAP) { atomicAdd(&bar[XB_TMO], 1u); break; } }
    }
    nloc = mine > 0u ? mine : 1u; nx = cnt > 0u ? cnt : 1u;
}
__device__ __forceinline__ void xcd_barrier(const XcdBarrier& b) {
    asm volatile("s_waitcnt vmcnt(0)" ::: "memory");
    __syncthreads();
    if (threadIdx.x == 0) {
        unsigned* bar = b.bar;
        __builtin_amdgcn_s_waitcnt(0);
        unsigned nloc = b.st[0], nx = b.st[1];
        if (nloc == 0u) { xcd_barrier_complete(bar, b.x, nloc, nx); b.st[0] = nloc; b.st[1] = nx; }
        const unsigned old = xb_add(&bar[XB_XSUB(b.x)], 1u);
        const unsigned gen = old / nloc;
        if (old + 1u == (gen + 1u) * nloc) {
            __builtin_amdgcn_fence(__ATOMIC_RELEASE, "agent");
            asm volatile("s_waitcnt vmcnt(0)" ::: "memory");
            const unsigned og = xb_add(&bar[XB_TOP], 1u);
            const unsigned tg = og / nx;
            if (og + 1u == (tg + 1u) * nx) xb_add(&bar[XB_TOPGEN], 1u);
            else XB_SPIN(xb_ld(&bar[XB_TOPGEN]) == tg, bar);
            __builtin_amdgcn_fence(__ATOMIC_ACQUIRE, "agent");
            xb_add(&bar[XB_XGEN(b.x)], 1u);
            asm volatile("s_waitcnt vmcnt(0)" ::: "memory");
        } else {
            XB_SPIN(xb_ld(&bar[XB_XGEN(b.x)]) == gen, bar);
            __builtin_amdgcn_fence(__ATOMIC_ACQUIRE, "agent");
            asm volatile("s_waitcnt vmcnt(0)" ::: "memory");
        }
    }
    __syncthreads();
}

constexpr int N_PHASES = 10;
#ifndef ONLY_PH
#define ONLY_PH -1
#endif
#define PH_ON(x) (ONLY_PH < 0 || ONLY_PH == (x))
__global__ void __launch_bounds__(512, 2) mega(Args a) {
    extern __shared__ __attribute__((aligned(16))) unsigned char lds[];
    cg::grid_group grid = cg::this_grid();
    unsigned char* ws = a.ws;
#define PH_RUN(x) (PH_ON(x) && a.ph_lo <= (x) && (x) < a.ph_hi)
#define PH_SYNC(x) do { if (a.ph_lo <= (x) && (x) + 1 < a.ph_hi) xcd_barrier(xb); } while (0)
    volatile LAS unsigned* xst = (volatile LAS unsigned*)((LAS unsigned char*)lds + 131072);
    if (threadIdx.x == 0) { xst[0] = 0u; xst[1] = 0u; }
    __syncthreads();
    const XcdBarrier xb = xcd_barrier_post((unsigned*)(ws + WS_BAR), xst);
    if (a.ph_hi > 1000) grid.sync();
    if (PH_RUN(0)) phase_prologue(a, lds);
    PH_SYNC(0);
    if (PH_RUN(1)) { pg8::Gemm g{(const bf16_t*)(ws + WS_XB), (const bf16_t*)(ws + WS_WIN), MT, NP, DM}; pg8::StaticOrder S; S.init(MT, NP, gridDim.x, blockIdx.x);
        pg8::EpiBf16 E{(bf16_t*)(ws + WS_PROJ), NP}; pg8::gemm_phase((LAS unsigned char*)lds, g, S, E); }
    PH_SYNC(1);
    if (PH_RUN(2)) { phase_yconv(a); phase_mlstm(a, lds, a.out); }
    PH_SYNC(2);
    if (PH_RUN(3)) phase_headnorm(a, a.out);
    PH_SYNC(3);
    if (PH_RUN(4)) { pg8::Gemm g{(const bf16_t*)(ws + WS_Y), (const bf16_t*)(ws + WS_WOUT), MT, DM, DM}; pg8::StaticOrder S; S.init(MT, DM, gridDim.x, blockIdx.x);
        pg8::EpiResF32 E{a.x, a.out, DM}; pg8::gemm_phase((LAS unsigned char*)lds, g, S, E); }
    PH_SYNC(4);
    if (PH_RUN(5)) phase_ln(a.out, a.ln1_g, a.ln1_b, (bf16_t*)(ws + WS_X1B));
    PH_SYNC(5);
    if (PH_RUN(6)) { pg8::Gemm g{(const bf16_t*)(ws + WS_X1B), (const bf16_t*)(ws + WS_WUP), MT, NUP, DM}; pg8::StaticOrder S; S.init(MT, NUP, gridDim.x, blockIdx.x);
        pg8::EpiConvFfn E{(bf16_t*)(ws + WS_ACT), (float*)(ws + WS_HALO), a.w_fc, a.b_fc}; pg8::gemm_phase((LAS unsigned char*)lds, g, S, E); }
    PH_SYNC(6);
    if (PH_RUN(7)) phase_fixup(a);
    PH_SYNC(7);
    if (PH_RUN(8)) { pg8::Gemm g{(const bf16_t*)(ws + WS_ACT), (const bf16_t*)(ws + WS_WDN), MT, DM, DFF}; pg8::StaticOrder S; S.init(MT, DM, gridDim.x, blockIdx.x);
        pg8::EpiResF32 E{a.out, a.out, DM}; pg8::gemm_phase((LAS unsigned char*)lds, g, S, E); }
    PH_SYNC(8);
    if (PH_RUN(9)) phase_ln(a.out, a.ln2_g, a.ln2_b, nullptr);
    if (DBG_STOP == 1 && a.ph_lo == 101) phase_dump((const bf16_t*)(ws + WS_PROJ), NP, 3072, a.out);
    if (DBG_STOP == 3 && a.ph_lo == 103) phase_dump((const bf16_t*)(ws + WS_Y), DM, 0, a.out);
    if (DBG_STOP == 7 && a.ph_lo == 107) phase_dump((const bf16_t*)(ws + WS_ACT), DFF, 0, a.out);
}

extern "C" void kernel_launch(void* const* d_in, const int* in_sizes, int n_in, void* d_out, int out_size, void* d_ws, size_t ws_size, hipStream_t stream) {
    static int grid = 0;
    if (grid == 0) {
        if (n_in != 14 || ws_size < WS_END) { fprintf(stderr, "kernel_launch: unexpected n_in %d / ws_size %zu (need %zu)\n", n_in, ws_size, (size_t)WS_END); grid = -1; return; }
        int dev = 0, cus = 0, per_cu = 0;
        hipGetDevice(&dev); hipDeviceGetAttribute(&cus, hipDeviceAttributeMultiprocessorCount, dev);
        if (hipFuncSetAttribute((const void*)mega, hipFuncAttributeMaxDynamicSharedMemorySize, LDS_BYTES) != hipSuccess) { fprintf(stderr, "kernel_launch: hipFuncSetAttribute failed\n"); grid = -1; return; }
        if (hipOccupancyMaxActiveBlocksPerMultiprocessor(&per_cu, (const void*)mega, 512, LDS_BYTES) != hipSuccess || per_cu < 1) { fprintf(stderr, "kernel_launch: occupancy query failed (%d)\n", per_cu); (void)hipGetLastError(); per_cu = 1; }
        grid = cus * 1;
        fprintf(stderr, "kernel_launch: cus %d per_cu %d grid %d\n", cus, per_cu, grid);
    }
    if (grid < 0) return;
    if (hipMemsetAsync((char*)d_ws + WS_BAR, 0, XCD_BAR_WORDS * 4, stream) != hipSuccess) { fprintf(stderr, "kernel_launch: memset failed\n"); return; }
    Args a{};
    a.x = (const float*)d_in[0]; a.w_in = (const float*)d_in[1]; a.b_gates = (const float*)d_in[2]; a.w_sc = (const float*)d_in[3]; a.mh_gain = (const float*)d_in[4]; a.w_out = (const float*)d_in[5];
    a.ln1_g = (const float*)d_in[6]; a.ln1_b = (const float*)d_in[7]; a.w_up = (const float*)d_in[8]; a.w_fc = (const float*)d_in[9]; a.b_fc = (const float*)d_in[10]; a.w_down = (const float*)d_in[11];
    a.ln2_g = (const float*)d_in[12]; a.ln2_b = (const float*)d_in[13];
    a.out = (float*)d_out; a.ws = (unsigned char*)d_ws;
#if MK_SINGLE
    a.ph_lo = 0; a.ph_hi = N_PHASES;
    void* args[] = {&a};
    hipError_t e = hipLaunchCooperativeKernel((const void*)mega, dim3(grid), dim3(512), args, LDS_BYTES, stream);
    if (e != hipSuccess) fprintf(stderr, "cooperative launch failed: %s (grid %d)\n", hipGetErrorString(e), grid);
#else
    for (int ph = 0; ph < N_PHASES; ++ph) { if (DBG_STOP >= 0 && ph > DBG_STOP) break; a.ph_lo = ph; a.ph_hi = ph + 1; hipLaunchKernelGGL(mega, dim3(grid), dim3(512), LDS_BYTES, stream, a); }
    if (DBG_STOP >= 0) { a.ph_lo = 100 + DBG_STOP; a.ph_hi = 101 + DBG_STOP; hipLaunchKernelGGL(mega, dim3(grid), dim3(512), LDS_BYTES, stream, a); }
#endif
}
```

```cpp
#include <hip/hip_runtime.h>
#include <hip/hip_cooperative_groups.h>
#include <cstdio>
#include <cstdint>
namespace cg = cooperative_groups;

#ifndef MK_SINGLE
#define MK_SINGLE 1
#endif

#define LAS __attribute__((address_space(3)))
typedef unsigned short bf16_t;
typedef short bf16x8 __attribute__((ext_vector_type(8)));
typedef float f32x4 __attribute__((ext_vector_type(4)));
typedef unsigned u32x4 __attribute__((ext_vector_type(4)));
typedef unsigned u32x2 __attribute__((ext_vector_type(2)));

constexpr int MT = 8192, DM = 2048, SEQ = 2048, NIN = 7176, NP = 7168, DFF = 5632, NUP = 11264, WCONV = 1024;
constexpr float ALPHA = 1.189207115002721f;
constexpr size_t WS_WIN = 0;
constexpr size_t WS_WOUT = WS_WIN + (size_t)NP * DM * 2;
constexpr size_t WS_WUP = WS_WOUT + (size_t)DM * DM * 2;
constexpr size_t WS_WDN = WS_WUP + (size_t)NUP * DM * 2;
constexpr size_t WS_X1B = WS_WDN + (size_t)DM * DFF * 2;
constexpr size_t WS_GATES = WS_X1B + (size_t)MT * DM * 2;
constexpr size_t WS_C = WS_GATES + (size_t)MT * 8 * 4;
constexpr size_t WS_PROJ = WS_C;
constexpr size_t WS_Y = WS_PROJ + (size_t)MT * NP * 2;
constexpr size_t WS_XB = WS_Y + (size_t)MT * DM * 2;
constexpr size_t WS_ACT = WS_C;
constexpr size_t WS_HALO = WS_ACT + (size_t)MT * DFF * 2;
constexpr size_t WS_BAR = WS_XB + (size_t)MT * DM * 2;
constexpr size_t WS_END = WS_BAR + 16384;
constexpr int LDS_BYTES = 131072 + 16;

struct Args {
    const float* x; const float* w_in; const float* b_gates; const float* w_sc; const float* mh_gain; const float* w_out;
    const float* ln1_g; const float* ln1_b; const float* w_up; const float* w_fc; const float* b_fc; const float* w_down;
    const float* ln2_g; const float* ln2_b;
    float* out; unsigned char* ws; int ph_lo, ph_hi;
};

typedef __bf16 bf16v2 __attribute__((ext_vector_type(2)));
typedef float f32x2 __attribute__((ext_vector_type(2)));
__device__ __forceinline__ unsigned cvt_pk_bf16(float lo, float hi) { const f32x2 v = {lo, hi}; const bf16v2 r = __builtin_convertvector(v, bf16v2); return __builtin_bit_cast(unsigned, r); }
__device__ __forceinline__ unsigned cvt_pk_bf16_asm(float lo, float hi) { unsigned r; asm volatile("v_cvt_pk_bf16_f32 %0, %1, %2" : "=v"(r) : "v"(lo), "v"(hi)); return r; }
__device__ __forceinline__ float bflo(unsigned u) { return __uint_as_float(u << 16); }
__device__ __forceinline__ float bfhi(unsigned u) { return __uint_as_float(u & 0xffff0000u); }
__device__ __forceinline__ bf16_t f2bf(float f) { unsigned u = __float_as_uint(f); u += 0x7FFFu + ((u >> 16) & 1u); return (bf16_t)(u >> 16); }

namespace pg8 {
constexpr int BM = 256, BK = 64, HALF = 128, HTB = HALF * BK * 2, STAGE_BYTES = 8 * HTB, NXCD = 8, WGM = 8;
__host__ __device__ __forceinline__ int lds_byte(int r, int c) { const int st = (r >> 4) * 2 + (c >> 5), rr = r & 15, cc = c & 31, ob = rr * 64 + cc * 2; return st * 1024 + (ob ^ (((ob >> 9) & 1) << 5)); }
__host__ __device__ __forceinline__ void stage_rc(int b, int& R, int& C) { const int st = b / 1024, sb = b % 1024, swz = sb ^ (((sb >> 9) & 1) << 5); R = (st >> 1) * 16 + swz / 64; C = (st & 1) * 32 + (swz % 64) / 2; }
__host__ __device__ __forceinline__ int perm32(int rho) { const int n = rho >> 4, i = rho & 15; return 8 * (i >> 2) + 4 * n + (i & 3); }
struct Unit { int pm, pn; };
struct Gemm { const bf16_t* A; const bf16_t* Bt; int M, N, K; };
struct StaticOrder {
    int nM, nN, nwg, G, c;
    __device__ void init(int M, int N, int G_, int c_) { nM = M / BM; nN = N / BM; nwg = nM * nN; G = G_; c = c_; }
    __device__ bool next(int i, Unit& u) const {
        const long L = (long)i * G + c; if (L >= nwg) return false;
        int wgid = (int)L; { const int q = nwg / NXCD, r = nwg % NXCD, xcd = wgid % NXCD, off = wgid / NXCD; wgid = (xcd < r ? xcd * (q + 1) : r * (q + 1) + (xcd - r) * q) + off; }
        const int nig = WGM * nN, gid = wgid / nig, fm = gid * WGM, gsz = (nM - fm) < WGM ? (nM - fm) : WGM;
        u.pm = fm + ((wgid % nig) % gsz); u.pn = (wgid % nig) / gsz; return true;
    }
};

template <class Epi>
__device__ __forceinline__ void gemm_phase(LAS unsigned char* lds, const Gemm g, const StaticOrder& S, const Epi& E) {
    const int tid = threadIdx.x, wid = __builtin_amdgcn_readfirstlane(tid >> 6), lane = tid & 63, wr = wid >> 2, wc = wid & 3, fr = lane & 15, fq = lane >> 4;
    const int K = g.K, nt = K / BK;
    unsigned voffA[2], voffB[2];
#pragma unroll
    for (int i = 0; i < 2; ++i) { int R, C; stage_rc(tid * 16 + i * 8192, R, C); const int Rb = Epi::PERM ? ((R & ~31) + perm32(R & 31)) : R;
        voffA[i] = (unsigned)(R * K + C) * 2u; voffB[i] = (unsigned)(Rb * K + C) * 2u; }
    const size_t kstep = (size_t)(BK * 2);
    const size_t hstep = (size_t)HALF * K * 2;
    const size_t tstep = 2 * hstep;
    const unsigned ldsw = (unsigned)wid * 1024u;
    const int aoff = lds_byte(wr * 64 + fr, fq * 8), boff = lds_byte(wc * 32 + fr, fq * 8);
#define PG8_SA(b, h) (((b) * 2 + (h)) * HTB)
#define PG8_SB(b, h) ((4 + (b) * 2 + (h)) * HTB)
#define PG8_STAGE(bufoff, gbase, voff) do { _Pragma("unroll") for (int _i = 0; _i < 2; ++_i) \
        __builtin_amdgcn_global_load_lds((const unsigned*)((const char*)(gbase) + (voff)[_i]), (LAS unsigned*)(lds + (bufoff) + ldsw + _i * 8192), 16, 0, 0); } while (0)
#define PG8_LDA(dst, b, h) do { _Pragma("unroll") for (int m = 0; m < 4; ++m) _Pragma("unroll") for (int k = 0; k < 2; ++k) dst[m][k] = *(const LAS bf16x8*)(lds + PG8_SA(b, h) + aoff + m * 2048 + k * 1024); } while (0)
#define PG8_LDB(dst, b, h) do { _Pragma("unroll") for (int n = 0; n < 2; ++n) _Pragma("unroll") for (int k = 0; k < 2; ++k) dst[n][k] = *(const LAS bf16x8*)(lds + PG8_SB(b, h) + boff + n * 2048 + k * 1024); } while (0)
#define PG8_MMA(ai, bj, At, Bt) do { __builtin_amdgcn_s_setprio(1); _Pragma("unroll") for (int m = 0; m < 4; ++m) _Pragma("unroll") for (int n = 0; n < 2; ++n) _Pragma("unroll") for (int k = 0; k < 2; ++k) \
        acc[ai][bj][m][n] = __builtin_amdgcn_mfma_f32_16x16x32_bf16(Bt[n][k], At[m][k], acc[ai][bj][m][n], 0, 0, 0); __builtin_amdgcn_s_setprio(0); } while (0)
#define PG8_WAIT_V(n) asm volatile("s_waitcnt vmcnt(" #n ")" ::: "memory")
#define PG8_WAIT_L(n) asm volatile("s_waitcnt lgkmcnt(" #n ")" ::: "memory")
#define PG8_BAR __builtin_amdgcn_s_barrier()
#define PG8_SCHED __builtin_amdgcn_sched_barrier(0)
    Unit cur, nxt; int ui = 0;
    if (!S.next(0, cur)) return;
    f32x4 acc[2][2][4][2];
#pragma unroll
    for (int a = 0; a < 2; ++a)
#pragma unroll
        for (int b = 0; b < 2; ++b)
#pragma unroll
            for (int m = 0; m < 4; ++m)
#pragma unroll
                for (int n = 0; n < 2; ++n) acc[a][b][m][n] = (f32x4){0.f, 0.f, 0.f, 0.f};
    bf16x8 At[4][2], B0[2][2], B1[2][2];
    const char* cA = (const char*)g.A + (size_t)cur.pm * tstep; const char* cB = (const char*)g.Bt + (size_t)cur.pn * tstep;
    PG8_STAGE(PG8_SB(0, 0), cB, voffB); PG8_STAGE(PG8_SA(0, 0), cA, voffA); PG8_STAGE(PG8_SB(0, 1), cB + hstep, voffB); PG8_STAGE(PG8_SA(0, 1), cA + hstep, voffA);
    if (wr == 1) PG8_BAR;
    PG8_WAIT_V(4); PG8_BAR;
    PG8_STAGE(PG8_SB(1, 0), cB + kstep, voffB); PG8_STAGE(PG8_SA(1, 0), cA + kstep, voffA); PG8_STAGE(PG8_SB(1, 1), cB + hstep + kstep, voffB);
    PG8_WAIT_V(6); PG8_BAR;
    for (;;) {
        const bool has_next = S.next(ui + 1, nxt);
        const char* nA = has_next ? (const char*)g.A + (size_t)nxt.pm * tstep : cA; const char* nB = has_next ? (const char*)g.Bt + (size_t)nxt.pn * tstep : cB;
        for (int t = 0; t < nt; t += 2) {
            const bool last = (t == nt - 2);
            const char* a1 = cA + (size_t)(t + 1) * kstep;
            const char* a2 = last ? nA : cA + (size_t)(t + 2) * kstep; const char* b2 = last ? nB : cB + (size_t)(t + 2) * kstep;
            const char* a3 = a2 + kstep; const char* b3 = b2 + kstep;
            PG8_LDB(B0, 0, 0); PG8_SCHED; PG8_LDA(At, 0, 0); PG8_STAGE(PG8_SA(1, 1), a1 + hstep, voffA);
            PG8_WAIT_L(8); PG8_BAR; PG8_WAIT_L(0); PG8_MMA(0, 0, At, B0); PG8_BAR; PG8_SCHED;
            PG8_LDB(B1, 0, 1); PG8_STAGE(PG8_SB(0, 0), b2, voffB);
            PG8_BAR; PG8_WAIT_L(0); PG8_MMA(0, 1, At, B1); PG8_BAR;
            PG8_LDA(At, 0, 1); PG8_STAGE(PG8_SA(0, 0), a2, voffA);
            PG8_BAR; PG8_WAIT_L(0); PG8_MMA(1, 0, At, B0); PG8_BAR; PG8_SCHED;
            PG8_STAGE(PG8_SB(0, 1), b2 + hstep, voffB);
            PG8_WAIT_V(6); PG8_BAR; PG8_MMA(1, 1, At, B1); PG8_BAR;
            PG8_LDB(B0, 1, 0); PG8_SCHED; PG8_LDA(At, 1, 0); PG8_STAGE(PG8_SA(0, 1), a2 + hstep, voffA);
            PG8_WAIT_L(8); PG8_BAR; PG8_WAIT_L(0); PG8_MMA(0, 0, At, B0); PG8_BAR; PG8_SCHED;
            PG8_LDB(B1, 1, 1); PG8_STAGE(PG8_SB(1, 0), b3, voffB);
            PG8_BAR; PG8_WAIT_L(0); PG8_MMA(0, 1, At, B1); PG8_BAR;
            PG8_LDA(At, 1, 1); PG8_STAGE(PG8_SA(1, 0), a3, voffA);
            PG8_BAR; PG8_WAIT_L(0); PG8_MMA(1, 0, At, B0); PG8_BAR; PG8_SCHED;
            PG8_STAGE(PG8_SB(1, 1), b3 + hstep, voffB);
            PG8_WAIT_V(6); PG8_BAR; PG8_MMA(1, 1, At, B1); PG8_BAR;
        }
        E(acc, cur, wr, wc, fr, fq);
        if (!has_next) break;
#pragma unroll
        for (int a = 0; a < 2; ++a)
#pragma unroll
            for (int b = 0; b < 2; ++b)
#pragma unroll
                for (int m = 0; m < 4; ++m)
#pragma unroll
                    for (int n = 0; n < 2; ++n) acc[a][b][m][n] = (f32x4){0.f, 0.f, 0.f, 0.f};
        cur = nxt; cA = nA; cB = nB; ++ui;
    }
    PG8_WAIT_V(0);
    if (wr == 0) PG8_BAR;
    PG8_BAR;
#undef PG8_SA
#undef PG8_SB
#undef PG8_STAGE
#undef PG8_LDA
#undef PG8_LDB
#undef PG8_MMA
#undef PG8_WAIT_V
#undef PG8_WAIT_L
#undef PG8_BAR
#undef PG8_SCHED
}

struct EpiBf16 {
    static constexpr bool PERM = true;
    bf16_t* O; int ldc;
    __device__ __forceinline__ void operator()(const f32x4 (&acc)[2][2][4][2], const Unit& u, int wr, int wc, int fr, int fq) const {
        const int row0 = u.pm * BM + wr * 64 + fr, col0 = u.pn * BM + wc * 32 + 8 * fq;
#pragma unroll
        for (int ai = 0; ai < 2; ++ai)
#pragma unroll
            for (int m = 0; m < 4; ++m) { bf16_t* rowp = O + (size_t)(row0 + ai * HALF + m * 16) * ldc + col0;
#pragma unroll
                for (int bj = 0; bj < 2; ++bj) { const f32x4 v0 = acc[ai][bj][m][0], v1 = acc[ai][bj][m][1];
                    u32x4 w; w.x = cvt_pk_bf16_asm(v0[0], v0[1]); w.y = cvt_pk_bf16_asm(v0[2], v0[3]); w.z = cvt_pk_bf16_asm(v1[0], v1[1]); w.w = cvt_pk_bf16_asm(v1[2], v1[3]);
                    *(u32x4*)(rowp + bj * HALF) = w; } }
    }
};
struct EpiResF32 {
    static constexpr bool PERM = false;
    const float* X; float* O; int ldc;
    __device__ __forceinline__ void operator()(const f32x4 (&acc)[2][2][4][2], const Unit& u, int wr, int wc, int fr, int fq) const {
        const int row0 = u.pm * BM + wr * 64 + fr, col0 = u.pn * BM + wc * 32 + 4 * fq;
#pragma unroll
        for (int ai = 0; ai < 2; ++ai)
#pragma unroll
            for (int m = 0; m < 4; ++m) { const size_t ro = (size_t)(row0 + ai * HALF + m * 16) * ldc + col0;
#pragma unroll
                for (int bj = 0; bj < 2; ++bj)
#pragma unroll
                    for (int n = 0; n < 2; ++n) { const f32x4 xv = *(const f32x4*)(X + ro + bj * HALF + n * 16);
                        *(f32x4*)(O + ro + bj * HALF + n * 16) = xv * ALPHA + acc[ai][bj][m][n]; } }
    }
};
#define DPP_SHR1(x) __builtin_bit_cast(float, __builtin_amdgcn_update_dpp(0, __builtin_bit_cast(int, (x)), 0x111, 0xf, 0xf, true))
#define DPP_SHR2(x) __builtin_bit_cast(float, __builtin_amdgcn_update_dpp(0, __builtin_bit_cast(int, (x)), 0x112, 0xf, 0xf, true))
#define DPP_SHL15(o, x) __builtin_bit_cast(float, __builtin_amdgcn_update_dpp(__builtin_bit_cast(int, (o)), __builtin_bit_cast(int, (x)), 0x10F, 0xf, 0xf, false))
#define DPP_SHL14(o, x) __builtin_bit_cast(float, __builtin_amdgcn_update_dpp(__builtin_bit_cast(int, (o)), __builtin_bit_cast(int, (x)), 0x10E, 0xf, 0xf, false))
struct EpiConvFfn {
    static constexpr bool PERM = true;
    bf16_t* act; float* halo; const float* cw; const float* cb;
    __device__ __forceinline__ void operator()(const f32x4 (&acc)[2][2][4][2], const Unit& u, int wr, int wc, int fr, int fq) const {
        const int fcol = u.pn * 128 + wc * 32 + 8 * fq;
#pragma unroll
        for (int ai = 0; ai < 2; ++ai) {
            float* hb = halo + (size_t)((u.pm * BM + ai * HALF + wr * 64) >> 6) * 4 * NUP + fcol;
            if (fr < 2) {
#pragma unroll
                for (int bj = 0; bj < 2; ++bj)
#pragma unroll
                    for (int n = 0; n < 2; ++n) *(f32x4*)(hb + (size_t)(2 + fr) * NUP + bj * DFF + 4 * n) = acc[ai][bj][0][n];
            }
            if (fr >= 14) {
#pragma unroll
                for (int bj = 0; bj < 2; ++bj)
#pragma unroll
                    for (int n = 0; n < 2; ++n) *(f32x4*)(hb + (size_t)(fr - 14) * NUP + bj * DFF + 4 * n) = acc[ai][bj][3][n];
            }
        }
        u32x2 pk0[2][4];
#pragma unroll
        for (int n = 0; n < 2; ++n) {
            f32x4 W0[2], W1[2], W2[2], Bb[2];
#pragma unroll
            for (int bj = 0; bj < 2; ++bj) { const int hc = bj * DFF + fcol + 4 * n;
                W0[bj] = *(const f32x4*)(cw + hc); W1[bj] = *(const f32x4*)(cw + NUP + hc); W2[bj] = *(const f32x4*)(cw + 2 * NUP + hc); Bb[bj] = *(const f32x4*)(cb + hc); }
#pragma unroll
            for (int ai = 0; ai < 2; ++ai) {
                const int rbase = u.pm * BM + ai * HALF + wr * 64;
#pragma unroll
                for (int m = 0; m < 4; ++m) {
                    float av[4];
#pragma unroll
                    for (int j = 0; j < 4; ++j) {
                        float hc[2];
#pragma unroll
                        for (int bj = 0; bj < 2; ++bj) {
                            const float cur = acc[ai][bj][m][n][j];
                            float p1 = DPP_SHR1(cur), p2 = DPP_SHR2(cur);
                            if (m > 0) { const float pv = acc[ai][bj][m > 0 ? m - 1 : 0][n][j]; p1 = DPP_SHL15(p1, pv); p2 = DPP_SHL14(p2, pv); }
                            hc[bj] = W2[bj][j] * cur + W1[bj][j] * p1 + W0[bj][j] * p2 + Bb[bj][j];
                        }
                        const float gt = hc[1];
                        av[j] = hc[0] * gt * __builtin_amdgcn_rcpf(1.0f + __expf(-gt));
                    }
                    u32x2 pk; pk.x = cvt_pk_bf16_asm(av[0], av[1]); pk.y = cvt_pk_bf16_asm(av[2], av[3]);
                    if (n == 0) pk0[ai][m] = pk;
                    else if (m > 0 || fr >= 2) { u32x4 w; w.x = pk0[ai][m].x; w.y = pk0[ai][m].y; w.z = pk.x; w.w = pk.y;
                        *(u32x4*)(act + (size_t)(rbase + m * 16 + fr) * DFF + fcol) = w; }
                }
            }
            asm volatile("" ::: "memory");
        }
    }
};
}

template <bool UPMAP>
__device__ __forceinline__ void transpose_macro(const float* W, int ldw, int k0, int n0, bf16_t* Wt, int ldt, unsigned char* lds) {
    bf16_t* sT = (bf16_t*)lds; const int tid = threadIdx.x;
    float4 v[2][4];
#pragma unroll
    for (int i = 0; i < 2; ++i)
#pragma unroll
        for (int j = 0; j < 4; ++j) v[i][j] = *(const float4*)(W + (size_t)(k0 + (tid >> 4) + 32 * i) * ldw + n0 + 64 * j + (tid & 15) * 4);
#pragma unroll
    for (int i = 0; i < 2; ++i)
#pragma unroll
        for (int j = 0; j < 4; ++j) { const int k = (tid >> 4) + 32 * i, n = 64 * j + (tid & 15) * 4;
            sT[(n + 0) * 66 + k] = f2bf(v[i][j].x); sT[(n + 1) * 66 + k] = f2bf(v[i][j].y); sT[(n + 2) * 66 + k] = f2bf(v[i][j].z); sT[(n + 3) * 66 + k] = f2bf(v[i][j].w); }
    __syncthreads();
#pragma unroll
    for (int j = 0; j < 4; ++j) { const int n = 64 * j + (tid >> 3), ks = (tid & 7) * 8; const unsigned* p = (const unsigned*)(sT + n * 66 + ks);
        u32x4 o; o.x = p[0]; o.y = p[1]; o.z = p[2]; o.w = p[3];
        int drow = n0 + n;
        if (UPMAP) { const int f = (drow < DFF) ? drow : drow - DFF; drow = 256 * (f >> 7) + (f & 127) + ((drow < DFF) ? 0 : 128); }
        *(u32x4*)(Wt + (size_t)drow * ldt + k0 + ks) = o; }
    __syncthreads();
}
constexpr int TM_IN = 32 * 28, TM_OUT = 32 * 8, TM_UP = 32 * 44, TM_DN = 88 * 8;
__device__ __forceinline__ void phase_transposes(const Args& A, unsigned char* lds, int g0, int g1, int worker, int nworkers) {
    unsigned char* ws = A.ws;
    for (int g = g0 + worker; g < g1; g += nworkers) {
        if (g < TM_IN) { const int tk = g / 28, tn = g % 28; transpose_macro<false>(A.w_in, NIN, tk * 64, tn * 256, (bf16_t*)(ws + WS_WIN), DM, lds); }
        else if (g < TM_IN + TM_OUT) { const int h = g - TM_IN, tk = h / 8, tn = h % 8; transpose_macro<false>(A.w_out, DM, tk * 64, tn * 256, (bf16_t*)(ws + WS_WOUT), DM, lds); }
        else if (g < TM_IN + TM_OUT + TM_UP) { const int h = g - TM_IN - TM_OUT, tk = h / 44, tn = h % 44; transpose_macro<true>(A.w_up, NUP, tk * 64, tn * 256, (bf16_t*)(ws + WS_WUP), DM, lds); }
        else { const int h = g - TM_IN - TM_OUT - TM_UP, tk = h / 8, tn = h % 8; transpose_macro<false>(A.w_down, DM, tk * 64, tn * 256, (bf16_t*)(ws + WS_WDN), DFF, lds); }
    }
}
__device__ __forceinline__ void phase_prologue(const Args& A, unsigned char* lds) {
    unsigned char* ws = A.ws;
    phase_transposes(A, lds, 0, TM_IN, blockIdx.x, gridDim.x);
    const int lane = threadIdx.x & 63, gw = blockIdx.x * 8 + (threadIdx.x >> 6), nw = gridDim.x * 8;
    bf16_t* xb = (bf16_t*)(ws + WS_XB); float* gates = (float*)(ws + WS_GATES);
    for (int it = gw; it < MT / 4; it += nw) {
        const int r0 = it * 4;
        float acc[4][8];
#pragma unroll
        for (int r = 0; r < 4; ++r)
#pragma unroll
            for (int q = 0; q < 8; ++q) acc[r][q] = 0.f;
#pragma unroll 1
        for (int i = 0; i < 8; ++i) {
            const int kb = i * 256 + lane * 4;
            f32x4 xv[4];
#pragma unroll
            for (int r = 0; r < 4; ++r) { xv[r] = *(const f32x4*)(A.x + (size_t)(r0 + r) * DM + kb);
                u32x2 o; o.x = cvt_pk_bf16(xv[r][0], xv[r][1]); o.y = cvt_pk_bf16(xv[r][2], xv[r][3]); *(u32x2*)(xb + (size_t)(r0 + r) * DM + kb) = o; }
#pragma unroll
            for (int j = 0; j < 4; ++j) {
                const f32x4* wp = (const f32x4*)(A.w_in + (size_t)(kb + j) * NIN + NP);
                const f32x4 w0 = wp[0], w1 = wp[1];
#pragma unroll
                for (int r = 0; r < 4; ++r) { const float xs = xv[r][j];
                    acc[r][0] += xs * w0[0]; acc[r][1] += xs * w0[1]; acc[r][2] += xs * w0[2]; acc[r][3] += xs * w0[3];
                    acc[r][4] += xs * w1[0]; acc[r][5] += xs * w1[1]; acc[r][6] += xs * w1[2]; acc[r][7] += xs * w1[3]; }
            }
        }
#pragma unroll
        for (int r = 0; r < 4; ++r)
#pragma unroll
            for (int q = 0; q < 8; ++q) { float v = acc[r][q];
#pragma unroll
                for (int off = 32; off >= 1; off >>= 1) v += __shfl_xor(v, off);
                acc[r][q] = v; }
        if (lane == 0) {
            const f32x4 b0 = *(const f32x4*)(A.b_gates), b1 = *(const f32x4*)(A.b_gates + 4);
#pragma unroll
            for (int r = 0; r < 4; ++r) {
                *(f32x4*)(gates + (size_t)(r0 + r) * 8) = (f32x4){acc[r][0] + b0[0], acc[r][1] + b0[1], acc[r][2] + b0[2], acc[r][3] + b0[3]};
                *(f32x4*)(gates + (size_t)(r0 + r) * 8 + 4) = (f32x4){acc[r][4] + b1[0], acc[r][5] + b1[1], acc[r][6] + b1[2], acc[r][7] + b1[3]}; }
        }
    }
}

__device__ __forceinline__ void phase_yconv(const Args& A) {
    const bf16_t* proj = (const bf16_t*)(A.ws + WS_PROJ); bf16_t* y = (bf16_t*)(A.ws + WS_Y);
    for (int idx = blockIdx.x * 512 + threadIdx.x; idx < MT * 128; idx += gridDim.x * 512) {
        const int row = idx >> 7, c = (idx & 127) * 8, t = row & (SEQ - 1);
        const bf16_t* pr = proj + (size_t)row * NP + c;
        const u32x4 bv = *(const u32x4*)pr;
        float cv[8];
#pragma unroll
        for (int i = 0; i < 8; ++i) cv[i] = 0.f;
#pragma unroll
        for (int j = 0; j < 3; ++j) {
            const int dt = 2 - j;
            if (t - dt >= 0) {
                const u32x4 cc = *(const u32x4*)(pr - (size_t)dt * NP + WCONV), hh = *(const u32x4*)(pr - (size_t)dt * NP + 2 * WCONV);
                const f32x4 w0 = *(const f32x4*)(A.w_sc + j * WCONV + c), w1 = *(const f32x4*)(A.w_sc + j * WCONV + c + 4);
                const float wv[8] = {w0[0], w0[1], w0[2], w0[3], w1[0], w1[1], w1[2], w1[3]};
#pragma unroll
                for (int q = 0; q < 4; ++q) { cv[2 * q] += wv[2 * q] * bflo(cc[q]) * bflo(hh[q]); cv[2 * q + 1] += wv[2 * q + 1] * bfhi(cc[q]) * bfhi(hh[q]); }
            }
        }
        u32x4 o;
#pragma unroll
        for (int q = 0; q < 4; ++q) o[q] = cvt_pk_bf16(bflo(bv[q]) * cv[2 * q], bfhi(bv[q]) * cv[2 * q + 1]);
        *(u32x4*)(y + (size_t)row * DM + c) = o;
    }
}

__device__ __forceinline__ void phase_mlstm(const Args& A, unsigned char* lds, float* hbuf) {
    const int tid = threadIdx.x, lane = tid & 63, w = tid >> 6, g = lane >> 4, l15 = lane & 15;
    const int a = w >> 2, ti = w & 3;
    unsigned char* QS = lds; unsigned char* KS = lds + 33792; unsigned char* VT = lds + 67584; unsigned char* WVT = VT + 4608; unsigned char* CT = WVT + 4608; unsigned char* XCH = CT + 33792;
    const bf16_t* proj = (const bf16_t*)(A.ws + WS_PROJ); const float* gates = (const float*)(A.ws + WS_GATES);
    for (int item = blockIdx.x; item < 256; item += gridDim.x) {
        const int xcd = item & 7, idx = item >> 3; const int bh = xcd * 2 + (idx >> 4), es = idx & 15;
        const int b = bh >> 2, hh = bh & 3, e0 = es * 16;
        const size_t row0 = (size_t)b * SEQ;
        __syncthreads();
        for (int i = tid; i < 16896 / 4; i += 512) ((unsigned*)CT)[i] = 0u;
        for (int i = tid; i < 16 * 72; i += 512) { const int r = 16 + i / 72, ci = i % 72; ((bf16_t*)VT)[r * 72 + ci] = (r == 16) ? (bf16_t)0x3F80 : (bf16_t)0; ((bf16_t*)WVT)[r * 72 + ci] = 0; }
        f32x4 Cst[2][2];
#pragma unroll
        for (int x = 0; x < 2; ++x)
#pragma unroll
            for (int et = 0; et < 2; ++et) Cst[x][et] = (f32x4){0.f, 0.f, 0.f, 0.f};
        float m_state = 0.f;
        u32x4 qr[4], kr[4], vr = (u32x4){0u, 0u, 0u, 0u}; float gi, gf;
        const bf16_t* qbase = proj + row0 * NP + 3072 + hh * 256;
#define ML_LOAD(c) do { _Pragma("unroll") for (int i = 0; i < 4; ++i) { const int p = tid + 512 * i, r = p >> 5, c16 = p & 31; const bf16_t* rp = qbase + (size_t)((c) * 64 + r) * NP + c16 * 8; \
            qr[i] = *(const u32x4*)rp; kr[i] = *(const u32x4*)(rp + 1024); } \
            if (tid < 128) vr = *(const u32x4*)(qbase + (size_t)((c) * 64 + (tid >> 1)) * NP + 2048 + e0 + (tid & 1) * 8); \
            { const float* gp = gates + (row0 + (c) * 64 + lane) * 8 + hh; gi = gp[0]; gf = gp[4]; } } while (0)
        ML_LOAD(0);
#pragma unroll 1
        for (int c = 0; c < 32; ++c) {
            const float lf = fminf(gf, 0.f) - log1pf(__expf(-fabsf(gf)));
            float bc = lf;
#pragma unroll
            for (int off = 1; off < 64; off <<= 1) { const float t = __shfl_up(bc, off); if (lane >= off) bc += t; }
            const float uv = gi - bc;
            float cm = uv;
#pragma unroll
            for (int off = 1; off < 64; off <<= 1) { const float t = __shfl_up(cm, off); if (lane >= off) cm = fmaxf(cm, t); }
            const float g_tot = __shfl(bc, 63), cm63 = __shfl(cm, 63);
            const float Mv = fmaxf(m_state, cm), M63 = fmaxf(m_state, cm63);
            const float w_s = __expf(uv - M63), decay = __expf(m_state - M63);
            const float interw = __expf(m_state - Mv) * 0.0625f, floorv = __expf(-(bc + Mv));
            m_state = g_tot + M63;
#pragma unroll
            for (int i = 0; i < 4; ++i) { const int p = tid + 512 * i, r = p >> 5, c16 = p & 31; *(u32x4*)(QS + r * 528 + c16 * 16) = qr[i]; *(u32x4*)(KS + r * 528 + c16 * 16) = kr[i]; }
            { const float wv = __shfl(w_s, (tid >> 1) & 63);
              if (tid < 128) { const int s = tid >> 1, hf = tid & 1;
#pragma unroll
                  for (int q = 0; q < 4; ++q) { const float v0 = bflo(vr[q]), v1 = bfhi(vr[q]);
                      ((bf16_t*)VT)[(8 * hf + 2 * q) * 72 + s] = (bf16_t)(vr[q] & 0xffffu); ((bf16_t*)VT)[(8 * hf + 2 * q + 1) * 72 + s] = (bf16_t)(vr[q] >> 16);
                      ((bf16_t*)WVT)[(8 * hf + 2 * q) * 72 + s] = f2bf(v0 * wv); ((bf16_t*)WVT)[(8 * hf + 2 * q + 1) * 72 + s] = f2bf(v1 * wv); } }
              if (w == 2) ((bf16_t*)WVT)[16 * 72 + lane] = f2bf(w_s); }
            if (c + 1 < 32) ML_LOAD(c + 1);
            __syncthreads();
            bf16x8 qf[8]; f32x4 S0 = (f32x4){0.f, 0.f, 0.f, 0.f}, S1 = S0;
#pragma unroll
            for (int kk = 0; kk < 8; ++kk) {
                qf[kk] = *(const bf16x8*)(QS + (16 * ti + l15) * 528 + kk * 64 + g * 16);
                const bf16x8 kf0 = *(const bf16x8*)(KS + (32 * a + l15) * 528 + kk * 64 + g * 16), kf1 = *(const bf16x8*)(KS + (32 * a + 16 + l15) * 528 + kk * 64 + g * 16);
                S0 = __builtin_amdgcn_mfma_f32_16x16x32_bf16(kf0, qf[kk], S0, 0, 0, 0); S1 = __builtin_amdgcn_mfma_f32_16x16x32_bf16(kf1, qf[kk], S1, 0, 0, 0);
            }
            const int tcol = 16 * ti + l15;
            const float Mt = __shfl(Mv, tcol);
            float p[8];
#pragma unroll
            for (int r = 0; r < 4; ++r) { const int s0 = 32 * a + 4 * g + r, s1 = s0 + 16; const float u0 = __shfl(uv, s0), u1 = __shfl(uv, s1);
                p[r] = (s0 <= tcol) ? S0[r] * 0.0625f * __expf(u0 - Mt) : 0.f; p[4 + r] = (s1 <= tcol) ? S1[r] * 0.0625f * __expf(u1 - Mt) : 0.f; }
            u32x4 pau; pau.x = cvt_pk_bf16(p[0], p[1]); pau.y = cvt_pk_bf16(p[2], p[3]); pau.z = cvt_pk_bf16(p[4], p[5]); pau.w = cvt_pk_bf16(p[6], p[7]);
            const bf16x8 pa = __builtin_bit_cast(bf16x8, pau);
            f32x4 rr[2];
#pragma unroll
            for (int et = 0; et < 2; ++et) { const unsigned char* vp = VT + (16 * et + l15) * 144 + (32 * a + 4 * g) * 2;
                const u32x2 lo = *(const u32x2*)vp, hi = *(const u32x2*)(vp + 32);
                u32x4 vbu; vbu.x = lo.x; vbu.y = lo.y; vbu.z = hi.x; vbu.w = hi.y;
                rr[et] = __builtin_amdgcn_mfma_f32_16x16x32_bf16(pa, __builtin_bit_cast(bf16x8, vbu), (f32x4){0.f, 0.f, 0.f, 0.f}, 0, 0, 0); }
            {
                const unsigned char* CTc = CT + (c & 1) * 16896;
                f32x4 in0 = (f32x4){0.f, 0.f, 0.f, 0.f}, in1 = in0;
#pragma unroll
                for (int k2 = 0; k2 < 4; ++k2) {
                    const bf16x8 qa = a ? qf[4 + k2] : qf[k2];
                    const bf16x8 c0 = *(const bf16x8*)(CTc + (l15) * 528 + (128 * a + 32 * k2 + 8 * g) * 2), c1 = *(const bf16x8*)(CTc + (16 + l15) * 528 + (128 * a + 32 * k2 + 8 * g) * 2);
                    in0 = __builtin_amdgcn_mfma_f32_16x16x32_bf16(qa, c0, in0, 0, 0, 0); in1 = __builtin_amdgcn_mfma_f32_16x16x32_bf16(qa, c1, in1, 0, 0, 0);
                }
#pragma unroll
                for (int r = 0; r < 4; ++r) { const float iw = __shfl(interw, 16 * ti + 4 * g + r); rr[0][r] += in0[r] * iw; rr[1][r] += in1[r] * iw; }
            }
            if (a == 1) { *(f32x4*)(XCH + ((ti * 2 + 0) * 64 + lane) * 16) = rr[0]; *(f32x4*)(XCH + ((ti * 2 + 1) * 64 + lane) * 16) = rr[1]; }
            {
                unsigned char* CTn = CT + ((c + 1) & 1) * 16896;
#pragma unroll
                for (int x = 0; x < 2; ++x) {
                    const int dt = 2 * w + x;
#pragma unroll
                    for (int et = 0; et < 2; ++et) Cst[x][et] *= decay;
#pragma unroll
                    for (int ks = 0; ks < 2; ++ks) {
                        bf16x8 ka;
#pragma unroll
                        for (int jj = 0; jj < 8; ++jj) ka[jj] = (short)*(const bf16_t*)(KS + (32 * ks + 8 * g + jj) * 528 + (16 * dt + l15) * 2);
#pragma unroll
                        for (int et = 0; et < 2; ++et) { const bf16x8 wvb = *(const bf16x8*)(WVT + (16 * et + l15) * 144 + (32 * ks + 8 * g) * 2);
                            Cst[x][et] = __builtin_amdgcn_mfma_f32_16x16x32_bf16(ka, wvb, Cst[x][et], 0, 0, 0); }
                    }
#pragma unroll
                    for (int et = 0; et < 2; ++et) { u32x2 o; o.x = cvt_pk_bf16(Cst[x][et][0], Cst[x][et][1]); o.y = cvt_pk_bf16(Cst[x][et][2], Cst[x][et][3]);
                        *(u32x2*)(CTn + (16 * et + l15) * 528 + (16 * dt + 4 * g) * 2) = o; }
                }
            }
            __syncthreads();
            if (a == 0) {
                const f32x4 o0 = *(const f32x4*)(XCH + ((ti * 2 + 0) * 64 + lane) * 16), o1 = *(const f32x4*)(XCH + ((ti * 2 + 1) * 64 + lane) * 16);
#pragma unroll
                for (int r = 0; r < 4; ++r) {
                    const float den = __shfl(rr[1][r] + o1[r], lane & 48), fl = __shfl(floorv, 16 * ti + 4 * g + r);
                    const float hv = (rr[0][r] + o0[r]) / fmaxf(fabsf(den), fl);
                    hbuf[(row0 + c * 64 + 16 * ti + 4 * g + r) * 1024 + hh * 256 + e0 + l15] = hv;
                }
            }
        }
#undef ML_LOAD
    }
}

__device__ __forceinline__ void phase_headnorm(const Args& A, const float* hbuf) {
    const bf16_t* proj = (const bf16_t*)(A.ws + WS_PROJ); bf16_t* y = (bf16_t*)(A.ws + WS_Y);
    const int lane = threadIdx.x & 63, gw = blockIdx.x * 8 + (threadIdx.x >> 6), nw = gridDim.x * 8;
    for (int it = gw; it < MT * 4; it += nw) {
        const int row = it >> 2, hh = it & 3;
        const f32x4 hv = *(const f32x4*)(hbuf + (size_t)row * 1024 + hh * 256 + lane * 4);
        float s = (hv[0] + hv[1]) + (hv[2] + hv[3]);
#pragma unroll
        for (int off = 32; off >= 1; off >>= 1) s += __shfl_xor(s, off);
        const float mu = s * (1.0f / 256.0f);
        const f32x4 d = hv - mu;
        float q = (d[0] * d[0] + d[1] * d[1]) + (d[2] * d[2] + d[3] * d[3]);
#pragma unroll
        for (int off = 32; off >= 1; off >>= 1) q += __shfl_xor(q, off);
        const float rstd = rsqrtf(q * (1.0f / 256.0f) + 1e-6f);
        const f32x4 gn = *(const f32x4*)(A.mh_gain + hh * 256 + lane * 4);
        const u32x2 ov = *(const u32x2*)(proj + (size_t)row * NP + 6144 + hh * 256 + lane * 4);
        const float o0 = bflo(ov.x), o1 = bfhi(ov.x), o2 = bflo(ov.y), o3 = bfhi(ov.y);
        const float y0 = d[0] * rstd * gn[0] / (1.0f + __expf(-o0)), y1 = d[1] * rstd * gn[1] / (1.0f + __expf(-o1));
        const float y2 = d[2] * rstd * gn[2] / (1.0f + __expf(-o2)), y3 = d[3] * rstd * gn[3] / (1.0f + __expf(-o3));
        u32x2 o; o.x = cvt_pk_bf16(y0, y1); o.y = cvt_pk_bf16(y2, y3);
        *(u32x2*)(y + (size_t)row * DM + WCONV + hh * 256 + lane * 4) = o;
    }
}

__device__ __forceinline__ void phase_ln(float* io, const float* gam, const float* bet, bf16_t* ob) {
    const int lane = threadIdx.x & 63, gw = blockIdx.x * 8 + (threadIdx.x >> 6), nw = gridDim.x * 8;
    for (int row = gw; row < MT; row += nw) {
        float* rp = io + (size_t)row * DM;
        f32x4 v[8]; float s = 0.f;
#pragma unroll
        for (int i = 0; i < 8; ++i) { v[i] = *(const f32x4*)(rp + i * 256 + lane * 4); s += (v[i][0] + v[i][1]) + (v[i][2] + v[i][3]); }
#pragma unroll
        for (int off = 32; off >= 1; off >>= 1) s += __shfl_xor(s, off);
        const float mu = s * (1.0f / DM);
        float q = 0.f;
#pragma unroll
        for (int i = 0; i < 8; ++i) { v[i] = v[i] - mu; q += (v[i][0] * v[i][0] + v[i][1] * v[i][1]) + (v[i][2] * v[i][2] + v[i][3] * v[i][3]); }
#pragma unroll
        for (int off = 32; off >= 1; off >>= 1) q += __shfl_xor(q, off);
        const float rstd = rsqrtf(q * (1.0f / DM) + 1e-5f);
#pragma unroll
        for (int i = 0; i < 8; ++i) { const f32x4 gg = *(const f32x4*)(gam + i * 256 + lane * 4), bb = *(const f32x4*)(bet + i * 256 + lane * 4);
            const f32x4 o = v[i] * rstd * gg + bb;
            *(f32x4*)(rp + i * 256 + lane * 4) = o;
            if (ob) { u32x2 p; p.x = cvt_pk_bf16(o[0], o[1]); p.y = cvt_pk_bf16(o[2], o[3]); *(u32x2*)(ob + (size_t)row * DM + i * 256 + lane * 4) = p; } }
    }
}

__device__ __forceinline__ void phase_fixup(const Args& A) {
    const float* halo = (const float*)(A.ws + WS_HALO); bf16_t* act = (bf16_t*)(A.ws + WS_ACT);
    for (int idx = blockIdx.x * 512 + threadIdx.x; idx < 128 * 2 * (DFF / 4); idx += gridDim.x * 512) {
        const int f = (idx % (DFF / 4)) * 4, br = idx / (DFF / 4), rr = br & 1, B = br >> 1;
        const bool first = (B & 31) == 0;
        const float* hc = halo + (size_t)B * 4 * NUP; const float* hp = hc - 4 * NUP;
        f32x4 hv[2];
#pragma unroll
        for (int bj = 0; bj < 2; ++bj) {
            const int col = bj * DFF + f;
            const f32x4 cur = *(const f32x4*)(hc + (size_t)(2 + rr) * NUP + col);
            f32x4 p1, p2; const f32x4 z = (f32x4){0.f, 0.f, 0.f, 0.f};
            if (rr == 0) { p1 = first ? z : *(const f32x4*)(hp + (size_t)1 * NUP + col); p2 = first ? z : *(const f32x4*)(hp + col); }
            else { p1 = *(const f32x4*)(hc + (size_t)2 * NUP + col); p2 = first ? z : *(const f32x4*)(hp + (size_t)1 * NUP + col); }
            const f32x4 w0 = *(const f32x4*)(A.w_fc + col), w1 = *(const f32x4*)(A.w_fc + NUP + col), w2 = *(const f32x4*)(A.w_fc + 2 * NUP + col), bb = *(const f32x4*)(A.b_fc + col);
            hv[bj] = w2 * cur + w1 * p1 + w0 * p2 + bb;
        }
        float av[4];
#pragma unroll
        for (int j = 0; j < 4; ++j) { const float gt = hv[1][j]; av[j] = hv[0][j] * gt / (1.0f + __expf(-gt)); }
        u32x2 o; o.x = cvt_pk_bf16(av[0], av[1]); o.y = cvt_pk_bf16(av[2], av[3]);
        *(u32x2*)(act + (size_t)(B * 64 + rr) * DFF + f) = o;
    }
}

__device__ __forceinline__ void phase_dump(const bf16_t* src, int ld, int c0, float* out) {
    for (size_t idx = (size_t)blockIdx.x * 512 + threadIdx.x; idx < (size_t)MT * DM; idx += (size_t)gridDim.x * 512) {
        const size_t row = idx / DM, col = idx % DM; out[idx] = bflo((unsigned)src[row * ld + c0 + col]); }
}
#ifndef DBG_STOP
#define DBG_STOP -1
#endif
#define XB_TMO      128
#define XB_XCNT(j)  (256  + 64 * (j))
#define XB_XSUB(j)  (1280 + 64 * (j))
#define XB_XGEN(j)  (2304 + 64 * (j))
#define XB_TOP      3328
#define XB_TOPGEN   3392
#define XCD_BAR_WORDS 3456
#define XB_SPIN_CAP (1u << 22)
__device__ __forceinline__ unsigned xb_ld(unsigned* p)              { return __hip_atomic_load(p, __ATOMIC_RELAXED, __HIP_MEMORY_SCOPE_AGENT); }
__device__ __forceinline__ unsigned xb_add(unsigned* p, unsigned v) { return __hip_atomic_fetch_add(p, v, __ATOMIC_RELAXED, __HIP_MEMORY_SCOPE_AGENT); }
__device__ __forceinline__ unsigned xb_xcc_id() { return (unsigned)__builtin_amdgcn_s_getreg((3 << 11) | 20) & 0xFu; }
#define XB_SPIN(cond, bar) do { unsigned _sp = 0; while (cond) { __builtin_amdgcn_s_sleep(1); \
    if ((++_sp & 255u) == 0u) { if (xb_ld(&(bar)[XB_TMO])) break; if (_sp > XB_SPIN_CAP) { atomicAdd(&(bar)[XB_TMO], 1u); break; } } } } while (0)
struct XcdBarrier { unsigned* bar; unsigned x; volatile LAS unsigned* st; };
__device__ __forceinline__ XcdBarrier xcd_barrier_post(unsigned* bar, volatile LAS unsigned* st) {
    XcdBarrier b; b.bar = bar; b.x = xb_xcc_id(); b.st = st;
    if (threadIdx.x == 0) (void)xb_add(&bar[XB_XCNT(b.x)], 1u);
    return b;
}
__device__ __forceinline__ void xcd_barrier_complete(unsigned* bar, unsigned x, unsigned& nloc, unsigned& nx) {
    const unsigned G = gridDim.x * gridDim.y * gridDim.z;
    unsigned sum, cnt, mine, sp = 0u;
    for (;;) {
        sum = 0u; cnt = 0u; mine = 0u;
#pragma unroll
        for (unsigned j = 0; j < 16; ++j) { const unsigned c = xb_ld(&bar[XB_XCNT(j)]); sum += c; cnt += (c > 0u) ? 1u : 0u; mine = (j == x) ? c : mine; }
        if (sum == G) break;
        __builtin_amdgcn_s_sleep(1);
        if ((++sp & 255u) == 0u) { if (xb_ld(&bar[XB_TMO])) break; if (sp > XB_SPIN_CAP) { atomicAdd(&bar[XB_TMO], 1u); break; } }
    }
    nloc = mine > 0u ? mine : 1u; nx = cnt > 0u ? cnt : 1u;
}
__device__ __forceinline__ void xcd_barrier(const XcdBarrier& b) {
    asm volatile("s_waitcnt vmcnt(0)" ::: "memory");
    __syncthreads();
    if (threadIdx.x == 0) {
        unsigned* bar = b.bar;
        __builtin_amdgcn_s_waitcnt(0);
        unsigned nloc = b.st[0], nx = b.st[1];
        if (nloc == 0u) { xcd_barrier_complete(bar, b.x, nloc, nx); b.st[0] = nloc; b.st[1] = nx; }
        const unsigned old = xb_add(&bar[XB_XSUB(b.x)], 1u);
        const unsigned gen = old / nloc;
        if (old + 1u == (gen + 1u) * nloc) {
            __builtin_amdgcn_fence(__ATOMIC_RELEASE, "agent");
            asm volatile("s_waitcnt vmcnt(0)" ::: "memory");
            const unsigned og = xb_add(&bar[XB_TOP], 1u);
            const unsigned tg = og / nx;
            if (og + 1u == (tg + 1u) * nx) xb_add(&bar[XB_TOPGEN], 1u);
            else XB_SPIN(xb_ld(&bar[XB_TOPGEN]) == tg, bar);
            __builtin_amdgcn_fence(__ATOMIC_ACQUIRE, "agent");
            xb_add(&bar[XB_XGEN(b.x)], 1u);
            asm volatile("s_waitcnt vmcnt(0)" ::: "memory");
        } else {
            XB_SPIN(xb_ld(&bar[XB_XGEN(b.x)]) == gen, bar);
            __builtin_amdgcn_fence(__ATOMIC_ACQUIRE, "agent");
            asm volatile("s_waitcnt vmcnt(0)" ::: "memory");
        }
    }
    __syncthreads();
}

constexpr int N_PHASES = 10;
#ifndef ONLY_PH
#define ONLY_PH -1
#endif
#define PH_ON(x) (ONLY_PH < 0 || ONLY_PH == (x))
__global__ void __launch_bounds__(512, 2) mega(Args a) {
    extern __shared__ __attribute__((aligned(16))) unsigned char lds[];
    cg::grid_group grid = cg::this_grid();
    unsigned char* ws = a.ws;
#define PH_RUN(x) (PH_ON(x) && a.ph_lo <= (x) && (x) < a.ph_hi)
#define PH_SYNC(x) do { if (a.ph_lo <= (x) && (x) + 1 < a.ph_hi) xcd_barrier(xb); } while (0)
    volatile LAS unsigned* xst = (volatile LAS unsigned*)((LAS unsigned char*)lds + 131072);
    if (threadIdx.x == 0) { xst[0] = 0u; xst[1] = 0u; }
    __syncthreads();
    const XcdBarrier xb = xcd_barrier_post((unsigned*)(ws + WS_BAR), xst);
    if (a.ph_hi > 1000) grid.sync();
#ifndef REP0
#define REP0 1
#endif
#ifndef REP2
#define REP2 1
#endif
#ifndef REP6
#define REP6 1
#endif
    if (PH_RUN(0)) for (int rep = 0; rep < REP0; ++rep) phase_prologue(a, lds);
    PH_SYNC(0);
    if (PH_RUN(1)) { pg8::Gemm g{(const bf16_t*)(ws + WS_XB), (const bf16_t*)(ws + WS_WIN), MT, NP, DM}; pg8::StaticOrder S; S.init(MT, NP, gridDim.x, blockIdx.x);
        pg8::EpiBf16 E{(bf16_t*)(ws + WS_PROJ), NP}; pg8::gemm_phase((LAS unsigned char*)lds, g, S, E);
        const int rem = ((MT / 256) * (NP / 256)) % (int)gridDim.x;
        if (rem == 0) phase_transposes(a, lds, TM_IN, TM_IN + TM_OUT + TM_UP + TM_DN, blockIdx.x, gridDim.x);
        else if ((int)blockIdx.x >= rem) phase_transposes(a, lds, TM_IN, TM_IN + TM_OUT + TM_UP + TM_DN, blockIdx.x - rem, gridDim.x - rem); }
    PH_SYNC(1);
    if (PH_RUN(2)) for (int rep = 0; rep < REP2; ++rep) { phase_yconv(a); phase_mlstm(a, lds, a.out); }
    PH_SYNC(2);
    if (PH_RUN(3)) phase_headnorm(a, a.out);
    PH_SYNC(3);
    if (PH_RUN(4)) { pg8::Gemm g{(const bf16_t*)(ws + WS_Y), (const bf16_t*)(ws + WS_WOUT), MT, DM, DM}; pg8::StaticOrder S; S.init(MT, DM, gridDim.x, blockIdx.x);
        pg8::EpiResF32 E{a.x, a.out, DM}; pg8::gemm_phase((LAS unsigned char*)lds, g, S, E); }
    PH_SYNC(4);
    if (PH_RUN(5)) phase_ln(a.out, a.ln1_g, a.ln1_b, (bf16_t*)(ws + WS_X1B));
    PH_SYNC(5);
    if (PH_RUN(6)) { pg8::Gemm g{(const bf16_t*)(ws + WS_X1B), (const bf16_t*)(ws + WS_WUP), MT, NUP, DM}; pg8::StaticOrder S; S.init(MT, NUP, gridDim.x, blockIdx.x);
        pg8::EpiConvFfn E{(bf16_t*)(ws + WS_ACT), (float*)(ws + WS_HALO), a.w_fc, a.b_fc}; pg8::gemm_phase((LAS unsigned char*)lds, g, S, E); }
    PH_SYNC(6);
    if (PH_RUN(7)) phase_fixup(a);
    PH_SYNC(7);
    if (PH_RUN(8)) { pg8::Gemm g{(const bf16_t*)(ws + WS_ACT), (const bf16_t*)(ws + WS_WDN), MT, DM, DFF}; pg8::StaticOrder S; S.init(MT, DM, gridDim.x, blockIdx.x);
        pg8::EpiResF32 E{a.out, a.out, DM}; pg8::gemm_phase((LAS unsigned char*)lds, g, S, E); }
    PH_SYNC(8);
    if (PH_RUN(9)) phase_ln(a.out, a.ln2_g, a.ln2_b, nullptr);
    if (DBG_STOP == 1 && a.ph_lo == 101) phase_dump((const bf16_t*)(ws + WS_PROJ), NP, 3072, a.out);
    if (DBG_STOP == 3 && a.ph_lo == 103) phase_dump((const bf16_t*)(ws + WS_Y), DM, 0, a.out);
    if (DBG_STOP == 7 && a.ph_lo == 107) phase_dump((const bf16_t*)(ws + WS_ACT), DFF, 0, a.out);
}

extern "C" void kernel_launch(void* const* d_in, const int* in_sizes, int n_in, void* d_out, int out_size, void* d_ws, size_t ws_size, hipStream_t stream) {
    static int grid = 0;
    if (grid == 0) {
        if (n_in != 14 || ws_size < WS_END) { fprintf(stderr, "kernel_launch: unexpected n_in %d / ws_size %zu (need %zu)\n", n_in, ws_size, (size_t)WS_END); grid = -1; return; }
        int dev = 0, cus = 0, per_cu = 0;
        hipGetDevice(&dev); hipDeviceGetAttribute(&cus, hipDeviceAttributeMultiprocessorCount, dev);
        if (hipFuncSetAttribute((const void*)mega, hipFuncAttributeMaxDynamicSharedMemorySize, LDS_BYTES) != hipSuccess) { fprintf(stderr, "kernel_launch: hipFuncSetAttribute failed\n"); grid = -1; return; }
        if (hipOccupancyMaxActiveBlocksPerMultiprocessor(&per_cu, (const void*)mega, 512, LDS_BYTES) != hipSuccess || per_cu < 1) { fprintf(stderr, "kernel_launch: occupancy query failed (%d)\n", per_cu); (void)hipGetLastError(); per_cu = 1; }
        grid = cus * 1;
        fprintf(stderr, "kernel_launch: cus %d per_cu %d grid %d\n", cus, per_cu, grid);
    }
    if (grid < 0) return;
    if (hipMemsetAsync((char*)d_ws + WS_BAR, 0, XCD_BAR_WORDS * 4, stream) != hipSuccess) { fprintf(stderr, "kernel_launch: memset failed\n"); return; }
    Args a{};
    a.x = (const float*)d_in[0]; a.w_in = (const float*)d_in[1]; a.b_gates = (const float*)d_in[2]; a.w_sc = (const float*)d_in[3]; a.mh_gain = (const float*)d_in[4]; a.w_out = (const float*)d_in[5];
    a.ln1_g = (const float*)d_in[6]; a.ln1_b = (const float*)d_in[7]; a.w_up = (const float*)d_in[8]; a.w_fc = (const float*)d_in[9]; a.b_fc = (const float*)d_in[10]; a.w_down = (const float*)d_in[11];
    a.ln2_g = (const float*)d_in[12]; a.ln2_b = (const float*)d_in[13];
    a.out = (float*)d_out; a.ws = (unsigned char*)d_ws;
#if MK_SINGLE
    a.ph_lo = 0; a.ph_hi = N_PHASES;
    void* args[] = {&a};
    hipError_t e = hipLaunchCooperativeKernel((const void*)mega, dim3(grid), dim3(512), args, LDS_BYTES, stream);
    if (e != hipSuccess) fprintf(stderr, "cooperative launch failed: %s (grid %d)\n", hipGetErrorString(e), grid);
#else
    for (int ph = 0; ph < N_PHASES; ++ph) { if (DBG_STOP >= 0 && ph > DBG_STOP) break; a.ph_lo = ph; a.ph_hi = ph + 1; hipLaunchKernelGGL(mega, dim3(grid), dim3(512), LDS_BYTES, stream, a); }
    if (DBG_STOP >= 0) { a.ph_lo = 100 + DBG_STOP; a.ph_hi = 101 + DBG_STOP; hipLaunchKernelGGL(mega, dim3(grid), dim3(512), LDS_BYTES, stream, a); }
#endif
}
```

```cpp
#include <hip/hip_runtime.h>
#include <hip/hip_cooperative_groups.h>
#include <cstdio>
#include <cstdint>
namespace cg = cooperative_groups;

#ifndef MK_SINGLE
#define MK_SINGLE 1
#endif

#define LAS __attribute__((address_space(3)))
typedef unsigned short bf16_t;
typedef short bf16x8 __attribute__((ext_vector_type(8)));
typedef float f32x4 __attribute__((ext_vector_type(4)));
typedef unsigned u32x4 __attribute__((ext_vector_type(4)));
typedef unsigned u32x2 __attribute__((ext_vector_type(2)));

constexpr int MT = 8192, DM = 2048, SEQ = 2048, NIN = 7176, NP = 7168, DFF = 5632, NUP = 11264, WCONV = 1024;
constexpr float ALPHA = 1.189207115002721f;
constexpr size_t WS_WIN = 0;
constexpr size_t WS_WOUT = WS_WIN + (size_t)NP * DM * 2;
constexpr size_t WS_WUP = WS_WOUT + (size_t)DM * DM * 2;
constexpr size_t WS_WDN = WS_WUP + (size_t)NUP * DM * 2;
constexpr size_t WS_X1B = WS_WDN + (size_t)DM * DFF * 2;
constexpr size_t WS_GATES = WS_X1B + (size_t)MT * DM * 2;
constexpr size_t WS_C = WS_GATES + (size_t)MT * 8 * 4;
constexpr size_t WS_PROJ = WS_C;
constexpr size_t WS_Y = WS_PROJ + (size_t)MT * NP * 2;
constexpr size_t WS_XB = WS_Y + (size_t)MT * DM * 2;
constexpr size_t WS_ACT = WS_C;
constexpr size_t WS_HALO = WS_ACT + (size_t)MT * DFF * 2;
constexpr size_t WS_BAR = WS_XB + (size_t)MT * DM * 2;
constexpr size_t WS_END = WS_BAR + 16384;
constexpr int LDS_BYTES = 131072 + 16 + 3 * 32 * 64 * 4;

struct Args {
    const float* x; const float* w_in; const float* b_gates; const float* w_sc; const float* mh_gain; const float* w_out;
    const float* ln1_g; const float* ln1_b; const float* w_up; const float* w_fc; const float* b_fc; const float* w_down;
    const float* ln2_g; const float* ln2_b;
    float* out; unsigned char* ws; int ph_lo, ph_hi;
};

typedef __bf16 bf16v2 __attribute__((ext_vector_type(2)));
typedef float f32x2 __attribute__((ext_vector_type(2)));
__device__ __forceinline__ unsigned cvt_pk_bf16(float lo, float hi) { const f32x2 v = {lo, hi}; const bf16v2 r = __builtin_convertvector(v, bf16v2); return __builtin_bit_cast(unsigned, r); }
__device__ __forceinline__ unsigned cvt_pk_bf16_asm(float lo, float hi) { unsigned r; asm volatile("v_cvt_pk_bf16_f32 %0, %1, %2" : "=v"(r) : "v"(lo), "v"(hi)); return r; }
__device__ __forceinline__ float bflo(unsigned u) { return __uint_as_float(u << 16); }
__device__ __forceinline__ float bfhi(unsigned u) { return __uint_as_float(u & 0xffff0000u); }
__device__ __forceinline__ bf16_t f2bf(float f) { unsigned u = __float_as_uint(f); u += 0x7FFFu + ((u >> 16) & 1u); return (bf16_t)(u >> 16); }

namespace pg8 {
constexpr int BM = 256, BK = 64, HALF = 128, HTB = HALF * BK * 2, STAGE_BYTES = 8 * HTB, NXCD = 8, WGM = 8;
__host__ __device__ __forceinline__ int lds_byte(int r, int c) { const int st = (r >> 4) * 2 + (c >> 5), rr = r & 15, cc = c & 31, ob = rr * 64 + cc * 2; return st * 1024 + (ob ^ (((ob >> 9) & 1) << 5)); }
__host__ __device__ __forceinline__ void stage_rc(int b, int& R, int& C) { const int st = b / 1024, sb = b % 1024, swz = sb ^ (((sb >> 9) & 1) << 5); R = (st >> 1) * 16 + swz / 64; C = (st & 1) * 32 + (swz % 64) / 2; }
__host__ __device__ __forceinline__ int perm32(int rho) { const int n = rho >> 4, i = rho & 15; return 8 * (i >> 2) + 4 * n + (i & 3); }
struct Unit { int pm, pn; };
struct Gemm { const bf16_t* A; const bf16_t* Bt; int M, N, K; };
struct StaticOrder {
    int nM, nN, nwg, G, c;
    __device__ void init(int M, int N, int G_, int c_) { nM = M / BM; nN = N / BM; nwg = nM * nN; G = G_; c = c_; }
    __device__ bool next(int i, Unit& u) const {
        const long L = (long)i * G + c; if (L >= nwg) return false;
        int wgid = (int)L; { const int q = nwg / NXCD, r = nwg % NXCD, xcd = wgid % NXCD, off = wgid / NXCD; wgid = (xcd < r ? xcd * (q + 1) : r * (q + 1) + (xcd - r) * q) + off; }
        const int nig = WGM * nN, gid = wgid / nig, fm = gid * WGM, gsz = (nM - fm) < WGM ? (nM - fm) : WGM;
        u.pm = fm + ((wgid % nig) % gsz); u.pn = (wgid % nig) / gsz; return true;
    }
};

template <class Epi>
__device__ __forceinline__ void gemm_phase(LAS unsigned char* lds, const Gemm g, const StaticOrder& S, const Epi& E) {
    const int tid = threadIdx.x, wid = __builtin_amdgcn_readfirstlane(tid >> 6), lane = tid & 63, wr = wid >> 2, wc = wid & 3, fr = lane & 15, fq = lane >> 4;
    const int K = g.K, nt = K / BK;
    unsigned voffA[2], voffB[2];
#pragma unroll
    for (int i = 0; i < 2; ++i) { int R, C; stage_rc(tid * 16 + i * 8192, R, C); const int Rb = Epi::PERM ? ((R & ~31) + perm32(R & 31)) : R;
        voffA[i] = (unsigned)(R * K + C) * 2u; voffB[i] = (unsigned)(Rb * K + C) * 2u; }
    const size_t kstep = (size_t)(BK * 2);
    const size_t hstep = (size_t)HALF * K * 2;
    const size_t tstep = 2 * hstep;
    const unsigned ldsw = (unsigned)wid * 1024u;
    const int aoff = lds_byte(wr * 64 + fr, fq * 8), boff = lds_byte(wc * 32 + fr, fq * 8);
#define PG8_SA(b, h) (((b) * 2 + (h)) * HTB)
#define PG8_SB(b, h) ((4 + (b) * 2 + (h)) * HTB)
#define PG8_STAGE(bufoff, gbase, voff) do { _Pragma("unroll") for (int _i = 0; _i < 2; ++_i) \
        __builtin_amdgcn_global_load_lds((const unsigned*)((const char*)(gbase) + (voff)[_i]), (LAS unsigned*)(lds + (bufoff) + ldsw + _i * 8192), 16, 0, 0); } while (0)
#define PG8_LDA(dst, b, h) do { _Pragma("unroll") for (int m = 0; m < 4; ++m) _Pragma("unroll") for (int k = 0; k < 2; ++k) dst[m][k] = *(const LAS bf16x8*)(lds + PG8_SA(b, h) + aoff + m * 2048 + k * 1024); } while (0)
#define PG8_LDB(dst, b, h) do { _Pragma("unroll") for (int n = 0; n < 2; ++n) _Pragma("unroll") for (int k = 0; k < 2; ++k) dst[n][k] = *(const LAS bf16x8*)(lds + PG8_SB(b, h) + boff + n * 2048 + k * 1024); } while (0)
#define PG8_MMA(ai, bj, At, Bt) do { __builtin_amdgcn_s_setprio(1); _Pragma("unroll") for (int m = 0; m < 4; ++m) _Pragma("unroll") for (int n = 0; n < 2; ++n) _Pragma("unroll") for (int k = 0; k < 2; ++k) \
        acc[ai][bj][m][n] = __builtin_amdgcn_mfma_f32_16x16x32_bf16(Bt[n][k], At[m][k], acc[ai][bj][m][n], 0, 0, 0); __builtin_amdgcn_s_setprio(0); } while (0)
#define PG8_WAIT_V(n) asm volatile("s_waitcnt vmcnt(" #n ")" ::: "memory")
#define PG8_WAIT_L(n) asm volatile("s_waitcnt lgkmcnt(" #n ")" ::: "memory")
#define PG8_BAR __builtin_amdgcn_s_barrier()
#define PG8_SCHED __builtin_amdgcn_sched_barrier(0)
    Unit cur, nxt; int ui = 0;
    if (!S.next(0, cur)) return;
    f32x4 acc[2][2][4][2];
#pragma unroll
    for (int a = 0; a < 2; ++a)
#pragma unroll
        for (int b = 0; b < 2; ++b)
#pragma unroll
            for (int m = 0; m < 4; ++m)
#pragma unroll
                for (int n = 0; n < 2; ++n) acc[a][b][m][n] = (f32x4){0.f, 0.f, 0.f, 0.f};
    bf16x8 At[4][2], B0[2][2], B1[2][2];
    const char* cA = (const char*)g.A + (size_t)cur.pm * tstep; const char* cB = (const char*)g.Bt + (size_t)cur.pn * tstep;
    PG8_STAGE(PG8_SB(0, 0), cB, voffB); PG8_STAGE(PG8_SA(0, 0), cA, voffA); PG8_STAGE(PG8_SB(0, 1), cB + hstep, voffB); PG8_STAGE(PG8_SA(0, 1), cA + hstep, voffA);
    if (wr == 1) PG8_BAR;
    PG8_WAIT_V(4); PG8_BAR;
    PG8_STAGE(PG8_SB(1, 0), cB + kstep, voffB); PG8_STAGE(PG8_SA(1, 0), cA + kstep, voffA); PG8_STAGE(PG8_SB(1, 1), cB + hstep + kstep, voffB);
    PG8_WAIT_V(6); PG8_BAR;
    for (;;) {
        const bool has_next = S.next(ui + 1, nxt);
        const char* nA = has_next ? (const char*)g.A + (size_t)nxt.pm * tstep : cA; const char* nB = has_next ? (const char*)g.Bt + (size_t)nxt.pn * tstep : cB;
        for (int t = 0; t < nt; t += 2) {
            const bool last = (t == nt - 2);
            const char* a1 = cA + (size_t)(t + 1) * kstep;
            const char* a2 = last ? nA : cA + (size_t)(t + 2) * kstep; const char* b2 = last ? nB : cB + (size_t)(t + 2) * kstep;
            const char* a3 = a2 + kstep; const char* b3 = b2 + kstep;
            PG8_LDB(B0, 0, 0); PG8_SCHED; PG8_LDA(At, 0, 0); PG8_STAGE(PG8_SA(1, 1), a1 + hstep, voffA);
            PG8_WAIT_L(8); PG8_BAR; PG8_WAIT_L(0); PG8_MMA(0, 0, At, B0); PG8_BAR; PG8_SCHED;
            PG8_LDB(B1, 0, 1); PG8_STAGE(PG8_SB(0, 0), b2, voffB);
            PG8_BAR; PG8_WAIT_L(0); PG8_MMA(0, 1, At, B1); PG8_BAR;
            PG8_LDA(At, 0, 1); PG8_STAGE(PG8_SA(0, 0), a2, voffA);
            PG8_BAR; PG8_WAIT_L(0); PG8_MMA(1, 0, At, B0); PG8_BAR; PG8_SCHED;
            PG8_STAGE(PG8_SB(0, 1), b2 + hstep, voffB);
            PG8_WAIT_V(6); PG8_BAR; PG8_MMA(1, 1, At, B1); PG8_BAR;
            PG8_LDB(B0, 1, 0); PG8_SCHED; PG8_LDA(At, 1, 0); PG8_STAGE(PG8_SA(0, 1), a2 + hstep, voffA);
            PG8_WAIT_L(8); PG8_BAR; PG8_WAIT_L(0); PG8_MMA(0, 0, At, B0); PG8_BAR; PG8_SCHED;
            PG8_LDB(B1, 1, 1); PG8_STAGE(PG8_SB(1, 0), b3, voffB);
            PG8_BAR; PG8_WAIT_L(0); PG8_MMA(0, 1, At, B1); PG8_BAR;
            PG8_LDA(At, 1, 1); PG8_STAGE(PG8_SA(1, 0), a3, voffA);
            PG8_BAR; PG8_WAIT_L(0); PG8_MMA(1, 0, At, B0); PG8_BAR; PG8_SCHED;
            PG8_STAGE(PG8_SB(1, 1), b3 + hstep, voffB);
            PG8_WAIT_V(6); PG8_BAR; PG8_MMA(1, 1, At, B1); PG8_BAR;
        }
        E(acc, cur, wr, wc, fr, fq);
        if (!has_next) break;
#pragma unroll
        for (int a = 0; a < 2; ++a)
#pragma unroll
            for (int b = 0; b < 2; ++b)
#pragma unroll
                for (int m = 0; m < 4; ++m)
#pragma unroll
                    for (int n = 0; n < 2; ++n) acc[a][b][m][n] = (f32x4){0.f, 0.f, 0.f, 0.f};
        cur = nxt; cA = nA; cB = nB; ++ui;
    }
    PG8_WAIT_V(0);
    if (wr == 0) PG8_BAR;
    PG8_BAR;
#undef PG8_SA
#undef PG8_SB
#undef PG8_STAGE
#undef PG8_LDA
#undef PG8_LDB
#undef PG8_MMA
#undef PG8_WAIT_V
#undef PG8_WAIT_L
#undef PG8_BAR
#undef PG8_SCHED
}

struct EpiBf16 {
    static constexpr bool PERM = true;
    bf16_t* O; int ldc;
    __device__ __forceinline__ void operator()(const f32x4 (&acc)[2][2][4][2], const Unit& u, int wr, int wc, int fr, int fq) const {
        const int row0 = u.pm * BM + wr * 64 + fr, col0 = u.pn * BM + wc * 32 + 8 * fq;
#pragma unroll
        for (int ai = 0; ai < 2; ++ai)
#pragma unroll
            for (int m = 0; m < 4; ++m) { bf16_t* rowp = O + (size_t)(row0 + ai * HALF + m * 16) * ldc + col0;
#pragma unroll
                for (int bj = 0; bj < 2; ++bj) { const f32x4 v0 = acc[ai][bj][m][0], v1 = acc[ai][bj][m][1];
                    u32x4 w; w.x = cvt_pk_bf16_asm(v0[0], v0[1]); w.y = cvt_pk_bf16_asm(v0[2], v0[3]); w.z = cvt_pk_bf16_asm(v1[0], v1[1]); w.w = cvt_pk_bf16_asm(v1[2], v1[3]);
                    *(u32x4*)(rowp + bj * HALF) = w; } }
    }
};
struct EpiResF32 {
    static constexpr bool PERM = false;
    const float* X; float* O; int ldc;
    __device__ __forceinline__ void operator()(const f32x4 (&acc)[2][2][4][2], const Unit& u, int wr, int wc, int fr, int fq) const {
        const int row0 = u.pm * BM + wr * 64 + fr, col0 = u.pn * BM + wc * 32 + 4 * fq;
#pragma unroll
        for (int ai = 0; ai < 2; ++ai)
#pragma unroll
            for (int m = 0; m < 4; ++m) { const size_t ro = (size_t)(row0 + ai * HALF + m * 16) * ldc + col0;
#pragma unroll
                for (int bj = 0; bj < 2; ++bj)
#pragma unroll
                    for (int n = 0; n < 2; ++n) { const f32x4 xv = *(const f32x4*)(X + ro + bj * HALF + n * 16);
                        *(f32x4*)(O + ro + bj * HALF + n * 16) = xv * ALPHA + acc[ai][bj][m][n]; } }
    }
};
#define DPP_SHR1(x) __builtin_bit_cast(float, __builtin_amdgcn_update_dpp(0, __builtin_bit_cast(int, (x)), 0x111, 0xf, 0xf, true))
#define DPP_SHR2(x) __builtin_bit_cast(float, __builtin_amdgcn_update_dpp(0, __builtin_bit_cast(int, (x)), 0x112, 0xf, 0xf, true))
#define DPP_SHL15(o, x) __builtin_bit_cast(float, __builtin_amdgcn_update_dpp(__builtin_bit_cast(int, (o)), __builtin_bit_cast(int, (x)), 0x10F, 0xf, 0xf, false))
#define DPP_SHL14(o, x) __builtin_bit_cast(float, __builtin_amdgcn_update_dpp(__builtin_bit_cast(int, (o)), __builtin_bit_cast(int, (x)), 0x10E, 0xf, 0xf, false))
struct EpiConvFfn {
    static constexpr bool PERM = true;
    bf16_t* act; float* halo; const float* cw; const float* cb;
    __device__ __forceinline__ void operator()(const f32x4 (&acc)[2][2][4][2], const Unit& u, int wr, int wc, int fr, int fq) const {
        const int fcol = u.pn * 128 + wc * 32 + 8 * fq;
#pragma unroll
        for (int ai = 0; ai < 2; ++ai) {
            float* hb = halo + (size_t)((u.pm * BM + ai * HALF + wr * 64) >> 6) * 4 * NUP + fcol;
            if (fr < 2) {
#pragma unroll
                for (int bj = 0; bj < 2; ++bj)
#pragma unroll
                    for (int n = 0; n < 2; ++n) *(f32x4*)(hb + (size_t)(2 + fr) * NUP + bj * DFF + 4 * n) = acc[ai][bj][0][n];
            }
            if (fr >= 14) {
#pragma unroll
                for (int bj = 0; bj < 2; ++bj)
#pragma unroll
                    for (int n = 0; n < 2; ++n) *(f32x4*)(hb + (size_t)(fr - 14) * NUP + bj * DFF + 4 * n) = acc[ai][bj][3][n];
            }
        }
        u32x2 pk0[2][4];
#pragma unroll
        for (int n = 0; n < 2; ++n) {
            f32x4 W0[2], W1[2], W2[2], Bb[2];
#pragma unroll
            for (int bj = 0; bj < 2; ++bj) { const int hc = bj * DFF + fcol + 4 * n;
                W0[bj] = *(const f32x4*)(cw + hc); W1[bj] = *(const f32x4*)(cw + NUP + hc); W2[bj] = *(const f32x4*)(cw + 2 * NUP + hc); Bb[bj] = *(const f32x4*)(cb + hc); }
#pragma unroll
            for (int ai = 0; ai < 2; ++ai) {
                const int rbase = u.pm * BM + ai * HALF + wr * 64;
#pragma unroll
                for (int m = 0; m < 4; ++m) {
                    float av[4];
#pragma unroll
                    for (int j = 0; j < 4; ++j) {
                        float hc[2];
#pragma unroll
                        for (int bj = 0; bj < 2; ++bj) {
                            const float cur = acc[ai][bj][m][n][j];
                            float p1 = DPP_SHR1(cur), p2 = DPP_SHR2(cur);
                            if (m > 0) { const float pv = acc[ai][bj][m > 0 ? m - 1 : 0][n][j]; p1 = DPP_SHL15(p1, pv); p2 = DPP_SHL14(p2, pv); }
                            hc[bj] = W2[bj][j] * cur + W1[bj][j] * p1 + W0[bj][j] * p2 + Bb[bj][j];
                        }
                        const float gt = hc[1];
                        av[j] = hc[0] * gt * __builtin_amdgcn_rcpf(1.0f + __expf(-gt));
                    }
                    u32x2 pk; pk.x = cvt_pk_bf16_asm(av[0], av[1]); pk.y = cvt_pk_bf16_asm(av[2], av[3]);
                    if (n == 0) pk0[ai][m] = pk;
                    else if (m > 0 || fr >= 2) { u32x4 w; w.x = pk0[ai][m].x; w.y = pk0[ai][m].y; w.z = pk.x; w.w = pk.y;
                        *(u32x4*)(act + (size_t)(rbase + m * 16 + fr) * DFF + fcol) = w; }
                }
            }
            asm volatile("" ::: "memory");
        }
    }
};
}

template <bool UPMAP>
__device__ __forceinline__ void transpose_macro(const float* W, int ldw, int k0, int n0, bf16_t* Wt, int ldt, unsigned char* lds) {
    bf16_t* sT = (bf16_t*)lds; const int tid = threadIdx.x;
    float4 v[2][4];
#pragma unroll
    for (int i = 0; i < 2; ++i)
#pragma unroll
        for (int j = 0; j < 4; ++j) v[i][j] = *(const float4*)(W + (size_t)(k0 + (tid >> 4) + 32 * i) * ldw + n0 + 64 * j + (tid & 15) * 4);
#pragma unroll
    for (int i = 0; i < 2; ++i)
#pragma unroll
        for (int j = 0; j < 4; ++j) { const int k = (tid >> 4) + 32 * i, n = 64 * j + (tid & 15) * 4;
            sT[(n + 0) * 66 + k] = f2bf(v[i][j].x); sT[(n + 1) * 66 + k] = f2bf(v[i][j].y); sT[(n + 2) * 66 + k] = f2bf(v[i][j].z); sT[(n + 3) * 66 + k] = f2bf(v[i][j].w); }
    __syncthreads();
#pragma unroll
    for (int j = 0; j < 4; ++j) { const int n = 64 * j + (tid >> 3), ks = (tid & 7) * 8; const unsigned* p = (const unsigned*)(sT + n * 66 + ks);
        u32x4 o; o.x = p[0]; o.y = p[1]; o.z = p[2]; o.w = p[3];
        int drow = n0 + n;
        if (UPMAP) { const int f = (drow < DFF) ? drow : drow - DFF; drow = 256 * (f >> 7) + (f & 127) + ((drow < DFF) ? 0 : 128); }
        *(u32x4*)(Wt + (size_t)drow * ldt + k0 + ks) = o; }
    __syncthreads();
}
constexpr int TM_IN = 32 * 28, TM_OUT = 32 * 8, TM_UP = 32 * 44, TM_DN = 88 * 8;
__device__ __forceinline__ void phase_transposes(const Args& A, unsigned char* lds, int g0, int g1, int worker, int nworkers) {
    unsigned char* ws = A.ws;
    for (int g = g0 + worker; g < g1; g += nworkers) {
        if (g < TM_IN) { const int tk = g / 28, tn = g % 28; transpose_macro<false>(A.w_in, NIN, tk * 64, tn * 256, (bf16_t*)(ws + WS_WIN), DM, lds); }
        else if (g < TM_IN + TM_OUT) { const int h = g - TM_IN, tk = h / 8, tn = h % 8; transpose_macro<false>(A.w_out, DM, tk * 64, tn * 256, (bf16_t*)(ws + WS_WOUT), DM, lds); }
        else if (g < TM_IN + TM_OUT + TM_UP) { const int h = g - TM_IN - TM_OUT, tk = h / 44, tn = h % 44; transpose_macro<true>(A.w_up, NUP, tk * 64, tn * 256, (bf16_t*)(ws + WS_WUP), DM, lds); }
        else { const int h = g - TM_IN - TM_OUT - TM_UP, tk = h / 8, tn = h % 8; transpose_macro<false>(A.w_down, DM, tk * 64, tn * 256, (bf16_t*)(ws + WS_WDN), DFF, lds); }
    }
}
__device__ __forceinline__ void phase_prologue(const Args& A, unsigned char* lds) {
    unsigned char* ws = A.ws;
    phase_transposes(A, lds, 0, TM_IN, blockIdx.x, gridDim.x);
    const int lane = threadIdx.x & 63, gw = blockIdx.x * 8 + (threadIdx.x >> 6), nw = gridDim.x * 8;
    bf16_t* xb = (bf16_t*)(ws + WS_XB); float* gates = (float*)(ws + WS_GATES);
    for (int it = gw; it < MT / 4; it += nw) {
        const int r0 = it * 4;
        float acc[4][8];
#pragma unroll
        for (int r = 0; r < 4; ++r)
#pragma unroll
            for (int q = 0; q < 8; ++q) acc[r][q] = 0.f;
#pragma unroll 1
        for (int i = 0; i < 8; ++i) {
            const int kb = i * 256 + lane * 4;
            f32x4 xv[4];
#pragma unroll
            for (int r = 0; r < 4; ++r) { xv[r] = *(const f32x4*)(A.x + (size_t)(r0 + r) * DM + kb);
                u32x2 o; o.x = cvt_pk_bf16(xv[r][0], xv[r][1]); o.y = cvt_pk_bf16(xv[r][2], xv[r][3]); *(u32x2*)(xb + (size_t)(r0 + r) * DM + kb) = o; }
#pragma unroll
            for (int j = 0; j < 4; ++j) {
                const f32x4* wp = (const f32x4*)(A.w_in + (size_t)(kb + j) * NIN + NP);
                const f32x4 w0 = wp[0], w1 = wp[1];
#pragma unroll
                for (int r = 0; r < 4; ++r) { const float xs = xv[r][j];
                    acc[r][0] += xs * w0[0]; acc[r][1] += xs * w0[1]; acc[r][2] += xs * w0[2]; acc[r][3] += xs * w0[3];
                    acc[r][4] += xs * w1[0]; acc[r][5] += xs * w1[1]; acc[r][6] += xs * w1[2]; acc[r][7] += xs * w1[3]; }
            }
        }
#pragma unroll
        for (int r = 0; r < 4; ++r)
#pragma unroll
            for (int q = 0; q < 8; ++q) { float v = acc[r][q];
#pragma unroll
                for (int off = 32; off >= 1; off >>= 1) v += __shfl_xor(v, off);
                acc[r][q] = v; }
        if (lane == 0) {
            const f32x4 b0 = *(const f32x4*)(A.b_gates), b1 = *(const f32x4*)(A.b_gates + 4);
#pragma unroll
            for (int r = 0; r < 4; ++r) {
                *(f32x4*)(gates + (size_t)(r0 + r) * 8) = (f32x4){acc[r][0] + b0[0], acc[r][1] + b0[1], acc[r][2] + b0[2], acc[r][3] + b0[3]};
                *(f32x4*)(gates + (size_t)(r0 + r) * 8 + 4) = (f32x4){acc[r][4] + b1[0], acc[r][5] + b1[1], acc[r][6] + b1[2], acc[r][7] + b1[3]}; }
        }
    }
}

__device__ __forceinline__ void phase_yconv(const Args& A) {
    const bf16_t* proj = (const bf16_t*)(A.ws + WS_PROJ); bf16_t* y = (bf16_t*)(A.ws + WS_Y);
    for (int idx = blockIdx.x * 512 + threadIdx.x; idx < MT * 128; idx += gridDim.x * 512) {
        const int row = idx >> 7, c = (idx & 127) * 8, t = row & (SEQ - 1);
        const bf16_t* pr = proj + (size_t)row * NP + c;
        const u32x4 bv = *(const u32x4*)pr;
        float cv[8];
#pragma unroll
        for (int i = 0; i < 8; ++i) cv[i] = 0.f;
#pragma unroll
        for (int j = 0; j < 3; ++j) {
            const int dt = 2 - j;
            if (t - dt >= 0) {
                const u32x4 cc = *(const u32x4*)(pr - (size_t)dt * NP + WCONV), hh = *(const u32x4*)(pr - (size_t)dt * NP + 2 * WCONV);
                const f32x4 w0 = *(const f32x4*)(A.w_sc + j * WCONV + c), w1 = *(const f32x4*)(A.w_sc + j * WCONV + c + 4);
                const float wv[8] = {w0[0], w0[1], w0[2], w0[3], w1[0], w1[1], w1[2], w1[3]};
#pragma unroll
                for (int q = 0; q < 4; ++q) { cv[2 * q] += wv[2 * q] * bflo(cc[q]) * bflo(hh[q]); cv[2 * q + 1] += wv[2 * q + 1] * bfhi(cc[q]) * bfhi(hh[q]); }
            }
        }
        u32x4 o;
#pragma unroll
        for (int q = 0; q < 4; ++q) o[q] = cvt_pk_bf16(bflo(bv[q]) * cv[2 * q], bfhi(bv[q]) * cv[2 * q + 1]);
        *(u32x4*)(y + (size_t)row * DM + c) = o;
    }
}

__device__ __forceinline__ void phase_mlstm(const Args& A, unsigned char* lds, float* hbuf) {
    const int tid = threadIdx.x, lane = tid & 63, w = tid >> 6, g = lane >> 4, l15 = lane & 15;
    const int a = w >> 2, ti = w & 3;
    unsigned char* QS = lds; unsigned char* KS = lds + 33792; unsigned char* VT = lds + 67584; unsigned char* WVT = VT + 4608; unsigned char* CT = WVT + 4608; unsigned char* XCH = CT + 33792;
    const bf16_t* proj = (const bf16_t*)(A.ws + WS_PROJ); const float* gates = (const float*)(A.ws + WS_GATES);
    float* TBC = (float*)(lds + 131088); float* TUV = TBC + 2048; float* TCM = TUV + 2048;
    for (int item = blockIdx.x; item < 256; item += gridDim.x) {
        const int xcd = item & 7, idx = item >> 3; const int bh = xcd * 2 + (idx >> 4), es = idx & 15;
        const int b = bh >> 2, hh = bh & 3, e0 = es * 16;
        const size_t row0 = (size_t)b * SEQ;
        __syncthreads();
        for (int i = tid; i < 16896 / 4; i += 512) ((unsigned*)CT)[i] = 0u;
        for (int i = tid; i < 16 * 72; i += 512) { const int r = 16 + i / 72, ci = i % 72; ((bf16_t*)VT)[r * 72 + ci] = (r == 16) ? (bf16_t)0x3F80 : (bf16_t)0; ((bf16_t*)WVT)[r * 72 + ci] = 0; }
        f32x4 Cst[2][2];
#pragma unroll
        for (int x = 0; x < 2; ++x)
#pragma unroll
            for (int et = 0; et < 2; ++et) Cst[x][et] = (f32x4){0.f, 0.f, 0.f, 0.f};
        float m_state = 0.f;
        u32x4 qr[4], kr[4], vr = (u32x4){0u, 0u, 0u, 0u};
        const bf16_t* qbase = proj + row0 * NP + 3072 + hh * 256;
#define ML_LOAD(c) do { _Pragma("unroll") for (int i = 0; i < 4; ++i) { const int p = tid + 512 * i, r = p >> 5, c16 = p & 31; const bf16_t* rp = qbase + (size_t)((c) * 64 + r) * NP + c16 * 8; \
            qr[i] = *(const u32x4*)rp; kr[i] = *(const u32x4*)(rp + 1024); } \
            if (tid < 128) vr = *(const u32x4*)(qbase + (size_t)((c) * 64 + (tid >> 1)) * NP + 2048 + e0 + (tid & 1) * 8); } while (0)
        ML_LOAD(0);
#pragma unroll 1
        for (int cc = 4 * w; cc < 4 * w + 4; ++cc) {
            const float* gp = gates + (row0 + cc * 64 + lane) * 8 + hh; const float gi = gp[0], gf = gp[4];
            const float lf = fminf(gf, 0.f) - log1pf(__expf(-fabsf(gf)));
            float bc = lf;
#pragma unroll
            for (int off = 1; off < 64; off <<= 1) { const float t = __shfl_up(bc, off); if (lane >= off) bc += t; }
            const float uv = gi - bc;
            float cm = uv;
#pragma unroll
            for (int off = 1; off < 64; off <<= 1) { const float t = __shfl_up(cm, off); if (lane >= off) cm = fmaxf(cm, t); }
            TBC[cc * 64 + lane] = bc; TUV[cc * 64 + lane] = uv; TCM[cc * 64 + lane] = cm;
        }
        __syncthreads();
#pragma unroll 1
        for (int c = 0; c < 32; ++c) {
            const float* tbc = TBC + c * 64; const float* tuv = TUV + c * 64; const float* tcm = TCM + c * 64;
            const float g_tot = tbc[63], cm63 = tcm[63];
            const float M63 = fmaxf(m_state, cm63), decay = __expf(m_state - M63);
            const float m_old = m_state;
            m_state = g_tot + M63;
#pragma unroll
            for (int i = 0; i < 4; ++i) { const int p = tid + 512 * i, r = p >> 5, c16 = p & 31; *(u32x4*)(QS + r * 528 + c16 * 16) = qr[i]; *(u32x4*)(KS + r * 528 + c16 * 16) = kr[i]; }
            { if (tid < 128) { const int s = tid >> 1, hf = tid & 1; const float wv = __expf(tuv[s] - M63);
#pragma unroll
                  for (int q = 0; q < 4; ++q) { const float v0 = bflo(vr[q]), v1 = bfhi(vr[q]);
                      ((bf16_t*)VT)[(8 * hf + 2 * q) * 72 + s] = (bf16_t)(vr[q] & 0xffffu); ((bf16_t*)VT)[(8 * hf + 2 * q + 1) * 72 + s] = (bf16_t)(vr[q] >> 16);
                      ((bf16_t*)WVT)[(8 * hf + 2 * q) * 72 + s] = f2bf(v0 * wv); ((bf16_t*)WVT)[(8 * hf + 2 * q + 1) * 72 + s] = f2bf(v1 * wv); } }
              if (w == 2) ((bf16_t*)WVT)[16 * 72 + lane] = f2bf(__expf(tuv[lane] - M63)); }
            if (c + 1 < 32) ML_LOAD(c + 1);
            __syncthreads();
            bf16x8 qf[8]; f32x4 S0 = (f32x4){0.f, 0.f, 0.f, 0.f}, S1 = S0;
#pragma unroll
            for (int kk = 0; kk < 8; ++kk) {
                qf[kk] = *(const bf16x8*)(QS + (16 * ti + l15) * 528 + kk * 64 + g * 16);
                const bf16x8 kf0 = *(const bf16x8*)(KS + (32 * a + l15) * 528 + kk * 64 + g * 16), kf1 = *(const bf16x8*)(KS + (32 * a + 16 + l15) * 528 + kk * 64 + g * 16);
                S0 = __builtin_amdgcn_mfma_f32_16x16x32_bf16(kf0, qf[kk], S0, 0, 0, 0); S1 = __builtin_amdgcn_mfma_f32_16x16x32_bf16(kf1, qf[kk], S1, 0, 0, 0);
            }
            const int tcol = 16 * ti + l15;
            const float Mt = fmaxf(m_old, tcm[tcol]);
            const f32x4 u0v = *(const f32x4*)(tuv + 32 * a + 4 * g), u1v = *(const f32x4*)(tuv + 32 * a + 16 + 4 * g);
            float p[8];
#pragma unroll
            for (int r = 0; r < 4; ++r) { const int s0 = 32 * a + 4 * g + r, s1 = s0 + 16;
                p[r] = (s0 <= tcol) ? S0[r] * 0.0625f * __expf(u0v[r] - Mt) : 0.f; p[4 + r] = (s1 <= tcol) ? S1[r] * 0.0625f * __expf(u1v[r] - Mt) : 0.f; }
            u32x4 pau; pau.x = cvt_pk_bf16(p[0], p[1]); pau.y = cvt_pk_bf16(p[2], p[3]); pau.z = cvt_pk_bf16(p[4], p[5]); pau.w = cvt_pk_bf16(p[6], p[7]);
            const bf16x8 pa = __builtin_bit_cast(bf16x8, pau);
            f32x4 rr[2];
#pragma unroll
            for (int et = 0; et < 2; ++et) { const unsigned char* vp = VT + (16 * et + l15) * 144 + (32 * a + 4 * g) * 2;
                const u32x2 lo = *(const u32x2*)vp, hi = *(const u32x2*)(vp + 32);
                u32x4 vbu; vbu.x = lo.x; vbu.y = lo.y; vbu.z = hi.x; vbu.w = hi.y;
                rr[et] = __builtin_amdgcn_mfma_f32_16x16x32_bf16(pa, __builtin_bit_cast(bf16x8, vbu), (f32x4){0.f, 0.f, 0.f, 0.f}, 0, 0, 0); }
            const f32x4 cmr = *(const f32x4*)(tcm + 16 * ti + 4 * g), bcr = *(const f32x4*)(tbc + 16 * ti + 4 * g);
            {
                const unsigned char* CTc = CT + (c & 1) * 16896;
                f32x4 in0 = (f32x4){0.f, 0.f, 0.f, 0.f}, in1 = in0;
#pragma unroll
                for (int k2 = 0; k2 < 4; ++k2) {
                    const bf16x8 qa = a ? qf[4 + k2] : qf[k2];
                    const bf16x8 c0 = *(const bf16x8*)(CTc + (l15) * 528 + (128 * a + 32 * k2 + 8 * g) * 2), c1 = *(const bf16x8*)(CTc + (16 + l15) * 528 + (128 * a + 32 * k2 + 8 * g) * 2);
                    in0 = __builtin_amdgcn_mfma_f32_16x16x32_bf16(qa, c0, in0, 0, 0, 0); in1 = __builtin_amdgcn_mfma_f32_16x16x32_bf16(qa, c1, in1, 0, 0, 0);
                }
#pragma unroll
                for (int r = 0; r < 4; ++r) { const float iw = __expf(m_old - fmaxf(m_old, cmr[r])) * 0.0625f; rr[0][r] += in0[r] * iw; rr[1][r] += in1[r] * iw; }
            }
            if (a == 1) { *(f32x4*)(XCH + ((ti * 2 + 0) * 64 + lane) * 16) = rr[0]; *(f32x4*)(XCH + ((ti * 2 + 1) * 64 + lane) * 16) = rr[1]; }
            {
                unsigned char* CTn = CT + ((c + 1) & 1) * 16896;
#pragma unroll
                for (int x = 0; x < 2; ++x) {
                    const int dt = 2 * w + x;
#pragma unroll
                    for (int et = 0; et < 2; ++et) Cst[x][et] *= decay;
#pragma unroll
                    for (int ks = 0; ks < 2; ++ks) {
                        bf16x8 ka;
#pragma unroll
                        for (int jj = 0; jj < 8; ++jj) ka[jj] = (short)*(const bf16_t*)(KS + (32 * ks + 8 * g + jj) * 528 + (16 * dt + l15) * 2);
#pragma unroll
                        for (int et = 0; et < 2; ++et) { const bf16x8 wvb = *(const bf16x8*)(WVT + (16 * et + l15) * 144 + (32 * ks + 8 * g) * 2);
                            Cst[x][et] = __builtin_amdgcn_mfma_f32_16x16x32_bf16(ka, wvb, Cst[x][et], 0, 0, 0); }
                    }
#pragma unroll
                    for (int et = 0; et < 2; ++et) { u32x2 o; o.x = cvt_pk_bf16(Cst[x][et][0], Cst[x][et][1]); o.y = cvt_pk_bf16(Cst[x][et][2], Cst[x][et][3]);
                        *(u32x2*)(CTn + (16 * et + l15) * 528 + (16 * dt + 4 * g) * 2) = o; }
                }
            }
            __syncthreads();
            if (a == 0) {
                const f32x4 o0 = *(const f32x4*)(XCH + ((ti * 2 + 0) * 64 + lane) * 16), o1 = *(const f32x4*)(XCH + ((ti * 2 + 1) * 64 + lane) * 16);
#pragma unroll
                for (int r = 0; r < 4; ++r) {
                    const float den = __shfl(rr[1][r] + o1[r], lane & 48), fl = __expf(-(bcr[r] + fmaxf(m_old, cmr[r])));
                    const float hv = (rr[0][r] + o0[r]) / fmaxf(fabsf(den), fl);
                    hbuf[(row0 + c * 64 + 16 * ti + 4 * g + r) * 1024 + hh * 256 + e0 + l15] = hv;
                }
            }
        }
#undef ML_LOAD
    }
}

__device__ __forceinline__ void phase_headnorm(const Args& A, const float* hbuf) {
    const bf16_t* proj = (const bf16_t*)(A.ws + WS_PROJ); bf16_t* y = (bf16_t*)(A.ws + WS_Y);
    const int lane = threadIdx.x & 63, gw = blockIdx.x * 8 + (threadIdx.x >> 6), nw = gridDim.x * 8;
    for (int it = gw; it < MT * 4; it += nw) {
        const int row = it >> 2, hh = it & 3;
        const f32x4 hv = *(const f32x4*)(hbuf + (size_t)row * 1024 + hh * 256 + lane * 4);
        float s = (hv[0] + hv[1]) + (hv[2] + hv[3]);
#pragma unroll
        for (int off = 32; off >= 1; off >>= 1) s += __shfl_xor(s, off);
        const float mu = s * (1.0f / 256.0f);
        const f32x4 d = hv - mu;
        float q = (d[0] * d[0] + d[1] * d[1]) + (d[2] * d[2] + d[3] * d[3]);
#pragma unroll
        for (int off = 32; off >= 1; off >>= 1) q += __shfl_xor(q, off);
        const float rstd = rsqrtf(q * (1.0f / 256.0f) + 1e-6f);
        const f32x4 gn = *(const f32x4*)(A.mh_gain + hh * 256 + lane * 4);
        const u32x2 ov = *(const u32x2*)(proj + (size_t)row * NP + 6144 + hh * 256 + lane * 4);
        const float o0 = bflo(ov.x), o1 = bfhi(ov.x), o2 = bflo(ov.y), o3 = bfhi(ov.y);
        const float y0 = d[0] * rstd * gn[0] / (1.0f + __expf(-o0)), y1 = d[1] * rstd * gn[1] / (1.0f + __expf(-o1));
        const float y2 = d[2] * rstd * gn[2] / (1.0f + __expf(-o2)), y3 = d[3] * rstd * gn[3] / (1.0f + __expf(-o3));
        u32x2 o; o.x = cvt_pk_bf16(y0, y1); o.y = cvt_pk_bf16(y2, y3);
        *(u32x2*)(y + (size_t)row * DM + WCONV + hh * 256 + lane * 4) = o;
    }
}

__device__ __forceinline__ void phase_ln(float* io, const float* gam, const float* bet, bf16_t* ob) {
    const int lane = threadIdx.x & 63, gw = blockIdx.x * 8 + (threadIdx.x >> 6), nw = gridDim.x * 8;
    for (int row = gw; row < MT; row += nw) {
        float* rp = io + (size_t)row * DM;
        f32x4 v[8]; float s = 0.f;
#pragma unroll
        for (int i = 0; i < 8; ++i) { v[i] = *(const f32x4*)(rp + i * 256 + lane * 4); s += (v[i][0] + v[i][1]) + (v[i][2] + v[i][3]); }
#pragma unroll
        for (int off = 32; off >= 1; off >>= 1) s += __shfl_xor(s, off);
        const float mu = s * (1.0f / DM);
        float q = 0.f;
#pragma unroll
        for (int i = 0; i < 8; ++i) { v[i] = v[i] - mu; q += (v[i][0] * v[i][0] + v[i][1] * v[i][1]) + (v[i][2] * v[i][2] + v[i][3] * v[i][3]); }
#pragma unroll
        for (int off = 32; off >= 1; off >>= 1) q += __shfl_xor(q, off);
        const float rstd = rsqrtf(q * (1.0f / DM) + 1e-5f);
#pragma unroll
        for (int i = 0; i < 8; ++i) { const f32x4 gg = *(const f32x4*)(gam + i * 256 + lane * 4), bb = *(const f32x4*)(bet + i * 256 + lane * 4);
            const f32x4 o = v[i] * rstd * gg + bb;
            *(f32x4*)(rp + i * 256 + lane * 4) = o;
            if (ob) { u32x2 p; p.x = cvt_pk_bf16(o[0], o[1]); p.y = cvt_pk_bf16(o[2], o[3]); *(u32x2*)(ob + (size_t)row * DM + i * 256 + lane * 4) = p; } }
    }
}

__device__ __forceinline__ void phase_fixup(const Args& A) {
    const float* halo = (const float*)(A.ws + WS_HALO); bf16_t* act = (bf16_t*)(A.ws + WS_ACT);
    for (int idx = blockIdx.x * 512 + threadIdx.x; idx < 128 * 2 * (DFF / 4); idx += gridDim.x * 512) {
        const int f = (idx % (DFF / 4)) * 4, br = idx / (DFF / 4), rr = br & 1, B = br >> 1;
        const bool first = (B & 31) == 0;
        const float* hc = halo + (size_t)B * 4 * NUP; const float* hp = hc - 4 * NUP;
        f32x4 hv[2];
#pragma unroll
        for (int bj = 0; bj < 2; ++bj) {
            const int col = bj * DFF + f;
            const f32x4 cur = *(const f32x4*)(hc + (size_t)(2 + rr) * NUP + col);
            f32x4 p1, p2; const f32x4 z = (f32x4){0.f, 0.f, 0.f, 0.f};
            if (rr == 0) { p1 = first ? z : *(const f32x4*)(hp + (size_t)1 * NUP + col); p2 = first ? z : *(const f32x4*)(hp + col); }
            else { p1 = *(const f32x4*)(hc + (size_t)2 * NUP + col); p2 = first ? z : *(const f32x4*)(hp + (size_t)1 * NUP + col); }
            const f32x4 w0 = *(const f32x4*)(A.w_fc + col), w1 = *(const f32x4*)(A.w_fc + NUP + col), w2 = *(const f32x4*)(A.w_fc + 2 * NUP + col), bb = *(const f32x4*)(A.b_fc + col);
            hv[bj] = w2 * cur + w1 * p1 + w0 * p2 + bb;
        }
        float av[4];
#pragma unroll
        for (int j = 0; j < 4; ++j) { const float gt = hv[1][j]; av[j] = hv[0][j] * gt / (1.0f + __expf(-gt)); }
        u32x2 o; o.x = cvt_pk_bf16(av[0], av[1]); o.y = cvt_pk_bf16(av[2], av[3]);
        *(u32x2*)(act + (size_t)(B * 64 + rr) * DFF + f) = o;
    }
}

__device__ __forceinline__ void phase_dump(const bf16_t* src, int ld, int c0, float* out) {
    for (size_t idx = (size_t)blockIdx.x * 512 + threadIdx.x; idx < (size_t)MT * DM; idx += (size_t)gridDim.x * 512) {
        const size_t row = idx / DM, col = idx % DM; out[idx] = bflo((unsigned)src[row * ld + c0 + col]); }
}
#ifndef DBG_STOP
#define DBG_STOP -1
#endif
#define XB_TMO      128
#define XB_XCNT(j)  (256  + 64 * (j))
#define XB_XSUB(j)  (1280 + 64 * (j))
#define XB_XGEN(j)  (2304 + 64 * (j))
#define XB_TOP      3328
#define XB_TOPGEN   3392
#define XCD_BAR_WORDS 3456
#define XB_SPIN_CAP (1u << 22)
__device__ __forceinline__ unsigned xb_ld(unsigned* p)              { return __hip_atomic_load(p, __ATOMIC_RELAXED, __HIP_MEMORY_SCOPE_AGENT); }
__device__ __forceinline__ unsigned xb_add(unsigned* p, unsigned v) { return __hip_atomic_fetch_add(p, v, __ATOMIC_RELAXED, __HIP_MEMORY_SCOPE_AGENT); }
__device__ __forceinline__ unsigned xb_xcc_id() { return (unsigned)__builtin_amdgcn_s_getreg((3 << 11) | 20) & 0xFu; }
#define XB_SPIN(cond, bar) do { unsigned _sp = 0; while (cond) { __builtin_amdgcn_s_sleep(1); \
    if ((++_sp & 255u) == 0u) { if (xb_ld(&(bar)[XB_TMO])) break; if (_sp > XB_SPIN_CAP) { atomicAdd(&(bar)[XB_TMO], 1u); break; } } } } while (0)
struct XcdBarrier { unsigned* bar; unsigned x; volatile LAS unsigned* st; };
__device__ __forceinline__ XcdBarrier xcd_barrier_post(unsigned* bar, volatile LAS unsigned* st) {
    XcdBarrier b; b.bar = bar; b.x = xb_xcc_id(); b.st = st;
    if (threadIdx.x == 0) (void)xb_add(&bar[XB_XCNT(b.x)], 1u);
    return b;
}
__device__ __forceinline__ void xcd_barrier_complete(unsigned* bar, unsigned x, unsigned& nloc, unsigned& nx) {
    const unsigned G = gridDim.x * gridDim.y * gridDim.z;
    unsigned sum, cnt, mine, sp = 0u;
    for (;;) {
        sum = 0u; cnt = 0u; mine = 0u;
#pragma unroll
        for (unsigned j = 0; j < 16; ++j) { const unsigned c = xb_ld(&bar[XB_XCNT(j)]); sum += c; cnt += (c > 0u) ? 1u : 0u; mine = (j == x) ? c : mine; }
        if (sum == G) break;
        __builtin_amdgcn_s_sleep(1);
        if ((++sp & 255u) == 0u) { if (xb_ld(&bar[XB_TMO])) break; if (sp > XB_SPIN_CAP) { atomicAdd(&bar[XB_TMO], 1u); break; } }
    }
    nloc = mine > 0u ? mine : 1u; nx = cnt > 0u ? cnt : 1u;
}
__device__ __forceinline__ void xcd_barrier(const XcdBarrier& b) {
    asm volatile("s_waitcnt vmcnt(0)" ::: "memory");
    __syncthreads();
    if (threadIdx.x == 0) {
        unsigned* bar = b.bar;
        __builtin_amdgcn_s_waitcnt(0);
        unsigned nloc = b.st[0], nx = b.st[1];
        if (nloc == 0u) { xcd_barrier_complete(bar, b.x, nloc, nx); b.st[0] = nloc; b.st[1] = nx; }
        const unsigned old = xb_add(&bar[XB_XSUB(b.x)], 1u);
        const unsigned gen = old / nloc;
        if (old + 1u == (gen + 1u) * nloc) {
            __builtin_amdgcn_fence(__ATOMIC_RELEASE, "agent");
            asm volatile("s_waitcnt vmcnt(0)" ::: "memory");
            const unsigned og = xb_add(&bar[XB_TOP], 1u);
            const unsigned tg = og / nx;
            if (og + 1u == (tg + 1u) * nx) xb_add(&bar[XB_TOPGEN], 1u);
            else XB_SPIN(xb_ld(&bar[XB_TOPGEN]) == tg, bar);
            __builtin_amdgcn_fence(__ATOMIC_ACQUIRE, "agent");
            xb_add(&bar[XB_XGEN(b.x)], 1u);
            asm volatile("s_waitcnt vmcnt(0)" ::: "memory");
        } else {
            XB_SPIN(xb_ld(&bar[XB_XGEN(b.x)]) == gen, bar);
            __builtin_amdgcn_fence(__ATOMIC_ACQUIRE, "agent");
            asm volatile("s_waitcnt vmcnt(0)" ::: "memory");
        }
    }
    __syncthreads();
}

constexpr int N_PHASES = 10;
#ifndef ONLY_PH
#define ONLY_PH -1
#endif
#define PH_ON(x) (ONLY_PH < 0 || ONLY_PH == (x))
__global__ void __launch_bounds__(512, 2) mega(Args a) {
    extern __shared__ __attribute__((aligned(16))) unsigned char lds[];
    cg::grid_group grid = cg::this_grid();
    unsigned char* ws = a.ws;
#define PH_RUN(x) (PH_ON(x) && a.ph_lo <= (x) && (x) < a.ph_hi)
#define PH_SYNC(x) do { if (a.ph_lo <= (x) && (x) + 1 < a.ph_hi) xcd_barrier(xb); } while (0)
    volatile LAS unsigned* xst = (volatile LAS unsigned*)((LAS unsigned char*)lds + 131072);
    if (threadIdx.x == 0) { xst[0] = 0u; xst[1] = 0u; }
    __syncthreads();
    const XcdBarrier xb = xcd_barrier_post((unsigned*)(ws + WS_BAR), xst);
    if (a.ph_hi > 1000) grid.sync();
#ifndef REP0
#define REP0 1
#endif
#ifndef REP2
#define REP2 1
#endif
#ifndef REP6
#define REP6 1
#endif
    if (PH_RUN(0)) for (int rep = 0; rep < REP0; ++rep) phase_prologue(a, lds);
    PH_SYNC(0);
    if (PH_RUN(1)) { pg8::Gemm g{(const bf16_t*)(ws + WS_XB), (const bf16_t*)(ws + WS_WIN), MT, NP, DM}; pg8::StaticOrder S; S.init(MT, NP, gridDim.x, blockIdx.x);
        pg8::EpiBf16 E{(bf16_t*)(ws + WS_PROJ), NP}; pg8::gemm_phase((LAS unsigned char*)lds, g, S, E);
        const int rem = ((MT / 256) * (NP / 256)) % (int)gridDim.x;
        if (rem == 0) phase_transposes(a, lds, TM_IN, TM_IN + TM_OUT + TM_UP, blockIdx.x, gridDim.x);
        else if ((int)blockIdx.x >= rem) phase_transposes(a, lds, TM_IN, TM_IN + TM_OUT + TM_UP, blockIdx.x - rem, gridDim.x - rem); }
    PH_SYNC(1);
    if (PH_RUN(2)) for (int rep = 0; rep < REP2; ++rep) { phase_yconv(a); phase_mlstm(a, lds, a.out); }
    PH_SYNC(2);
    if (PH_RUN(3)) phase_headnorm(a, a.out);
    PH_SYNC(3);
    if (PH_RUN(4)) { pg8::Gemm g{(const bf16_t*)(ws + WS_Y), (const bf16_t*)(ws + WS_WOUT), MT, DM, DM}; pg8::StaticOrder S; S.init(MT, DM, gridDim.x, blockIdx.x);
        pg8::EpiResF32 E{a.x, a.out, DM}; pg8::gemm_phase((LAS unsigned char*)lds, g, S, E); }
    PH_SYNC(4);
    if (PH_RUN(5)) phase_ln(a.out, a.ln1_g, a.ln1_b, (bf16_t*)(ws + WS_X1B));
    PH_SYNC(5);
    if (PH_RUN(6)) { pg8::Gemm g{(const bf16_t*)(ws + WS_X1B), (const bf16_t*)(ws + WS_WUP), MT, NUP, DM}; pg8::StaticOrder S; S.init(MT, NUP, gridDim.x, blockIdx.x);
        pg8::EpiConvFfn E{(bf16_t*)(ws + WS_ACT), (float*)(ws + WS_HALO), a.w_fc, a.b_fc}; pg8::gemm_phase((LAS unsigned char*)lds, g, S, E);
        const int rem = ((MT / 256) * (NUP / 256)) % (int)gridDim.x; const int t0 = TM_IN + TM_OUT + TM_UP, t1 = t0 + TM_DN;
        if (rem == 0) phase_transposes(a, lds, t0, t1, blockIdx.x, gridDim.x);
        else if ((int)blockIdx.x >= rem) phase_transposes(a, lds, t0, t1, blockIdx.x - rem, gridDim.x - rem); }
    PH_SYNC(6);
    if (PH_RUN(7)) phase_fixup(a);
    PH_SYNC(7);
    if (PH_RUN(8)) { pg8::Gemm g{(const bf16_t*)(ws + WS_ACT), (const bf16_t*)(ws + WS_WDN), MT, DM, DFF}; pg8::StaticOrder S; S.init(MT, DM, gridDim.x, blockIdx.x);
        pg8::EpiResF32 E{a.out, a.out, DM}; pg8::gemm_phase((LAS unsigned char*)lds, g, S, E); }
    PH_SYNC(8);
    if (PH_RUN(9)) phase_ln(a.out, a.ln2_g, a.ln2_b, nullptr);
    if (DBG_STOP == 1 && a.ph_lo == 101) phase_dump((const bf16_t*)(ws + WS_PROJ), NP, 3072, a.out);
    if (DBG_STOP == 3 && a.ph_lo == 103) phase_dump((const bf16_t*)(ws + WS_Y), DM, 0, a.out);
    if (DBG_STOP == 7 && a.ph_lo == 107) phase_dump((const bf16_t*)(ws + WS_ACT), DFF, 0, a.out);
}

extern "C" void kernel_launch(void* const* d_in, const int* in_sizes, int n_in, void* d_out, int out_size, void* d_ws, size_t ws_size, hipStream_t stream) {
    static int grid = 0;
    if (grid == 0) {
        if (n_in != 14 || ws_size < WS_END) { fprintf(stderr, "kernel_launch: unexpected n_in %d / ws_size %zu (need %zu)\n", n_in, ws_size, (size_t)WS_END); grid = -1; return; }
        int dev = 0, cus = 0, per_cu = 0;
        hipGetDevice(&dev); hipDeviceGetAttribute(&cus, hipDeviceAttributeMultiprocessorCount, dev);
        if (hipFuncSetAttribute((const void*)mega, hipFuncAttributeMaxDynamicSharedMemorySize, LDS_BYTES) != hipSuccess) { fprintf(stderr, "kernel_launch: hipFuncSetAttribute failed\n"); grid = -1; return; }
        if (hipOccupancyMaxActiveBlocksPerMultiprocessor(&per_cu, (const void*)mega, 512, LDS_BYTES) != hipSuccess || per_cu < 1) { fprintf(stderr, "kernel_launch: occupancy query failed (%d)\n", per_cu); (void)hipGetLastError(); per_cu = 1; }
        grid = cus * 1;
        fprintf(stderr, "kernel_launch: cus %d per_cu %d grid %d\n", cus, per_cu, grid);
    }
    if (grid < 0) return;
    if (hipMemsetAsync((char*)d_ws + WS_BAR, 0, XCD_BAR_WORDS * 4, stream) != hipSuccess) { fprintf(stderr, "kernel_launch: memset failed\n"); return; }
    Args a{};
    a.x = (const float*)d_in[0]; a.w_in = (const float*)d_in[1]; a.b_gates = (const float*)d_in[2]; a.w_sc = (const float*)d_in[3]; a.mh_gain = (const float*)d_in[4]; a.w_out = (const float*)d_in[5];
    a.ln1_g = (const float*)d_in[6]; a.ln1_b = (const float*)d_in[7]; a.w_up = (const float*)d_in[8]; a.w_fc = (const float*)d_in[9]; a.b_fc = (const float*)d_in[10]; a.w_down = (const float*)d_in[11];
    a.ln2_g = (const float*)d_in[12]; a.ln2_b = (const float*)d_in[13];
    a.out = (float*)d_out; a.ws = (unsigned char*)d_ws;
#if MK_SINGLE
    a.ph_lo = 0; a.ph_hi = N_PHASES;
    void* args[] = {&a};
    hipError_t e = hipLaunchCooperativeKernel((const void*)mega, dim3(grid), dim3(512), args, LDS_BYTES, stream);
    if (e != hipSuccess) fprintf(stderr, "cooperative launch failed: %s (grid %d)\n", hipGetErrorString(e), grid);
#else
    for (int ph = 0; ph < N_PHASES; ++ph) { if (DBG_STOP >= 0 && ph > DBG_STOP) break; a.ph_lo = ph; a.ph_hi = ph + 1; hipLaunchKernelGGL(mega, dim3(grid), dim3(512), LDS_BYTES, stream, a); }
    if (DBG_STOP >= 0) { a.ph_lo = 100 + DBG_STOP; a.ph_hi = 101 + DBG_STOP; hipLaunchKernelGGL(mega, dim3(grid), dim3(512), LDS_BYTES, stream, a); }
#endif
}
```

```cpp
#include <hip/hip_runtime.h>
#include <hip/hip_cooperative_groups.h>
#include <cstdio>
#include <cstdint>
namespace cg = cooperative_groups;

#ifndef MK_SINGLE
#define MK_SINGLE 1
#endif

#define LAS __attribute__((address_space(3)))
typedef unsigned short bf16_t;
typedef short bf16x8 __attribute__((ext_vector_type(8)));
typedef float f32x4 __attribute__((ext_vector_type(4)));
typedef unsigned u32x4 __attribute__((ext_vector_type(4)));
typedef unsigned u32x2 __attribute__((ext_vector_type(2)));

constexpr int MT = 8192, DM = 2048, SEQ = 2048, NIN = 7176, NP = 7168, DFF = 5632, NUP = 11264, WCONV = 1024;
constexpr float ALPHA = 1.189207115002721f;
constexpr size_t WS_WIN = 0;
constexpr size_t WS_WOUT = WS_WIN + (size_t)NP * DM * 2;
constexpr size_t WS_WUP = WS_WOUT + (size_t)DM * DM * 2;
constexpr size_t WS_WDN = WS_WUP + (size_t)NUP * DM * 2;
constexpr size_t WS_X1B = WS_WDN + (size_t)DM * DFF * 2;
constexpr size_t WS_GATES = WS_X1B + (size_t)MT * DM * 2;
constexpr size_t WS_C = WS_GATES + (size_t)MT * 8 * 4;
constexpr size_t WS_PROJ = WS_C;
constexpr size_t WS_Y = WS_PROJ + (size_t)MT * NP * 2;
constexpr size_t WS_XB = WS_Y + (size_t)MT * DM * 2;
constexpr size_t WS_ACT = WS_C;
constexpr size_t WS_HALO = WS_ACT + (size_t)MT * DFF * 2;
constexpr size_t WS_BAR = WS_XB + (size_t)MT * DM * 2;
constexpr size_t WS_RS1 = WS_BAR + 16384;
constexpr size_t WS_RS2 = WS_RS1 + (size_t)MT * 8;
constexpr size_t WS_CNT = WS_RS2 + (size_t)MT * 8;
constexpr size_t WS_END = WS_CNT + 2 * 32 * 256;
constexpr int LDS_BYTES = 131072 + 16 + 3 * 32 * 64 * 4;

struct Args {
    const float* x; const float* w_in; const float* b_gates; const float* w_sc; const float* mh_gain; const float* w_out;
    const float* ln1_g; const float* ln1_b; const float* w_up; const float* w_fc; const float* b_fc; const float* w_down;
    const float* ln2_g; const float* ln2_b;
    float* out; unsigned char* ws; int ph_lo, ph_hi, fuse_ln, pad0;
};

typedef __bf16 bf16v2 __attribute__((ext_vector_type(2)));
typedef float f32x2 __attribute__((ext_vector_type(2)));
__device__ __forceinline__ unsigned cvt_pk_bf16(float lo, float hi) { const f32x2 v = {lo, hi}; const bf16v2 r = __builtin_convertvector(v, bf16v2); return __builtin_bit_cast(unsigned, r); }
__device__ __forceinline__ unsigned cvt_pk_bf16_asm(float lo, float hi) { unsigned r; asm volatile("v_cvt_pk_bf16_f32 %0, %1, %2" : "=v"(r) : "v"(lo), "v"(hi)); return r; }
__device__ __forceinline__ float bflo(unsigned u) { return __uint_as_float(u << 16); }
__device__ __forceinline__ float bfhi(unsigned u) { return __uint_as_float(u & 0xffff0000u); }
__device__ __forceinline__ bf16_t f2bf(float f) { unsigned u = __float_as_uint(f); u += 0x7FFFu + ((u >> 16) & 1u); return (bf16_t)(u >> 16); }

namespace pg8 {
constexpr int BM = 256, BK = 64, HALF = 128, HTB = HALF * BK * 2, STAGE_BYTES = 8 * HTB, NXCD = 8, WGM = 8;
__host__ __device__ __forceinline__ int lds_byte(int r, int c) { const int st = (r >> 4) * 2 + (c >> 5), rr = r & 15, cc = c & 31, ob = rr * 64 + cc * 2; return st * 1024 + (ob ^ (((ob >> 9) & 1) << 5)); }
__host__ __device__ __forceinline__ void stage_rc(int b, int& R, int& C) { const int st = b / 1024, sb = b % 1024, swz = sb ^ (((sb >> 9) & 1) << 5); R = (st >> 1) * 16 + swz / 64; C = (st & 1) * 32 + (swz % 64) / 2; }
__host__ __device__ __forceinline__ int perm32(int rho) { const int n = rho >> 4, i = rho & 15; return 8 * (i >> 2) + 4 * n + (i & 3); }
struct Unit { int pm, pn; };
struct Gemm { const bf16_t* A; const bf16_t* Bt; int M, N, K; };
struct StaticOrder {
    int nM, nN, nwg, G, c;
    __device__ void init(int M, int N, int G_, int c_) { nM = M / BM; nN = N / BM; nwg = nM * nN; G = G_; c = c_; }
    __device__ bool next(int i, Unit& u) const {
        const long L = (long)i * G + c; if (L >= nwg) return false;
        int wgid = (int)L; { const int q = nwg / NXCD, r = nwg % NXCD, xcd = wgid % NXCD, off = wgid / NXCD; wgid = (xcd < r ? xcd * (q + 1) : r * (q + 1) + (xcd - r) * q) + off; }
        const int nig = WGM * nN, gid = wgid / nig, fm = gid * WGM, gsz = (nM - fm) < WGM ? (nM - fm) : WGM;
        u.pm = fm + ((wgid % nig) % gsz); u.pn = (wgid % nig) / gsz; return true;
    }
};

template <class Epi>
__device__ __forceinline__ void gemm_phase(LAS unsigned char* lds, const Gemm g, const StaticOrder& S, const Epi& E) {
    const int tid = threadIdx.x, wid = __builtin_amdgcn_readfirstlane(tid >> 6), lane = tid & 63, wr = wid >> 2, wc = wid & 3, fr = lane & 15, fq = lane >> 4;
    const int K = g.K, nt = K / BK;
    unsigned voffA[2], voffB[2];
#pragma unroll
    for (int i = 0; i < 2; ++i) { int R, C; stage_rc(tid * 16 + i * 8192, R, C); const int Rb = Epi::PERM ? ((R & ~31) + perm32(R & 31)) : R;
        voffA[i] = (unsigned)(R * K + C) * 2u; voffB[i] = (unsigned)(Rb * K + C) * 2u; }
    const size_t kstep = (size_t)(BK * 2);
    const size_t hstep = (size_t)HALF * K * 2;
    const size_t tstep = 2 * hstep;
    const unsigned ldsw = (unsigned)wid * 1024u;
    const int aoff = lds_byte(wr * 64 + fr, fq * 8), boff = lds_byte(wc * 32 + fr, fq * 8);
#define PG8_SA(b, h) (((b) * 2 + (h)) * HTB)
#define PG8_SB(b, h) ((4 + (b) * 2 + (h)) * HTB)
#define PG8_STAGE(bufoff, gbase, voff) do { _Pragma("unroll") for (int _i = 0; _i < 2; ++_i) \
        __builtin_amdgcn_global_load_lds((const unsigned*)((const char*)(gbase) + (voff)[_i]), (LAS unsigned*)(lds + (bufoff) + ldsw + _i * 8192), 16, 0, 0); } while (0)
#define PG8_LDA(dst, b, h) do { _Pragma("unroll") for (int m = 0; m < 4; ++m) _Pragma("unroll") for (int k = 0; k < 2; ++k) dst[m][k] = *(const LAS bf16x8*)(lds + PG8_SA(b, h) + aoff + m * 2048 + k * 1024); } while (0)
#define PG8_LDB(dst, b, h) do { _Pragma("unroll") for (int n = 0; n < 2; ++n) _Pragma("unroll") for (int k = 0; k < 2; ++k) dst[n][k] = *(const LAS bf16x8*)(lds + PG8_SB(b, h) + boff + n * 2048 + k * 1024); } while (0)
#define PG8_MMA(ai, bj, At, Bt) do { __builtin_amdgcn_s_setprio(1); _Pragma("unroll") for (int m = 0; m < 4; ++m) _Pragma("unroll") for (int n = 0; n < 2; ++n) _Pragma("unroll") for (int k = 0; k < 2; ++k) \
        acc[ai][bj][m][n] = __builtin_amdgcn_mfma_f32_16x16x32_bf16(Bt[n][k], At[m][k], acc[ai][bj][m][n], 0, 0, 0); __builtin_amdgcn_s_setprio(0); } while (0)
#define PG8_WAIT_V(n) asm volatile("s_waitcnt vmcnt(" #n ")" ::: "memory")
#define PG8_WAIT_L(n) asm volatile("s_waitcnt lgkmcnt(" #n ")" ::: "memory")
#define PG8_BAR __builtin_amdgcn_s_barrier()
#define PG8_SCHED __builtin_amdgcn_sched_barrier(0)
    Unit cur, nxt; int ui = 0;
    if (!S.next(0, cur)) return;
    f32x4 acc[2][2][4][2];
#pragma unroll
    for (int a = 0; a < 2; ++a)
#pragma unroll
        for (int b = 0; b < 2; ++b)
#pragma unroll
            for (int m = 0; m < 4; ++m)
#pragma unroll
                for (int n = 0; n < 2; ++n) acc[a][b][m][n] = (f32x4){0.f, 0.f, 0.f, 0.f};
    bf16x8 At[4][2], B0[2][2], B1[2][2];
    const char* cA = (const char*)g.A + (size_t)cur.pm * tstep; const char* cB = (const char*)g.Bt + (size_t)cur.pn * tstep;
    PG8_STAGE(PG8_SB(0, 0), cB, voffB); PG8_STAGE(PG8_SA(0, 0), cA, voffA); PG8_STAGE(PG8_SB(0, 1), cB + hstep, voffB); PG8_STAGE(PG8_SA(0, 1), cA + hstep, voffA);
    if (wr == 1) PG8_BAR;
    PG8_WAIT_V(4); PG8_BAR;
    PG8_STAGE(PG8_SB(1, 0), cB + kstep, voffB); PG8_STAGE(PG8_SA(1, 0), cA + kstep, voffA); PG8_STAGE(PG8_SB(1, 1), cB + hstep + kstep, voffB);
    PG8_WAIT_V(6); PG8_BAR;
    for (;;) {
        const bool has_next = S.next(ui + 1, nxt);
        const char* nA = has_next ? (const char*)g.A + (size_t)nxt.pm * tstep : cA; const char* nB = has_next ? (const char*)g.Bt + (size_t)nxt.pn * tstep : cB;
        for (int t = 0; t < nt; t += 2) {
            const bool last = (t == nt - 2);
            const char* a1 = cA + (size_t)(t + 1) * kstep;
            const char* a2 = last ? nA : cA + (size_t)(t + 2) * kstep; const char* b2 = last ? nB : cB + (size_t)(t + 2) * kstep;
            const char* a3 = a2 + kstep; const char* b3 = b2 + kstep;
            PG8_LDB(B0, 0, 0); PG8_SCHED; PG8_LDA(At, 0, 0); PG8_STAGE(PG8_SA(1, 1), a1 + hstep, voffA);
            PG8_WAIT_L(8); PG8_BAR; PG8_WAIT_L(0); PG8_MMA(0, 0, At, B0); PG8_BAR; PG8_SCHED;
            PG8_LDB(B1, 0, 1); PG8_STAGE(PG8_SB(0, 0), b2, voffB);
            PG8_BAR; PG8_WAIT_L(0); PG8_MMA(0, 1, At, B1); PG8_BAR;
            PG8_LDA(At, 0, 1); PG8_STAGE(PG8_SA(0, 0), a2, voffA);
            PG8_BAR; PG8_WAIT_L(0); PG8_MMA(1, 0, At, B0); PG8_BAR; PG8_SCHED;
            PG8_STAGE(PG8_SB(0, 1), b2 + hstep, voffB);
            PG8_WAIT_V(6); PG8_BAR; PG8_MMA(1, 1, At, B1); PG8_BAR;
            PG8_LDB(B0, 1, 0); PG8_SCHED; PG8_LDA(At, 1, 0); PG8_STAGE(PG8_SA(0, 1), a2 + hstep, voffA);
            PG8_WAIT_L(8); PG8_BAR; PG8_WAIT_L(0); PG8_MMA(0, 0, At, B0); PG8_BAR; PG8_SCHED;
            PG8_LDB(B1, 1, 1); PG8_STAGE(PG8_SB(1, 0), b3, voffB);
            PG8_BAR; PG8_WAIT_L(0); PG8_MMA(0, 1, At, B1); PG8_BAR;
            PG8_LDA(At, 1, 1); PG8_STAGE(PG8_SA(1, 0), a3, voffA);
            PG8_BAR; PG8_WAIT_L(0); PG8_MMA(1, 0, At, B0); PG8_BAR; PG8_SCHED;
            PG8_STAGE(PG8_SB(1, 1), b3 + hstep, voffB);
            PG8_WAIT_V(6); PG8_BAR; PG8_MMA(1, 1, At, B1); PG8_BAR;
        }
        if constexpr (!Epi::AFTER_DRAIN) E(acc, cur, wr, wc, fr, fq);
        if (!has_next) break;
#pragma unroll
        for (int a = 0; a < 2; ++a)
#pragma unroll
            for (int b = 0; b < 2; ++b)
#pragma unroll
                for (int m = 0; m < 4; ++m)
#pragma unroll
                    for (int n = 0; n < 2; ++n) acc[a][b][m][n] = (f32x4){0.f, 0.f, 0.f, 0.f};
        cur = nxt; cA = nA; cB = nB; ++ui;
    }
    PG8_WAIT_V(0);
    if (wr == 0) PG8_BAR;
    PG8_BAR;
    if constexpr (Epi::AFTER_DRAIN) E(acc, cur, wr, wc, fr, fq);
#undef PG8_SA
#undef PG8_SB
#undef PG8_STAGE
#undef PG8_LDA
#undef PG8_LDB
#undef PG8_MMA
#undef PG8_WAIT_V
#undef PG8_WAIT_L
#undef PG8_BAR
#undef PG8_SCHED
}

struct EpiBf16 {
    static constexpr bool PERM = true, AFTER_DRAIN = false;
    bf16_t* O; int ldc;
    __device__ __forceinline__ void operator()(f32x4 (&acc)[2][2][4][2], const Unit& u, int wr, int wc, int fr, int fq) const {
        const int row0 = u.pm * BM + wr * 64 + fr, col0 = u.pn * BM + wc * 32 + 8 * fq;
#pragma unroll
        for (int ai = 0; ai < 2; ++ai)
#pragma unroll
            for (int m = 0; m < 4; ++m) { bf16_t* rowp = O + (size_t)(row0 + ai * HALF + m * 16) * ldc + col0;
#pragma unroll
                for (int bj = 0; bj < 2; ++bj) { const f32x4 v0 = acc[ai][bj][m][0], v1 = acc[ai][bj][m][1];
                    u32x4 w; w.x = cvt_pk_bf16_asm(v0[0], v0[1]); w.y = cvt_pk_bf16_asm(v0[2], v0[3]); w.z = cvt_pk_bf16_asm(v1[0], v1[1]); w.w = cvt_pk_bf16_asm(v1[2], v1[3]);
                    *(u32x4*)(rowp + bj * HALF) = w; } }
    }
};
struct EpiResF32 {
    static constexpr bool PERM = false, AFTER_DRAIN = false;
    const float* X; float* O; int ldc;
    __device__ __forceinline__ void operator()(f32x4 (&acc)[2][2][4][2], const Unit& u, int wr, int wc, int fr, int fq) const {
        const int row0 = u.pm * BM + wr * 64 + fr, col0 = u.pn * BM + wc * 32 + 4 * fq;
#pragma unroll
        for (int ai = 0; ai < 2; ++ai)
#pragma unroll
            for (int m = 0; m < 4; ++m) { const size_t ro = (size_t)(row0 + ai * HALF + m * 16) * ldc + col0;
#pragma unroll
                for (int bj = 0; bj < 2; ++bj)
#pragma unroll
                    for (int n = 0; n < 2; ++n) { const f32x4 xv = *(const f32x4*)(X + ro + bj * HALF + n * 16);
                        *(f32x4*)(O + ro + bj * HALF + n * 16) = xv * ALPHA + acc[ai][bj][m][n]; } }
    }
};
struct EpiResLn {
    static constexpr bool PERM = false, AFTER_DRAIN = true;
    const float* X; float* O; bf16_t* OB; const float* gam; const float* bet; float* rs; unsigned* cnt;
    __device__ __forceinline__ void operator()(f32x4 (&acc)[2][2][4][2], const Unit& u, int wr, int wc, int fr, int fq) const {
        const int row0 = u.pm * BM + wr * 64 + fr, col0 = u.pn * BM + wc * 32 + 4 * fq;
#pragma unroll
        for (int ai = 0; ai < 2; ++ai)
#pragma unroll
            for (int m = 0; m < 4; ++m) { const int row = row0 + ai * HALF + m * 16; const size_t ro = (size_t)row * DM + col0;
                float s = 0.f, q = 0.f;
#pragma unroll
                for (int bj = 0; bj < 2; ++bj)
#pragma unroll
                    for (int n = 0; n < 2; ++n) { const f32x4 xv = *(const f32x4*)(X + ro + bj * HALF + n * 16); const f32x4 z = xv * ALPHA + acc[ai][bj][m][n]; acc[ai][bj][m][n] = z;
                        s += (z[0] + z[1]) + (z[2] + z[3]); q += (z[0] * z[0] + z[1] * z[1]) + (z[2] * z[2] + z[3] * z[3]); }
                s += __shfl_xor(s, 16); s += __shfl_xor(s, 32); q += __shfl_xor(q, 16); q += __shfl_xor(q, 32);
                if (fq == 0) { (void)__hip_atomic_fetch_add(rs + 2 * row, s, __ATOMIC_RELAXED, __HIP_MEMORY_SCOPE_AGENT); (void)__hip_atomic_fetch_add(rs + 2 * row + 1, q, __ATOMIC_RELAXED, __HIP_MEMORY_SCOPE_AGENT); } }
        asm volatile("s_waitcnt vmcnt(0)" ::: "memory");
        unsigned* cp = cnt + 64 * u.pm;
        if ((threadIdx.x & 63) == 0) (void)__hip_atomic_fetch_add(cp, 1u, __ATOMIC_RELAXED, __HIP_MEMORY_SCOPE_AGENT);
        { unsigned sp = 0; while ((unsigned)__builtin_amdgcn_readfirstlane(__hip_atomic_load(cp, __ATOMIC_RELAXED, __HIP_MEMORY_SCOPE_AGENT)) < 64u) { __builtin_amdgcn_s_sleep(2); if (++sp > (1u << 22)) break; } }
        f32x4 gg[2][2], bb[2][2];
#pragma unroll
        for (int bj = 0; bj < 2; ++bj)
#pragma unroll
            for (int n = 0; n < 2; ++n) { gg[bj][n] = *(const f32x4*)(gam + col0 + bj * HALF + n * 16); bb[bj][n] = *(const f32x4*)(bet + col0 + bj * HALF + n * 16); }
#pragma unroll
        for (int ai = 0; ai < 2; ++ai)
#pragma unroll
            for (int m = 0; m < 4; ++m) { const int row = row0 + ai * HALF + m * 16; const size_t ro = (size_t)row * DM + col0;
                const float s = __hip_atomic_load(rs + 2 * row, __ATOMIC_RELAXED, __HIP_MEMORY_SCOPE_AGENT), q = __hip_atomic_load(rs + 2 * row + 1, __ATOMIC_RELAXED, __HIP_MEMORY_SCOPE_AGENT);
                const float mu = s * (1.0f / DM), rstd = rsqrtf(fmaxf(q * (1.0f / DM) - mu * mu, 0.f) + 1e-5f);
#pragma unroll
                for (int bj = 0; bj < 2; ++bj)
#pragma unroll
                    for (int n = 0; n < 2; ++n) { const f32x4 o = (acc[ai][bj][m][n] - mu) * rstd * gg[bj][n] + bb[bj][n];
                        *(f32x4*)(O + ro + bj * HALF + n * 16) = o;
                        if (OB) { u32x2 p; p.x = cvt_pk_bf16_asm(o[0], o[1]); p.y = cvt_pk_bf16_asm(o[2], o[3]); *(u32x2*)(OB + ro + bj * HALF + n * 16) = p; } } }
    }
};
#define DPP_SHR1(x) __builtin_bit_cast(float, __builtin_amdgcn_update_dpp(0, __builtin_bit_cast(int, (x)), 0x111, 0xf, 0xf, true))
#define DPP_SHR2(x) __builtin_bit_cast(float, __builtin_amdgcn_update_dpp(0, __builtin_bit_cast(int, (x)), 0x112, 0xf, 0xf, true))
#define DPP_SHL15(o, x) __builtin_bit_cast(float, __builtin_amdgcn_update_dpp(__builtin_bit_cast(int, (o)), __builtin_bit_cast(int, (x)), 0x10F, 0xf, 0xf, false))
#define DPP_SHL14(o, x) __builtin_bit_cast(float, __builtin_amdgcn_update_dpp(__builtin_bit_cast(int, (o)), __builtin_bit_cast(int, (x)), 0x10E, 0xf, 0xf, false))
struct EpiConvFfn {
    static constexpr bool PERM = true, AFTER_DRAIN = false;
    bf16_t* act; float* halo; const float* cw; const float* cb;
    __device__ __forceinline__ void operator()(f32x4 (&acc)[2][2][4][2], const Unit& u, int wr, int wc, int fr, int fq) const {
        const int fcol = u.pn * 128 + wc * 32 + 8 * fq;
#pragma unroll
        for (int ai = 0; ai < 2; ++ai) {
            float* hb = halo + (size_t)((u.pm * BM + ai * HALF + wr * 64) >> 6) * 4 * NUP + fcol;
            if (fr < 2) {
#pragma unroll
                for (int bj = 0; bj < 2; ++bj)
#pragma unroll
                    for (int n = 0; n < 2; ++n) *(f32x4*)(hb + (size_t)(2 + fr) * NUP + bj * DFF + 4 * n) = acc[ai][bj][0][n];
            }
            if (fr >= 14) {
#pragma unroll
                for (int bj = 0; bj < 2; ++bj)
#pragma unroll
                    for (int n = 0; n < 2; ++n) *(f32x4*)(hb + (size_t)(fr - 14) * NUP + bj * DFF + 4 * n) = acc[ai][bj][3][n];
            }
        }
        u32x2 pk0[2][4];
#pragma unroll
        for (int n = 0; n < 2; ++n) {
            f32x4 W0[2], W1[2], W2[2], Bb[2];
#pragma unroll
            for (int bj = 0; bj < 2; ++bj) { const int hc = bj * DFF + fcol + 4 * n;
                W0[bj] = *(const f32x4*)(cw + hc); W1[bj] = *(const f32x4*)(cw + NUP + hc); W2[bj] = *(const f32x4*)(cw + 2 * NUP + hc); Bb[bj] = *(const f32x4*)(cb + hc); }
#pragma unroll
            for (int ai = 0; ai < 2; ++ai) {
                const int rbase = u.pm * BM + ai * HALF + wr * 64;
#pragma unroll
                for (int m = 0; m < 4; ++m) {
                    float av[4];
#pragma unroll
                    for (int j = 0; j < 4; ++j) {
                        float hc[2];
#pragma unroll
                        for (int bj = 0; bj < 2; ++bj) {
                            const float cur = acc[ai][bj][m][n][j];
                            float p1 = DPP_SHR1(cur), p2 = DPP_SHR2(cur);
                            if (m > 0) { const float pv = acc[ai][bj][m > 0 ? m - 1 : 0][n][j]; p1 = DPP_SHL15(p1, pv); p2 = DPP_SHL14(p2, pv); }
                            hc[bj] = W2[bj][j] * cur + W1[bj][j] * p1 + W0[bj][j] * p2 + Bb[bj][j];
                        }
                        const float gt = hc[1];
                        av[j] = hc[0] * gt * __builtin_amdgcn_rcpf(1.0f + __expf(-gt));
                    }
                    u32x2 pk; pk.x = cvt_pk_bf16_asm(av[0], av[1]); pk.y = cvt_pk_bf16_asm(av[2], av[3]);
                    if (n == 0) pk0[ai][m] = pk;
                    else if (m > 0 || fr >= 2) { u32x4 w; w.x = pk0[ai][m].x; w.y = pk0[ai][m].y; w.z = pk.x; w.w = pk.y;
                        *(u32x4*)(act + (size_t)(rbase + m * 16 + fr) * DFF + fcol) = w; }
                }
            }
            asm volatile("" ::: "memory");
        }
    }
};
}

template <bool UPMAP>
__device__ __forceinline__ void transpose_macro(const float* W, int ldw, int k0, int n0, bf16_t* Wt, int ldt, unsigned char* lds) {
    bf16_t* sT = (bf16_t*)lds; const int tid = threadIdx.x;
    float4 v[2][4];
#pragma unroll
    for (int i = 0; i < 2; ++i)
#pragma unroll
        for (int j = 0; j < 4; ++j) v[i][j] = *(const float4*)(W + (size_t)(k0 + (tid >> 4) + 32 * i) * ldw + n0 + 64 * j + (tid & 15) * 4);
#pragma unroll
    for (int i = 0; i < 2; ++i)
#pragma unroll
        for (int j = 0; j < 4; ++j) { const int k = (tid >> 4) + 32 * i, n = 64 * j + (tid & 15) * 4;
            sT[(n + 0) * 66 + k] = f2bf(v[i][j].x); sT[(n + 1) * 66 + k] = f2bf(v[i][j].y); sT[(n + 2) * 66 + k] = f2bf(v[i][j].z); sT[(n + 3) * 66 + k] = f2bf(v[i][j].w); }
    __syncthreads();
#pragma unroll
    for (int j = 0; j < 4; ++j) { const int n = 64 * j + (tid >> 3), ks = (tid & 7) * 8; const unsigned* p = (const unsigned*)(sT + n * 66 + ks);
        u32x4 o; o.x = p[0]; o.y = p[1]; o.z = p[2]; o.w = p[3];
        int drow = n0 + n;
        if (UPMAP) { const int f = (drow < DFF) ? drow : drow - DFF; drow = 256 * (f >> 7) + (f & 127) + ((drow < DFF) ? 0 : 128); }
        *(u32x4*)(Wt + (size_t)drow * ldt + k0 + ks) = o; }
    __syncthreads();
}
constexpr int TM_IN = 32 * 28, TM_OUT = 32 * 8, TM_UP = 32 * 44, TM_DN = 88 * 8;
__device__ __forceinline__ void phase_transposes(const Args& A, unsigned char* lds, int g0, int g1, int worker, int nworkers) {
    unsigned char* ws = A.ws;
    for (int g = g0 + worker; g < g1; g += nworkers) {
        if (g < TM_IN) { const int tk = g / 28, tn = g % 28; transpose_macro<false>(A.w_in, NIN, tk * 64, tn * 256, (bf16_t*)(ws + WS_WIN), DM, lds); }
        else if (g < TM_IN + TM_OUT) { const int h = g - TM_IN, tk = h / 8, tn = h % 8; transpose_macro<false>(A.w_out, DM, tk * 64, tn * 256, (bf16_t*)(ws + WS_WOUT), DM, lds); }
        else if (g < TM_IN + TM_OUT + TM_UP) { const int h = g - TM_IN - TM_OUT, tk = h / 44, tn = h % 44; transpose_macro<true>(A.w_up, NUP, tk * 64, tn * 256, (bf16_t*)(ws + WS_WUP), DM, lds); }
        else { const int h = g - TM_IN - TM_OUT - TM_UP, tk = h / 8, tn = h % 8; transpose_macro<false>(A.w_down, DM, tk * 64, tn * 256, (bf16_t*)(ws + WS_WDN), DFF, lds); }
    }
}
__device__ __forceinline__ void phase_prologue(const Args& A, unsigned char* lds) {
    unsigned char* ws = A.ws;
    phase_transposes(A, lds, 0, TM_IN, blockIdx.x, gridDim.x);
    const int lane = threadIdx.x & 63, gw = blockIdx.x * 8 + (threadIdx.x >> 6), nw = gridDim.x * 8;
    bf16_t* xb = (bf16_t*)(ws + WS_XB); float* gates = (float*)(ws + WS_GATES);
    for (int it = gw; it < MT / 4; it += nw) {
        const int r0 = it * 4;
        float acc[4][8];
#pragma unroll
        for (int r = 0; r < 4; ++r)
#pragma unroll
            for (int q = 0; q < 8; ++q) acc[r][q] = 0.f;
#pragma unroll 1
        for (int i = 0; i < 8; ++i) {
            const int kb = i * 256 + lane * 4;
            f32x4 xv[4];
#pragma unroll
            for (int r = 0; r < 4; ++r) { xv[r] = *(const f32x4*)(A.x + (size_t)(r0 + r) * DM + kb);
                u32x2 o; o.x = cvt_pk_bf16(xv[r][0], xv[r][1]); o.y = cvt_pk_bf16(xv[r][2], xv[r][3]); *(u32x2*)(xb + (size_t)(r0 + r) * DM + kb) = o; }
#pragma unroll
            for (int j = 0; j < 4; ++j) {
                const f32x4* wp = (const f32x4*)(A.w_in + (size_t)(kb + j) * NIN + NP);
                const f32x4 w0 = wp[0], w1 = wp[1];
#pragma unroll
                for (int r = 0; r < 4; ++r) { const float xs = xv[r][j];
                    acc[r][0] += xs * w0[0]; acc[r][1] += xs * w0[1]; acc[r][2] += xs * w0[2]; acc[r][3] += xs * w0[3];
                    acc[r][4] += xs * w1[0]; acc[r][5] += xs * w1[1]; acc[r][6] += xs * w1[2]; acc[r][7] += xs * w1[3]; }
            }
        }
#pragma unroll
        for (int r = 0; r < 4; ++r)
#pragma unroll
            for (int q = 0; q < 8; ++q) { float v = acc[r][q];
#pragma unroll
                for (int off = 32; off >= 1; off >>= 1) v += __shfl_xor(v, off);
                acc[r][q] = v; }
        if (lane == 0) {
            const f32x4 b0 = *(const f32x4*)(A.b_gates), b1 = *(const f32x4*)(A.b_gates + 4);
#pragma unroll
            for (int r = 0; r < 4; ++r) {
                *(f32x4*)(gates + (size_t)(r0 + r) * 8) = (f32x4){acc[r][0] + b0[0], acc[r][1] + b0[1], acc[r][2] + b0[2], acc[r][3] + b0[3]};
                *(f32x4*)(gates + (size_t)(r0 + r) * 8 + 4) = (f32x4){acc[r][4] + b1[0], acc[r][5] + b1[1], acc[r][6] + b1[2], acc[r][7] + b1[3]}; }
        }
    }
}

__device__ __forceinline__ void phase_yconv(const Args& A) {
    const bf16_t* proj = (const bf16_t*)(A.ws + WS_PROJ); bf16_t* y = (bf16_t*)(A.ws + WS_Y);
    for (int idx = blockIdx.x * 512 + threadIdx.x; idx < MT * 128; idx += gridDim.x * 512) {
        const int row = idx >> 7, c = (idx & 127) * 8, t = row & (SEQ - 1);
        const bf16_t* pr = proj + (size_t)row * NP + c;
        const u32x4 bv = *(const u32x4*)pr;
        float cv[8];
#pragma unroll
        for (int i = 0; i < 8; ++i) cv[i] = 0.f;
#pragma unroll
        for (int j = 0; j < 3; ++j) {
            const int dt = 2 - j;
            if (t - dt >= 0) {
                const u32x4 cc = *(const u32x4*)(pr - (size_t)dt * NP + WCONV), hh = *(const u32x4*)(pr - (size_t)dt * NP + 2 * WCONV);
                const f32x4 w0 = *(const f32x4*)(A.w_sc + j * WCONV + c), w1 = *(const f32x4*)(A.w_sc + j * WCONV + c + 4);
                const float wv[8] = {w0[0], w0[1], w0[2], w0[3], w1[0], w1[1], w1[2], w1[3]};
#pragma unroll
                for (int q = 0; q < 4; ++q) { cv[2 * q] += wv[2 * q] * bflo(cc[q]) * bflo(hh[q]); cv[2 * q + 1] += wv[2 * q + 1] * bfhi(cc[q]) * bfhi(hh[q]); }
            }
        }
        u32x4 o;
#pragma unroll
        for (int q = 0; q < 4; ++q) o[q] = cvt_pk_bf16(bflo(bv[q]) * cv[2 * q], bfhi(bv[q]) * cv[2 * q + 1]);
        *(u32x4*)(y + (size_t)row * DM + c) = o;
    }
}

__device__ __forceinline__ void phase_mlstm(const Args& A, unsigned char* lds, float* hbuf) {
    const int tid = threadIdx.x, lane = tid & 63, w = tid >> 6, g = lane >> 4, l15 = lane & 15;
    const int a = w >> 2, ti = w & 3;
    unsigned char* QS = lds; unsigned char* KS = lds + 33792; unsigned char* VT = lds + 67584; unsigned char* WVT = VT + 4608; unsigned char* CT = WVT + 4608; unsigned char* XCH = CT + 33792;
    const bf16_t* proj = (const bf16_t*)(A.ws + WS_PROJ); const float* gates = (const float*)(A.ws + WS_GATES);
    float* TBC = (float*)(lds + 131088); float* TUV = TBC + 2048; float* TCM = TUV + 2048;
    for (int item = blockIdx.x; item < 256; item += gridDim.x) {
        const int xcd = item & 7, idx = item >> 3; const int bh = xcd * 2 + (idx >> 4), es = idx & 15;
        const int b = bh >> 2, hh = bh & 3, e0 = es * 16;
        const size_t row0 = (size_t)b * SEQ;
        __syncthreads();
        for (int i = tid; i < 16896 / 4; i += 512) ((unsigned*)CT)[i] = 0u;
        for (int i = tid; i < 16 * 72; i += 512) { const int r = 16 + i / 72, ci = i % 72; ((bf16_t*)VT)[r * 72 + ci] = (r == 16) ? (bf16_t)0x3F80 : (bf16_t)0; ((bf16_t*)WVT)[r * 72 + ci] = 0; }
        f32x4 Cst[2][2];
#pragma unroll
        for (int x = 0; x < 2; ++x)
#pragma unroll
            for (int et = 0; et < 2; ++et) Cst[x][et] = (f32x4){0.f, 0.f, 0.f, 0.f};
        float m_state = 0.f;
        u32x4 qr[4], kr[4], vr = (u32x4){0u, 0u, 0u, 0u};
        const bf16_t* qbase = proj + row0 * NP + 3072 + hh * 256;
#define ML_LOAD(c) do { _Pragma("unroll") for (int i = 0; i < 4; ++i) { const int p = tid + 512 * i, r = p >> 5, c16 = p & 31; const bf16_t* rp = qbase + (size_t)((c) * 64 + r) * NP + c16 * 8; \
            qr[i] = *(const u32x4*)rp; kr[i] = *(const u32x4*)(rp + 1024); } \
            if (tid < 128) vr = *(const u32x4*)(qbase + (size_t)((c) * 64 + (tid >> 1)) * NP + 2048 + e0 + (tid & 1) * 8); } while (0)
        ML_LOAD(0);
#pragma unroll 1
        for (int cc = 4 * w; cc < 4 * w + 4; ++cc) {
            const float* gp = gates + (row0 + cc * 64 + lane) * 8 + hh; const float gi = gp[0], gf = gp[4];
            const float lf = fminf(gf, 0.f) - log1pf(__expf(-fabsf(gf)));
            float bc = lf;
#pragma unroll
            for (int off = 1; off < 64; off <<= 1) { const float t = __shfl_up(bc, off); if (lane >= off) bc += t; }
            const float uv = gi - bc;
            float cm = uv;
#pragma unroll
            for (int off = 1; off < 64; off <<= 1) { const float t = __shfl_up(cm, off); if (lane >= off) cm = fmaxf(cm, t); }
            TBC[cc * 64 + lane] = bc; TUV[cc * 64 + lane] = uv; TCM[cc * 64 + lane] = cm;
        }
        __syncthreads();
#pragma unroll 1
        for (int c = 0; c < 32; ++c) {
            const float* tbc = TBC + c * 64; const float* tuv = TUV + c * 64; const float* tcm = TCM + c * 64;
            const float g_tot = tbc[63], cm63 = tcm[63];
            const float M63 = fmaxf(m_state, cm63), decay = __expf(m_state - M63);
            const float m_old = m_state;
            m_state = g_tot + M63;
#pragma unroll
            for (int i = 0; i < 4; ++i) { const int p = tid + 512 * i, r = p >> 5, c16 = p & 31; *(u32x4*)(QS + r * 528 + c16 * 16) = qr[i]; *(u32x4*)(KS + r * 528 + c16 * 16) = kr[i]; }
            { if (tid < 128) { const int s = tid >> 1, hf = tid & 1; const float wv = __expf(tuv[s] - M63);
#pragma unroll
                  for (int q = 0; q < 4; ++q) { const float v0 = bflo(vr[q]), v1 = bfhi(vr[q]);
                      ((bf16_t*)VT)[(8 * hf + 2 * q) * 72 + s] = (bf16_t)(vr[q] & 0xffffu); ((bf16_t*)VT)[(8 * hf + 2 * q + 1) * 72 + s] = (bf16_t)(vr[q] >> 16);
                      ((bf16_t*)WVT)[(8 * hf + 2 * q) * 72 + s] = f2bf(v0 * wv); ((bf16_t*)WVT)[(8 * hf + 2 * q + 1) * 72 + s] = f2bf(v1 * wv); } }
              if (w == 2) ((bf16_t*)WVT)[16 * 72 + lane] = f2bf(__expf(tuv[lane] - M63)); }
            if (c + 1 < 32) ML_LOAD(c + 1);
            __syncthreads();
            bf16x8 qf[8]; f32x4 S0 = (f32x4){0.f, 0.f, 0.f, 0.f}, S1 = S0;
#pragma unroll
            for (int kk = 0; kk < 8; ++kk) {
                qf[kk] = *(const bf16x8*)(QS + (16 * ti + l15) * 528 + kk * 64 + g * 16);
                const bf16x8 kf0 = *(const bf16x8*)(KS + (32 * a + l15) * 528 + kk * 64 + g * 16), kf1 = *(const bf16x8*)(KS + (32 * a + 16 + l15) * 528 + kk * 64 + g * 16);
                S0 = __builtin_amdgcn_mfma_f32_16x16x32_bf16(kf0, qf[kk], S0, 0, 0, 0); S1 = __builtin_amdgcn_mfma_f32_16x16x32_bf16(kf1, qf[kk], S1, 0, 0, 0);
            }
            const int tcol = 16 * ti + l15;
            const float Mt = fmaxf(m_old, tcm[tcol]);
            const f32x4 u0v = *(const f32x4*)(tuv + 32 * a + 4 * g), u1v = *(const f32x4*)(tuv + 32 * a + 16 + 4 * g);
            float p[8];
#pragma unroll
            for (int r = 0; r < 4; ++r) { const int s0 = 32 * a + 4 * g + r, s1 = s0 + 16;
                p[r] = (s0 <= tcol) ? S0[r] * 0.0625f * __expf(u0v[r] - Mt) : 0.f; p[4 + r] = (s1 <= tcol) ? S1[r] * 0.0625f * __expf(u1v[r] - Mt) : 0.f; }
            u32x4 pau; pau.x = cvt_pk_bf16(p[0], p[1]); pau.y = cvt_pk_bf16(p[2], p[3]); pau.z = cvt_pk_bf16(p[4], p[5]); pau.w = cvt_pk_bf16(p[6], p[7]);
            const bf16x8 pa = __builtin_bit_cast(bf16x8, pau);
            f32x4 rr[2];
#pragma unroll
            for (int et = 0; et < 2; ++et) { const unsigned char* vp = VT + (16 * et + l15) * 144 + (32 * a + 4 * g) * 2;
                const u32x2 lo = *(const u32x2*)vp, hi = *(const u32x2*)(vp + 32);
                u32x4 vbu; vbu.x = lo.x; vbu.y = lo.y; vbu.z = hi.x; vbu.w = hi.y;
                rr[et] = __builtin_amdgcn_mfma_f32_16x16x32_bf16(pa, __builtin_bit_cast(bf16x8, vbu), (f32x4){0.f, 0.f, 0.f, 0.f}, 0, 0, 0); }
            const f32x4 cmr = *(const f32x4*)(tcm + 16 * ti + 4 * g), bcr = *(const f32x4*)(tbc + 16 * ti + 4 * g);
            {
                const unsigned char* CTc = CT + (c & 1) * 16896;
                f32x4 in0 = (f32x4){0.f, 0.f, 0.f, 0.f}, in1 = in0;
#pragma unroll
                for (int k2 = 0; k2 < 4; ++k2) {
                    const bf16x8 qa = a ? qf[4 + k2] : qf[k2];
                    const bf16x8 c0 = *(const bf16x8*)(CTc + (l15) * 528 + (128 * a + 32 * k2 + 8 * g) * 2), c1 = *(const bf16x8*)(CTc + (16 + l15) * 528 + (128 * a + 32 * k2 + 8 * g) * 2);
                    in0 = __builtin_amdgcn_mfma_f32_16x16x32_bf16(qa, c0, in0, 0, 0, 0); in1 = __builtin_amdgcn_mfma_f32_16x16x32_bf16(qa, c1, in1, 0, 0, 0);
                }
#pragma unroll
                for (int r = 0; r < 4; ++r) { const float iw = __expf(m_old - fmaxf(m_old, cmr[r])) * 0.0625f; rr[0][r] += in0[r] * iw; rr[1][r] += in1[r] * iw; }
            }
            if (a == 1) { *(f32x4*)(XCH + ((ti * 2 + 0) * 64 + lane) * 16) = rr[0]; *(f32x4*)(XCH + ((ti * 2 + 1) * 64 + lane) * 16) = rr[1]; }
            {
                unsigned char* CTn = CT + ((c + 1) & 1) * 16896;
#pragma unroll
                for (int x = 0; x < 2; ++x) {
                    const int dt = 2 * w + x;
#pragma unroll
                    for (int et = 0; et < 2; ++et) Cst[x][et] *= decay;
#pragma unroll
                    for (int ks = 0; ks < 2; ++ks) {
                        bf16x8 ka;
#pragma unroll
                        for (int jj = 0; jj < 8; ++jj) ka[jj] = (short)*(const bf16_t*)(KS + (32 * ks + 8 * g + jj) * 528 + (16 * dt + l15) * 2);
#pragma unroll
                        for (int et = 0; et < 2; ++et) { const bf16x8 wvb = *(const bf16x8*)(WVT + (16 * et + l15) * 144 + (32 * ks + 8 * g) * 2);
                            Cst[x][et] = __builtin_amdgcn_mfma_f32_16x16x32_bf16(ka, wvb, Cst[x][et], 0, 0, 0); }
                    }
#pragma unroll
                    for (int et = 0; et < 2; ++et) { u32x2 o; o.x = cvt_pk_bf16(Cst[x][et][0], Cst[x][et][1]); o.y = cvt_pk_bf16(Cst[x][et][2], Cst[x][et][3]);
                        *(u32x2*)(CTn + (16 * et + l15) * 528 + (16 * dt + 4 * g) * 2) = o; }
                }
            }
            __syncthreads();
            if (a == 0) {
                const f32x4 o0 = *(const f32x4*)(XCH + ((ti * 2 + 0) * 64 + lane) * 16), o1 = *(const f32x4*)(XCH + ((ti * 2 + 1) * 64 + lane) * 16);
#pragma unroll
                for (int r = 0; r < 4; ++r) {
                    const float den = __shfl(rr[1][r] + o1[r], lane & 48), fl = __expf(-(bcr[r] + fmaxf(m_old, cmr[r])));
                    const float hv = (rr[0][r] + o0[r]) / fmaxf(fabsf(den), fl);
                    hbuf[(row0 + c * 64 + 16 * ti + 4 * g + r) * 1024 + hh * 256 + e0 + l15] = hv;
                }
            }
        }
#undef ML_LOAD
    }
}

__device__ __forceinline__ void phase_headnorm(const Args& A, const float* hbuf) {
    const bf16_t* proj = (const bf16_t*)(A.ws + WS_PROJ); bf16_t* y = (bf16_t*)(A.ws + WS_Y);
    const int lane = threadIdx.x & 63, gw = blockIdx.x * 8 + (threadIdx.x >> 6), nw = gridDim.x * 8;
    for (int it = gw; it < MT * 4; it += nw) {
        const int row = it >> 2, hh = it & 3;
        const f32x4 hv = *(const f32x4*)(hbuf + (size_t)row * 1024 + hh * 256 + lane * 4);
        float s = (hv[0] + hv[1]) + (hv[2] + hv[3]);
#pragma unroll
        for (int off = 32; off >= 1; off >>= 1) s += __shfl_xor(s, off);
        const float mu = s * (1.0f / 256.0f);
        const f32x4 d = hv - mu;
        float q = (d[0] * d[0] + d[1] * d[1]) + (d[2] * d[2] + d[3] * d[3]);
#pragma unroll
        for (int off = 32; off >= 1; off >>= 1) q += __shfl_xor(q, off);
        const float rstd = rsqrtf(q * (1.0f / 256.0f) + 1e-6f);
        const f32x4 gn = *(const f32x4*)(A.mh_gain + hh * 256 + lane * 4);
        const u32x2 ov = *(const u32x2*)(proj + (size_t)row * NP + 6144 + hh * 256 + lane * 4);
        const float o0 = bflo(ov.x), o1 = bfhi(ov.x), o2 = bflo(ov.y), o3 = bfhi(ov.y);
        const float y0 = d[0] * rstd * gn[0] / (1.0f + __expf(-o0)), y1 = d[1] * rstd * gn[1] / (1.0f + __expf(-o1));
        const float y2 = d[2] * rstd * gn[2] / (1.0f + __expf(-o2)), y3 = d[3] * rstd * gn[3] / (1.0f + __expf(-o3));
        u32x2 o; o.x = cvt_pk_bf16(y0, y1); o.y = cvt_pk_bf16(y2, y3);
        *(u32x2*)(y + (size_t)row * DM + WCONV + hh * 256 + lane * 4) = o;
    }
}

__device__ __forceinline__ void phase_ln(float* io, const float* gam, const float* bet, bf16_t* ob) {
    const int lane = threadIdx.x & 63, gw = blockIdx.x * 8 + (threadIdx.x >> 6), nw = gridDim.x * 8;
    for (int row = gw; row < MT; row += nw) {
        float* rp = io + (size_t)row * DM;
        f32x4 v[8]; float s = 0.f;
#pragma unroll
        for (int i = 0; i < 8; ++i) { v[i] = *(const f32x4*)(rp + i * 256 + lane * 4); s += (v[i][0] + v[i][1]) + (v[i][2] + v[i][3]); }
#pragma unroll
        for (int off = 32; off >= 1; off >>= 1) s += __shfl_xor(s, off);
        const float mu = s * (1.0f / DM);
        float q = 0.f;
#pragma unroll
        for (int i = 0; i < 8; ++i) { v[i] = v[i] - mu; q += (v[i][0] * v[i][0] + v[i][1] * v[i][1]) + (v[i][2] * v[i][2] + v[i][3] * v[i][3]); }
#pragma unroll
        for (int off = 32; off >= 1; off >>= 1) q += __shfl_xor(q, off);
        const float rstd = rsqrtf(q * (1.0f / DM) + 1e-5f);
#pragma unroll
        for (int i = 0; i < 8; ++i) { const f32x4 gg = *(const f32x4*)(gam + i * 256 + lane * 4), bb = *(const f32x4*)(bet + i * 256 + lane * 4);
            const f32x4 o = v[i] * rstd * gg + bb;
            *(f32x4*)(rp + i * 256 + lane * 4) = o;
            if (ob) { u32x2 p; p.x = cvt_pk_bf16(o[0], o[1]); p.y = cvt_pk_bf16(o[2], o[3]); *(u32x2*)(ob + (size_t)row * DM + i * 256 + lane * 4) = p; } }
    }
}

__device__ __forceinline__ void phase_fixup(const Args& A) {
    const float* halo = (const float*)(A.ws + WS_HALO); bf16_t* act = (bf16_t*)(A.ws + WS_ACT);
    for (int idx = blockIdx.x * 512 + threadIdx.x; idx < 128 * 2 * (DFF / 4); idx += gridDim.x * 512) {
        const int f = (idx % (DFF / 4)) * 4, br = idx / (DFF / 4), rr = br & 1, B = br >> 1;
        const bool first = (B & 31) == 0;
        const float* hc = halo + (size_t)B * 4 * NUP; const float* hp = hc - 4 * NUP;
        f32x4 hv[2];
#pragma unroll
        for (int bj = 0; bj < 2; ++bj) {
            const int col = bj * DFF + f;
            const f32x4 cur = *(const f32x4*)(hc + (size_t)(2 + rr) * NUP + col);
            f32x4 p1, p2; const f32x4 z = (f32x4){0.f, 0.f, 0.f, 0.f};
            if (rr == 0) { p1 = first ? z : *(const f32x4*)(hp + (size_t)1 * NUP + col); p2 = first ? z : *(const f32x4*)(hp + col); }
            else { p1 = *(const f32x4*)(hc + (size_t)2 * NUP + col); p2 = first ? z : *(const f32x4*)(hp + (size_t)1 * NUP + col); }
            const f32x4 w0 = *(const f32x4*)(A.w_fc + col), w1 = *(const f32x4*)(A.w_fc + NUP + col), w2 = *(const f32x4*)(A.w_fc + 2 * NUP + col), bb = *(const f32x4*)(A.b_fc + col);
            hv[bj] = w2 * cur + w1 * p1 + w0 * p2 + bb;
        }
        float av[4];
#pragma unroll
        for (int j = 0; j < 4; ++j) { const float gt = hv[1][j]; av[j] = hv[0][j] * gt / (1.0f + __expf(-gt)); }
        u32x2 o; o.x = cvt_pk_bf16(av[0], av[1]); o.y = cvt_pk_bf16(av[2], av[3]);
        *(u32x2*)(act + (size_t)(B * 64 + rr) * DFF + f) = o;
    }
}

__device__ __forceinline__ void phase_dump(const bf16_t* src, int ld, int c0, float* out) {
    for (size_t idx = (size_t)blockIdx.x * 512 + threadIdx.x; idx < (size_t)MT * DM; idx += (size_t)gridDim.x * 512) {
        const size_t row = idx / DM, col = idx % DM; out[idx] = bflo((unsigned)src[row * ld + c0 + col]); }
}
#ifndef DBG_STOP
#define DBG_STOP -1
#endif
#define XB_TMO      128
#define XB_XCNT(j)  (256  + 64 * (j))
#define XB_XSUB(j)  (1280 + 64 * (j))
#define XB_XGEN(j)  (2304 + 64 * (j))
#define XB_TOP      3328
#define XB_TOPGEN   3392
#define XCD_BAR_WORDS 3456
#define XB_SPIN_CAP (1u << 22)
__device__ __forceinline__ unsigned xb_ld(unsigned* p)              { return __hip_atomic_load(p, __ATOMIC_RELAXED, __HIP_MEMORY_SCOPE_AGENT); }
__device__ __forceinline__ unsigned xb_add(unsigned* p, unsigned v) { return __hip_atomic_fetch_add(p, v, __ATOMIC_RELAXED, __HIP_MEMORY_SCOPE_AGENT); }
__device__ __forceinline__ unsigned xb_xcc_id() { return (unsigned)__builtin_amdgcn_s_getreg((3 << 11) | 20) & 0xFu; }
#define XB_SPIN(cond, bar) do { unsigned _sp = 0; while (cond) { __builtin_amdgcn_s_sleep(1); \
    if ((++_sp & 255u) == 0u) { if (xb_ld(&(bar)[XB_TMO])) break; if (_sp > XB_SPIN_CAP) { atomicAdd(&(bar)[XB_TMO], 1u); break; } } } } while (0)
struct XcdBarrier { unsigned* bar; unsigned x; volatile LAS unsigned* st; };
__device__ __forceinline__ XcdBarrier xcd_barrier_post(unsigned* bar, volatile LAS unsigned* st) {
    XcdBarrier b; b.bar = bar; b.x = xb_xcc_id(); b.st = st;
    if (threadIdx.x == 0) (void)xb_add(&bar[XB_XCNT(b.x)], 1u);
    return b;
}
__device__ __forceinline__ void xcd_barrier_complete(unsigned* bar, unsigned x, unsigned& nloc, unsigned& nx) {
    const unsigned G = gridDim.x * gridDim.y * gridDim.z;
    unsigned sum, cnt, mine, sp = 0u;
    for (;;) {
        sum = 0u; cnt = 0u; mine = 0u;
#pragma unroll
        for (unsigned j = 0; j < 16; ++j) { const unsigned c = xb_ld(&bar[XB_XCNT(j)]); sum += c; cnt += (c > 0u) ? 1u : 0u; mine = (j == x) ? c : mine; }
        if (sum == G) break;
        __builtin_amdgcn_s_sleep(1);
        if ((++sp & 255u) == 0u) { if (xb_ld(&bar[XB_TMO])) break; if (sp > XB_SPIN_CAP) { atomicAdd(&bar[XB_TMO], 1u); break; } }
    }
    nloc = mine > 0u ? mine : 1u; nx = cnt > 0u ? cnt : 1u;
}
__device__ __forceinline__ void xcd_barrier(const XcdBarrier& b) {
    asm volatile("s_waitcnt vmcnt(0)" ::: "memory");
    __syncthreads();
    if (threadIdx.x == 0) {
        unsigned* bar = b.bar;
        __builtin_amdgcn_s_waitcnt(0);
        unsigned nloc = b.st[0], nx = b.st[1];
        if (nloc == 0u) { xcd_barrier_complete(bar, b.x, nloc, nx); b.st[0] = nloc; b.st[1] = nx; }
        const unsigned old = xb_add(&bar[XB_XSUB(b.x)], 1u);
        const unsigned gen = old / nloc;
        if (old + 1u == (gen + 1u) * nloc) {
            __builtin_amdgcn_fence(__ATOMIC_RELEASE, "agent");
            asm volatile("s_waitcnt vmcnt(0)" ::: "memory");
            const unsigned og = xb_add(&bar[XB_TOP], 1u);
            const unsigned tg = og / nx;
            if (og + 1u == (tg + 1u) * nx) xb_add(&bar[XB_TOPGEN], 1u);
            else XB_SPIN(xb_ld(&bar[XB_TOPGEN]) == tg, bar);
            __builtin_amdgcn_fence(__ATOMIC_ACQUIRE, "agent");
            xb_add(&bar[XB_XGEN(b.x)], 1u);
            asm volatile("s_waitcnt vmcnt(0)" ::: "memory");
        } else {
            XB_SPIN(xb_ld(&bar[XB_XGEN(b.x)]) == gen, bar);
            __builtin_amdgcn_fence(__ATOMIC_ACQUIRE, "agent");
            asm volatile("s_waitcnt vmcnt(0)" ::: "memory");
        }
    }
    __syncthreads();
}

constexpr int N_PHASES = 10;
#ifndef ONLY_PH
#define ONLY_PH -1
#endif
#define PH_ON(x) (ONLY_PH < 0 || ONLY_PH == (x))
__global__ void __launch_bounds__(512, 2) mega(Args a) {
    extern __shared__ __attribute__((aligned(16))) unsigned char lds[];
    cg::grid_group grid = cg::this_grid();
    unsigned char* ws = a.ws;
#define PH_RUN(x) (PH_ON(x) && a.ph_lo <= (x) && (x) < a.ph_hi)
#define PH_SYNC(x) do { if (a.ph_lo <= (x) && (x) + 1 < a.ph_hi) xcd_barrier(xb); } while (0)
    volatile LAS unsigned* xst = (volatile LAS unsigned*)((LAS unsigned char*)lds + 131072);
    if (threadIdx.x == 0) { xst[0] = 0u; xst[1] = 0u; }
    __syncthreads();
    const XcdBarrier xb = xcd_barrier_post((unsigned*)(ws + WS_BAR), xst);
    if (a.ph_hi > 1000) grid.sync();
#ifndef REP0
#define REP0 1
#endif
#ifndef REP2
#define REP2 1
#endif
#ifndef REP6
#define REP6 1
#endif
    if (PH_RUN(0)) for (int rep = 0; rep < REP0; ++rep) phase_prologue(a, lds);
    PH_SYNC(0);
    if (PH_RUN(1)) { pg8::Gemm g{(const bf16_t*)(ws + WS_XB), (const bf16_t*)(ws + WS_WIN), MT, NP, DM}; pg8::StaticOrder S; S.init(MT, NP, gridDim.x, blockIdx.x);
        pg8::EpiBf16 E{(bf16_t*)(ws + WS_PROJ), NP}; pg8::gemm_phase((LAS unsigned char*)lds, g, S, E);
        const int rem = ((MT / 256) * (NP / 256)) % (int)gridDim.x;
        if (rem == 0) phase_transposes(a, lds, TM_IN, TM_IN + TM_OUT + TM_UP, blockIdx.x, gridDim.x);
        else if ((int)blockIdx.x >= rem) phase_transposes(a, lds, TM_IN, TM_IN + TM_OUT + TM_UP, blockIdx.x - rem, gridDim.x - rem); }
    PH_SYNC(1);
    if (PH_RUN(2)) for (int rep = 0; rep < REP2; ++rep) { phase_yconv(a); phase_mlstm(a, lds, a.out); }
    PH_SYNC(2);
    if (PH_RUN(3)) phase_headnorm(a, a.out);
    PH_SYNC(3);
    if (PH_RUN(4)) { pg8::Gemm g{(const bf16_t*)(ws + WS_Y), (const bf16_t*)(ws + WS_WOUT), MT, DM, DM}; pg8::StaticOrder S; S.init(MT, DM, gridDim.x, blockIdx.x);
        if (a.fuse_ln) { pg8::EpiResLn E{a.x, a.out, (bf16_t*)(ws + WS_X1B), a.ln1_g, a.ln1_b, (float*)(ws + WS_RS1), (unsigned*)(ws + WS_CNT)}; pg8::gemm_phase((LAS unsigned char*)lds, g, S, E); }
        else { pg8::EpiResF32 E{a.x, a.out, DM}; pg8::gemm_phase((LAS unsigned char*)lds, g, S, E); } }
    PH_SYNC(4);
    if (PH_RUN(5) && !a.fuse_ln) phase_ln(a.out, a.ln1_g, a.ln1_b, (bf16_t*)(ws + WS_X1B));
    if (!a.fuse_ln) PH_SYNC(5);
    if (PH_RUN(6)) { pg8::Gemm g{(const bf16_t*)(ws + WS_X1B), (const bf16_t*)(ws + WS_WUP), MT, NUP, DM}; pg8::StaticOrder S; S.init(MT, NUP, gridDim.x, blockIdx.x);
        pg8::EpiConvFfn E{(bf16_t*)(ws + WS_ACT), (float*)(ws + WS_HALO), a.w_fc, a.b_fc}; pg8::gemm_phase((LAS unsigned char*)lds, g, S, E);
        const int rem = ((MT / 256) * (NUP / 256)) % (int)gridDim.x; const int t0 = TM_IN + TM_OUT + TM_UP, t1 = t0 + TM_DN;
        if (rem == 0) phase_transposes(a, lds, t0, t1, blockIdx.x, gridDim.x);
        else if ((int)blockIdx.x >= rem) phase_transposes(a, lds, t0, t1, blockIdx.x - rem, gridDim.x - rem); }
    PH_SYNC(6);
    if (PH_RUN(7)) phase_fixup(a);
    PH_SYNC(7);
    if (PH_RUN(8)) { pg8::Gemm g{(const bf16_t*)(ws + WS_ACT), (const bf16_t*)(ws + WS_WDN), MT, DM, DFF}; pg8::StaticOrder S; S.init(MT, DM, gridDim.x, blockIdx.x);
        if (a.fuse_ln) { pg8::EpiResLn E{a.out, a.out, nullptr, a.ln2_g, a.ln2_b, (float*)(ws + WS_RS2), (unsigned*)(ws + WS_CNT) + 32 * 64}; pg8::gemm_phase((LAS unsigned char*)lds, g, S, E); }
        else { pg8::EpiResF32 E{a.out, a.out, DM}; pg8::gemm_phase((LAS unsigned char*)lds, g, S, E); } }
    if (!a.fuse_ln) PH_SYNC(8);
    if (PH_RUN(9) && !a.fuse_ln) phase_ln(a.out, a.ln2_g, a.ln2_b, nullptr);
    if (DBG_STOP == 1 && a.ph_lo == 101) phase_dump((const bf16_t*)(ws + WS_PROJ), NP, 3072, a.out);
    if (DBG_STOP == 3 && a.ph_lo == 103) phase_dump((const bf16_t*)(ws + WS_Y), DM, 0, a.out);
    if (DBG_STOP == 7 && a.ph_lo == 107) phase_dump((const bf16_t*)(ws + WS_ACT), DFF, 0, a.out);
}

extern "C" void kernel_launch(void* const* d_in, const int* in_sizes, int n_in, void* d_out, int out_size, void* d_ws, size_t ws_size, hipStream_t stream) {
    static int grid = 0;
    if (grid == 0) {
        if (n_in != 14 || ws_size < WS_END) { fprintf(stderr, "kernel_launch: unexpected n_in %d / ws_size %zu (need %zu)\n", n_in, ws_size, (size_t)WS_END); grid = -1; return; }
        int dev = 0, cus = 0, per_cu = 0;
        hipGetDevice(&dev); hipDeviceGetAttribute(&cus, hipDeviceAttributeMultiprocessorCount, dev);
        if (hipFuncSetAttribute((const void*)mega, hipFuncAttributeMaxDynamicSharedMemorySize, LDS_BYTES) != hipSuccess) { fprintf(stderr, "kernel_launch: hipFuncSetAttribute failed\n"); grid = -1; return; }
        if (hipOccupancyMaxActiveBlocksPerMultiprocessor(&per_cu, (const void*)mega, 512, LDS_BYTES) != hipSuccess || per_cu < 1) { fprintf(stderr, "kernel_launch: occupancy query failed (%d)\n", per_cu); (void)hipGetLastError(); per_cu = 1; }
        grid = cus * 1;
        fprintf(stderr, "kernel_launch: cus %d per_cu %d grid %d\n", cus, per_cu, grid);
    }
    if (grid < 0) return;
    if (hipMemsetAsync((char*)d_ws + WS_BAR, 0, WS_END - WS_BAR, stream)     != hipSuccess) { fprintf(stderr, "kernel_launch: memset failed\n"); return; }
    Args a{};
    a.x = (const float*)d_in[0]; a.w_in = (const float*)d_in[1]; a.b_gates = (const float*)d_in[2]; a.w_sc = (const float*)d_in[3]; a.mh_gain = (const float*)d_in[4]; a.w_out = (const float*)d_in[5];
    a.ln1_g = (const float*)d_in[6]; a.ln1_b = (const float*)d_in[7]; a.w_up = (const float*)d_in[8]; a.w_fc = (const float*)d_in[9]; a.b_fc = (const float*)d_in[10]; a.w_down = (const float*)d_in[11];
    a.ln2_g = (const float*)d_in[12]; a.ln2_b = (const float*)d_in[13];
    a.out = (float*)d_out; a.ws = (unsigned char*)d_ws;
    a.fuse_ln = (MK_SINGLE && grid == 256) ? 1 : 0;
#if MK_SINGLE
    a.ph_lo = 0; a.ph_hi = N_PHASES;
    void* args[] = {&a};
    hipError_t e = hipLaunchCooperativeKernel((const void*)mega, dim3(grid), dim3(512), args, LDS_BYTES, stream);
    if (e != hipSuccess) fprintf(stderr, "cooperative launch failed: %s (grid %d)\n", hipGetErrorString(e), grid);
#else
    for (int ph = 0; ph < N_PHASES; ++ph) { if (DBG_STOP >= 0 && ph > DBG_STOP) break; a.ph_lo = ph; a.ph_hi = ph + 1; hipLaunchKernelGGL(mega, dim3(grid), dim3(512), LDS_BYTES, stream, a); }
    if (DBG_STOP >= 0) { a.ph_lo = 100 + DBG_STOP; a.ph_hi = 101 + DBG_STOP; hipLaunchKernelGGL(mega, dim3(grid), dim3(512), LDS_BYTES, stream, a); }
#endif
}
```

```cpp
#include <hip/hip_runtime.h>
#include <hip/hip_cooperative_groups.h>
#include <cstdio>
#include <cstdint>
namespace cg = cooperative_groups;

#ifndef MK_SINGLE
#define MK_SINGLE 1
#endif

#define LAS __attribute__((address_space(3)))
typedef unsigned short bf16_t;
typedef short bf16x8 __attribute__((ext_vector_type(8)));
typedef float f32x4 __attribute__((ext_vector_type(4)));
typedef unsigned u32x4 __attribute__((ext_vector_type(4)));
typedef unsigned u32x2 __attribute__((ext_vector_type(2)));

constexpr int MT = 8192, DM = 2048, SEQ = 2048, NIN = 7176, NP = 7168, DFF = 5632, NUP = 11264, WCONV = 1024;
constexpr float ALPHA = 1.189207115002721f;
constexpr size_t WS_WIN = 0;
constexpr size_t WS_WOUT = WS_WIN + (size_t)NP * DM * 2;
constexpr size_t WS_WUP = WS_WOUT + (size_t)DM * DM * 2;
constexpr size_t WS_WDN = WS_WUP + (size_t)NUP * DM * 2;
constexpr size_t WS_X1B = WS_WDN + (size_t)DM * DFF * 2;
constexpr size_t WS_GATES = WS_X1B + (size_t)MT * DM * 2;
constexpr size_t WS_C = WS_GATES + (size_t)MT * 8 * 4;
constexpr size_t WS_PROJ = WS_C;
constexpr size_t WS_Y = WS_PROJ + (size_t)MT * NP * 2;
constexpr size_t WS_XB = WS_Y + (size_t)MT * DM * 2;
constexpr size_t WS_ACT = WS_C;
constexpr size_t WS_HALO = WS_ACT + (size_t)MT * DFF * 2;
constexpr size_t WS_BAR = WS_XB + (size_t)MT * DM * 2;
constexpr size_t WS_RS1 = WS_BAR + 16384;
constexpr size_t WS_RS2 = WS_RS1 + (size_t)MT * 8;
constexpr size_t WS_CNT = WS_RS2 + (size_t)MT * 8;
constexpr size_t WS_END = WS_CNT + 2 * 32 * 256;
constexpr int LDS_BYTES = 131072 + 16 + 3 * 32 * 64 * 4;

struct Args {
    const float* x; const float* w_in; const float* b_gates; const float* w_sc; const float* mh_gain; const float* w_out;
    const float* ln1_g; const float* ln1_b; const float* w_up; const float* w_fc; const float* b_fc; const float* w_down;
    const float* ln2_g; const float* ln2_b;
    float* out; unsigned char* ws; int ph_lo, ph_hi, fuse_ln, pad0;
};

typedef __bf16 bf16v2 __attribute__((ext_vector_type(2)));
typedef float f32x2 __attribute__((ext_vector_type(2)));
__device__ __forceinline__ unsigned cvt_pk_bf16(float lo, float hi) { const f32x2 v = {lo, hi}; const bf16v2 r = __builtin_convertvector(v, bf16v2); return __builtin_bit_cast(unsigned, r); }
__device__ __forceinline__ unsigned cvt_pk_bf16_asm(float lo, float hi) { unsigned r; asm volatile("v_cvt_pk_bf16_f32 %0, %1, %2" : "=v"(r) : "v"(lo), "v"(hi)); return r; }
__device__ __forceinline__ float bflo(unsigned u) { return __uint_as_float(u << 16); }
__device__ __forceinline__ float bfhi(unsigned u) { return __uint_as_float(u & 0xffff0000u); }
__device__ __forceinline__ bf16_t f2bf(float f) { unsigned u = __float_as_uint(f); u += 0x7FFFu + ((u >> 16) & 1u); return (bf16_t)(u >> 16); }

namespace pg8 {
constexpr int BM = 256, BK = 64, HALF = 128, HTB = HALF * BK * 2, STAGE_BYTES = 8 * HTB, NXCD = 8, WGM = 8;
__host__ __device__ __forceinline__ int lds_byte(int r, int c) { const int st = (r >> 4) * 2 + (c >> 5), rr = r & 15, cc = c & 31, ob = rr * 64 + cc * 2; return st * 1024 + (ob ^ (((ob >> 9) & 1) << 5)); }
__host__ __device__ __forceinline__ void stage_rc(int b, int& R, int& C) { const int st = b / 1024, sb = b % 1024, swz = sb ^ (((sb >> 9) & 1) << 5); R = (st >> 1) * 16 + swz / 64; C = (st & 1) * 32 + (swz % 64) / 2; }
__host__ __device__ __forceinline__ int perm32(int rho) { const int n = rho >> 4, i = rho & 15; return 8 * (i >> 2) + 4 * n + (i & 3); }
struct Unit { int pm, pn; };
struct Gemm { const bf16_t* A; const bf16_t* Bt; int M, N, K; };
struct StaticOrder {
    int nM, nN, nwg, G, c;
    __device__ void init(int M, int N, int G_, int c_) { nM = M / BM; nN = N / BM; nwg = nM * nN; G = G_; c = c_; }
    __device__ bool next(int i, Unit& u) const {
        const long L = (long)i * G + c; if (L >= nwg) return false;
        int wgid = (int)L; { const int q = nwg / NXCD, r = nwg % NXCD, xcd = wgid % NXCD, off = wgid / NXCD; wgid = (xcd < r ? xcd * (q + 1) : r * (q + 1) + (xcd - r) * q) + off; }
        const int nig = WGM * nN, gid = wgid / nig, fm = gid * WGM, gsz = (nM - fm) < WGM ? (nM - fm) : WGM;
        u.pm = fm + ((wgid % nig) % gsz); u.pn = (wgid % nig) / gsz; return true;
    }
};

template <class Epi, bool ALIGN_EPI = false, bool SP2 = true>
__device__ __forceinline__ void gemm_phase(LAS unsigned char* lds, const Gemm g, const StaticOrder& S, const Epi& E) {
    const int tid = threadIdx.x, wid = __builtin_amdgcn_readfirstlane(tid >> 6), lane = tid & 63, wr = wid >> 2, wc = wid & 3, fr = lane & 15, fq = lane >> 4;
    const int K = g.K, nt = K / BK;
    unsigned voffA[2], voffB[2];
#pragma unroll
    for (int i = 0; i < 2; ++i) { int R, C; stage_rc(tid * 16 + i * 8192, R, C); const int Rb = Epi::PERM ? ((R & ~31) + perm32(R & 31)) : R;
        voffA[i] = (unsigned)(R * K + C) * 2u; voffB[i] = (unsigned)(Rb * K + C) * 2u; }
    const size_t kstep = (size_t)(BK * 2);
    const size_t hstep = (size_t)HALF * K * 2;
    const size_t tstep = 2 * hstep;
    const unsigned ldsw = (unsigned)wid * 1024u;
    const int aoff = lds_byte(wr * 64 + fr, fq * 8), boff = lds_byte(wc * 32 + fr, fq * 8);
#define PG8_SA(b, h) (((b) * 2 + (h)) * HTB)
#define PG8_SB(b, h) ((4 + (b) * 2 + (h)) * HTB)
#define PG8_STAGE(bufoff, gbase, voff) do { _Pragma("unroll") for (int _i = 0; _i < 2; ++_i) \
        __builtin_amdgcn_global_load_lds((const unsigned*)((const char*)(gbase) + (voff)[_i]), (LAS unsigned*)(lds + (bufoff) + ldsw + _i * 8192), 16, 0, 0); } while (0)
#define PG8_LDA(dst, b, h) do { _Pragma("unroll") for (int m = 0; m < 4; ++m) _Pragma("unroll") for (int k = 0; k < 2; ++k) dst[m][k] = *(const LAS bf16x8*)(lds + PG8_SA(b, h) + aoff + m * 2048 + k * 1024); } while (0)
#define PG8_LDB(dst, b, h) do { _Pragma("unroll") for (int n = 0; n < 2; ++n) _Pragma("unroll") for (int k = 0; k < 2; ++k) dst[n][k] = *(const LAS bf16x8*)(lds + PG8_SB(b, h) + boff + n * 2048 + k * 1024); } while (0)
#define PG8_MMA(ai, bj, At, Bt) do { __builtin_amdgcn_s_setprio(1); _Pragma("unroll") for (int m = 0; m < 4; ++m) _Pragma("unroll") for (int n = 0; n < 2; ++n) _Pragma("unroll") for (int k = 0; k < 2; ++k) \
        acc[ai][bj][m][n] = __builtin_amdgcn_mfma_f32_16x16x32_bf16(Bt[n][k], At[m][k], acc[ai][bj][m][n], 0, 0, 0); __builtin_amdgcn_s_setprio(0); } while (0)
#define PG8_WAIT_V(n) asm volatile("s_waitcnt vmcnt(" #n ")" ::: "memory")
#define PG8_WAIT_L(n) asm volatile("s_waitcnt lgkmcnt(" #n ")" ::: "memory")
#define PG8_BAR __builtin_amdgcn_s_barrier()
#define PG8_SCHED __builtin_amdgcn_sched_barrier(0)
    Unit cur, nxt; int ui = 0;
    if (!S.next(0, cur)) return;
    f32x4 acc[2][2][4][2];
#pragma unroll
    for (int a = 0; a < 2; ++a)
#pragma unroll
        for (int b = 0; b < 2; ++b)
#pragma unroll
            for (int m = 0; m < 4; ++m)
#pragma unroll
                for (int n = 0; n < 2; ++n) acc[a][b][m][n] = (f32x4){0.f, 0.f, 0.f, 0.f};
    bf16x8 At[4][2], B0[2][2], B1[2][2];
    const char* cA = (const char*)g.A + (size_t)cur.pm * tstep; const char* cB = (const char*)g.Bt + (size_t)cur.pn * tstep;
    if constexpr (SP2) {
        PG8_STAGE(PG8_SB(0, 0), cB, voffB); PG8_STAGE(PG8_SB(0, 1), cB + hstep, voffB); PG8_STAGE(PG8_SA(0, 0), cA, voffA); PG8_STAGE(PG8_SA(0, 1), cA + hstep, voffA);
        if (wr == 1) PG8_BAR;
        PG8_WAIT_V(2); PG8_BAR;
        PG8_STAGE(PG8_SB(1, 0), cB + kstep, voffB); PG8_STAGE(PG8_SA(1, 0), cA + kstep, voffA); PG8_STAGE(PG8_SB(1, 1), cB + hstep + kstep, voffB);
        PG8_WAIT_V(6); PG8_BAR;
    } else {
        PG8_STAGE(PG8_SB(0, 0), cB, voffB); PG8_STAGE(PG8_SA(0, 0), cA, voffA); PG8_STAGE(PG8_SB(0, 1), cB + hstep, voffB); PG8_STAGE(PG8_SA(0, 1), cA + hstep, voffA);
        if (wr == 1) PG8_BAR;
        PG8_WAIT_V(4); PG8_BAR;
        PG8_STAGE(PG8_SB(1, 0), cB + kstep, voffB); PG8_STAGE(PG8_SA(1, 0), cA + kstep, voffA); PG8_STAGE(PG8_SB(1, 1), cB + hstep + kstep, voffB);
        PG8_WAIT_V(6); PG8_BAR;
    }
    for (;;) {
        const bool has_next = S.next(ui + 1, nxt);
        const char* nA = has_next ? (const char*)g.A + (size_t)nxt.pm * tstep : cA; const char* nB = has_next ? (const char*)g.Bt + (size_t)nxt.pn * tstep : cB;
        for (int t = 0; t < nt; t += 2) {
            const bool last = (t == nt - 2);
            const char* a1 = cA + (size_t)(t + 1) * kstep;
            const char* a2 = last ? nA : cA + (size_t)(t + 2) * kstep; const char* b2 = last ? nB : cB + (size_t)(t + 2) * kstep;
            const char* a3 = a2 + kstep; const char* b3 = b2 + kstep;
            if constexpr (SP2) {
            PG8_LDB(B0, 0, 0); PG8_LDB(B1, 0, 1); PG8_SCHED; PG8_LDA(At, 0, 0); PG8_STAGE(PG8_SA(1, 1), a1 + hstep, voffA);
            PG8_WAIT_V(8); PG8_WAIT_L(0); PG8_BAR; PG8_MMA(0, 0, At, B0); PG8_MMA(0, 1, At, B1); PG8_BAR; PG8_SCHED;
            PG8_LDA(At, 0, 1); PG8_STAGE(PG8_SB(0, 0), b2, voffB); PG8_STAGE(PG8_SB(0, 1), b2 + hstep, voffB); PG8_STAGE(PG8_SA(0, 0), a2, voffA);
            PG8_WAIT_V(8); PG8_WAIT_L(0); PG8_BAR; PG8_MMA(1, 0, At, B0); PG8_MMA(1, 1, At, B1); PG8_BAR; PG8_SCHED;
            PG8_LDB(B0, 1, 0); PG8_LDB(B1, 1, 1); PG8_SCHED; PG8_LDA(At, 1, 0); PG8_STAGE(PG8_SA(0, 1), a2 + hstep, voffA);
            PG8_WAIT_V(8); PG8_WAIT_L(0); PG8_BAR; PG8_MMA(0, 0, At, B0); PG8_MMA(0, 1, At, B1); PG8_BAR; PG8_SCHED;
            PG8_LDA(At, 1, 1); PG8_STAGE(PG8_SB(1, 0), b3, voffB); PG8_STAGE(PG8_SB(1, 1), b3 + hstep, voffB); PG8_STAGE(PG8_SA(1, 0), a3, voffA);
            PG8_WAIT_V(8); PG8_WAIT_L(0); PG8_BAR; PG8_MMA(1, 0, At, B0); PG8_MMA(1, 1, At, B1); PG8_BAR; PG8_SCHED;
            } else {
            PG8_LDB(B0, 0, 0); PG8_SCHED; PG8_LDA(At, 0, 0); PG8_STAGE(PG8_SA(1, 1), a1 + hstep, voffA);
            PG8_WAIT_L(8); PG8_BAR; PG8_WAIT_L(0); PG8_MMA(0, 0, At, B0); PG8_BAR; PG8_SCHED;
            PG8_LDB(B1, 0, 1); PG8_STAGE(PG8_SB(0, 0), b2, voffB);
            PG8_BAR; PG8_WAIT_L(0); PG8_MMA(0, 1, At, B1); PG8_BAR;
            PG8_LDA(At, 0, 1); PG8_STAGE(PG8_SA(0, 0), a2, voffA);
            PG8_BAR; PG8_WAIT_L(0); PG8_MMA(1, 0, At, B0); PG8_BAR; PG8_SCHED;
            PG8_STAGE(PG8_SB(0, 1), b2 + hstep, voffB);
            PG8_WAIT_V(6); PG8_BAR; PG8_MMA(1, 1, At, B1); PG8_BAR;
            PG8_LDB(B0, 1, 0); PG8_SCHED; PG8_LDA(At, 1, 0); PG8_STAGE(PG8_SA(0, 1), a2 + hstep, voffA);
            PG8_WAIT_L(8); PG8_BAR; PG8_WAIT_L(0); PG8_MMA(0, 0, At, B0); PG8_BAR; PG8_SCHED;
            PG8_LDB(B1, 1, 1); PG8_STAGE(PG8_SB(1, 0), b3, voffB);
            PG8_BAR; PG8_WAIT_L(0); PG8_MMA(0, 1, At, B1); PG8_BAR;
            PG8_LDA(At, 1, 1); PG8_STAGE(PG8_SA(1, 0), a3, voffA);
            PG8_BAR; PG8_WAIT_L(0); PG8_MMA(1, 0, At, B0); PG8_BAR; PG8_SCHED;
            PG8_STAGE(PG8_SB(1, 1), b3 + hstep, voffB);
            PG8_WAIT_V(6); PG8_BAR; PG8_MMA(1, 1, At, B1); PG8_BAR;

            }
        }
        if constexpr (ALIGN_EPI) { if (wr == 0) PG8_BAR; }
        if constexpr (!Epi::AFTER_DRAIN) E(acc, cur, wr, wc, fr, fq);
        if (!has_next) break;
#pragma unroll
        for (int a = 0; a < 2; ++a)
#pragma unroll
            for (int b = 0; b < 2; ++b)
#pragma unroll
                for (int m = 0; m < 4; ++m)
#pragma unroll
                    for (int n = 0; n < 2; ++n) acc[a][b][m][n] = (f32x4){0.f, 0.f, 0.f, 0.f};
        cur = nxt; cA = nA; cB = nB; ++ui;
        if constexpr (ALIGN_EPI) { if (wr == 1) PG8_BAR; }
    }
    PG8_WAIT_V(0);
    if constexpr (!ALIGN_EPI) { if (wr == 0) PG8_BAR; }
    PG8_BAR;
    if constexpr (Epi::AFTER_DRAIN) E(acc, cur, wr, wc, fr, fq);
#undef PG8_SA
#undef PG8_SB
#undef PG8_STAGE
#undef PG8_LDA
#undef PG8_LDB
#undef PG8_MMA
#undef PG8_WAIT_V
#undef PG8_WAIT_L
#undef PG8_BAR
#undef PG8_SCHED
}

struct EpiBf16 {
    static constexpr bool PERM = true, AFTER_DRAIN = false;
    bf16_t* O; int ldc;
    __device__ __forceinline__ void operator()(f32x4 (&acc)[2][2][4][2], const Unit& u, int wr, int wc, int fr, int fq) const {
        const int row0 = u.pm * BM + wr * 64 + fr, col0 = u.pn * BM + wc * 32 + 8 * fq;
#pragma unroll
        for (int ai = 0; ai < 2; ++ai)
#pragma unroll
            for (int m = 0; m < 4; ++m) { bf16_t* rowp = O + (size_t)(row0 + ai * HALF + m * 16) * ldc + col0;
#pragma unroll
                for (int bj = 0; bj < 2; ++bj) { const f32x4 v0 = acc[ai][bj][m][0], v1 = acc[ai][bj][m][1];
                    u32x4 w; w.x = cvt_pk_bf16_asm(v0[0], v0[1]); w.y = cvt_pk_bf16_asm(v0[2], v0[3]); w.z = cvt_pk_bf16_asm(v1[0], v1[1]); w.w = cvt_pk_bf16_asm(v1[2], v1[3]);
                    *(u32x4*)(rowp + bj * HALF) = w; } }
    }
};
struct EpiResF32 {
    static constexpr bool PERM = false, AFTER_DRAIN = false;
    const float* X; float* O; int ldc;
    __device__ __forceinline__ void operator()(f32x4 (&acc)[2][2][4][2], const Unit& u, int wr, int wc, int fr, int fq) const {
        const int row0 = u.pm * BM + wr * 64 + fr, col0 = u.pn * BM + wc * 32 + 4 * fq;
#pragma unroll
        for (int ai = 0; ai < 2; ++ai)
#pragma unroll
            for (int m = 0; m < 4; ++m) { const size_t ro = (size_t)(row0 + ai * HALF + m * 16) * ldc + col0;
#pragma unroll
                for (int bj = 0; bj < 2; ++bj)
#pragma unroll
                    for (int n = 0; n < 2; ++n) { const f32x4 xv = *(const f32x4*)(X + ro + bj * HALF + n * 16);
                        *(f32x4*)(O + ro + bj * HALF + n * 16) = xv * ALPHA + acc[ai][bj][m][n]; } }
    }
};
struct EpiResLn {
    static constexpr bool PERM = false, AFTER_DRAIN = true;
    const float* X; float* O; bf16_t* OB; const float* gam; const float* bet; float* rs; unsigned* cnt;
    __device__ __forceinline__ void operator()(f32x4 (&acc)[2][2][4][2], const Unit& u, int wr, int wc, int fr, int fq) const {
        const int row0 = u.pm * BM + wr * 64 + fr, col0 = u.pn * BM + wc * 32 + 4 * fq;
#pragma unroll
        for (int ai = 0; ai < 2; ++ai)
#pragma unroll
            for (int m = 0; m < 4; ++m) { const int row = row0 + ai * HALF + m * 16; const size_t ro = (size_t)row * DM + col0;
                float s = 0.f, q = 0.f;
#pragma unroll
                for (int bj = 0; bj < 2; ++bj)
#pragma unroll
                    for (int n = 0; n < 2; ++n) { const f32x4 xv = *(const f32x4*)(X + ro + bj * HALF + n * 16); const f32x4 z = xv * ALPHA + acc[ai][bj][m][n]; acc[ai][bj][m][n] = z;
                        s += (z[0] + z[1]) + (z[2] + z[3]); q += (z[0] * z[0] + z[1] * z[1]) + (z[2] * z[2] + z[3] * z[3]); }
                s += __shfl_xor(s, 16); s += __shfl_xor(s, 32); q += __shfl_xor(q, 16); q += __shfl_xor(q, 32);
                if (fq == 0) { (void)__hip_atomic_fetch_add(rs + 2 * row, s, __ATOMIC_RELAXED, __HIP_MEMORY_SCOPE_AGENT); (void)__hip_atomic_fetch_add(rs + 2 * row + 1, q, __ATOMIC_RELAXED, __HIP_MEMORY_SCOPE_AGENT); } }
        asm volatile("s_waitcnt vmcnt(0)" ::: "memory");
        unsigned* cp = cnt + 64 * u.pm;
        if ((threadIdx.x & 63) == 0) (void)__hip_atomic_fetch_add(cp, 1u, __ATOMIC_RELAXED, __HIP_MEMORY_SCOPE_AGENT);
        { unsigned sp = 0; while ((unsigned)__builtin_amdgcn_readfirstlane(__hip_atomic_load(cp, __ATOMIC_RELAXED, __HIP_MEMORY_SCOPE_AGENT)) < 64u) { __builtin_amdgcn_s_sleep(2); if (++sp > (1u << 22)) break; } }
        f32x4 gg[2][2], bb[2][2];
#pragma unroll
        for (int bj = 0; bj < 2; ++bj)
#pragma unroll
            for (int n = 0; n < 2; ++n) { gg[bj][n] = *(const f32x4*)(gam + col0 + bj * HALF + n * 16); bb[bj][n] = *(const f32x4*)(bet + col0 + bj * HALF + n * 16); }
#pragma unroll
        for (int ai = 0; ai < 2; ++ai)
#pragma unroll
            for (int m = 0; m < 4; ++m) { const int row = row0 + ai * HALF + m * 16; const size_t ro = (size_t)row * DM + col0;
                const float s = __hip_atomic_load(rs + 2 * row, __ATOMIC_RELAXED, __HIP_MEMORY_SCOPE_AGENT), q = __hip_atomic_load(rs + 2 * row + 1, __ATOMIC_RELAXED, __HIP_MEMORY_SCOPE_AGENT);
                const float mu = s * (1.0f / DM), rstd = rsqrtf(fmaxf(q * (1.0f / DM) - mu * mu, 0.f) + 1e-5f);
#pragma unroll
                for (int bj = 0; bj < 2; ++bj)
#pragma unroll
                    for (int n = 0; n < 2; ++n) { const f32x4 o = (acc[ai][bj][m][n] - mu) * rstd * gg[bj][n] + bb[bj][n];
                        *(f32x4*)(O + ro + bj * HALF + n * 16) = o;
                        if (OB) { u32x2 p; p.x = cvt_pk_bf16_asm(o[0], o[1]); p.y = cvt_pk_bf16_asm(o[2], o[3]); *(u32x2*)(OB + ro + bj * HALF + n * 16) = p; } } }
    }
};
#define DPP_SHR1(x) __builtin_bit_cast(float, __builtin_amdgcn_update_dpp(0, __builtin_bit_cast(int, (x)), 0x111, 0xf, 0xf, true))
#define DPP_SHR2(x) __builtin_bit_cast(float, __builtin_amdgcn_update_dpp(0, __builtin_bit_cast(int, (x)), 0x112, 0xf, 0xf, true))
#define DPP_SHL15(o, x) __builtin_bit_cast(float, __builtin_amdgcn_update_dpp(__builtin_bit_cast(int, (o)), __builtin_bit_cast(int, (x)), 0x10F, 0xf, 0xf, false))
#define DPP_SHL14(o, x) __builtin_bit_cast(float, __builtin_amdgcn_update_dpp(__builtin_bit_cast(int, (o)), __builtin_bit_cast(int, (x)), 0x10E, 0xf, 0xf, false))
struct EpiConvFfn {
    static constexpr bool PERM = true, AFTER_DRAIN = false;
    bf16_t* act; float* halo; const float* cw; const float* cb;
    __device__ __forceinline__ void operator()(f32x4 (&acc)[2][2][4][2], const Unit& u, int wr, int wc, int fr, int fq) const {
        const int fcol = u.pn * 128 + wc * 32 + 8 * fq;
#pragma unroll
        for (int ai = 0; ai < 2; ++ai) {
            float* hb = halo + (size_t)((u.pm * BM + ai * HALF + wr * 64) >> 6) * 4 * NUP + fcol;
            if (fr < 2) {
#pragma unroll
                for (int bj = 0; bj < 2; ++bj)
#pragma unroll
                    for (int n = 0; n < 2; ++n) *(f32x4*)(hb + (size_t)(2 + fr) * NUP + bj * DFF + 4 * n) = acc[ai][bj][0][n];
            }
            if (fr >= 14) {
#pragma unroll
                for (int bj = 0; bj < 2; ++bj)
#pragma unroll
                    for (int n = 0; n < 2; ++n) *(f32x4*)(hb + (size_t)(fr - 14) * NUP + bj * DFF + 4 * n) = acc[ai][bj][3][n];
            }
        }
        u32x2 pk0[2][4];
#pragma unroll
        for (int n = 0; n < 2; ++n) {
            f32x4 W0[2], W1[2], W2[2], Bb[2];
#pragma unroll
            for (int bj = 0; bj < 2; ++bj) { const int hc = bj * DFF + fcol + 4 * n;
                W0[bj] = *(const f32x4*)(cw + hc); W1[bj] = *(const f32x4*)(cw + NUP + hc); W2[bj] = *(const f32x4*)(cw + 2 * NUP + hc); Bb[bj] = *(const f32x4*)(cb + hc); }
#pragma unroll
            for (int ai = 0; ai < 2; ++ai) {
                const int rbase = u.pm * BM + ai * HALF + wr * 64;
#pragma unroll
                for (int m = 0; m < 4; ++m) {
                    float av[4];
#pragma unroll
                    for (int j = 0; j < 4; ++j) {
                        float hc[2];
#pragma unroll
                        for (int bj = 0; bj < 2; ++bj) {
                            const float cur = acc[ai][bj][m][n][j];
                            float p1 = DPP_SHR1(cur), p2 = DPP_SHR2(cur);
                            if (m > 0) { const float pv = acc[ai][bj][m > 0 ? m - 1 : 0][n][j]; p1 = DPP_SHL15(p1, pv); p2 = DPP_SHL14(p2, pv); }
                            hc[bj] = W2[bj][j] * cur + W1[bj][j] * p1 + W0[bj][j] * p2 + Bb[bj][j];
                        }
                        const float gt = hc[1];
                        av[j] = hc[0] * gt * __builtin_amdgcn_rcpf(1.0f + __expf(-gt));
                    }
                    u32x2 pk; pk.x = cvt_pk_bf16_asm(av[0], av[1]); pk.y = cvt_pk_bf16_asm(av[2], av[3]);
                    if (n == 0) pk0[ai][m] = pk;
                    else if (m > 0 || fr >= 2) { u32x4 w; w.x = pk0[ai][m].x; w.y = pk0[ai][m].y; w.z = pk.x; w.w = pk.y;
                        *(u32x4*)(act + (size_t)(rbase + m * 16 + fr) * DFF + fcol) = w; }
                }
            }
            asm volatile("" ::: "memory");
        }
    }
};
}

template <bool UPMAP>
__device__ __forceinline__ void transpose_macro(const float* W, int ldw, int k0, int n0, bf16_t* Wt, int ldt, unsigned char* lds) {
    bf16_t* sT = (bf16_t*)lds; const int tid = threadIdx.x;
    float4 v[2][4];
#pragma unroll
    for (int i = 0; i < 2; ++i)
#pragma unroll
        for (int j = 0; j < 4; ++j) v[i][j] = *(const float4*)(W + (size_t)(k0 + (tid >> 4) + 32 * i) * ldw + n0 + 64 * j + (tid & 15) * 4);
#pragma unroll
    for (int i = 0; i < 2; ++i)
#pragma unroll
        for (int j = 0; j < 4; ++j) { const int k = (tid >> 4) + 32 * i, n = 64 * j + (tid & 15) * 4;
            sT[(n + 0) * 66 + k] = f2bf(v[i][j].x); sT[(n + 1) * 66 + k] = f2bf(v[i][j].y); sT[(n + 2) * 66 + k] = f2bf(v[i][j].z); sT[(n + 3) * 66 + k] = f2bf(v[i][j].w); }
    __syncthreads();
#pragma unroll
    for (int j = 0; j < 4; ++j) { const int n = 64 * j + (tid >> 3), ks = (tid & 7) * 8; const unsigned* p = (const unsigned*)(sT + n * 66 + ks);
        u32x4 o; o.x = p[0]; o.y = p[1]; o.z = p[2]; o.w = p[3];
        int drow = n0 + n;
        if (UPMAP) { const int f = (drow < DFF) ? drow : drow - DFF; drow = 256 * (f >> 7) + (f & 127) + ((drow < DFF) ? 0 : 128); }
        *(u32x4*)(Wt + (size_t)drow * ldt + k0 + ks) = o; }
    __syncthreads();
}
constexpr int TM_IN = 32 * 28, TM_OUT = 32 * 8, TM_UP = 32 * 44, TM_DN = 88 * 8;
__device__ __forceinline__ void phase_transposes(const Args& A, unsigned char* lds, int g0, int g1, int worker, int nworkers) {
    unsigned char* ws = A.ws;
    for (int g = g0 + worker; g < g1; g += nworkers) {
        if (g < TM_IN) { const int tk = g / 28, tn = g % 28; transpose_macro<false>(A.w_in, NIN, tk * 64, tn * 256, (bf16_t*)(ws + WS_WIN), DM, lds); }
        else if (g < TM_IN + TM_OUT) { const int h = g - TM_IN, tk = h / 8, tn = h % 8; transpose_macro<false>(A.w_out, DM, tk * 64, tn * 256, (bf16_t*)(ws + WS_WOUT), DM, lds); }
        else if (g < TM_IN + TM_OUT + TM_UP) { const int h = g - TM_IN - TM_OUT, tk = h / 44, tn = h % 44; transpose_macro<true>(A.w_up, NUP, tk * 64, tn * 256, (bf16_t*)(ws + WS_WUP), DM, lds); }
        else { const int h = g - TM_IN - TM_OUT - TM_UP, tk = h / 8, tn = h % 8; transpose_macro<false>(A.w_down, DM, tk * 64, tn * 256, (bf16_t*)(ws + WS_WDN), DFF, lds); }
    }
}
__device__ __forceinline__ void phase_prologue(const Args& A, unsigned char* lds) {
    unsigned char* ws = A.ws;
    phase_transposes(A, lds, 0, TM_IN, blockIdx.x, gridDim.x);
    const int lane = threadIdx.x & 63, gw = blockIdx.x * 8 + (threadIdx.x >> 6), nw = gridDim.x * 8;
    bf16_t* xb = (bf16_t*)(ws + WS_XB); float* gates = (float*)(ws + WS_GATES);
    for (int it = gw; it < MT / 4; it += nw) {
        const int r0 = it * 4;
        float acc[4][8];
#pragma unroll
        for (int r = 0; r < 4; ++r)
#pragma unroll
            for (int q = 0; q < 8; ++q) acc[r][q] = 0.f;
#pragma unroll 1
        for (int i = 0; i < 8; ++i) {
            const int kb = i * 256 + lane * 4;
            f32x4 xv[4];
#pragma unroll
            for (int r = 0; r < 4; ++r) { xv[r] = *(const f32x4*)(A.x + (size_t)(r0 + r) * DM + kb);
                u32x2 o; o.x = cvt_pk_bf16(xv[r][0], xv[r][1]); o.y = cvt_pk_bf16(xv[r][2], xv[r][3]); *(u32x2*)(xb + (size_t)(r0 + r) * DM + kb) = o; }
#pragma unroll
            for (int j = 0; j < 4; ++j) {
                const f32x4* wp = (const f32x4*)(A.w_in + (size_t)(kb + j) * NIN + NP);
                const f32x4 w0 = wp[0], w1 = wp[1];
#pragma unroll
                for (int r = 0; r < 4; ++r) { const float xs = xv[r][j];
                    acc[r][0] += xs * w0[0]; acc[r][1] += xs * w0[1]; acc[r][2] += xs * w0[2]; acc[r][3] += xs * w0[3];
                    acc[r][4] += xs * w1[0]; acc[r][5] += xs * w1[1]; acc[r][6] += xs * w1[2]; acc[r][7] += xs * w1[3]; }
            }
        }
#pragma unroll
        for (int r = 0; r < 4; ++r)
#pragma unroll
            for (int q = 0; q < 8; ++q) { float v = acc[r][q];
#pragma unroll
                for (int off = 32; off >= 1; off >>= 1) v += __shfl_xor(v, off);
                acc[r][q] = v; }
        if (lane == 0) {
            const f32x4 b0 = *(const f32x4*)(A.b_gates), b1 = *(const f32x4*)(A.b_gates + 4);
#pragma unroll
            for (int r = 0; r < 4; ++r) {
                *(f32x4*)(gates + (size_t)(r0 + r) * 8) = (f32x4){acc[r][0] + b0[0], acc[r][1] + b0[1], acc[r][2] + b0[2], acc[r][3] + b0[3]};
                *(f32x4*)(gates + (size_t)(r0 + r) * 8 + 4) = (f32x4){acc[r][4] + b1[0], acc[r][5] + b1[1], acc[r][6] + b1[2], acc[r][7] + b1[3]}; }
        }
    }
}

__device__ __forceinline__ void phase_yconv(const Args& A) {
    const bf16_t* proj = (const bf16_t*)(A.ws + WS_PROJ); bf16_t* y = (bf16_t*)(A.ws + WS_Y);
    for (int idx = blockIdx.x * 512 + threadIdx.x; idx < MT * 128; idx += gridDim.x * 512) {
        const int row = idx >> 7, c = (idx & 127) * 8, t = row & (SEQ - 1);
        const bf16_t* pr = proj + (size_t)row * NP + c;
        const u32x4 bv = *(const u32x4*)pr;
        float cv[8];
#pragma unroll
        for (int i = 0; i < 8; ++i) cv[i] = 0.f;
#pragma unroll
        for (int j = 0; j < 3; ++j) {
            const int dt = 2 - j;
            if (t - dt >= 0) {
                const u32x4 cc = *(const u32x4*)(pr - (size_t)dt * NP + WCONV), hh = *(const u32x4*)(pr - (size_t)dt * NP + 2 * WCONV);
                const f32x4 w0 = *(const f32x4*)(A.w_sc + j * WCONV + c), w1 = *(const f32x4*)(A.w_sc + j * WCONV + c + 4);
                const float wv[8] = {w0[0], w0[1], w0[2], w0[3], w1[0], w1[1], w1[2], w1[3]};
#pragma unroll
                for (int q = 0; q < 4; ++q) { cv[2 * q] += wv[2 * q] * bflo(cc[q]) * bflo(hh[q]); cv[2 * q + 1] += wv[2 * q + 1] * bfhi(cc[q]) * bfhi(hh[q]); }
            }
        }
        u32x4 o;
#pragma unroll
        for (int q = 0; q < 4; ++q) o[q] = cvt_pk_bf16(bflo(bv[q]) * cv[2 * q], bfhi(bv[q]) * cv[2 * q + 1]);
        *(u32x4*)(y + (size_t)row * DM + c) = o;
    }
}

__device__ __forceinline__ void phase_mlstm(const Args& A, unsigned char* lds, float* hbuf) {
    const int tid = threadIdx.x, lane = tid & 63, w = tid >> 6, g = lane >> 4, l15 = lane & 15;
    const int a = w >> 2, ti = w & 3;
    unsigned char* QS = lds; unsigned char* KS = lds + 33792; unsigned char* VT = lds + 67584; unsigned char* WVT = VT + 4608; unsigned char* CT = WVT + 4608; unsigned char* XCH = CT + 33792;
    const bf16_t* proj = (const bf16_t*)(A.ws + WS_PROJ); const float* gates = (const float*)(A.ws + WS_GATES);
    float* TBC = (float*)(lds + 131088); float* TUV = TBC + 2048; float* TCM = TUV + 2048;
    for (int item = blockIdx.x; item < 256; item += gridDim.x) {
        const int xcd = item & 7, idx = item >> 3; const int bh = xcd * 2 + (idx >> 4), es = idx & 15;
        const int b = bh >> 2, hh = bh & 3, e0 = es * 16;
        const size_t row0 = (size_t)b * SEQ;
        __syncthreads();
        for (int i = tid; i < 16896 / 4; i += 512) ((unsigned*)CT)[i] = 0u;
        for (int i = tid; i < 16 * 72; i += 512) { const int r = 16 + i / 72, ci = i % 72; ((bf16_t*)VT)[r * 72 + ci] = (r == 16) ? (bf16_t)0x3F80 : (bf16_t)0; ((bf16_t*)WVT)[r * 72 + ci] = 0; }
        f32x4 Cst[2][2];
#pragma unroll
        for (int x = 0; x < 2; ++x)
#pragma unroll
            for (int et = 0; et < 2; ++et) Cst[x][et] = (f32x4){0.f, 0.f, 0.f, 0.f};
        float m_state = 0.f;
        u32x4 qr[4], kr[4], vr = (u32x4){0u, 0u, 0u, 0u};
        const bf16_t* qbase = proj + row0 * NP + 3072 + hh * 256;
#define ML_LOAD(c) do { _Pragma("unroll") for (int i = 0; i < 4; ++i) { const int p = tid + 512 * i, r = p >> 5, c16 = p & 31; const bf16_t* rp = qbase + (size_t)((c) * 64 + r) * NP + c16 * 8; \
            qr[i] = *(const u32x4*)rp; kr[i] = *(const u32x4*)(rp + 1024); } \
            if (tid < 128) vr = *(const u32x4*)(qbase + (size_t)((c) * 64 + (tid >> 1)) * NP + 2048 + e0 + (tid & 1) * 8); } while (0)
        ML_LOAD(0);
#pragma unroll 1
        for (int cc = 4 * w; cc < 4 * w + 4; ++cc) {
            const float* gp = gates + (row0 + cc * 64 + lane) * 8 + hh; const float gi = gp[0], gf = gp[4];
            const float lf = fminf(gf, 0.f) - log1pf(__expf(-fabsf(gf)));
            float bc = lf;
#pragma unroll
            for (int off = 1; off < 64; off <<= 1) { const float t = __shfl_up(bc, off); if (lane >= off) bc += t; }
            const float uv = gi - bc;
            float cm = uv;
#pragma unroll
            for (int off = 1; off < 64; off <<= 1) { const float t = __shfl_up(cm, off); if (lane >= off) cm = fmaxf(cm, t); }
            TBC[cc * 64 + lane] = bc; TUV[cc * 64 + lane] = uv; TCM[cc * 64 + lane] = cm;
        }
        __syncthreads();
#pragma unroll 1
        for (int c = 0; c < 32; ++c) {
            const float* tbc = TBC + c * 64; const float* tuv = TUV + c * 64; const float* tcm = TCM + c * 64;
            const float g_tot = tbc[63], cm63 = tcm[63];
            const float M63 = fmaxf(m_state, cm63), decay = __expf(m_state - M63);
            const float m_old = m_state;
            m_state = g_tot + M63;
#pragma unroll
            for (int i = 0; i < 4; ++i) { const int p = tid + 512 * i, r = p >> 5, c16 = p & 31; *(u32x4*)(QS + r * 528 + c16 * 16) = qr[i]; *(u32x4*)(KS + r * 528 + c16 * 16) = kr[i]; }
            { if (tid < 128) { const int s = tid >> 1, hf = tid & 1; const float wv = __expf(tuv[s] - M63);
#pragma unroll
                  for (int q = 0; q < 4; ++q) { const float v0 = bflo(vr[q]), v1 = bfhi(vr[q]);
                      ((bf16_t*)VT)[(8 * hf + 2 * q) * 72 + s] = (bf16_t)(vr[q] & 0xffffu); ((bf16_t*)VT)[(8 * hf + 2 * q + 1) * 72 + s] = (bf16_t)(vr[q] >> 16);
                      ((bf16_t*)WVT)[(8 * hf + 2 * q) * 72 + s] = f2bf(v0 * wv); ((bf16_t*)WVT)[(8 * hf + 2 * q + 1) * 72 + s] = f2bf(v1 * wv); } }
              if (w == 2) ((bf16_t*)WVT)[16 * 72 + lane] = f2bf(__expf(tuv[lane] - M63)); }
            if (c + 1 < 32) ML_LOAD(c + 1);
            __syncthreads();
            bf16x8 qf[8]; f32x4 S0 = (f32x4){0.f, 0.f, 0.f, 0.f}, S1 = S0;
#pragma unroll
            for (int kk = 0; kk < 8; ++kk) {
                qf[kk] = *(const bf16x8*)(QS + (16 * ti + l15) * 528 + kk * 64 + g * 16);
                const bf16x8 kf0 = *(const bf16x8*)(KS + (32 * a + l15) * 528 + kk * 64 + g * 16), kf1 = *(const bf16x8*)(KS + (32 * a + 16 + l15) * 528 + kk * 64 + g * 16);
                S0 = __builtin_amdgcn_mfma_f32_16x16x32_bf16(kf0, qf[kk], S0, 0, 0, 0); S1 = __builtin_amdgcn_mfma_f32_16x16x32_bf16(kf1, qf[kk], S1, 0, 0, 0);
            }
            const int tcol = 16 * ti + l15;
            const float Mt = fmaxf(m_old, tcm[tcol]);
            const f32x4 u0v = *(const f32x4*)(tuv + 32 * a + 4 * g), u1v = *(const f32x4*)(tuv + 32 * a + 16 + 4 * g);
            float p[8];
#pragma unroll
            for (int r = 0; r < 4; ++r) { const int s0 = 32 * a + 4 * g + r, s1 = s0 + 16;
                p[r] = (s0 <= tcol) ? S0[r] * 0.0625f * __expf(u0v[r] - Mt) : 0.f; p[4 + r] = (s1 <= tcol) ? S1[r] * 0.0625f * __expf(u1v[r] - Mt) : 0.f; }
            u32x4 pau; pau.x = cvt_pk_bf16(p[0], p[1]); pau.y = cvt_pk_bf16(p[2], p[3]); pau.z = cvt_pk_bf16(p[4], p[5]); pau.w = cvt_pk_bf16(p[6], p[7]);
            const bf16x8 pa = __builtin_bit_cast(bf16x8, pau);
            f32x4 rr[2];
#pragma unroll
            for (int et = 0; et < 2; ++et) { const unsigned char* vp = VT + (16 * et + l15) * 144 + (32 * a + 4 * g) * 2;
                const u32x2 lo = *(const u32x2*)vp, hi = *(const u32x2*)(vp + 32);
                u32x4 vbu; vbu.x = lo.x; vbu.y = lo.y; vbu.z = hi.x; vbu.w = hi.y;
                rr[et] = __builtin_amdgcn_mfma_f32_16x16x32_bf16(pa, __builtin_bit_cast(bf16x8, vbu), (f32x4){0.f, 0.f, 0.f, 0.f}, 0, 0, 0); }
            const f32x4 cmr = *(const f32x4*)(tcm + 16 * ti + 4 * g), bcr = *(const f32x4*)(tbc + 16 * ti + 4 * g);
            {
                const unsigned char* CTc = CT + (c & 1) * 16896;
                f32x4 in0 = (f32x4){0.f, 0.f, 0.f, 0.f}, in1 = in0;
#pragma unroll
                for (int k2 = 0; k2 < 4; ++k2) {
                    const bf16x8 qa = a ? qf[4 + k2] : qf[k2];
                    const bf16x8 c0 = *(const bf16x8*)(CTc + (l15) * 528 + (128 * a + 32 * k2 + 8 * g) * 2), c1 = *(const bf16x8*)(CTc + (16 + l15) * 528 + (128 * a + 32 * k2 + 8 * g) * 2);
                    in0 = __builtin_amdgcn_mfma_f32_16x16x32_bf16(qa, c0, in0, 0, 0, 0); in1 = __builtin_amdgcn_mfma_f32_16x16x32_bf16(qa, c1, in1, 0, 0, 0);
                }
#pragma unroll
                for (int r = 0; r < 4; ++r) { const float iw = __expf(m_old - fmaxf(m_old, cmr[r])) * 0.0625f; rr[0][r] += in0[r] * iw; rr[1][r] += in1[r] * iw; }
            }
            if (a == 1) { *(f32x4*)(XCH + ((ti * 2 + 0) * 64 + lane) * 16) = rr[0]; *(f32x4*)(XCH + ((ti * 2 + 1) * 64 + lane) * 16) = rr[1]; }
            {
                unsigned char* CTn = CT + ((c + 1) & 1) * 16896;
#pragma unroll
                for (int x = 0; x < 2; ++x) {
                    const int dt = 2 * w + x;
#pragma unroll
                    for (int et = 0; et < 2; ++et) Cst[x][et] *= decay;
#pragma unroll
                    for (int ks = 0; ks < 2; ++ks) {
                        bf16x8 ka;
#pragma unroll
                        for (int jj = 0; jj < 8; ++jj) ka[jj] = (short)*(const bf16_t*)(KS + (32 * ks + 8 * g + jj) * 528 + (16 * dt + l15) * 2);
#pragma unroll
                        for (int et = 0; et < 2; ++et) { const bf16x8 wvb = *(const bf16x8*)(WVT + (16 * et + l15) * 144 + (32 * ks + 8 * g) * 2);
                            Cst[x][et] = __builtin_amdgcn_mfma_f32_16x16x32_bf16(ka, wvb, Cst[x][et], 0, 0, 0); }
                    }
#pragma unroll
                    for (int et = 0; et < 2; ++et) { u32x2 o; o.x = cvt_pk_bf16(Cst[x][et][0], Cst[x][et][1]); o.y = cvt_pk_bf16(Cst[x][et][2], Cst[x][et][3]);
                        *(u32x2*)(CTn + (16 * et + l15) * 528 + (16 * dt + 4 * g) * 2) = o; }
                }
            }
            __syncthreads();
            if (a == 0) {
                const f32x4 o0 = *(const f32x4*)(XCH + ((ti * 2 + 0) * 64 + lane) * 16), o1 = *(const f32x4*)(XCH + ((ti * 2 + 1) * 64 + lane) * 16);
#pragma unroll
                for (int r = 0; r < 4; ++r) {
                    const float den = __shfl(rr[1][r] + o1[r], lane & 48), fl = __expf(-(bcr[r] + fmaxf(m_old, cmr[r])));
                    const float hv = (rr[0][r] + o0[r]) / fmaxf(fabsf(den), fl);
                    hbuf[(row0 + c * 64 + 16 * ti + 4 * g + r) * 1024 + hh * 256 + e0 + l15] = hv;
                }
            }
        }
#undef ML_LOAD
    }
}

__device__ __forceinline__ void phase_headnorm(const Args& A, const float* hbuf) {
    const bf16_t* proj = (const bf16_t*)(A.ws + WS_PROJ); bf16_t* y = (bf16_t*)(A.ws + WS_Y);
    const int lane = threadIdx.x & 63, gw = blockIdx.x * 8 + (threadIdx.x >> 6), nw = gridDim.x * 8;
    for (int it = gw; it < MT * 4; it += nw) {
        const int row = it >> 2, hh = it & 3;
        const f32x4 hv = *(const f32x4*)(hbuf + (size_t)row * 1024 + hh * 256 + lane * 4);
        float s = (hv[0] + hv[1]) + (hv[2] + hv[3]);
#pragma unroll
        for (int off = 32; off >= 1; off >>= 1) s += __shfl_xor(s, off);
        const float mu = s * (1.0f / 256.0f);
        const f32x4 d = hv - mu;
        float q = (d[0] * d[0] + d[1] * d[1]) + (d[2] * d[2] + d[3] * d[3]);
#pragma unroll
        for (int off = 32; off >= 1; off >>= 1) q += __shfl_xor(q, off);
        const float rstd = rsqrtf(q * (1.0f / 256.0f) + 1e-6f);
        const f32x4 gn = *(const f32x4*)(A.mh_gain + hh * 256 + lane * 4);
        const u32x2 ov = *(const u32x2*)(proj + (size_t)row * NP + 6144 + hh * 256 + lane * 4);
        const float o0 = bflo(ov.x), o1 = bfhi(ov.x), o2 = bflo(ov.y), o3 = bfhi(ov.y);
        const float y0 = d[0] * rstd * gn[0] / (1.0f + __expf(-o0)), y1 = d[1] * rstd * gn[1] / (1.0f + __expf(-o1));
        const float y2 = d[2] * rstd * gn[2] / (1.0f + __expf(-o2)), y3 = d[3] * rstd * gn[3] / (1.0f + __expf(-o3));
        u32x2 o; o.x = cvt_pk_bf16(y0, y1); o.y = cvt_pk_bf16(y2, y3);
        *(u32x2*)(y + (size_t)row * DM + WCONV + hh * 256 + lane * 4) = o;
    }
}

__device__ __forceinline__ void phase_ln(float* io, const float* gam, const float* bet, bf16_t* ob) {
    const int lane = threadIdx.x & 63, gw = blockIdx.x * 8 + (threadIdx.x >> 6), nw = gridDim.x * 8;
    for (int row = gw; row < MT; row += nw) {
        float* rp = io + (size_t)row * DM;
        f32x4 v[8]; float s = 0.f;
#pragma unroll
        for (int i = 0; i < 8; ++i) { v[i] = *(const f32x4*)(rp + i * 256 + lane * 4); s += (v[i][0] + v[i][1]) + (v[i][2] + v[i][3]); }
#pragma unroll
        for (int off = 32; off >= 1; off >>= 1) s += __shfl_xor(s, off);
        const float mu = s * (1.0f / DM);
        float q = 0.f;
#pragma unroll
        for (int i = 0; i < 8; ++i) { v[i] = v[i] - mu; q += (v[i][0] * v[i][0] + v[i][1] * v[i][1]) + (v[i][2] * v[i][2] + v[i][3] * v[i][3]); }
#pragma unroll
        for (int off = 32; off >= 1; off >>= 1) q += __shfl_xor(q, off);
        const float rstd = rsqrtf(q * (1.0f / DM) + 1e-5f);
#pragma unroll
        for (int i = 0; i < 8; ++i) { const f32x4 gg = *(const f32x4*)(gam + i * 256 + lane * 4), bb = *(const f32x4*)(bet + i * 256 + lane * 4);
            const f32x4 o = v[i] * rstd * gg + bb;
            *(f32x4*)(rp + i * 256 + lane * 4) = o;
            if (ob) { u32x2 p; p.x = cvt_pk_bf16(o[0], o[1]); p.y = cvt_pk_bf16(o[2], o[3]); *(u32x2*)(ob + (size_t)row * DM + i * 256 + lane * 4) = p; } }
    }
}

__device__ __forceinline__ void phase_fixup(const Args& A) {
    const float* halo = (const float*)(A.ws + WS_HALO); bf16_t* act = (bf16_t*)(A.ws + WS_ACT);
    for (int idx = blockIdx.x * 512 + threadIdx.x; idx < 128 * 2 * (DFF / 4); idx += gridDim.x * 512) {
        const int f = (idx % (DFF / 4)) * 4, br = idx / (DFF / 4), rr = br & 1, B = br >> 1;
        const bool first = (B & 31) == 0;
        const float* hc = halo + (size_t)B * 4 * NUP; const float* hp = hc - 4 * NUP;
        f32x4 hv[2];
#pragma unroll
        for (int bj = 0; bj < 2; ++bj) {
            const int col = bj * DFF + f;
            const f32x4 cur = *(const f32x4*)(hc + (size_t)(2 + rr) * NUP + col);
            f32x4 p1, p2; const f32x4 z = (f32x4){0.f, 0.f, 0.f, 0.f};
            if (rr == 0) { p1 = first ? z : *(const f32x4*)(hp + (size_t)1 * NUP + col); p2 = first ? z : *(const f32x4*)(hp + col); }
            else { p1 = *(const f32x4*)(hc + (size_t)2 * NUP + col); p2 = first ? z : *(const f32x4*)(hp + (size_t)1 * NUP + col); }
            const f32x4 w0 = *(const f32x4*)(A.w_fc + col), w1 = *(const f32x4*)(A.w_fc + NUP + col), w2 = *(const f32x4*)(A.w_fc + 2 * NUP + col), bb = *(const f32x4*)(A.b_fc + col);
            hv[bj] = w2 * cur + w1 * p1 + w0 * p2 + bb;
        }
        float av[4];
#pragma unroll
        for (int j = 0; j < 4; ++j) { const float gt = hv[1][j]; av[j] = hv[0][j] * gt / (1.0f + __expf(-gt)); }
        u32x2 o; o.x = cvt_pk_bf16(av[0], av[1]); o.y = cvt_pk_bf16(av[2], av[3]);
        *(u32x2*)(act + (size_t)(B * 64 + rr) * DFF + f) = o;
    }
}

__device__ __forceinline__ void phase_dump(const bf16_t* src, int ld, int c0, float* out) {
    for (size_t idx = (size_t)blockIdx.x * 512 + threadIdx.x; idx < (size_t)MT * DM; idx += (size_t)gridDim.x * 512) {
        const size_t row = idx / DM, col = idx % DM; out[idx] = bflo((unsigned)src[row * ld + c0 + col]); }
}
#ifndef DBG_STOP
#define DBG_STOP -1
#endif
#define XB_TMO      128
#define XB_XCNT(j)  (256  + 64 * (j))
#define XB_XSUB(j)  (1280 + 64 * (j))
#define XB_XGEN(j)  (2304 + 64 * (j))
#define XB_TOP      3328
#define XB_TOPGEN   3392
#define XCD_BAR_WORDS 3456
#define XB_SPIN_CAP (1u << 22)
__device__ __forceinline__ unsigned xb_ld(unsigned* p)              { return __hip_atomic_load(p, __ATOMIC_RELAXED, __HIP_MEMORY_SCOPE_AGENT); }
__device__ __forceinline__ unsigned xb_add(unsigned* p, unsigned v) { return __hip_atomic_fetch_add(p, v, __ATOMIC_RELAXED, __HIP_MEMORY_SCOPE_AGENT); }
__device__ __forceinline__ unsigned xb_xcc_id() { return (unsigned)__builtin_amdgcn_s_getreg((3 << 11) | 20) & 0xFu; }
#define XB_SPIN(cond, bar) do { unsigned _sp = 0; while (cond) { __builtin_amdgcn_s_sleep(1); \
    if ((++_sp & 255u) == 0u) { if (xb_ld(&(bar)[XB_TMO])) break; if (_sp > XB_SPIN_CAP) { atomicAdd(&(bar)[XB_TMO], 1u); break; } } } } while (0)
struct XcdBarrier { unsigned* bar; unsigned x; volatile LAS unsigned* st; };
__device__ __forceinline__ XcdBarrier xcd_barrier_post(unsigned* bar, volatile LAS unsigned* st) {
    XcdBarrier b; b.bar = bar; b.x = xb_xcc_id(); b.st = st;
    if (threadIdx.x == 0) (void)xb_add(&bar[XB_XCNT(b.x)], 1u);
    return b;
}
__device__ __forceinline__ void xcd_barrier_complete(unsigned* bar, unsigned x, unsigned& nloc, unsigned& nx) {
    const unsigned G = gridDim.x * gridDim.y * gridDim.z;
    unsigned sum, cnt, mine, sp = 0u;
    for (;;) {
        sum = 0u; cnt = 0u; mine = 0u;
#pragma unroll
        for (unsigned j = 0; j < 16; ++j) { const unsigned c = xb_ld(&bar[XB_XCNT(j)]); sum += c; cnt += (c > 0u) ? 1u : 0u; mine = (j == x) ? c : mine; }
        if (sum == G) break;
        __builtin_amdgcn_s_sleep(1);
        if ((++sp & 255u) == 0u) { if (xb_ld(&bar[XB_TMO])) break; if (sp > XB_SPIN_CAP) { atomicAdd(&bar[XB_TMO], 1u); break; } }
    }
    nloc = mine > 0u ? mine : 1u; nx = cnt > 0u ? cnt : 1u;
}
__device__ __forceinline__ void xcd_barrier(const XcdBarrier& b) {
    asm volatile("s_waitcnt vmcnt(0)" ::: "memory");
    __syncthreads();
    if (threadIdx.x == 0) {
        unsigned* bar = b.bar;
        __builtin_amdgcn_s_waitcnt(0);
        unsigned nloc = b.st[0], nx = b.st[1];
        if (nloc == 0u) { xcd_barrier_complete(bar, b.x, nloc, nx); b.st[0] = nloc; b.st[1] = nx; }
        const unsigned old = xb_add(&bar[XB_XSUB(b.x)], 1u);
        const unsigned gen = old / nloc;
        if (old + 1u == (gen + 1u) * nloc) {
            __builtin_amdgcn_fence(__ATOMIC_RELEASE, "agent");
            asm volatile("s_waitcnt vmcnt(0)" ::: "memory");
            const unsigned og = xb_add(&bar[XB_TOP], 1u);
            const unsigned tg = og / nx;
            if (og + 1u == (tg + 1u) * nx) xb_add(&bar[XB_TOPGEN], 1u);
            else XB_SPIN(xb_ld(&bar[XB_TOPGEN]) == tg, bar);
            __builtin_amdgcn_fence(__ATOMIC_ACQUIRE, "agent");
            xb_add(&bar[XB_XGEN(b.x)], 1u);
            asm volatile("s_waitcnt vmcnt(0)" ::: "memory");
        } else {
            XB_SPIN(xb_ld(&bar[XB_XGEN(b.x)]) == gen, bar);
            __builtin_amdgcn_fence(__ATOMIC_ACQUIRE, "agent");
            asm volatile("s_waitcnt vmcnt(0)" ::: "memory");
        }
    }
    __syncthreads();
}

constexpr int N_PHASES = 10;
#ifndef ONLY_PH
#define ONLY_PH -1
#endif
#define PH_ON(x) (ONLY_PH < 0 || ONLY_PH == (x))
__global__ void __launch_bounds__(512, 2) mega(Args a) {
    extern __shared__ __attribute__((aligned(16))) unsigned char lds[];
    cg::grid_group grid = cg::this_grid();
    unsigned char* ws = a.ws;
#define PH_RUN(x) (PH_ON(x) && a.ph_lo <= (x) && (x) < a.ph_hi)
#define PH_SYNC(x) do { if (a.ph_lo <= (x) && (x) + 1 < a.ph_hi) xcd_barrier(xb); } while (0)
    volatile LAS unsigned* xst = (volatile LAS unsigned*)((LAS unsigned char*)lds + 131072);
    if (threadIdx.x == 0) { xst[0] = 0u; xst[1] = 0u; }
    __syncthreads();
    const XcdBarrier xb = xcd_barrier_post((unsigned*)(ws + WS_BAR), xst);
    if (a.ph_hi > 1000) grid.sync();
#ifndef REP0
#define REP0 1
#endif
#ifndef REP2
#define REP2 1
#endif
#ifndef REP6
#define REP6 1
#endif
    if (PH_RUN(0)) for (int rep = 0; rep < REP0; ++rep) phase_prologue(a, lds);
    PH_SYNC(0);
    if (PH_RUN(1)) { pg8::Gemm g{(const bf16_t*)(ws + WS_XB), (const bf16_t*)(ws + WS_WIN), MT, NP, DM}; pg8::StaticOrder S; S.init(MT, NP, gridDim.x, blockIdx.x);
        pg8::EpiBf16 E{(bf16_t*)(ws + WS_PROJ), NP}; pg8::gemm_phase<pg8::EpiBf16, true>((LAS unsigned char*)lds, g, S, E);
        const int rem = ((MT / 256) * (NP / 256)) % (int)gridDim.x;
        if (rem == 0) phase_transposes(a, lds, TM_IN, TM_IN + TM_OUT + TM_UP, blockIdx.x, gridDim.x);
        else if ((int)blockIdx.x >= rem) phase_transposes(a, lds, TM_IN, TM_IN + TM_OUT + TM_UP, blockIdx.x - rem, gridDim.x - rem); }
    PH_SYNC(1);
    if (PH_RUN(2)) for (int rep = 0; rep < REP2; ++rep) { phase_yconv(a); phase_mlstm(a, lds, a.out); }
    PH_SYNC(2);
    if (PH_RUN(3)) phase_headnorm(a, a.out);
    PH_SYNC(3);
    if (PH_RUN(4)) { pg8::Gemm g{(const bf16_t*)(ws + WS_Y), (const bf16_t*)(ws + WS_WOUT), MT, DM, DM}; pg8::StaticOrder S; S.init(MT, DM, gridDim.x, blockIdx.x);
        if (a.fuse_ln) { pg8::EpiResLn E{a.x, a.out, (bf16_t*)(ws + WS_X1B), a.ln1_g, a.ln1_b, (float*)(ws + WS_RS1), (unsigned*)(ws + WS_CNT)}; pg8::gemm_phase((LAS unsigned char*)lds, g, S, E); }
        else { pg8::EpiResF32 E{a.x, a.out, DM}; pg8::gemm_phase((LAS unsigned char*)lds, g, S, E); } }
    PH_SYNC(4);
    if (PH_RUN(5) && !a.fuse_ln) phase_ln(a.out, a.ln1_g, a.ln1_b, (bf16_t*)(ws + WS_X1B));
    if (!a.fuse_ln) PH_SYNC(5);
    if (PH_RUN(6)) { pg8::Gemm g{(const bf16_t*)(ws + WS_X1B), (const bf16_t*)(ws + WS_WUP), MT, NUP, DM}; pg8::StaticOrder S; S.init(MT, NUP, gridDim.x, blockIdx.x);
        pg8::EpiConvFfn E{(bf16_t*)(ws + WS_ACT), (float*)(ws + WS_HALO), a.w_fc, a.b_fc}; pg8::gemm_phase<pg8::EpiConvFfn, true>((LAS unsigned char*)lds, g, S, E);
        const int rem = ((MT / 256) * (NUP / 256)) % (int)gridDim.x; const int t0 = TM_IN + TM_OUT + TM_UP, t1 = t0 + TM_DN;
        if (rem == 0) phase_transposes(a, lds, t0, t1, blockIdx.x, gridDim.x);
        else if ((int)blockIdx.x >= rem) phase_transposes(a, lds, t0, t1, blockIdx.x - rem, gridDim.x - rem); }
    PH_SYNC(6);
    if (PH_RUN(7)) phase_fixup(a);
    PH_SYNC(7);
    if (PH_RUN(8)) { pg8::Gemm g{(const bf16_t*)(ws + WS_ACT), (const bf16_t*)(ws + WS_WDN), MT, DM, DFF}; pg8::StaticOrder S; S.init(MT, DM, gridDim.x, blockIdx.x);
        if (a.fuse_ln) { pg8::EpiResLn E{a.out, a.out, nullptr, a.ln2_g, a.ln2_b, (float*)(ws + WS_RS2), (unsigned*)(ws + WS_CNT) + 32 * 64}; pg8::gemm_phase((LAS unsigned char*)lds, g, S, E); }
        else { pg8::EpiResF32 E{a.out, a.out, DM}; pg8::gemm_phase((LAS unsigned char*)lds, g, S, E); } }
    if (!a.fuse_ln) PH_SYNC(8);
    if (PH_RUN(9) && !a.fuse_ln) phase_ln(a.out, a.ln2_g, a.ln2_b, nullptr);
    if (DBG_STOP == 1 && a.ph_lo == 101) phase_dump((const bf16_t*)(ws + WS_PROJ), NP, 3072, a.out);
    if (DBG_STOP == 3 && a.ph_lo == 103) phase_dump((const bf16_t*)(ws + WS_Y), DM, 0, a.out);
    if (DBG_STOP == 7 && a.ph_lo == 107) phase_dump((const bf16_t*)(ws + WS_ACT), DFF, 0, a.out);
}

extern "C" void kernel_launch(void* const* d_in, const int* in_sizes, int n_in, void* d_out, int out_size, void* d_ws, size_t ws_size, hipStream_t stream) {
    static int grid = 0;
    if (grid == 0) {
        if (n_in != 14 || ws_size < WS_END) { fprintf(stderr, "kernel_launch: unexpected n_in %d / ws_size %zu (need %zu)\n", n_in, ws_size, (size_t)WS_END); grid = -1; return; }
        int dev = 0, cus = 0, per_cu = 0;
        hipGetDevice(&dev); hipDeviceGetAttribute(&cus, hipDeviceAttributeMultiprocessorCount, dev);
        if (hipFuncSetAttribute((const void*)mega, hipFuncAttributeMaxDynamicSharedMemorySize, LDS_BYTES) != hipSuccess) { fprintf(stderr, "kernel_launch: hipFuncSetAttribute failed\n"); grid = -1; return; }
        if (hipOccupancyMaxActiveBlocksPerMultiprocessor(&per_cu, (const void*)mega, 512, LDS_BYTES) != hipSuccess || per_cu < 1) { fprintf(stderr, "kernel_launch: occupancy query failed (%d)\n", per_cu); (void)hipGetLastError(); per_cu = 1; }
        grid = cus * 1;
        fprintf(stderr, "kernel_launch: cus %d per_cu %d grid %d\n", cus, per_cu, grid);
    }
    if (grid < 0) return;
    if (hipMemsetAsync((char*)d_ws + WS_BAR, 0, WS_END - WS_BAR, stream)     != hipSuccess) { fprintf(stderr, "kernel_launch: memset failed\n"); return; }
    Args a{};
    a.x = (const float*)d_in[0]; a.w_in = (const float*)d_in[1]; a.b_gates = (const float*)d_in[2]; a.w_sc = (const float*)d_in[3]; a.mh_gain = (const float*)d_in[4]; a.w_out = (const float*)d_in[5];
    a.ln1_g = (const float*)d_in[6]; a.ln1_b = (const float*)d_in[7]; a.w_up = (const float*)d_in[8]; a.w_fc = (const float*)d_in[9]; a.b_fc = (const float*)d_in[10]; a.w_down = (const float*)d_in[11];
    a.ln2_g = (const float*)d_in[12]; a.ln2_b = (const float*)d_in[13];
    a.out = (float*)d_out; a.ws = (unsigned char*)d_ws;
    a.fuse_ln = (MK_SINGLE && grid == 256) ? 1 : 0;
#if MK_SINGLE
    a.ph_lo = 0; a.ph_hi = N_PHASES;
    void* args[] = {&a};
    hipError_t e = hipLaunchCooperativeKernel((const void*)mega, dim3(grid), dim3(512), args, LDS_BYTES, stream);
    if (e != hipSuccess) fprintf(stderr, "cooperative launch failed: %s (grid %d)\n", hipGetErrorString(e), grid);
#else
    for (int ph = 0; ph < N_PHASES; ++ph) { if (DBG_STOP >= 0 && ph > DBG_STOP) break; a.ph_lo = ph; a.ph_hi = ph + 1; hipLaunchKernelGGL(mega, dim3(grid), dim3(512), LDS_BYTES, stream, a); }
    if (DBG_STOP >= 0) { a.ph_lo = 100 + DBG_STOP; a.ph_hi = 101 + DBG_STOP; hipLaunchKernelGGL(mega, dim3(grid), dim3(512), LDS_BYTES, stream, a); }
#endif
}
```

```cpp
#include <hip/hip_runtime.h>
#include <hip/hip_cooperative_groups.h>
#include <cstdio>
#include <cstdint>
namespace cg = cooperative_groups;

#ifndef MK_SINGLE
#define MK_SINGLE 1
#endif

#define LAS __attribute__((address_space(3)))
typedef unsigned short bf16_t;
typedef short bf16x8 __attribute__((ext_vector_type(8)));
typedef float f32x4 __attribute__((ext_vector_type(4)));
typedef unsigned u32x4 __attribute__((ext_vector_type(4)));
typedef unsigned u32x2 __attribute__((ext_vector_type(2)));

constexpr int MT = 8192, DM = 2048, SEQ = 2048, NIN = 7176, NP = 7168, DFF = 5632, NUP = 11264, WCONV = 1024;
constexpr float ALPHA = 1.189207115002721f;
constexpr size_t WS_WIN = 0;
constexpr size_t WS_WOUT = WS_WIN + (size_t)NP * DM * 2;
constexpr size_t WS_WUP = WS_WOUT + (size_t)DM * DM * 2;
constexpr size_t WS_WDN = WS_WUP + (size_t)NUP * DM * 2;
constexpr size_t WS_X1B = WS_WDN + (size_t)DM * DFF * 2;
constexpr size_t WS_GATES = WS_X1B + (size_t)MT * DM * 2;
constexpr size_t WS_C = WS_GATES + (size_t)MT * 8 * 4;
constexpr size_t WS_PROJ = WS_C;
constexpr size_t WS_Y = WS_PROJ + (size_t)MT * NP * 2;
constexpr size_t WS_XB = WS_Y + (size_t)MT * DM * 2;
constexpr size_t WS_ACT = WS_C;
constexpr size_t WS_HALO = WS_ACT + (size_t)MT * DFF * 2;
constexpr size_t WS_BAR = WS_XB + (size_t)MT * DM * 2;
constexpr size_t WS_RS1 = WS_BAR + 16384;
constexpr size_t WS_RS2 = WS_RS1 + (size_t)MT * 8;
constexpr size_t WS_CNT = WS_RS2 + (size_t)MT * 8;
constexpr size_t WS_END = WS_CNT + 2 * 32 * 256;
constexpr int LDS_BYTES = 131072 + 16 + 3 * 32 * 64 * 4;

struct Args {
    const float* x; const float* w_in; const float* b_gates; const float* w_sc; const float* mh_gain; const float* w_out;
    const float* ln1_g; const float* ln1_b; const float* w_up; const float* w_fc; const float* b_fc; const float* w_down;
    const float* ln2_g; const float* ln2_b;
    float* out; unsigned char* ws; int ph_lo, ph_hi, fuse_ln, pad0;
};

typedef __bf16 bf16v2 __attribute__((ext_vector_type(2)));
typedef float f32x2 __attribute__((ext_vector_type(2)));
__device__ __forceinline__ unsigned cvt_pk_bf16(float lo, float hi) { const f32x2 v = {lo, hi}; const bf16v2 r = __builtin_convertvector(v, bf16v2); return __builtin_bit_cast(unsigned, r); }
__device__ __forceinline__ unsigned cvt_pk_bf16_asm(float lo, float hi) { unsigned r; asm volatile("v_cvt_pk_bf16_f32 %0, %1, %2" : "=v"(r) : "v"(lo), "v"(hi)); return r; }
__device__ __forceinline__ float bflo(unsigned u) { return __uint_as_float(u << 16); }
__device__ __forceinline__ float bfhi(unsigned u) { return __uint_as_float(u & 0xffff0000u); }
__device__ __forceinline__ bf16_t f2bf(float f) { unsigned u = __float_as_uint(f); u += 0x7FFFu + ((u >> 16) & 1u); return (bf16_t)(u >> 16); }

namespace pg8 {
constexpr int BM = 256, BK = 64, HALF = 128, HTB = HALF * BK * 2, STAGE_BYTES = 8 * HTB, NXCD = 8, WGM = 8;
__host__ __device__ __forceinline__ int lds_byte(int r, int c) { const int st = (r >> 4) * 2 + (c >> 5), rr = r & 15, cc = c & 31, ob = rr * 64 + cc * 2; return st * 1024 + (ob ^ (((ob >> 9) & 1) << 5)); }
__host__ __device__ __forceinline__ void stage_rc(int b, int& R, int& C) { const int st = b / 1024, sb = b % 1024, swz = sb ^ (((sb >> 9) & 1) << 5); R = (st >> 1) * 16 + swz / 64; C = (st & 1) * 32 + (swz % 64) / 2; }
__host__ __device__ __forceinline__ int perm32(int rho) { const int n = rho >> 4, i = rho & 15; return 8 * (i >> 2) + 4 * n + (i & 3); }
struct Unit { int pm, pn; };
struct Gemm { const bf16_t* A; const bf16_t* Bt; int M, N, K; };
struct StaticOrder {
    int nM, nN, nwg, G, c;
    __device__ void init(int M, int N, int G_, int c_) { nM = M / BM; nN = N / BM; nwg = nM * nN; G = G_; c = c_; }
    __device__ bool next(int i, Unit& u) const {
        const long L = (long)i * G + c; if (L >= nwg) return false;
        int wgid = (int)L; { const int q = nwg / NXCD, r = nwg % NXCD, xcd = wgid % NXCD, off = wgid / NXCD; wgid = (xcd < r ? xcd * (q + 1) : r * (q + 1) + (xcd - r) * q) + off; }
        const int nig = WGM * nN, gid = wgid / nig, fm = gid * WGM, gsz = (nM - fm) < WGM ? (nM - fm) : WGM;
        u.pm = fm + ((wgid % nig) % gsz); u.pn = (wgid % nig) / gsz; return true;
    }
};

template <class Epi, bool ALIGN_EPI = false, bool SP2 = true>
__device__ __forceinline__ void gemm_phase(LAS unsigned char* lds, const Gemm g, const StaticOrder& S, const Epi& E) {
    const int tid = threadIdx.x, wid = __builtin_amdgcn_readfirstlane(tid >> 6), lane = tid & 63, wr = wid >> 2, wc = wid & 3, fr = lane & 15, fq = lane >> 4;
    const int K = g.K, nt = K / BK;
    unsigned voffA[2], voffB[2];
#pragma unroll
    for (int i = 0; i < 2; ++i) { int R, C; stage_rc(tid * 16 + i * 8192, R, C); const int Rb = Epi::PERM ? ((R & ~31) + perm32(R & 31)) : R;
        const int Ra = Epi::AROWPERM ? (128 * (R >> 6) + 8 * (R & 15) + ((R >> 4) & 3)) : R;
        voffA[i] = (unsigned)(Ra * K + C) * 2u; voffB[i] = (unsigned)(Rb * K + C) * 2u; }
    const size_t kstep = (size_t)(BK * 2);
    const size_t hstep = (size_t)HALF * K * 2;
    const size_t hstepA = Epi::AROWPERM ? (size_t)4 * K * 2 : hstep;
    const size_t tstep = 2 * hstep;
    const unsigned ldsw = (unsigned)wid * 1024u;
    const int aoff = lds_byte(wr * 64 + fr, fq * 8), boff = lds_byte(wc * 32 + fr, fq * 8);
#define PG8_SA(b, h) (((b) * 2 + (h)) * HTB)
#define PG8_SB(b, h) ((4 + (b) * 2 + (h)) * HTB)
#define PG8_STAGE(bufoff, gbase, voff) do { _Pragma("unroll") for (int _i = 0; _i < 2; ++_i) \
        __builtin_amdgcn_global_load_lds((const unsigned*)((const char*)(gbase) + (voff)[_i]), (LAS unsigned*)(lds + (bufoff) + ldsw + _i * 8192), 16, 0, 0); } while (0)
#define PG8_LDA(dst, b, h) do { _Pragma("unroll") for (int m = 0; m < 4; ++m) _Pragma("unroll") for (int k = 0; k < 2; ++k) dst[m][k] = *(const LAS bf16x8*)(lds + PG8_SA(b, h) + aoff + m * 2048 + k * 1024); } while (0)
#define PG8_LDB(dst, b, h) do { _Pragma("unroll") for (int n = 0; n < 2; ++n) _Pragma("unroll") for (int k = 0; k < 2; ++k) dst[n][k] = *(const LAS bf16x8*)(lds + PG8_SB(b, h) + boff + n * 2048 + k * 1024); } while (0)
#define PG8_MMA(ai, bj, At, Bt) do { __builtin_amdgcn_s_setprio(1); _Pragma("unroll") for (int m = 0; m < 4; ++m) _Pragma("unroll") for (int n = 0; n < 2; ++n) _Pragma("unroll") for (int k = 0; k < 2; ++k) \
        acc[ai][bj][m][n] = __builtin_amdgcn_mfma_f32_16x16x32_bf16(Bt[n][k], At[m][k], acc[ai][bj][m][n], 0, 0, 0); __builtin_amdgcn_s_setprio(0); } while (0)
#define PG8_WAIT_V(n) asm volatile("s_waitcnt vmcnt(" #n ")" ::: "memory")
#define PG8_WAIT_L(n) asm volatile("s_waitcnt lgkmcnt(" #n ")" ::: "memory")
#define PG8_BAR __builtin_amdgcn_s_barrier()
#define PG8_SCHED __builtin_amdgcn_sched_barrier(0)
    Unit cur, nxt; int ui = 0;
    if (!S.next(0, cur)) return;
    f32x4 acc[2][2][4][2];
#pragma unroll
    for (int a = 0; a < 2; ++a)
#pragma unroll
        for (int b = 0; b < 2; ++b)
#pragma unroll
            for (int m = 0; m < 4; ++m)
#pragma unroll
                for (int n = 0; n < 2; ++n) acc[a][b][m][n] = (f32x4){0.f, 0.f, 0.f, 0.f};
    bf16x8 At[4][2], B0[2][2], B1[2][2];
    const char* cA = (const char*)g.A + (size_t)cur.pm * tstep; const char* cB = (const char*)g.Bt + (size_t)cur.pn * tstep;
    if constexpr (SP2) {
        PG8_STAGE(PG8_SB(0, 0), cB, voffB); PG8_STAGE(PG8_SB(0, 1), cB + hstep, voffB); PG8_STAGE(PG8_SA(0, 0), cA, voffA); PG8_STAGE(PG8_SA(0, 1), cA + hstepA, voffA);
        if (wr == 1) PG8_BAR;
        PG8_WAIT_V(2); PG8_BAR;
        PG8_STAGE(PG8_SB(1, 0), cB + kstep, voffB); PG8_STAGE(PG8_SA(1, 0), cA + kstep, voffA); PG8_STAGE(PG8_SB(1, 1), cB + hstep + kstep, voffB);
        PG8_WAIT_V(6); PG8_BAR;
    } else {
        PG8_STAGE(PG8_SB(0, 0), cB, voffB); PG8_STAGE(PG8_SA(0, 0), cA, voffA); PG8_STAGE(PG8_SB(0, 1), cB + hstep, voffB); PG8_STAGE(PG8_SA(0, 1), cA + hstepA, voffA);
        if (wr == 1) PG8_BAR;
        PG8_WAIT_V(4); PG8_BAR;
        PG8_STAGE(PG8_SB(1, 0), cB + kstep, voffB); PG8_STAGE(PG8_SA(1, 0), cA + kstep, voffA); PG8_STAGE(PG8_SB(1, 1), cB + hstep + kstep, voffB);
        PG8_WAIT_V(6); PG8_BAR;
    }
    for (;;) {
        const bool has_next = S.next(ui + 1, nxt);
        const char* nA = has_next ? (const char*)g.A + (size_t)nxt.pm * tstep : cA; const char* nB = has_next ? (const char*)g.Bt + (size_t)nxt.pn * tstep : cB;
        for (int t = 0; t < nt; t += 2) {
            const bool last = (t == nt - 2);
            const char* a1 = cA + (size_t)(t + 1) * kstep;
            const char* a2 = last ? nA : cA + (size_t)(t + 2) * kstep; const char* b2 = last ? nB : cB + (size_t)(t + 2) * kstep;
            const char* a3 = a2 + kstep; const char* b3 = b2 + kstep;
            if constexpr (SP2) {
            PG8_LDB(B0, 0, 0); PG8_LDB(B1, 0, 1); PG8_SCHED; PG8_LDA(At, 0, 0); PG8_STAGE(PG8_SA(1, 1), a1 + hstepA, voffA);
            PG8_WAIT_V(8); PG8_WAIT_L(0); PG8_BAR; PG8_MMA(0, 0, At, B0); PG8_MMA(0, 1, At, B1); PG8_BAR; PG8_SCHED;
            PG8_LDA(At, 0, 1); PG8_STAGE(PG8_SB(0, 0), b2, voffB); PG8_STAGE(PG8_SB(0, 1), b2 + hstep, voffB); PG8_STAGE(PG8_SA(0, 0), a2, voffA);
            PG8_WAIT_V(8); PG8_WAIT_L(0); PG8_BAR; PG8_MMA(1, 0, At, B0); PG8_MMA(1, 1, At, B1); PG8_BAR; PG8_SCHED;
            PG8_LDB(B0, 1, 0); PG8_LDB(B1, 1, 1); PG8_SCHED; PG8_LDA(At, 1, 0); PG8_STAGE(PG8_SA(0, 1), a2 + hstepA, voffA);
            PG8_WAIT_V(8); PG8_WAIT_L(0); PG8_BAR; PG8_MMA(0, 0, At, B0); PG8_MMA(0, 1, At, B1); PG8_BAR; PG8_SCHED;
            PG8_LDA(At, 1, 1); PG8_STAGE(PG8_SB(1, 0), b3, voffB); PG8_STAGE(PG8_SB(1, 1), b3 + hstep, voffB); PG8_STAGE(PG8_SA(1, 0), a3, voffA);
            PG8_WAIT_V(8); PG8_WAIT_L(0); PG8_BAR; PG8_MMA(1, 0, At, B0); PG8_MMA(1, 1, At, B1); PG8_BAR; PG8_SCHED;
            } else {
            PG8_LDB(B0, 0, 0); PG8_SCHED; PG8_LDA(At, 0, 0); PG8_STAGE(PG8_SA(1, 1), a1 + hstepA, voffA);
            PG8_WAIT_L(8); PG8_BAR; PG8_WAIT_L(0); PG8_MMA(0, 0, At, B0); PG8_BAR; PG8_SCHED;
            PG8_LDB(B1, 0, 1); PG8_STAGE(PG8_SB(0, 0), b2, voffB);
            PG8_BAR; PG8_WAIT_L(0); PG8_MMA(0, 1, At, B1); PG8_BAR;
            PG8_LDA(At, 0, 1); PG8_STAGE(PG8_SA(0, 0), a2, voffA);
            PG8_BAR; PG8_WAIT_L(0); PG8_MMA(1, 0, At, B0); PG8_BAR; PG8_SCHED;
            PG8_STAGE(PG8_SB(0, 1), b2 + hstep, voffB);
            PG8_WAIT_V(6); PG8_BAR; PG8_MMA(1, 1, At, B1); PG8_BAR;
            PG8_LDB(B0, 1, 0); PG8_SCHED; PG8_LDA(At, 1, 0); PG8_STAGE(PG8_SA(0, 1), a2 + hstepA, voffA);
            PG8_WAIT_L(8); PG8_BAR; PG8_WAIT_L(0); PG8_MMA(0, 0, At, B0); PG8_BAR; PG8_SCHED;
            PG8_LDB(B1, 1, 1); PG8_STAGE(PG8_SB(1, 0), b3, voffB);
            PG8_BAR; PG8_WAIT_L(0); PG8_MMA(0, 1, At, B1); PG8_BAR;
            PG8_LDA(At, 1, 1); PG8_STAGE(PG8_SA(1, 0), a3, voffA);
            PG8_BAR; PG8_WAIT_L(0); PG8_MMA(1, 0, At, B0); PG8_BAR; PG8_SCHED;
            PG8_STAGE(PG8_SB(1, 1), b3 + hstep, voffB);
            PG8_WAIT_V(6); PG8_BAR; PG8_MMA(1, 1, At, B1); PG8_BAR;

            }
        }
        if constexpr (ALIGN_EPI) { if (wr == 0) PG8_BAR; }
        if constexpr (!Epi::AFTER_DRAIN) E(acc, cur, wr, wc, fr, fq);
        if (!has_next) break;
#pragma unroll
        for (int a = 0; a < 2; ++a)
#pragma unroll
            for (int b = 0; b < 2; ++b)
#pragma unroll
                for (int m = 0; m < 4; ++m)
#pragma unroll
                    for (int n = 0; n < 2; ++n) acc[a][b][m][n] = (f32x4){0.f, 0.f, 0.f, 0.f};
        cur = nxt; cA = nA; cB = nB; ++ui;
        if constexpr (ALIGN_EPI) { if (wr == 1) PG8_BAR; }
    }
    PG8_WAIT_V(0);
    if constexpr (!ALIGN_EPI) { if (wr == 0) PG8_BAR; }
    PG8_BAR;
    if constexpr (Epi::AFTER_DRAIN) E(acc, cur, wr, wc, fr, fq);
#undef PG8_SA
#undef PG8_SB
#undef PG8_STAGE
#undef PG8_LDA
#undef PG8_LDB
#undef PG8_MMA
#undef PG8_WAIT_V
#undef PG8_WAIT_L
#undef PG8_BAR
#undef PG8_SCHED
}

struct EpiBf16 {
    static constexpr bool PERM = true, AFTER_DRAIN = false, AROWPERM = false;
    bf16_t* O; int ldc;
    __device__ __forceinline__ void operator()(f32x4 (&acc)[2][2][4][2], const Unit& u, int wr, int wc, int fr, int fq) const {
        const int row0 = u.pm * BM + wr * 64 + fr, col0 = u.pn * BM + wc * 32 + 8 * fq;
#pragma unroll
        for (int ai = 0; ai < 2; ++ai)
#pragma unroll
            for (int m = 0; m < 4; ++m) { bf16_t* rowp = O + (size_t)(row0 + ai * HALF + m * 16) * ldc + col0;
#pragma unroll
                for (int bj = 0; bj < 2; ++bj) { const f32x4 v0 = acc[ai][bj][m][0], v1 = acc[ai][bj][m][1];
                    u32x4 w; w.x = cvt_pk_bf16_asm(v0[0], v0[1]); w.y = cvt_pk_bf16_asm(v0[2], v0[3]); w.z = cvt_pk_bf16_asm(v1[0], v1[1]); w.w = cvt_pk_bf16_asm(v1[2], v1[3]);
                    *(u32x4*)(rowp + bj * HALF) = w; } }
    }
};
struct EpiResF32 {
    static constexpr bool PERM = false, AFTER_DRAIN = false, AROWPERM = false;
    const float* X; float* O; int ldc;
    __device__ __forceinline__ void operator()(f32x4 (&acc)[2][2][4][2], const Unit& u, int wr, int wc, int fr, int fq) const {
        const int row0 = u.pm * BM + wr * 64 + fr, col0 = u.pn * BM + wc * 32 + 4 * fq;
#pragma unroll
        for (int ai = 0; ai < 2; ++ai)
#pragma unroll
            for (int m = 0; m < 4; ++m) { const size_t ro = (size_t)(row0 + ai * HALF + m * 16) * ldc + col0;
#pragma unroll
                for (int bj = 0; bj < 2; ++bj)
#pragma unroll
                    for (int n = 0; n < 2; ++n) { const f32x4 xv = *(const f32x4*)(X + ro + bj * HALF + n * 16);
                        *(f32x4*)(O + ro + bj * HALF + n * 16) = xv * ALPHA + acc[ai][bj][m][n]; } }
    }
};
struct EpiResLn {
    static constexpr bool PERM = false, AFTER_DRAIN = true, AROWPERM = false;
    const float* X; float* O; bf16_t* OB; const float* gam; const float* bet; float* rs; unsigned* cnt;
    __device__ __forceinline__ void operator()(f32x4 (&acc)[2][2][4][2], const Unit& u, int wr, int wc, int fr, int fq) const {
        const int row0 = u.pm * BM + wr * 64 + fr, col0 = u.pn * BM + wc * 32 + 4 * fq;
#pragma unroll
        for (int ai = 0; ai < 2; ++ai)
#pragma unroll
            for (int m = 0; m < 4; ++m) { const int row = row0 + ai * HALF + m * 16; const size_t ro = (size_t)row * DM + col0;
                float s = 0.f, q = 0.f;
#pragma unroll
                for (int bj = 0; bj < 2; ++bj)
#pragma unroll
                    for (int n = 0; n < 2; ++n) { const f32x4 xv = *(const f32x4*)(X + ro + bj * HALF + n * 16); const f32x4 z = xv * ALPHA + acc[ai][bj][m][n]; acc[ai][bj][m][n] = z;
                        s += (z[0] + z[1]) + (z[2] + z[3]); q += (z[0] * z[0] + z[1] * z[1]) + (z[2] * z[2] + z[3] * z[3]); }
                s += __shfl_xor(s, 16); s += __shfl_xor(s, 32); q += __shfl_xor(q, 16); q += __shfl_xor(q, 32);
                if (fq == 0) { (void)__hip_atomic_fetch_add(rs + 2 * row, s, __ATOMIC_RELAXED, __HIP_MEMORY_SCOPE_AGENT); (void)__hip_atomic_fetch_add(rs + 2 * row + 1, q, __ATOMIC_RELAXED, __HIP_MEMORY_SCOPE_AGENT); } }
        asm volatile("s_waitcnt vmcnt(0)" ::: "memory");
        unsigned* cp = cnt + 64 * u.pm;
        if ((threadIdx.x & 63) == 0) (void)__hip_atomic_fetch_add(cp, 1u, __ATOMIC_RELAXED, __HIP_MEMORY_SCOPE_AGENT);
        { unsigned sp = 0; while ((unsigned)__builtin_amdgcn_readfirstlane(__hip_atomic_load(cp, __ATOMIC_RELAXED, __HIP_MEMORY_SCOPE_AGENT)) < 64u) { __builtin_amdgcn_s_sleep(2); if (++sp > (1u << 22)) break; } }
        f32x4 gg[2][2], bb[2][2];
#pragma unroll
        for (int bj = 0; bj < 2; ++bj)
#pragma unroll
            for (int n = 0; n < 2; ++n) { gg[bj][n] = *(const f32x4*)(gam + col0 + bj * HALF + n * 16); bb[bj][n] = *(const f32x4*)(bet + col0 + bj * HALF + n * 16); }
#pragma unroll
        for (int ai = 0; ai < 2; ++ai)
#pragma unroll
            for (int m = 0; m < 4; ++m) { const int row = row0 + ai * HALF + m * 16; const size_t ro = (size_t)row * DM + col0;
                const float s = __hip_atomic_load(rs + 2 * row, __ATOMIC_RELAXED, __HIP_MEMORY_SCOPE_AGENT), q = __hip_atomic_load(rs + 2 * row + 1, __ATOMIC_RELAXED, __HIP_MEMORY_SCOPE_AGENT);
                const float mu = s * (1.0f / DM), rstd = rsqrtf(fmaxf(q * (1.0f / DM) - mu * mu, 0.f) + 1e-5f);
#pragma unroll
                for (int bj = 0; bj < 2; ++bj)
#pragma unroll
                    for (int n = 0; n < 2; ++n) { const f32x4 o = (acc[ai][bj][m][n] - mu) * rstd * gg[bj][n] + bb[bj][n];
                        *(f32x4*)(O + ro + bj * HALF + n * 16) = o;
                        if (OB) { u32x2 p; p.x = cvt_pk_bf16_asm(o[0], o[1]); p.y = cvt_pk_bf16_asm(o[2], o[3]); *(u32x2*)(OB + ro + bj * HALF + n * 16) = p; } } }
    }
};
__device__ __forceinline__ float dpp_shr1(float x) { return __builtin_bit_cast(float, __builtin_amdgcn_update_dpp(0, __builtin_bit_cast(int, x), 0x111, 0xf, 0xf, true)); }
struct EpiConvFfn {
    static constexpr bool PERM = true, AFTER_DRAIN = false, AROWPERM = true;
    bf16_t* act; float* halo; const float* cw; const float* cb;
    __device__ __forceinline__ void operator()(f32x4 (&acc)[2][2][4][2], const Unit& u, int wr, int wc, int fr, int fq) const {
        const int fcol = u.pn * 128 + wc * 32 + 8 * fq;
        const int rbase = u.pm * BM + wr * 128;
        {
            float* hb = halo + (size_t)(rbase >> 7) * 4 * NUP + fcol;
            if (fr == 0) {
#pragma unroll
                for (int bj = 0; bj < 2; ++bj)
#pragma unroll
                    for (int n = 0; n < 2; ++n) { *(f32x4*)(hb + (size_t)2 * NUP + bj * DFF + 4 * n) = acc[0][bj][0][n]; *(f32x4*)(hb + (size_t)3 * NUP + bj * DFF + 4 * n) = acc[0][bj][1][n]; }
            }
            if (fr == 15) {
#pragma unroll
                for (int bj = 0; bj < 2; ++bj)
#pragma unroll
                    for (int n = 0; n < 2; ++n) { *(f32x4*)(hb + bj * DFF + 4 * n) = acc[1][bj][2][n]; *(f32x4*)(hb + (size_t)1 * NUP + bj * DFF + 4 * n) = acc[1][bj][3][n]; }
            }
        }
        u32x2 pk0[8];
#pragma unroll
        for (int n = 0; n < 2; ++n) {
            f32x4 W0[2], W1[2], W2[2], Bb[2];
#pragma unroll
            for (int bj = 0; bj < 2; ++bj) { const int hc = bj * DFF + fcol + 4 * n;
                W0[bj] = *(const f32x4*)(cw + hc); W1[bj] = *(const f32x4*)(cw + NUP + hc); W2[bj] = *(const f32x4*)(cw + 2 * NUP + hc); Bb[bj] = *(const f32x4*)(cb + hc); }
            f32x4 E6[2], E7[2];
#pragma unroll
            for (int bj = 0; bj < 2; ++bj) { const f32x4 s6 = acc[1][bj][2][n], s7 = acc[1][bj][3][n];
                E6[bj][0] = dpp_shr1(s6[0]); E6[bj][1] = dpp_shr1(s6[1]); E6[bj][2] = dpp_shr1(s6[2]); E6[bj][3] = dpp_shr1(s6[3]);
                E7[bj][0] = dpp_shr1(s7[0]); E7[bj][1] = dpp_shr1(s7[1]); E7[bj][2] = dpp_shr1(s7[2]); E7[bj][3] = dpp_shr1(s7[3]); }
            float av[8][4];
#pragma unroll
            for (int j = 0; j < 4; ++j) {
                float hc[2][8];
#pragma unroll
                for (int bj = 0; bj < 2; ++bj) {
                    const float e6 = E6[bj][j], e7 = E7[bj][j];
#pragma unroll
                    for (int i = 0; i < 8; ++i) {
                        const float cur = acc[i >> 2][bj][i & 3][n][j];
                        const float p1 = (i >= 1) ? acc[(i - 1 >= 0 ? i - 1 : 0) >> 2][bj][(i - 1 >= 0 ? i - 1 : 0) & 3][n][j] : e7;
                        const float p2 = (i >= 2) ? acc[(i - 2 >= 0 ? i - 2 : 0) >> 2][bj][(i - 2 >= 0 ? i - 2 : 0) & 3][n][j] : (i == 1 ? e7 : e6);
                        hc[bj][i] = W2[bj][j] * cur + W1[bj][j] * p1 + W0[bj][j] * p2 + Bb[bj][j];
                    }
                }
#pragma unroll
                for (int i = 0; i < 8; ++i) { const float gt = hc[1][i]; av[i][j] = hc[0][i] * gt * __builtin_amdgcn_rcpf(1.0f + __expf(-gt)); }
            }
#pragma unroll
            for (int i = 0; i < 8; ++i) {
                u32x2 pk; pk.x = cvt_pk_bf16_asm(av[i][0], av[i][1]); pk.y = cvt_pk_bf16_asm(av[i][2], av[i][3]);
                if (n == 0) pk0[i] = pk;
                else if (i >= 2 || fr > 0) { u32x4 w; w.x = pk0[i].x; w.y = pk0[i].y; w.z = pk.x; w.w = pk.y;
                    *(u32x4*)(act + (size_t)(rbase + 8 * fr + i) * DFF + fcol) = w; }
            }
            asm volatile("" ::: "memory");
        }
    }
};
}

template <bool UPMAP>
__device__ __forceinline__ void transpose_macro(const float* W, int ldw, int k0, int n0, bf16_t* Wt, int ldt, unsigned char* lds) {
    bf16_t* sT = (bf16_t*)lds; const int tid = threadIdx.x;
    float4 v[2][4];
#pragma unroll
    for (int i = 0; i < 2; ++i)
#pragma unroll
        for (int j = 0; j < 4; ++j) v[i][j] = *(const float4*)(W + (size_t)(k0 + (tid >> 4) + 32 * i) * ldw + n0 + 64 * j + (tid & 15) * 4);
#pragma unroll
    for (int i = 0; i < 2; ++i)
#pragma unroll
        for (int j = 0; j < 4; ++j) { const int k = (tid >> 4) + 32 * i, n = 64 * j + (tid & 15) * 4;
            sT[(n + 0) * 66 + k] = f2bf(v[i][j].x); sT[(n + 1) * 66 + k] = f2bf(v[i][j].y); sT[(n + 2) * 66 + k] = f2bf(v[i][j].z); sT[(n + 3) * 66 + k] = f2bf(v[i][j].w); }
    __syncthreads();
#pragma unroll
    for (int j = 0; j < 4; ++j) { const int n = 64 * j + (tid >> 3), ks = (tid & 7) * 8; const unsigned* p = (const unsigned*)(sT + n * 66 + ks);
        u32x4 o; o.x = p[0]; o.y = p[1]; o.z = p[2]; o.w = p[3];
        int drow = n0 + n;
        if (UPMAP) { const int f = (drow < DFF) ? drow : drow - DFF; drow = 256 * (f >> 7) + (f & 127) + ((drow < DFF) ? 0 : 128); }
        *(u32x4*)(Wt + (size_t)drow * ldt + k0 + ks) = o; }
    __syncthreads();
}
constexpr int TM_IN = 32 * 28, TM_OUT = 32 * 8, TM_UP = 32 * 44, TM_DN = 88 * 8;
__device__ __forceinline__ void phase_transposes(const Args& A, unsigned char* lds, int g0, int g1, int worker, int nworkers) {
    unsigned char* ws = A.ws;
    for (int g = g0 + worker; g < g1; g += nworkers) {
        if (g < TM_IN) { const int tk = g / 28, tn = g % 28; transpose_macro<false>(A.w_in, NIN, tk * 64, tn * 256, (bf16_t*)(ws + WS_WIN), DM, lds); }
        else if (g < TM_IN + TM_OUT) { const int h = g - TM_IN, tk = h / 8, tn = h % 8; transpose_macro<false>(A.w_out, DM, tk * 64, tn * 256, (bf16_t*)(ws + WS_WOUT), DM, lds); }
        else if (g < TM_IN + TM_OUT + TM_UP) { const int h = g - TM_IN - TM_OUT, tk = h / 44, tn = h % 44; transpose_macro<true>(A.w_up, NUP, tk * 64, tn * 256, (bf16_t*)(ws + WS_WUP), DM, lds); }
        else { const int h = g - TM_IN - TM_OUT - TM_UP, tk = h / 8, tn = h % 8; transpose_macro<false>(A.w_down, DM, tk * 64, tn * 256, (bf16_t*)(ws + WS_WDN), DFF, lds); }
    }
}
__device__ __forceinline__ void phase_prologue(const Args& A, unsigned char* lds) {
    unsigned char* ws = A.ws;
    phase_transposes(A, lds, 0, TM_IN, blockIdx.x, gridDim.x);
    const int lane = threadIdx.x & 63, gw = blockIdx.x * 8 + (threadIdx.x >> 6), nw = gridDim.x * 8;
    bf16_t* xb = (bf16_t*)(ws + WS_XB); float* gates = (float*)(ws + WS_GATES);
    for (int it = gw; it < MT / 4; it += nw) {
        const int r0 = it * 4;
        float acc[4][8];
#pragma unroll
        for (int r = 0; r < 4; ++r)
#pragma unroll
            for (int q = 0; q < 8; ++q) acc[r][q] = 0.f;
#pragma unroll 1
        for (int i = 0; i < 8; ++i) {
            const int kb = i * 256 + lane * 4;
            f32x4 xv[4];
#pragma unroll
            for (int r = 0; r < 4; ++r) { xv[r] = *(const f32x4*)(A.x + (size_t)(r0 + r) * DM + kb);
                u32x2 o; o.x = cvt_pk_bf16(xv[r][0], xv[r][1]); o.y = cvt_pk_bf16(xv[r][2], xv[r][3]); *(u32x2*)(xb + (size_t)(r0 + r) * DM + kb) = o; }
#pragma unroll
            for (int j = 0; j < 4; ++j) {
                const f32x4* wp = (const f32x4*)(A.w_in + (size_t)(kb + j) * NIN + NP);
                const f32x4 w0 = wp[0], w1 = wp[1];
#pragma unroll
                for (int r = 0; r < 4; ++r) { const float xs = xv[r][j];
                    acc[r][0] += xs * w0[0]; acc[r][1] += xs * w0[1]; acc[r][2] += xs * w0[2]; acc[r][3] += xs * w0[3];
                    acc[r][4] += xs * w1[0]; acc[r][5] += xs * w1[1]; acc[r][6] += xs * w1[2]; acc[r][7] += xs * w1[3]; }
            }
        }
#pragma unroll
        for (int r = 0; r < 4; ++r)
#pragma unroll
            for (int q = 0; q < 8; ++q) { float v = acc[r][q];
#pragma unroll
                for (int off = 32; off >= 1; off >>= 1) v += __shfl_xor(v, off);
                acc[r][q] = v; }
        if (lane == 0) {
            const f32x4 b0 = *(const f32x4*)(A.b_gates), b1 = *(const f32x4*)(A.b_gates + 4);
#pragma unroll
            for (int r = 0; r < 4; ++r) {
                *(f32x4*)(gates + (size_t)(r0 + r) * 8) = (f32x4){acc[r][0] + b0[0], acc[r][1] + b0[1], acc[r][2] + b0[2], acc[r][3] + b0[3]};
                *(f32x4*)(gates + (size_t)(r0 + r) * 8 + 4) = (f32x4){acc[r][4] + b1[0], acc[r][5] + b1[1], acc[r][6] + b1[2], acc[r][7] + b1[3]}; }
        }
    }
}

__device__ __forceinline__ void phase_yconv(const Args& A) {
    const bf16_t* proj = (const bf16_t*)(A.ws + WS_PROJ); bf16_t* y = (bf16_t*)(A.ws + WS_Y);
    for (int idx = blockIdx.x * 512 + threadIdx.x; idx < MT * 128; idx += gridDim.x * 512) {
        const int row = idx >> 7, c = (idx & 127) * 8, t = row & (SEQ - 1);
        const bf16_t* pr = proj + (size_t)row * NP + c;
        const u32x4 bv = *(const u32x4*)pr;
        float cv[8];
#pragma unroll
        for (int i = 0; i < 8; ++i) cv[i] = 0.f;
#pragma unroll
        for (int j = 0; j < 3; ++j) {
            const int dt = 2 - j;
            if (t - dt >= 0) {
                const u32x4 cc = *(const u32x4*)(pr - (size_t)dt * NP + WCONV), hh = *(const u32x4*)(pr - (size_t)dt * NP + 2 * WCONV);
                const f32x4 w0 = *(const f32x4*)(A.w_sc + j * WCONV + c), w1 = *(const f32x4*)(A.w_sc + j * WCONV + c + 4);
                const float wv[8] = {w0[0], w0[1], w0[2], w0[3], w1[0], w1[1], w1[2], w1[3]};
#pragma unroll
                for (int q = 0; q < 4; ++q) { cv[2 * q] += wv[2 * q] * bflo(cc[q]) * bflo(hh[q]); cv[2 * q + 1] += wv[2 * q + 1] * bfhi(cc[q]) * bfhi(hh[q]); }
            }
        }
        u32x4 o;
#pragma unroll
        for (int q = 0; q < 4; ++q) o[q] = cvt_pk_bf16(bflo(bv[q]) * cv[2 * q], bfhi(bv[q]) * cv[2 * q + 1]);
        *(u32x4*)(y + (size_t)row * DM + c) = o;
    }
}

__device__ __forceinline__ void phase_mlstm(const Args& A, unsigned char* lds, float* hbuf) {
    const int tid = threadIdx.x, lane = tid & 63, w = tid >> 6, g = lane >> 4, l15 = lane & 15;
    const int a = w >> 2, ti = w & 3;
    unsigned char* QS = lds; unsigned char* KS = lds + 33792; unsigned char* VT = lds + 67584; unsigned char* WVT = VT + 4608; unsigned char* CT = WVT + 4608; unsigned char* XCH = CT + 33792;
    const bf16_t* proj = (const bf16_t*)(A.ws + WS_PROJ); const float* gates = (const float*)(A.ws + WS_GATES);
    float* TBC = (float*)(lds + 131088); float* TUV = TBC + 2048; float* TCM = TUV + 2048;
    for (int item = blockIdx.x; item < 256; item += gridDim.x) {
        const int xcd = item & 7, idx = item >> 3; const int bh = xcd * 2 + (idx >> 4), es = idx & 15;
        const int b = bh >> 2, hh = bh & 3, e0 = es * 16;
        const size_t row0 = (size_t)b * SEQ;
        __syncthreads();
        for (int i = tid; i < 16896 / 4; i += 512) ((unsigned*)CT)[i] = 0u;
        for (int i = tid; i < 16 * 72; i += 512) { const int r = 16 + i / 72, ci = i % 72; ((bf16_t*)VT)[r * 72 + ci] = (r == 16) ? (bf16_t)0x3F80 : (bf16_t)0; ((bf16_t*)WVT)[r * 72 + ci] = 0; }
        f32x4 Cst[2][2];
#pragma unroll
        for (int x = 0; x < 2; ++x)
#pragma unroll
            for (int et = 0; et < 2; ++et) Cst[x][et] = (f32x4){0.f, 0.f, 0.f, 0.f};
        float m_state = 0.f;
        u32x4 qr[4], kr[4], vr = (u32x4){0u, 0u, 0u, 0u};
        const bf16_t* qbase = proj + row0 * NP + 3072 + hh * 256;
#define ML_LOAD(c) do { _Pragma("unroll") for (int i = 0; i < 4; ++i) { const int p = tid + 512 * i, r = p >> 5, c16 = p & 31; const bf16_t* rp = qbase + (size_t)((c) * 64 + r) * NP + c16 * 8; \
            qr[i] = *(const u32x4*)rp; kr[i] = *(const u32x4*)(rp + 1024); } \
            if (tid < 128) vr = *(const u32x4*)(qbase + (size_t)((c) * 64 + (tid >> 1)) * NP + 2048 + e0 + (tid & 1) * 8); } while (0)
        ML_LOAD(0);
#pragma unroll 1
        for (int cc = 4 * w; cc < 4 * w + 4; ++cc) {
            const float* gp = gates + (row0 + cc * 64 + lane) * 8 + hh; const float gi = gp[0], gf = gp[4];
            const float lf = fminf(gf, 0.f) - log1pf(__expf(-fabsf(gf)));
            float bc = lf;
#pragma unroll
            for (int off = 1; off < 64; off <<= 1) { const float t = __shfl_up(bc, off); if (lane >= off) bc += t; }
            const float uv = gi - bc;
            float cm = uv;
#pragma unroll
            for (int off = 1; off < 64; off <<= 1) { const float t = __shfl_up(cm, off); if (lane >= off) cm = fmaxf(cm, t); }
            TBC[cc * 64 + lane] = bc; TUV[cc * 64 + lane] = uv; TCM[cc * 64 + lane] = cm;
        }
        __syncthreads();
#pragma unroll 1
        for (int c = 0; c < 32; ++c) {
            const float* tbc = TBC + c * 64; const float* tuv = TUV + c * 64; const float* tcm = TCM + c * 64;
            const float g_tot = tbc[63], cm63 = tcm[63];
            const float M63 = fmaxf(m_state, cm63), decay = __expf(m_state - M63);
            const float m_old = m_state;
            m_state = g_tot + M63;
#pragma unroll
            for (int i = 0; i < 4; ++i) { const int p = tid + 512 * i, r = p >> 5, c16 = p & 31; *(u32x4*)(QS + r * 528 + c16 * 16) = qr[i]; *(u32x4*)(KS + r * 528 + c16 * 16) = kr[i]; }
            { if (tid < 128) { const int s = tid >> 1, hf = tid & 1; const float wv = __expf(tuv[s] - M63);
#pragma unroll
                  for (int q = 0; q < 4; ++q) { const float v0 = bflo(vr[q]), v1 = bfhi(vr[q]);
                      ((bf16_t*)VT)[(8 * hf + 2 * q) * 72 + s] = (bf16_t)(vr[q] & 0xffffu); ((bf16_t*)VT)[(8 * hf + 2 * q + 1) * 72 + s] = (bf16_t)(vr[q] >> 16);
                      ((bf16_t*)WVT)[(8 * hf + 2 * q) * 72 + s] = f2bf(v0 * wv); ((bf16_t*)WVT)[(8 * hf + 2 * q + 1) * 72 + s] = f2bf(v1 * wv); } }
              if (w == 2) ((bf16_t*)WVT)[16 * 72 + lane] = f2bf(__expf(tuv[lane] - M63)); }
            if (c + 1 < 32) ML_LOAD(c + 1);
            __syncthreads();
            bf16x8 qf[8]; f32x4 S0 = (f32x4){0.f, 0.f, 0.f, 0.f}, S1 = S0;
#pragma unroll
            for (int kk = 0; kk < 8; ++kk) {
                qf[kk] = *(const bf16x8*)(QS + (16 * ti + l15) * 528 + kk * 64 + g * 16);
                const bf16x8 kf0 = *(const bf16x8*)(KS + (32 * a + l15) * 528 + kk * 64 + g * 16), kf1 = *(const bf16x8*)(KS + (32 * a + 16 + l15) * 528 + kk * 64 + g * 16);
                S0 = __builtin_amdgcn_mfma_f32_16x16x32_bf16(kf0, qf[kk], S0, 0, 0, 0); S1 = __builtin_amdgcn_mfma_f32_16x16x32_bf16(kf1, qf[kk], S1, 0, 0, 0);
            }
            const int tcol = 16 * ti + l15;
            const float Mt = fmaxf(m_old, tcm[tcol]);
            const f32x4 u0v = *(const f32x4*)(tuv + 32 * a + 4 * g), u1v = *(const f32x4*)(tuv + 32 * a + 16 + 4 * g);
            float p[8];
#pragma unroll
            for (int r = 0; r < 4; ++r) { const int s0 = 32 * a + 4 * g + r, s1 = s0 + 16;
                p[r] = (s0 <= tcol) ? S0[r] * 0.0625f * __expf(u0v[r] - Mt) : 0.f; p[4 + r] = (s1 <= tcol) ? S1[r] * 0.0625f * __expf(u1v[r] - Mt) : 0.f; }
            u32x4 pau; pau.x = cvt_pk_bf16(p[0], p[1]); pau.y = cvt_pk_bf16(p[2], p[3]); pau.z = cvt_pk_bf16(p[4], p[5]); pau.w = cvt_pk_bf16(p[6], p[7]);
            const bf16x8 pa = __builtin_bit_cast(bf16x8, pau);
            f32x4 rr[2];
#pragma unroll
            for (int et = 0; et < 2; ++et) { const unsigned char* vp = VT + (16 * et + l15) * 144 + (32 * a + 4 * g) * 2;
                const u32x2 lo = *(const u32x2*)vp, hi = *(const u32x2*)(vp + 32);
                u32x4 vbu; vbu.x = lo.x; vbu.y = lo.y; vbu.z = hi.x; vbu.w = hi.y;
                rr[et] = __builtin_amdgcn_mfma_f32_16x16x32_bf16(pa, __builtin_bit_cast(bf16x8, vbu), (f32x4){0.f, 0.f, 0.f, 0.f}, 0, 0, 0); }
            const f32x4 cmr = *(const f32x4*)(tcm + 16 * ti + 4 * g), bcr = *(const f32x4*)(tbc + 16 * ti + 4 * g);
            {
                const unsigned char* CTc = CT + (c & 1) * 16896;
                f32x4 in0 = (f32x4){0.f, 0.f, 0.f, 0.f}, in1 = in0;
#pragma unroll
                for (int k2 = 0; k2 < 4; ++k2) {
                    const bf16x8 qa = a ? qf[4 + k2] : qf[k2];
                    const bf16x8 c0 = *(const bf16x8*)(CTc + (l15) * 528 + (128 * a + 32 * k2 + 8 * g) * 2), c1 = *(const bf16x8*)(CTc + (16 + l15) * 528 + (128 * a + 32 * k2 + 8 * g) * 2);
                    in0 = __builtin_amdgcn_mfma_f32_16x16x32_bf16(qa, c0, in0, 0, 0, 0); in1 = __builtin_amdgcn_mfma_f32_16x16x32_bf16(qa, c1, in1, 0, 0, 0);
                }
#pragma unroll
                for (int r = 0; r < 4; ++r) { const float iw = __expf(m_old - fmaxf(m_old, cmr[r])) * 0.0625f; rr[0][r] += in0[r] * iw; rr[1][r] += in1[r] * iw; }
            }
            if (a == 1) { *(f32x4*)(XCH + ((ti * 2 + 0) * 64 + lane) * 16) = rr[0]; *(f32x4*)(XCH + ((ti * 2 + 1) * 64 + lane) * 16) = rr[1]; }
            {
                unsigned char* CTn = CT + ((c + 1) & 1) * 16896;
#pragma unroll
                for (int x = 0; x < 2; ++x) {
                    const int dt = 2 * w + x;
#pragma unroll
                    for (int et = 0; et < 2; ++et) Cst[x][et] *= decay;
#pragma unroll
                    for (int ks = 0; ks < 2; ++ks) {
                        bf16x8 ka;
#pragma unroll
                        for (int jj = 0; jj < 8; ++jj) ka[jj] = (short)*(const bf16_t*)(KS + (32 * ks + 8 * g + jj) * 528 + (16 * dt + l15) * 2);
#pragma unroll
                        for (int et = 0; et < 2; ++et) { const bf16x8 wvb = *(const bf16x8*)(WVT + (16 * et + l15) * 144 + (32 * ks + 8 * g) * 2);
                            Cst[x][et] = __builtin_amdgcn_mfma_f32_16x16x32_bf16(ka, wvb, Cst[x][et], 0, 0, 0); }
                    }
#pragma unroll
                    for (int et = 0; et < 2; ++et) { u32x2 o; o.x = cvt_pk_bf16(Cst[x][et][0], Cst[x][et][1]); o.y = cvt_pk_bf16(Cst[x][et][2], Cst[x][et][3]);
                        *(u32x2*)(CTn + (16 * et + l15) * 528 + (16 * dt + 4 * g) * 2) = o; }
                }
            }
            __syncthreads();
            if (a == 0) {
                const f32x4 o0 = *(const f32x4*)(XCH + ((ti * 2 + 0) * 64 + lane) * 16), o1 = *(const f32x4*)(XCH + ((ti * 2 + 1) * 64 + lane) * 16);
#pragma unroll
                for (int r = 0; r < 4; ++r) {
                    const float den = __shfl(rr[1][r] + o1[r], lane & 48), fl = __expf(-(bcr[r] + fmaxf(m_old, cmr[r])));
                    const float hv = (rr[0][r] + o0[r]) / fmaxf(fabsf(den), fl);
                    hbuf[(row0 + c * 64 + 16 * ti + 4 * g + r) * 1024 + hh * 256 + e0 + l15] = hv;
                }
            }
        }
#undef ML_LOAD
    }
}

__device__ __forceinline__ void phase_headnorm(const Args& A, const float* hbuf) {
    const bf16_t* proj = (const bf16_t*)(A.ws + WS_PROJ); bf16_t* y = (bf16_t*)(A.ws + WS_Y);
    const int lane = threadIdx.x & 63, gw = blockIdx.x * 8 + (threadIdx.x >> 6), nw = gridDim.x * 8;
    for (int it = gw; it < MT * 4; it += nw) {
        const int row = it >> 2, hh = it & 3;
        const f32x4 hv = *(const f32x4*)(hbuf + (size_t)row * 1024 + hh * 256 + lane * 4);
        float s = (hv[0] + hv[1]) + (hv[2] + hv[3]);
#pragma unroll
        for (int off = 32; off >= 1; off >>= 1) s += __shfl_xor(s, off);
        const float mu = s * (1.0f / 256.0f);
        const f32x4 d = hv - mu;
        float q = (d[0] * d[0] + d[1] * d[1]) + (d[2] * d[2] + d[3] * d[3]);
#pragma unroll
        for (int off = 32; off >= 1; off >>= 1) q += __shfl_xor(q, off);
        const float rstd = rsqrtf(q * (1.0f / 256.0f) + 1e-6f);
        const f32x4 gn = *(const f32x4*)(A.mh_gain + hh * 256 + lane * 4);
        const u32x2 ov = *(const u32x2*)(proj + (size_t)row * NP + 6144 + hh * 256 + lane * 4);
        const float o0 = bflo(ov.x), o1 = bfhi(ov.x), o2 = bflo(ov.y), o3 = bfhi(ov.y);
        const float y0 = d[0] * rstd * gn[0] / (1.0f + __expf(-o0)), y1 = d[1] * rstd * gn[1] / (1.0f + __expf(-o1));
        const float y2 = d[2] * rstd * gn[2] / (1.0f + __expf(-o2)), y3 = d[3] * rstd * gn[3] / (1.0f + __expf(-o3));
        u32x2 o; o.x = cvt_pk_bf16(y0, y1); o.y = cvt_pk_bf16(y2, y3);
        *(u32x2*)(y + (size_t)row * DM + WCONV + hh * 256 + lane * 4) = o;
    }
}

__device__ __forceinline__ void phase_ln(float* io, const float* gam, const float* bet, bf16_t* ob) {
    const int lane = threadIdx.x & 63, gw = blockIdx.x * 8 + (threadIdx.x >> 6), nw = gridDim.x * 8;
    for (int row = gw; row < MT; row += nw) {
        float* rp = io + (size_t)row * DM;
        f32x4 v[8]; float s = 0.f;
#pragma unroll
        for (int i = 0; i < 8; ++i) { v[i] = *(const f32x4*)(rp + i * 256 + lane * 4); s += (v[i][0] + v[i][1]) + (v[i][2] + v[i][3]); }
#pragma unroll
        for (int off = 32; off >= 1; off >>= 1) s += __shfl_xor(s, off);
        const float mu = s * (1.0f / DM);
        float q = 0.f;
#pragma unroll
        for (int i = 0; i < 8; ++i) { v[i] = v[i] - mu; q += (v[i][0] * v[i][0] + v[i][1] * v[i][1]) + (v[i][2] * v[i][2] + v[i][3] * v[i][3]); }
#pragma unroll
        for (int off = 32; off >= 1; off >>= 1) q += __shfl_xor(q, off);
        const float rstd = rsqrtf(q * (1.0f / DM) + 1e-5f);
#pragma unroll
        for (int i = 0; i < 8; ++i) { const f32x4 gg = *(const f32x4*)(gam + i * 256 + lane * 4), bb = *(const f32x4*)(bet + i * 256 + lane * 4);
            const f32x4 o = v[i] * rstd * gg + bb;
            *(f32x4*)(rp + i * 256 + lane * 4) = o;
            if (ob) { u32x2 p; p.x = cvt_pk_bf16(o[0], o[1]); p.y = cvt_pk_bf16(o[2], o[3]); *(u32x2*)(ob + (size_t)row * DM + i * 256 + lane * 4) = p; } }
    }
}

__device__ __forceinline__ void phase_fixup(const Args& A) {
    const float* halo = (const float*)(A.ws + WS_HALO); bf16_t* act = (bf16_t*)(A.ws + WS_ACT);
    for (int idx = blockIdx.x * 512 + threadIdx.x; idx < 64 * 2 * (DFF / 4); idx += gridDim.x * 512) {
        const int f = (idx % (DFF / 4)) * 4, br = idx / (DFF / 4), rr = br & 1, B = br >> 1;
        const bool first = (B & 15) == 0;
        const float* hc = halo + (size_t)B * 4 * NUP; const float* hp = hc - 4 * NUP;
        f32x4 hv[2];
#pragma unroll
        for (int bj = 0; bj < 2; ++bj) {
            const int col = bj * DFF + f;
            const f32x4 cur = *(const f32x4*)(hc + (size_t)(2 + rr) * NUP + col);
            f32x4 p1, p2; const f32x4 z = (f32x4){0.f, 0.f, 0.f, 0.f};
            if (rr == 0) { p1 = first ? z : *(const f32x4*)(hp + (size_t)1 * NUP + col); p2 = first ? z : *(const f32x4*)(hp + col); }
            else { p1 = *(const f32x4*)(hc + (size_t)2 * NUP + col); p2 = first ? z : *(const f32x4*)(hp + (size_t)1 * NUP + col); }
            const f32x4 w0 = *(const f32x4*)(A.w_fc + col), w1 = *(const f32x4*)(A.w_fc + NUP + col), w2 = *(const f32x4*)(A.w_fc + 2 * NUP + col), bb = *(const f32x4*)(A.b_fc + col);
            hv[bj] = w2 * cur + w1 * p1 + w0 * p2 + bb;
        }
        float av[4];
#pragma unroll
        for (int j = 0; j < 4; ++j) { const float gt = hv[1][j]; av[j] = hv[0][j] * gt / (1.0f + __expf(-gt)); }
        u32x2 o; o.x = cvt_pk_bf16(av[0], av[1]); o.y = cvt_pk_bf16(av[2], av[3]);
        *(u32x2*)(act + (size_t)(B * 128 + rr) * DFF + f) = o;
    }
}

__device__ __forceinline__ void phase_dump(const bf16_t* src, int ld, int c0, float* out) {
    for (size_t idx = (size_t)blockIdx.x * 512 + threadIdx.x; idx < (size_t)MT * DM; idx += (size_t)gridDim.x * 512) {
        const size_t row = idx / DM, col = idx % DM; out[idx] = bflo((unsigned)src[row * ld + c0 + col]); }
}
#ifndef DBG_STOP
#define DBG_STOP -1
#endif
#define XB_TMO      128
#define XB_XCNT(j)  (256  + 64 * (j))
#define XB_XSUB(j)  (1280 + 64 * (j))
#define XB_XGEN(j)  (2304 + 64 * (j))
#define XB_TOP      3328
#define XB_TOPGEN   3392
#define XCD_BAR_WORDS 3456
#define XB_SPIN_CAP (1u << 22)
__device__ __forceinline__ unsigned xb_ld(unsigned* p)              { return __hip_atomic_load(p, __ATOMIC_RELAXED, __HIP_MEMORY_SCOPE_AGENT); }
__device__ __forceinline__ unsigned xb_add(unsigned* p, unsigned v) { return __hip_atomic_fetch_add(p, v, __ATOMIC_RELAXED, __HIP_MEMORY_SCOPE_AGENT); }
__device__ __forceinline__ unsigned xb_xcc_id() { return (unsigned)__builtin_amdgcn_s_getreg((3 << 11) | 20) & 0xFu; }
#define XB_SPIN(cond, bar) do { unsigned _sp = 0; while (cond) { __builtin_amdgcn_s_sleep(1); \
    if ((++_sp & 255u) == 0u) { if (xb_ld(&(bar)[XB_TMO])) break; if (_sp > XB_SPIN_CAP) { atomicAdd(&(bar)[XB_TMO], 1u); break; } } } } while (0)
struct XcdBarrier { unsigned* bar; unsigned x; volatile LAS unsigned* st; };
__device__ __forceinline__ XcdBarrier xcd_barrier_post(unsigned* bar, volatile LAS unsigned* st) {
    XcdBarrier b; b.bar = bar; b.x = xb_xcc_id(); b.st = st;
    if (threadIdx.x == 0) (void)xb_add(&bar[XB_XCNT(b.x)], 1u);
    return b;
}
__device__ __forceinline__ void xcd_barrier_complete(unsigned* bar, unsigned x, unsigned& nloc, unsigned& nx) {
    const unsigned G = gridDim.x * gridDim.y * gridDim.z;
    unsigned sum, cnt, mine, sp = 0u;
    for (;;) {
        sum = 0u; cnt = 0u; mine = 0u;
#pragma unroll
        for (unsigned j = 0; j < 16; ++j) { const unsigned c = xb_ld(&bar[XB_XCNT(j)]); sum += c; cnt += (c > 0u) ? 1u : 0u; mine = (j == x) ? c : mine; }
        if (sum == G) break;
        __builtin_amdgcn_s_sleep(1);
        if ((++sp & 255u) == 0u) { if (xb_ld(&bar[XB_TMO])) break; if (sp > XB_SPIN_CAP) { atomicAdd(&bar[XB_TMO], 1u); break; } }
    }
    nloc = mine > 0u ? mine : 1u; nx = cnt > 0u ? cnt : 1u;
}
__device__ __forceinline__ void xcd_barrier(const XcdBarrier& b) {
    asm volatile("s_waitcnt vmcnt(0)" ::: "memory");
    __syncthreads();
    if (threadIdx.x == 0) {
        unsigned* bar = b.bar;
        __builtin_amdgcn_s_waitcnt(0);
        unsigned nloc = b.st[0], nx = b.st[1];
        if (nloc == 0u) { xcd_barrier_complete(bar, b.x, nloc, nx); b.st[0] = nloc; b.st[1] = nx; }
        const unsigned old = xb_add(&bar[XB_XSUB(b.x)], 1u);
        const unsigned gen = old / nloc;
        if (old + 1u == (gen + 1u) * nloc) {
            __builtin_amdgcn_fence(__ATOMIC_RELEASE, "agent");
            asm volatile("s_waitcnt vmcnt(0)" ::: "memory");
            const unsigned og = xb_add(&bar[XB_TOP], 1u);
            const unsigned tg = og / nx;
            if (og + 1u == (tg + 1u) * nx) xb_add(&bar[XB_TOPGEN], 1u);
            else XB_SPIN(xb_ld(&bar[XB_TOPGEN]) == tg, bar);
            __builtin_amdgcn_fence(__ATOMIC_ACQUIRE, "agent");
            xb_add(&bar[XB_XGEN(b.x)], 1u);
            asm volatile("s_waitcnt vmcnt(0)" ::: "memory");
        } else {
            XB_SPIN(xb_ld(&bar[XB_XGEN(b.x)]) == gen, bar);
            __builtin_amdgcn_fence(__ATOMIC_ACQUIRE, "agent");
            asm volatile("s_waitcnt vmcnt(0)" ::: "memory");
        }
    }
    __syncthreads();
}

constexpr int N_PHASES = 10;
#ifndef ONLY_PH
#define ONLY_PH -1
#endif
#define PH_ON(x) (ONLY_PH < 0 || ONLY_PH == (x))
__global__ void __launch_bounds__(512, 2) mega(Args a) {
    extern __shared__ __attribute__((aligned(16))) unsigned char lds[];
    cg::grid_group grid = cg::this_grid();
    unsigned char* ws = a.ws;
#define PH_RUN(x) (PH_ON(x) && a.ph_lo <= (x) && (x) < a.ph_hi)
#define PH_SYNC(x) do { if (a.ph_lo <= (x) && (x) + 1 < a.ph_hi) xcd_barrier(xb); } while (0)
    volatile LAS unsigned* xst = (volatile LAS unsigned*)((LAS unsigned char*)lds + 131072);
    if (threadIdx.x == 0) { xst[0] = 0u; xst[1] = 0u; }
    __syncthreads();
    const XcdBarrier xb = xcd_barrier_post((unsigned*)(ws + WS_BAR), xst);
    if (a.ph_hi > 1000) grid.sync();
#ifndef REP0
#define REP0 1
#endif
#ifndef REP2
#define REP2 1
#endif
#ifndef REP6
#define REP6 1
#endif
    if (PH_RUN(0)) for (int rep = 0; rep < REP0; ++rep) phase_prologue(a, lds);
    PH_SYNC(0);
    if (PH_RUN(1)) { pg8::Gemm g{(const bf16_t*)(ws + WS_XB), (const bf16_t*)(ws + WS_WIN), MT, NP, DM}; pg8::StaticOrder S; S.init(MT, NP, gridDim.x, blockIdx.x);
        pg8::EpiBf16 E{(bf16_t*)(ws + WS_PROJ), NP}; pg8::gemm_phase<pg8::EpiBf16, true>((LAS unsigned char*)lds, g, S, E);
        const int rem = ((MT / 256) * (NP / 256)) % (int)gridDim.x;
        if (rem == 0) phase_transposes(a, lds, TM_IN, TM_IN + TM_OUT + TM_UP, blockIdx.x, gridDim.x);
        else if ((int)blockIdx.x >= rem) phase_transposes(a, lds, TM_IN, TM_IN + TM_OUT + TM_UP, blockIdx.x - rem, gridDim.x - rem); }
    PH_SYNC(1);
    if (PH_RUN(2)) for (int rep = 0; rep < REP2; ++rep) { phase_yconv(a); phase_mlstm(a, lds, a.out); }
    PH_SYNC(2);
    if (PH_RUN(3)) phase_headnorm(a, a.out);
    PH_SYNC(3);
    if (PH_RUN(4)) { pg8::Gemm g{(const bf16_t*)(ws + WS_Y), (const bf16_t*)(ws + WS_WOUT), MT, DM, DM}; pg8::StaticOrder S; S.init(MT, DM, gridDim.x, blockIdx.x);
        if (a.fuse_ln) { pg8::EpiResLn E{a.x, a.out, (bf16_t*)(ws + WS_X1B), a.ln1_g, a.ln1_b, (float*)(ws + WS_RS1), (unsigned*)(ws + WS_CNT)}; pg8::gemm_phase((LAS unsigned char*)lds, g, S, E); }
        else { pg8::EpiResF32 E{a.x, a.out, DM}; pg8::gemm_phase((LAS unsigned char*)lds, g, S, E); } }
    PH_SYNC(4);
    if (PH_RUN(5) && !a.fuse_ln) phase_ln(a.out, a.ln1_g, a.ln1_b, (bf16_t*)(ws + WS_X1B));
    if (!a.fuse_ln) PH_SYNC(5);
    if (PH_RUN(6)) { pg8::Gemm g{(const bf16_t*)(ws + WS_X1B), (const bf16_t*)(ws + WS_WUP), MT, NUP, DM}; pg8::StaticOrder S; S.init(MT, NUP, gridDim.x, blockIdx.x);
        pg8::EpiConvFfn E{(bf16_t*)(ws + WS_ACT), (float*)(ws + WS_HALO), a.w_fc, a.b_fc}; pg8::gemm_phase<pg8::EpiConvFfn, true>((LAS unsigned char*)lds, g, S, E);
        const int rem = ((MT / 256) * (NUP / 256)) % (int)gridDim.x; const int t0 = TM_IN + TM_OUT + TM_UP, t1 = t0 + TM_DN;
        if (rem == 0) phase_transposes(a, lds, t0, t1, blockIdx.x, gridDim.x);
        else if ((int)blockIdx.x >= rem) phase_transposes(a, lds, t0, t1, blockIdx.x - rem, gridDim.x - rem); }
    PH_SYNC(6);
    if (PH_RUN(7)) phase_fixup(a);
    PH_SYNC(7);
    if (PH_RUN(8)) { pg8::Gemm g{(const bf16_t*)(ws + WS_ACT), (const bf16_t*)(ws + WS_WDN), MT, DM, DFF}; pg8::StaticOrder S; S.init(MT, DM, gridDim.x, blockIdx.x);
        if (a.fuse_ln) { pg8::EpiResLn E{a.out, a.out, nullptr, a.ln2_g, a.ln2_b, (float*)(ws + WS_RS2), (unsigned*)(ws + WS_CNT) + 32 * 64}; pg8::gemm_phase((LAS unsigned char*)lds, g, S, E); }
        else { pg8::EpiResF32 E{a.out, a.out, DM}; pg8::gemm_phase((LAS unsigned char*)lds, g, S, E); } }
    if (!a.fuse_ln) PH_SYNC(8);
    if (PH_RUN(9) && !a.fuse_ln) phase_ln(a.out, a.ln2_g, a.ln2_b, nullptr);
    if (DBG_STOP == 1 && a.ph_lo == 101) phase_dump((const bf16_t*)(ws + WS_PROJ), NP, 3072, a.out);
    if (DBG_STOP == 3 && a.ph_lo == 103) phase_dump((const bf16_t*)(ws + WS_Y), DM, 0, a.out);
    if (DBG_STOP == 7 && a.ph_lo == 107) phase_dump((const bf16_t*)(ws + WS_ACT), DFF, 0, a.out);
}

extern "C" void kernel_launch(void* const* d_in, const int* in_sizes, int n_in, void* d_out, int out_size, void* d_ws, size_t ws_size, hipStream_t stream) {
    static int grid = 0;
    if (grid == 0) {
        if (n_in != 14 || ws_size < WS_END) { fprintf(stderr, "kernel_launch: unexpected n_in %d / ws_size %zu (need %zu)\n", n_in, ws_size, (size_t)WS_END); grid = -1; return; }
        int dev = 0, cus = 0, per_cu = 0;
        hipGetDevice(&dev); hipDeviceGetAttribute(&cus, hipDeviceAttributeMultiprocessorCount, dev);
        if (hipFuncSetAttribute((const void*)mega, hipFuncAttributeMaxDynamicSharedMemorySize, LDS_BYTES) != hipSuccess) { fprintf(stderr, "kernel_launch: hipFuncSetAttribute failed\n"); grid = -1; return; }
        if (hipOccupancyMaxActiveBlocksPerMultiprocessor(&per_cu, (const void*)mega, 512, LDS_BYTES) != hipSuccess || per_cu < 1) { fprintf(stderr, "kernel_launch: occupancy query failed (%d)\n", per_cu); (void)hipGetLastError(); per_cu = 1; }
        grid = cus * 1;
        fprintf(stderr, "kernel_launch: cus %d per_cu %d grid %d\n", cus, per_cu, grid);
    }
    if (grid < 0) return;
    if (hipMemsetAsync((char*)d_ws + WS_BAR, 0, WS_END - WS_BAR, stream)     != hipSuccess) { fprintf(stderr, "kernel_launch: memset failed\n"); return; }
    Args a{};
    a.x = (const float*)d_in[0]; a.w_in = (const float*)d_in[1]; a.b_gates = (const float*)d_in[2]; a.w_sc = (const float*)d_in[3]; a.mh_gain = (const float*)d_in[4]; a.w_out = (const float*)d_in[5];
    a.ln1_g = (const float*)d_in[6]; a.ln1_b = (const float*)d_in[7]; a.w_up = (const float*)d_in[8]; a.w_fc = (const float*)d_in[9]; a.b_fc = (const float*)d_in[10]; a.w_down = (const float*)d_in[11];
    a.ln2_g = (const float*)d_in[12]; a.ln2_b = (const float*)d_in[13];
    a.out = (float*)d_out; a.ws = (unsigned char*)d_ws;
    a.fuse_ln = (MK_SINGLE && grid == 256) ? 1 : 0;
#if MK_SINGLE
    a.ph_lo = 0; a.ph_hi = N_PHASES;
    void* args[] = {&a};
    hipError_t e = hipLaunchCooperativeKernel((const void*)mega, dim3(grid), dim3(512), args, LDS_BYTES, stream);
    if (e != hipSuccess) fprintf(stderr, "cooperative launch failed: %s (grid %d)\n", hipGetErrorString(e), grid);
#else
    for (int ph = 0; ph < N_PHASES; ++ph) { if (DBG_STOP >= 0 && ph > DBG_STOP) break; a.ph_lo = ph; a.ph_hi = ph + 1; hipLaunchKernelGGL(mega, dim3(grid), dim3(512), LDS_BYTES, stream, a); }
    if (DBG_STOP >= 0) { a.ph_lo = 100 + DBG_STOP; a.ph_hi = 101 + DBG_STOP; hipLaunchKernelGGL(mega, dim3(grid), dim3(512), LDS_BYTES, stream, a); }
#endif
}
```

```cpp
#include <hip/hip_runtime.h>
#include <hip/hip_cooperative_groups.h>
#include <cstdio>
#include <cstdint>
namespace cg = cooperative_groups;

#ifndef MK_SINGLE
#define MK_SINGLE 1
#endif

#define LAS __attribute__((address_space(3)))
typedef unsigned short bf16_t;
typedef short bf16x8 __attribute__((ext_vector_type(8)));
typedef float f32x4 __attribute__((ext_vector_type(4)));
typedef unsigned u32x4 __attribute__((ext_vector_type(4)));
typedef unsigned u32x2 __attribute__((ext_vector_type(2)));
typedef short s16x4 __attribute__((ext_vector_type(4)));

constexpr int MT = 8192, DM = 2048, SEQ = 2048, NIN = 7176, NP = 7168, DFF = 5632, NUP = 11264, WCONV = 1024;
constexpr float ALPHA = 1.189207115002721f;
constexpr size_t WS_WIN = 0;
constexpr size_t WS_WOUT = WS_WIN + (size_t)NP * DM * 2;
constexpr size_t WS_WUP = WS_WOUT + (size_t)DM * DM * 2;
constexpr size_t WS_WDN = WS_WUP + (size_t)NUP * DM * 2;
constexpr size_t WS_X1B = WS_WDN + (size_t)DM * DFF * 2;
constexpr size_t WS_GATES = WS_X1B + (size_t)MT * DM * 2;
constexpr size_t WS_C = WS_GATES + (size_t)MT * 8 * 4;
constexpr size_t WS_PROJ = WS_C;
constexpr size_t WS_Y = WS_PROJ + (size_t)MT * NP * 2;
constexpr size_t WS_XB = WS_Y + (size_t)MT * DM * 2;
constexpr size_t WS_ACT = WS_C;
constexpr size_t WS_HALO = WS_ACT + (size_t)MT * DFF * 2;
constexpr size_t WS_BAR = WS_XB + (size_t)MT * DM * 2;
constexpr size_t WS_RS1 = WS_BAR + 16384;
constexpr size_t WS_RS2 = WS_RS1 + (size_t)MT * 8;
constexpr size_t WS_CNT = WS_RS2 + (size_t)MT * 8;
constexpr size_t WS_END = WS_CNT + 2 * 32 * 256;
constexpr int LDS_BYTES = 131072 + 16 + 3 * 32 * 64 * 4;

struct Args {
    const float* x; const float* w_in; const float* b_gates; const float* w_sc; const float* mh_gain; const float* w_out;
    const float* ln1_g; const float* ln1_b; const float* w_up; const float* w_fc; const float* b_fc; const float* w_down;
    const float* ln2_g; const float* ln2_b;
    float* out; unsigned char* ws; int ph_lo, ph_hi, fuse_ln, pad0;
};

typedef __bf16 bf16v2 __attribute__((ext_vector_type(2)));
typedef float f32x2 __attribute__((ext_vector_type(2)));
__device__ __forceinline__ unsigned cvt_pk_bf16(float lo, float hi) { const f32x2 v = {lo, hi}; const bf16v2 r = __builtin_convertvector(v, bf16v2); return __builtin_bit_cast(unsigned, r); }
__device__ __forceinline__ unsigned cvt_pk_bf16_asm(float lo, float hi) { unsigned r; asm volatile("v_cvt_pk_bf16_f32 %0, %1, %2" : "=v"(r) : "v"(lo), "v"(hi)); return r; }
__device__ __forceinline__ float bflo(unsigned u) { return __uint_as_float(u << 16); }
__device__ __forceinline__ float bfhi(unsigned u) { return __uint_as_float(u & 0xffff0000u); }
__device__ __forceinline__ bf16_t f2bf(float f) { unsigned u = __float_as_uint(f); u += 0x7FFFu + ((u >> 16) & 1u); return (bf16_t)(u >> 16); }

namespace pg8 {
constexpr int BM = 256, BK = 64, HALF = 128, HTB = HALF * BK * 2, STAGE_BYTES = 8 * HTB, NXCD = 8, WGM = 8;
__host__ __device__ __forceinline__ int lds_byte(int r, int c) { const int st = (r >> 4) * 2 + (c >> 5), rr = r & 15, cc = c & 31, ob = rr * 64 + cc * 2; return st * 1024 + (ob ^ (((ob >> 9) & 1) << 5)); }
__host__ __device__ __forceinline__ void stage_rc(int b, int& R, int& C) { const int st = b / 1024, sb = b % 1024, swz = sb ^ (((sb >> 9) & 1) << 5); R = (st >> 1) * 16 + swz / 64; C = (st & 1) * 32 + (swz % 64) / 2; }
__host__ __device__ __forceinline__ int perm32(int rho) { const int n = rho >> 4, i = rho & 15; return 8 * (i >> 2) + 4 * n + (i & 3); }
struct Unit { int pm, pn; };
struct Gemm { const bf16_t* A; const bf16_t* Bt; int M, N, K; };
struct StaticOrder {
    int nM, nN, nwg, G, c;
    __device__ void init(int M, int N, int G_, int c_) { nM = M / BM; nN = N / BM; nwg = nM * nN; G = G_; c = c_; }
    __device__ bool next(int i, Unit& u) const {
        const long L = (long)i * G + c; if (L >= nwg) return false;
        int wgid = (int)L; { const int q = nwg / NXCD, r = nwg % NXCD, xcd = wgid % NXCD, off = wgid / NXCD; wgid = (xcd < r ? xcd * (q + 1) : r * (q + 1) + (xcd - r) * q) + off; }
        const int nig = WGM * nN, gid = wgid / nig, fm = gid * WGM, gsz = (nM - fm) < WGM ? (nM - fm) : WGM;
        u.pm = fm + ((wgid % nig) % gsz); u.pn = (wgid % nig) / gsz; return true;
    }
};

template <class Epi, bool ALIGN_EPI = false, bool SP2 = true>
__device__ __forceinline__ void gemm_phase(LAS unsigned char* lds, const Gemm g, const StaticOrder& S, const Epi& E) {
    const int tid = threadIdx.x, wid = __builtin_amdgcn_readfirstlane(tid >> 6), lane = tid & 63, wr = wid >> 2, wc = wid & 3, fr = lane & 15, fq = lane >> 4;
    const int K = g.K, nt = K / BK;
    unsigned voffA[2], voffB[2];
#pragma unroll
    for (int i = 0; i < 2; ++i) { int R, C; stage_rc(tid * 16 + i * 8192, R, C); const int Rb = Epi::PERM ? ((R & ~31) + perm32(R & 31)) : R;
        const int Ra = Epi::AROWPERM ? (128 * (R >> 6) + 8 * (R & 15) + ((R >> 4) & 3)) : R;
        voffA[i] = (unsigned)(Ra * K + C) * 2u; voffB[i] = (unsigned)(Rb * K + C) * 2u; }
    const size_t kstep = (size_t)(BK * 2);
    const size_t hstep = (size_t)HALF * K * 2;
    const size_t hstepA = Epi::AROWPERM ? (size_t)4 * K * 2 : hstep;
    const size_t tstep = 2 * hstep;
    const unsigned ldsw = (unsigned)wid * 1024u;
    const int aoff = lds_byte(wr * 64 + fr, fq * 8), boff = lds_byte(wc * 32 + fr, fq * 8);
#define PG8_SA(b, h) (((b) * 2 + (h)) * HTB)
#define PG8_SB(b, h) ((4 + (b) * 2 + (h)) * HTB)
#define PG8_STAGE(bufoff, gbase, voff) do { _Pragma("unroll") for (int _i = 0; _i < 2; ++_i) \
        __builtin_amdgcn_global_load_lds((const unsigned*)((const char*)(gbase) + (voff)[_i]), (LAS unsigned*)(lds + (bufoff) + ldsw + _i * 8192), 16, 0, 0); } while (0)
#define PG8_LDA(dst, b, h) do { _Pragma("unroll") for (int m = 0; m < 4; ++m) _Pragma("unroll") for (int k = 0; k < 2; ++k) dst[m][k] = *(const LAS bf16x8*)(lds + PG8_SA(b, h) + aoff + m * 2048 + k * 1024); } while (0)
#define PG8_LDB(dst, b, h) do { _Pragma("unroll") for (int n = 0; n < 2; ++n) _Pragma("unroll") for (int k = 0; k < 2; ++k) dst[n][k] = *(const LAS bf16x8*)(lds + PG8_SB(b, h) + boff + n * 2048 + k * 1024); } while (0)
#define PG8_MMA(ai, bj, At, Bt) do { __builtin_amdgcn_s_setprio(1); _Pragma("unroll") for (int m = 0; m < 4; ++m) _Pragma("unroll") for (int n = 0; n < 2; ++n) _Pragma("unroll") for (int k = 0; k < 2; ++k) \
        acc[ai][bj][m][n] = __builtin_amdgcn_mfma_f32_16x16x32_bf16(Bt[n][k], At[m][k], acc[ai][bj][m][n], 0, 0, 0); __builtin_amdgcn_s_setprio(0); } while (0)
#define PG8_WAIT_V(n) asm volatile("s_waitcnt vmcnt(" #n ")" ::: "memory")
#define PG8_WAIT_L(n) asm volatile("s_waitcnt lgkmcnt(" #n ")" ::: "memory")
#define PG8_BAR __builtin_amdgcn_s_barrier()
#define PG8_SCHED __builtin_amdgcn_sched_barrier(0)
    Unit cur, nxt; int ui = 0;
    if (!S.next(0, cur)) return;
    f32x4 acc[2][2][4][2];
#pragma unroll
    for (int a = 0; a < 2; ++a)
#pragma unroll
        for (int b = 0; b < 2; ++b)
#pragma unroll
            for (int m = 0; m < 4; ++m)
#pragma unroll
                for (int n = 0; n < 2; ++n) acc[a][b][m][n] = (f32x4){0.f, 0.f, 0.f, 0.f};
    bf16x8 At[4][2], B0[2][2], B1[2][2];
    const char* cA = (const char*)g.A + (size_t)cur.pm * tstep; const char* cB = (const char*)g.Bt + (size_t)cur.pn * tstep;
    if constexpr (SP2) {
        PG8_STAGE(PG8_SB(0, 0), cB, voffB); PG8_STAGE(PG8_SB(0, 1), cB + hstep, voffB); PG8_STAGE(PG8_SA(0, 0), cA, voffA); PG8_STAGE(PG8_SA(0, 1), cA + hstepA, voffA);
        if (wr == 1) PG8_BAR;
        PG8_WAIT_V(2); PG8_BAR;
        PG8_STAGE(PG8_SB(1, 0), cB + kstep, voffB); PG8_STAGE(PG8_SA(1, 0), cA + kstep, voffA); PG8_STAGE(PG8_SB(1, 1), cB + hstep + kstep, voffB);
        PG8_WAIT_V(6); PG8_BAR;
    } else {
        PG8_STAGE(PG8_SB(0, 0), cB, voffB); PG8_STAGE(PG8_SA(0, 0), cA, voffA); PG8_STAGE(PG8_SB(0, 1), cB + hstep, voffB); PG8_STAGE(PG8_SA(0, 1), cA + hstepA, voffA);
        if (wr == 1) PG8_BAR;
        PG8_WAIT_V(4); PG8_BAR;
        PG8_STAGE(PG8_SB(1, 0), cB + kstep, voffB); PG8_STAGE(PG8_SA(1, 0), cA + kstep, voffA); PG8_STAGE(PG8_SB(1, 1), cB + hstep + kstep, voffB);
        PG8_WAIT_V(6); PG8_BAR;
    }
    for (;;) {
        const bool has_next = S.next(ui + 1, nxt);
        const char* nA = has_next ? (const char*)g.A + (size_t)nxt.pm * tstep : cA; const char* nB = has_next ? (const char*)g.Bt + (size_t)nxt.pn * tstep : cB;
        for (int t = 0; t < nt; t += 2) {
            const bool last = (t == nt - 2);
            const char* a1 = cA + (size_t)(t + 1) * kstep;
            const char* a2 = last ? nA : cA + (size_t)(t + 2) * kstep; const char* b2 = last ? nB : cB + (size_t)(t + 2) * kstep;
            const char* a3 = a2 + kstep; const char* b3 = b2 + kstep;
            if constexpr (SP2) {
            PG8_LDB(B0, 0, 0); PG8_LDB(B1, 0, 1); PG8_SCHED; PG8_LDA(At, 0, 0); PG8_STAGE(PG8_SA(1, 1), a1 + hstepA, voffA);
            PG8_WAIT_V(8); PG8_WAIT_L(0); PG8_BAR; PG8_MMA(0, 0, At, B0); PG8_MMA(0, 1, At, B1); PG8_BAR; PG8_SCHED;
            PG8_LDA(At, 0, 1); PG8_STAGE(PG8_SB(0, 0), b2, voffB); PG8_STAGE(PG8_SB(0, 1), b2 + hstep, voffB); PG8_STAGE(PG8_SA(0, 0), a2, voffA);
            PG8_WAIT_V(8); PG8_WAIT_L(0); PG8_BAR; PG8_MMA(1, 0, At, B0); PG8_MMA(1, 1, At, B1); PG8_BAR; PG8_SCHED;
            PG8_LDB(B0, 1, 0); PG8_LDB(B1, 1, 1); PG8_SCHED; PG8_LDA(At, 1, 0); PG8_STAGE(PG8_SA(0, 1), a2 + hstepA, voffA);
            PG8_WAIT_V(8); PG8_WAIT_L(0); PG8_BAR; PG8_MMA(0, 0, At, B0); PG8_MMA(0, 1, At, B1); PG8_BAR; PG8_SCHED;
            PG8_LDA(At, 1, 1); PG8_STAGE(PG8_SB(1, 0), b3, voffB); PG8_STAGE(PG8_SB(1, 1), b3 + hstep, voffB); PG8_STAGE(PG8_SA(1, 0), a3, voffA);
            PG8_WAIT_V(8); PG8_WAIT_L(0); PG8_BAR; PG8_MMA(1, 0, At, B0); PG8_MMA(1, 1, At, B1); PG8_BAR; PG8_SCHED;
            } else {
            PG8_LDB(B0, 0, 0); PG8_SCHED; PG8_LDA(At, 0, 0); PG8_STAGE(PG8_SA(1, 1), a1 + hstepA, voffA);
            PG8_WAIT_L(8); PG8_BAR; PG8_WAIT_L(0); PG8_MMA(0, 0, At, B0); PG8_BAR; PG8_SCHED;
            PG8_LDB(B1, 0, 1); PG8_STAGE(PG8_SB(0, 0), b2, voffB);
            PG8_BAR; PG8_WAIT_L(0); PG8_MMA(0, 1, At, B1); PG8_BAR;
            PG8_LDA(At, 0, 1); PG8_STAGE(PG8_SA(0, 0), a2, voffA);
            PG8_BAR; PG8_WAIT_L(0); PG8_MMA(1, 0, At, B0); PG8_BAR; PG8_SCHED;
            PG8_STAGE(PG8_SB(0, 1), b2 + hstep, voffB);
            PG8_WAIT_V(6); PG8_BAR; PG8_MMA(1, 1, At, B1); PG8_BAR;
            PG8_LDB(B0, 1, 0); PG8_SCHED; PG8_LDA(At, 1, 0); PG8_STAGE(PG8_SA(0, 1), a2 + hstepA, voffA);
            PG8_WAIT_L(8); PG8_BAR; PG8_WAIT_L(0); PG8_MMA(0, 0, At, B0); PG8_BAR; PG8_SCHED;
            PG8_LDB(B1, 1, 1); PG8_STAGE(PG8_SB(1, 0), b3, voffB);
            PG8_BAR; PG8_WAIT_L(0); PG8_MMA(0, 1, At, B1); PG8_BAR;
            PG8_LDA(At, 1, 1); PG8_STAGE(PG8_SA(1, 0), a3, voffA);
            PG8_BAR; PG8_WAIT_L(0); PG8_MMA(1, 0, At, B0); PG8_BAR; PG8_SCHED;
            PG8_STAGE(PG8_SB(1, 1), b3 + hstep, voffB);
            PG8_WAIT_V(6); PG8_BAR; PG8_MMA(1, 1, At, B1); PG8_BAR;

            }
        }
        if constexpr (ALIGN_EPI) { if (wr == 0) PG8_BAR; }
        if constexpr (!Epi::AFTER_DRAIN) E(acc, cur, wr, wc, fr, fq);
        if (!has_next) break;
#pragma unroll
        for (int a = 0; a < 2; ++a)
#pragma unroll
            for (int b = 0; b < 2; ++b)
#pragma unroll
                for (int m = 0; m < 4; ++m)
#pragma unroll
                    for (int n = 0; n < 2; ++n) acc[a][b][m][n] = (f32x4){0.f, 0.f, 0.f, 0.f};
        cur = nxt; cA = nA; cB = nB; ++ui;
        if constexpr (ALIGN_EPI) { if (wr == 1) PG8_BAR; }
    }
    PG8_WAIT_V(0);
    if constexpr (!ALIGN_EPI) { if (wr == 0) PG8_BAR; }
    PG8_BAR;
    if constexpr (Epi::AFTER_DRAIN) E(acc, cur, wr, wc, fr, fq);
#undef PG8_SA
#undef PG8_SB
#undef PG8_STAGE
#undef PG8_LDA
#undef PG8_LDB
#undef PG8_MMA
#undef PG8_WAIT_V
#undef PG8_WAIT_L
#undef PG8_BAR
#undef PG8_SCHED
}

struct EpiBf16 {
    static constexpr bool PERM = true, AFTER_DRAIN = false, AROWPERM = false;
    bf16_t* O; int ldc;
    __device__ __forceinline__ void operator()(f32x4 (&acc)[2][2][4][2], const Unit& u, int wr, int wc, int fr, int fq) const {
        const int row0 = u.pm * BM + wr * 64 + fr, col0 = u.pn * BM + wc * 32 + 8 * fq;
#pragma unroll
        for (int ai = 0; ai < 2; ++ai)
#pragma unroll
            for (int m = 0; m < 4; ++m) { bf16_t* rowp = O + (size_t)(row0 + ai * HALF + m * 16) * ldc + col0;
#pragma unroll
                for (int bj = 0; bj < 2; ++bj) { const f32x4 v0 = acc[ai][bj][m][0], v1 = acc[ai][bj][m][1];
                    u32x4 w; w.x = cvt_pk_bf16_asm(v0[0], v0[1]); w.y = cvt_pk_bf16_asm(v0[2], v0[3]); w.z = cvt_pk_bf16_asm(v1[0], v1[1]); w.w = cvt_pk_bf16_asm(v1[2], v1[3]);
                    *(u32x4*)(rowp + bj * HALF) = w; } }
    }
};
struct EpiResF32 {
    static constexpr bool PERM = false, AFTER_DRAIN = false, AROWPERM = false;
    const float* X; float* O; int ldc;
    __device__ __forceinline__ void operator()(f32x4 (&acc)[2][2][4][2], const Unit& u, int wr, int wc, int fr, int fq) const {
        const int row0 = u.pm * BM + wr * 64 + fr, col0 = u.pn * BM + wc * 32 + 4 * fq;
#pragma unroll
        for (int ai = 0; ai < 2; ++ai)
#pragma unroll
            for (int m = 0; m < 4; ++m) { const size_t ro = (size_t)(row0 + ai * HALF + m * 16) * ldc + col0;
#pragma unroll
                for (int bj = 0; bj < 2; ++bj)
#pragma unroll
                    for (int n = 0; n < 2; ++n) { const f32x4 xv = *(const f32x4*)(X + ro + bj * HALF + n * 16);
                        *(f32x4*)(O + ro + bj * HALF + n * 16) = xv * ALPHA + acc[ai][bj][m][n]; } }
    }
};
struct EpiResLn {
    static constexpr bool PERM = false, AFTER_DRAIN = true, AROWPERM = false;
    const float* X; float* O; bf16_t* OB; const float* gam; const float* bet; float* rs; unsigned* cnt;
    __device__ __forceinline__ void operator()(f32x4 (&acc)[2][2][4][2], const Unit& u, int wr, int wc, int fr, int fq) const {
        const int row0 = u.pm * BM + wr * 64 + fr, col0 = u.pn * BM + wc * 32 + 4 * fq;
#pragma unroll
        for (int ai = 0; ai < 2; ++ai)
#pragma unroll
            for (int m = 0; m < 4; ++m) { const int row = row0 + ai * HALF + m * 16; const size_t ro = (size_t)row * DM + col0;
                float s = 0.f, q = 0.f;
#pragma unroll
                for (int bj = 0; bj < 2; ++bj)
#pragma unroll
                    for (int n = 0; n < 2; ++n) { const f32x4 xv = *(const f32x4*)(X + ro + bj * HALF + n * 16); const f32x4 z = xv * ALPHA + acc[ai][bj][m][n]; acc[ai][bj][m][n] = z;
                        s += (z[0] + z[1]) + (z[2] + z[3]); q += (z[0] * z[0] + z[1] * z[1]) + (z[2] * z[2] + z[3] * z[3]); }
                s += __shfl_xor(s, 16); s += __shfl_xor(s, 32); q += __shfl_xor(q, 16); q += __shfl_xor(q, 32);
                if (fq == 0) { (void)__hip_atomic_fetch_add(rs + 2 * row, s, __ATOMIC_RELAXED, __HIP_MEMORY_SCOPE_AGENT); (void)__hip_atomic_fetch_add(rs + 2 * row + 1, q, __ATOMIC_RELAXED, __HIP_MEMORY_SCOPE_AGENT); } }
        asm volatile("s_waitcnt vmcnt(0)" ::: "memory");
        unsigned* cp = cnt + 64 * u.pm;
        if ((threadIdx.x & 63) == 0) (void)__hip_atomic_fetch_add(cp, 1u, __ATOMIC_RELAXED, __HIP_MEMORY_SCOPE_AGENT);
        { unsigned sp = 0; while ((unsigned)__builtin_amdgcn_readfirstlane(__hip_atomic_load(cp, __ATOMIC_RELAXED, __HIP_MEMORY_SCOPE_AGENT)) < 64u) { __builtin_amdgcn_s_sleep(2); if (++sp > (1u << 22)) break; } }
        f32x4 gg[2][2], bb[2][2];
#pragma unroll
        for (int bj = 0; bj < 2; ++bj)
#pragma unroll
            for (int n = 0; n < 2; ++n) { gg[bj][n] = *(const f32x4*)(gam + col0 + bj * HALF + n * 16); bb[bj][n] = *(const f32x4*)(bet + col0 + bj * HALF + n * 16); }
#pragma unroll
        for (int ai = 0; ai < 2; ++ai)
#pragma unroll
            for (int m = 0; m < 4; ++m) { const int row = row0 + ai * HALF + m * 16; const size_t ro = (size_t)row * DM + col0;
                const float s = __hip_atomic_load(rs + 2 * row, __ATOMIC_RELAXED, __HIP_MEMORY_SCOPE_AGENT), q = __hip_atomic_load(rs + 2 * row + 1, __ATOMIC_RELAXED, __HIP_MEMORY_SCOPE_AGENT);
                const float mu = s * (1.0f / DM), rstd = rsqrtf(fmaxf(q * (1.0f / DM) - mu * mu, 0.f) + 1e-5f);
#pragma unroll
                for (int bj = 0; bj < 2; ++bj)
#pragma unroll
                    for (int n = 0; n < 2; ++n) { const f32x4 o = (acc[ai][bj][m][n] - mu) * rstd * gg[bj][n] + bb[bj][n];
                        *(f32x4*)(O + ro + bj * HALF + n * 16) = o;
                        if (OB) { u32x2 p; p.x = cvt_pk_bf16_asm(o[0], o[1]); p.y = cvt_pk_bf16_asm(o[2], o[3]); *(u32x2*)(OB + ro + bj * HALF + n * 16) = p; } } }
    }
};
__device__ __forceinline__ float dpp_shr1(float x) { return __builtin_bit_cast(float, __builtin_amdgcn_update_dpp(0, __builtin_bit_cast(int, x), 0x111, 0xf, 0xf, true)); }
struct EpiConvFfn {
    static constexpr bool PERM = true, AFTER_DRAIN = false, AROWPERM = true;
    bf16_t* act; float* halo; const float* cw; const float* cb;
    __device__ __forceinline__ void operator()(f32x4 (&acc)[2][2][4][2], const Unit& u, int wr, int wc, int fr, int fq) const {
        const int fcol = u.pn * 128 + wc * 32 + 8 * fq;
        const int rbase = u.pm * BM + wr * 128;
        {
            float* hb = halo + (size_t)(rbase >> 7) * 4 * NUP + fcol;
            if (fr == 0) {
#pragma unroll
                for (int bj = 0; bj < 2; ++bj)
#pragma unroll
                    for (int n = 0; n < 2; ++n) { *(f32x4*)(hb + (size_t)2 * NUP + bj * DFF + 4 * n) = acc[0][bj][0][n]; *(f32x4*)(hb + (size_t)3 * NUP + bj * DFF + 4 * n) = acc[0][bj][1][n]; }
            }
            if (fr == 15) {
#pragma unroll
                for (int bj = 0; bj < 2; ++bj)
#pragma unroll
                    for (int n = 0; n < 2; ++n) { *(f32x4*)(hb + bj * DFF + 4 * n) = acc[1][bj][2][n]; *(f32x4*)(hb + (size_t)1 * NUP + bj * DFF + 4 * n) = acc[1][bj][3][n]; }
            }
        }
        u32x2 pk0[8];
#pragma unroll
        for (int n = 0; n < 2; ++n) {
            f32x4 W0[2], W1[2], W2[2], Bb[2];
#pragma unroll
            for (int bj = 0; bj < 2; ++bj) { const int hc = bj * DFF + fcol + 4 * n;
                W0[bj] = *(const f32x4*)(cw + hc); W1[bj] = *(const f32x4*)(cw + NUP + hc); W2[bj] = *(const f32x4*)(cw + 2 * NUP + hc); Bb[bj] = *(const f32x4*)(cb + hc); }
            f32x4 E6[2], E7[2];
#pragma unroll
            for (int bj = 0; bj < 2; ++bj) { const f32x4 s6 = acc[1][bj][2][n], s7 = acc[1][bj][3][n];
                E6[bj][0] = dpp_shr1(s6[0]); E6[bj][1] = dpp_shr1(s6[1]); E6[bj][2] = dpp_shr1(s6[2]); E6[bj][3] = dpp_shr1(s6[3]);
                E7[bj][0] = dpp_shr1(s7[0]); E7[bj][1] = dpp_shr1(s7[1]); E7[bj][2] = dpp_shr1(s7[2]); E7[bj][3] = dpp_shr1(s7[3]); }
            float av[8][4];
#pragma unroll
            for (int j = 0; j < 4; ++j) {
                float hc[2][8];
#pragma unroll
                for (int bj = 0; bj < 2; ++bj) {
                    const float e6 = E6[bj][j], e7 = E7[bj][j];
#pragma unroll
                    for (int i = 0; i < 8; ++i) {
                        const float cur = acc[i >> 2][bj][i & 3][n][j];
                        const float p1 = (i >= 1) ? acc[(i - 1 >= 0 ? i - 1 : 0) >> 2][bj][(i - 1 >= 0 ? i - 1 : 0) & 3][n][j] : e7;
                        const float p2 = (i >= 2) ? acc[(i - 2 >= 0 ? i - 2 : 0) >> 2][bj][(i - 2 >= 0 ? i - 2 : 0) & 3][n][j] : (i == 1 ? e7 : e6);
                        hc[bj][i] = W2[bj][j] * cur + W1[bj][j] * p1 + W0[bj][j] * p2 + Bb[bj][j];
                    }
                }
#pragma unroll
                for (int i = 0; i < 8; ++i) { const float gt = hc[1][i]; av[i][j] = hc[0][i] * gt * __builtin_amdgcn_rcpf(1.0f + __expf(-gt)); }
            }
#pragma unroll
            for (int i = 0; i < 8; ++i) {
                u32x2 pk; pk.x = cvt_pk_bf16_asm(av[i][0], av[i][1]); pk.y = cvt_pk_bf16_asm(av[i][2], av[i][3]);
                if (n == 0) pk0[i] = pk;
                else if (i >= 2 || fr > 0) { u32x4 w; w.x = pk0[i].x; w.y = pk0[i].y; w.z = pk.x; w.w = pk.y;
                    *(u32x4*)(act + (size_t)(rbase + 8 * fr + i) * DFF + fcol) = w; }
            }
            asm volatile("" ::: "memory");
        }
    }
};
}

template <bool UPMAP>
__device__ __forceinline__ void transpose_macro(const float* W, int ldw, int k0, int n0, bf16_t* Wt, int ldt, unsigned char* lds) {
    bf16_t* sT = (bf16_t*)lds; const int tid = threadIdx.x;
    float4 v[2][4];
#pragma unroll
    for (int i = 0; i < 2; ++i)
#pragma unroll
        for (int j = 0; j < 4; ++j) v[i][j] = *(const float4*)(W + (size_t)(k0 + (tid >> 4) + 32 * i) * ldw + n0 + 64 * j + (tid & 15) * 4);
#pragma unroll
    for (int i = 0; i < 2; ++i)
#pragma unroll
        for (int j = 0; j < 4; ++j) { const int k = (tid >> 4) + 32 * i, n = 64 * j + (tid & 15) * 4;
            sT[(n + 0) * 66 + k] = f2bf(v[i][j].x); sT[(n + 1) * 66 + k] = f2bf(v[i][j].y); sT[(n + 2) * 66 + k] = f2bf(v[i][j].z); sT[(n + 3) * 66 + k] = f2bf(v[i][j].w); }
    __syncthreads();
#pragma unroll
    for (int j = 0; j < 4; ++j) { const int n = 64 * j + (tid >> 3), ks = (tid & 7) * 8; const unsigned* p = (const unsigned*)(sT + n * 66 + ks);
        u32x4 o; o.x = p[0]; o.y = p[1]; o.z = p[2]; o.w = p[3];
        int drow = n0 + n;
        if (UPMAP) { const int f = (drow < DFF) ? drow : drow - DFF; drow = 256 * (f >> 7) + (f & 127) + ((drow < DFF) ? 0 : 128); }
        *(u32x4*)(Wt + (size_t)drow * ldt + k0 + ks) = o; }
    __syncthreads();
}
constexpr int TM_IN = 32 * 28, TM_OUT = 32 * 8, TM_UP = 32 * 44, TM_DN = 88 * 8;
__device__ __forceinline__ void phase_transposes(const Args& A, unsigned char* lds, int g0, int g1, int worker, int nworkers) {
    unsigned char* ws = A.ws;
    for (int g = g0 + worker; g < g1; g += nworkers) {
        if (g < TM_IN) { const int tk = g / 28, tn = g % 28; transpose_macro<false>(A.w_in, NIN, tk * 64, tn * 256, (bf16_t*)(ws + WS_WIN), DM, lds); }
        else if (g < TM_IN + TM_OUT) { const int h = g - TM_IN, tk = h / 8, tn = h % 8; transpose_macro<false>(A.w_out, DM, tk * 64, tn * 256, (bf16_t*)(ws + WS_WOUT), DM, lds); }
        else if (g < TM_IN + TM_OUT + TM_UP) { const int h = g - TM_IN - TM_OUT, tk = h / 44, tn = h % 44; transpose_macro<true>(A.w_up, NUP, tk * 64, tn * 256, (bf16_t*)(ws + WS_WUP), DM, lds); }
        else { const int h = g - TM_IN - TM_OUT - TM_UP, tk = h / 8, tn = h % 8; transpose_macro<false>(A.w_down, DM, tk * 64, tn * 256, (bf16_t*)(ws + WS_WDN), DFF, lds); }
    }
}
__device__ __forceinline__ void phase_prologue(const Args& A, unsigned char* lds) {
    unsigned char* ws = A.ws;
    phase_transposes(A, lds, 0, TM_IN, blockIdx.x, gridDim.x);
    const int lane = threadIdx.x & 63, gw = blockIdx.x * 8 + (threadIdx.x >> 6), nw = gridDim.x * 8;
    bf16_t* xb = (bf16_t*)(ws + WS_XB); float* gates = (float*)(ws + WS_GATES);
    for (int it = gw; it < MT / 4; it += nw) {
        const int r0 = it * 4;
        float acc[4][8];
#pragma unroll
        for (int r = 0; r < 4; ++r)
#pragma unroll
            for (int q = 0; q < 8; ++q) acc[r][q] = 0.f;
#pragma unroll 1
        for (int i = 0; i < 8; ++i) {
            const int kb = i * 256 + lane * 4;
            f32x4 xv[4];
#pragma unroll
            for (int r = 0; r < 4; ++r) { xv[r] = *(const f32x4*)(A.x + (size_t)(r0 + r) * DM + kb);
                u32x2 o; o.x = cvt_pk_bf16(xv[r][0], xv[r][1]); o.y = cvt_pk_bf16(xv[r][2], xv[r][3]); *(u32x2*)(xb + (size_t)(r0 + r) * DM + kb) = o; }
#pragma unroll
            for (int j = 0; j < 4; ++j) {
                const f32x4* wp = (const f32x4*)(A.w_in + (size_t)(kb + j) * NIN + NP);
                const f32x4 w0 = wp[0], w1 = wp[1];
#pragma unroll
                for (int r = 0; r < 4; ++r) { const float xs = xv[r][j];
                    acc[r][0] += xs * w0[0]; acc[r][1] += xs * w0[1]; acc[r][2] += xs * w0[2]; acc[r][3] += xs * w0[3];
                    acc[r][4] += xs * w1[0]; acc[r][5] += xs * w1[1]; acc[r][6] += xs * w1[2]; acc[r][7] += xs * w1[3]; }
            }
        }
#pragma unroll
        for (int r = 0; r < 4; ++r)
#pragma unroll
            for (int q = 0; q < 8; ++q) { float v = acc[r][q];
#pragma unroll
                for (int off = 32; off >= 1; off >>= 1) v += __shfl_xor(v, off);
                acc[r][q] = v; }
        if (lane == 0) {
            const f32x4 b0 = *(const f32x4*)(A.b_gates), b1 = *(const f32x4*)(A.b_gates + 4);
#pragma unroll
            for (int r = 0; r < 4; ++r) {
                *(f32x4*)(gates + (size_t)(r0 + r) * 8) = (f32x4){acc[r][0] + b0[0], acc[r][1] + b0[1], acc[r][2] + b0[2], acc[r][3] + b0[3]};
                *(f32x4*)(gates + (size_t)(r0 + r) * 8 + 4) = (f32x4){acc[r][4] + b1[0], acc[r][5] + b1[1], acc[r][6] + b1[2], acc[r][7] + b1[3]}; }
        }
    }
}

__device__ __forceinline__ void phase_yconv(const Args& A) {
    const bf16_t* proj = (const bf16_t*)(A.ws + WS_PROJ); bf16_t* y = (bf16_t*)(A.ws + WS_Y);
    for (int idx = blockIdx.x * 512 + threadIdx.x; idx < MT * 128; idx += gridDim.x * 512) {
        const int row = idx >> 7, c = (idx & 127) * 8, t = row & (SEQ - 1);
        const bf16_t* pr = proj + (size_t)row * NP + c;
        const u32x4 bv = *(const u32x4*)pr;
        float cv[8];
#pragma unroll
        for (int i = 0; i < 8; ++i) cv[i] = 0.f;
#pragma unroll
        for (int j = 0; j < 3; ++j) {
            const int dt = 2 - j;
            if (t - dt >= 0) {
                const u32x4 cc = *(const u32x4*)(pr - (size_t)dt * NP + WCONV), hh = *(const u32x4*)(pr - (size_t)dt * NP + 2 * WCONV);
                const f32x4 w0 = *(const f32x4*)(A.w_sc + j * WCONV + c), w1 = *(const f32x4*)(A.w_sc + j * WCONV + c + 4);
                const float wv[8] = {w0[0], w0[1], w0[2], w0[3], w1[0], w1[1], w1[2], w1[3]};
#pragma unroll
                for (int q = 0; q < 4; ++q) { cv[2 * q] += wv[2 * q] * bflo(cc[q]) * bflo(hh[q]); cv[2 * q + 1] += wv[2 * q + 1] * bfhi(cc[q]) * bfhi(hh[q]); }
            }
        }
        u32x4 o;
#pragma unroll
        for (int q = 0; q < 4; ++q) o[q] = cvt_pk_bf16(bflo(bv[q]) * cv[2 * q], bfhi(bv[q]) * cv[2 * q + 1]);
        *(u32x4*)(y + (size_t)row * DM + c) = o;
    }
}

__device__ __forceinline__ void phase_mlstm(const Args& A, unsigned char* lds, float* hbuf) {
    const int tid = threadIdx.x, lane = tid & 63, w = tid >> 6, g = lane >> 4, l15 = lane & 15;
    const int a = w >> 2, ti = w & 3;
    unsigned char* QS = lds; unsigned char* KS = lds + 33792; unsigned char* VT = lds + 67584; unsigned char* WVT = VT + 4608; unsigned char* CT = WVT + 4608; unsigned char* XCH = CT + 33792;
    const bf16_t* proj = (const bf16_t*)(A.ws + WS_PROJ); const float* gates = (const float*)(A.ws + WS_GATES);
    float* TBC = (float*)(lds + 131088); float* TUV = TBC + 2048; float* TCM = TUV + 2048;
    for (int item = blockIdx.x; item < 256; item += gridDim.x) {
        const int xcd = item & 7, idx = item >> 3; const int bh = xcd * 2 + (idx >> 4), es = idx & 15;
        const int b = bh >> 2, hh = bh & 3, e0 = es * 16;
        const size_t row0 = (size_t)b * SEQ;
        __syncthreads();
        for (int i = tid; i < 16896 / 4; i += 512) ((unsigned*)CT)[i] = 0u;
        for (int i = tid; i < 16 * 72; i += 512) { const int r = 16 + i / 72, ci = i % 72; ((bf16_t*)VT)[r * 72 + ci] = (r == 16) ? (bf16_t)0x3F80 : (bf16_t)0; ((bf16_t*)WVT)[r * 72 + ci] = 0; }
        f32x4 Cst[2][2];
#pragma unroll
        for (int x = 0; x < 2; ++x)
#pragma unroll
            for (int et = 0; et < 2; ++et) Cst[x][et] = (f32x4){0.f, 0.f, 0.f, 0.f};
        float m_state = 0.f;
        u32x4 qr[4], kr[4], vr = (u32x4){0u, 0u, 0u, 0u};
        const bf16_t* qbase = proj + row0 * NP + 3072 + hh * 256;
#define ML_LOAD(c) do { _Pragma("unroll") for (int i = 0; i < 4; ++i) { const int p = tid + 512 * i, r = p >> 5, c16 = p & 31; const bf16_t* rp = qbase + (size_t)((c) * 64 + r) * NP + c16 * 8; \
            qr[i] = *(const u32x4*)rp; kr[i] = *(const u32x4*)(rp + 1024); } \
            if (tid < 128) vr = *(const u32x4*)(qbase + (size_t)((c) * 64 + (tid >> 1)) * NP + 2048 + e0 + (tid & 1) * 8); } while (0)
        ML_LOAD(0);
#pragma unroll 1
        for (int cc = 4 * w; cc < 4 * w + 4; ++cc) {
            const float* gp = gates + (row0 + cc * 64 + lane) * 8 + hh; const float gi = gp[0], gf = gp[4];
            const float lf = fminf(gf, 0.f) - log1pf(__expf(-fabsf(gf)));
            float bc = lf;
#pragma unroll
            for (int off = 1; off < 64; off <<= 1) { const float t = __shfl_up(bc, off); if (lane >= off) bc += t; }
            const float uv = gi - bc;
            float cm = uv;
#pragma unroll
            for (int off = 1; off < 64; off <<= 1) { const float t = __shfl_up(cm, off); if (lane >= off) cm = fmaxf(cm, t); }
            TBC[cc * 64 + lane] = bc; TUV[cc * 64 + lane] = uv; TCM[cc * 64 + lane] = cm;
        }
        __syncthreads();
#pragma unroll 1
        for (int c = 0; c < 32; ++c) {
            const float* tbc = TBC + c * 64; const float* tuv = TUV + c * 64; const float* tcm = TCM + c * 64;
            const float g_tot = tbc[63], cm63 = tcm[63];
            const float M63 = fmaxf(m_state, cm63), decay = __expf(m_state - M63);
            const float m_old = m_state;
            m_state = g_tot + M63;
#pragma unroll
            for (int i = 0; i < 4; ++i) { const int p = tid + 512 * i, r = p >> 5, c16 = p & 31; *(u32x4*)(QS + r * 528 + c16 * 16) = qr[i]; *(u32x4*)(KS + r * 528 + c16 * 16) = kr[i]; }
            { if (tid < 128) { const int s = tid >> 1, hf = tid & 1; const float wv = __expf(tuv[s] - M63);
#pragma unroll
                  for (int q = 0; q < 4; ++q) { const float v0 = bflo(vr[q]), v1 = bfhi(vr[q]);
                      ((bf16_t*)VT)[(8 * hf + 2 * q) * 72 + s] = (bf16_t)(vr[q] & 0xffffu); ((bf16_t*)VT)[(8 * hf + 2 * q + 1) * 72 + s] = (bf16_t)(vr[q] >> 16);
                      ((bf16_t*)WVT)[(8 * hf + 2 * q) * 72 + s] = f2bf(v0 * wv); ((bf16_t*)WVT)[(8 * hf + 2 * q + 1) * 72 + s] = f2bf(v1 * wv); } }
              if (w == 2) ((bf16_t*)WVT)[16 * 72 + lane] = f2bf(__expf(tuv[lane] - M63)); }
            if (c + 1 < 32) ML_LOAD(c + 1);
            __syncthreads();
            bf16x8 qf[8]; f32x4 S0 = (f32x4){0.f, 0.f, 0.f, 0.f}, S1 = S0;
#pragma unroll
            for (int kk = 0; kk < 8; ++kk) {
                qf[kk] = *(const bf16x8*)(QS + (16 * ti + l15) * 528 + kk * 64 + g * 16);
                const bf16x8 kf0 = *(const bf16x8*)(KS + (32 * a + l15) * 528 + kk * 64 + g * 16), kf1 = *(const bf16x8*)(KS + (32 * a + 16 + l15) * 528 + kk * 64 + g * 16);
                S0 = __builtin_amdgcn_mfma_f32_16x16x32_bf16(kf0, qf[kk], S0, 0, 0, 0); S1 = __builtin_amdgcn_mfma_f32_16x16x32_bf16(kf1, qf[kk], S1, 0, 0, 0);
            }
            const int tcol = 16 * ti + l15;
            const float Mt = fmaxf(m_old, tcm[tcol]);
            const f32x4 u0v = *(const f32x4*)(tuv + 32 * a + 4 * g), u1v = *(const f32x4*)(tuv + 32 * a + 16 + 4 * g);
            float p[8];
#pragma unroll
            for (int r = 0; r < 4; ++r) { const int s0 = 32 * a + 4 * g + r, s1 = s0 + 16;
                p[r] = (s0 <= tcol) ? S0[r] * 0.0625f * __expf(u0v[r] - Mt) : 0.f; p[4 + r] = (s1 <= tcol) ? S1[r] * 0.0625f * __expf(u1v[r] - Mt) : 0.f; }
            u32x4 pau; pau.x = cvt_pk_bf16(p[0], p[1]); pau.y = cvt_pk_bf16(p[2], p[3]); pau.z = cvt_pk_bf16(p[4], p[5]); pau.w = cvt_pk_bf16(p[6], p[7]);
            const bf16x8 pa = __builtin_bit_cast(bf16x8, pau);
            f32x4 rr[2];
#pragma unroll
            for (int et = 0; et < 2; ++et) { const unsigned char* vp = VT + (16 * et + l15) * 144 + (32 * a + 4 * g) * 2;
                const u32x2 lo = *(const u32x2*)vp, hi = *(const u32x2*)(vp + 32);
                u32x4 vbu; vbu.x = lo.x; vbu.y = lo.y; vbu.z = hi.x; vbu.w = hi.y;
                rr[et] = __builtin_amdgcn_mfma_f32_16x16x32_bf16(pa, __builtin_bit_cast(bf16x8, vbu), (f32x4){0.f, 0.f, 0.f, 0.f}, 0, 0, 0); }
            const f32x4 cmr = *(const f32x4*)(tcm + 16 * ti + 4 * g), bcr = *(const f32x4*)(tbc + 16 * ti + 4 * g);
            {
                const unsigned char* CTc = CT + (c & 1) * 16896;
                f32x4 in0 = (f32x4){0.f, 0.f, 0.f, 0.f}, in1 = in0;
#pragma unroll
                for (int k2 = 0; k2 < 4; ++k2) {
                    const bf16x8 qa = a ? qf[4 + k2] : qf[k2];
                    const bf16x8 c0 = *(const bf16x8*)(CTc + (l15) * 528 + (128 * a + 32 * k2 + 8 * g) * 2), c1 = *(const bf16x8*)(CTc + (16 + l15) * 528 + (128 * a + 32 * k2 + 8 * g) * 2);
                    in0 = __builtin_amdgcn_mfma_f32_16x16x32_bf16(qa, c0, in0, 0, 0, 0); in1 = __builtin_amdgcn_mfma_f32_16x16x32_bf16(qa, c1, in1, 0, 0, 0);
                }
#pragma unroll
                for (int r = 0; r < 4; ++r) { const float iw = __expf(m_old - fmaxf(m_old, cmr[r])) * 0.0625f; rr[0][r] += in0[r] * iw; rr[1][r] += in1[r] * iw; }
            }
            if (a == 1) { *(f32x4*)(XCH + ((ti * 2 + 0) * 64 + lane) * 16) = rr[0]; *(f32x4*)(XCH + ((ti * 2 + 1) * 64 + lane) * 16) = rr[1]; }
            {
                unsigned char* CTn = CT + ((c + 1) & 1) * 16896;
#pragma unroll
                for (int x = 0; x < 2; ++x) {
                    const int dt = 2 * w + x;
#pragma unroll
                    for (int et = 0; et < 2; ++et) Cst[x][et] *= decay;
#pragma unroll
                    for (int ks = 0; ks < 2; ++ks) {
                        const s16x4 klo = __builtin_amdgcn_ds_read_tr16_b64_v4i16((LAS s16x4*)(KS + (32 * ks + 8 * g + (l15 >> 2)) * 528 + (16 * dt + 4 * (l15 & 3)) * 2));
                        const s16x4 khi = __builtin_amdgcn_ds_read_tr16_b64_v4i16((LAS s16x4*)(KS + (32 * ks + 8 * g + 4 + (l15 >> 2)) * 528 + (16 * dt + 4 * (l15 & 3)) * 2));
                        const bf16x8 ka = {klo[0], klo[1], klo[2], klo[3], khi[0], khi[1], khi[2], khi[3]};
#pragma unroll
                        for (int et = 0; et < 2; ++et) { const bf16x8 wvb = *(const bf16x8*)(WVT + (16 * et + l15) * 144 + (32 * ks + 8 * g) * 2);
                            Cst[x][et] = __builtin_amdgcn_mfma_f32_16x16x32_bf16(ka, wvb, Cst[x][et], 0, 0, 0); }
                    }
#pragma unroll
                    for (int et = 0; et < 2; ++et) { u32x2 o; o.x = cvt_pk_bf16(Cst[x][et][0], Cst[x][et][1]); o.y = cvt_pk_bf16(Cst[x][et][2], Cst[x][et][3]);
                        *(u32x2*)(CTn + (16 * et + l15) * 528 + (16 * dt + 4 * g) * 2) = o; }
                }
            }
            __syncthreads();
            if (a == 0) {
                const f32x4 o0 = *(const f32x4*)(XCH + ((ti * 2 + 0) * 64 + lane) * 16), o1 = *(const f32x4*)(XCH + ((ti * 2 + 1) * 64 + lane) * 16);
#pragma unroll
                for (int r = 0; r < 4; ++r) {
                    const float den = __shfl(rr[1][r] + o1[r], lane & 48), fl = __expf(-(bcr[r] + fmaxf(m_old, cmr[r])));
                    const float hv = (rr[0][r] + o0[r]) * __builtin_amdgcn_rcpf(fmaxf(fabsf(den), fl));
                    hbuf[(row0 + c * 64 + 16 * ti + 4 * g + r) * 1024 + hh * 256 + e0 + l15] = hv;
                }
            }
        }
#undef ML_LOAD
    }
}

__device__ __forceinline__ void phase_headnorm(const Args& A, const float* hbuf) {
    const bf16_t* proj = (const bf16_t*)(A.ws + WS_PROJ); bf16_t* y = (bf16_t*)(A.ws + WS_Y);
    const int lane = threadIdx.x & 63, gw = blockIdx.x * 8 + (threadIdx.x >> 6), nw = gridDim.x * 8;
    for (int it = gw; it < MT * 4; it += nw) {
        const int row = it >> 2, hh = it & 3;
        const f32x4 hv = *(const f32x4*)(hbuf + (size_t)row * 1024 + hh * 256 + lane * 4);
        float s = (hv[0] + hv[1]) + (hv[2] + hv[3]);
#pragma unroll
        for (int off = 32; off >= 1; off >>= 1) s += __shfl_xor(s, off);
        const float mu = s * (1.0f / 256.0f);
        const f32x4 d = hv - mu;
        float q = (d[0] * d[0] + d[1] * d[1]) + (d[2] * d[2] + d[3] * d[3]);
#pragma unroll
        for (int off = 32; off >= 1; off >>= 1) q += __shfl_xor(q, off);
        const float rstd = rsqrtf(q * (1.0f / 256.0f) + 1e-6f);
        const f32x4 gn = *(const f32x4*)(A.mh_gain + hh * 256 + lane * 4);
        const u32x2 ov = *(const u32x2*)(proj + (size_t)row * NP + 6144 + hh * 256 + lane * 4);
        const float o0 = bflo(ov.x), o1 = bfhi(ov.x), o2 = bflo(ov.y), o3 = bfhi(ov.y);
        const float y0 = d[0] * rstd * gn[0] * __builtin_amdgcn_rcpf(1.0f + __expf(-o0)), y1 = d[1] * rstd * gn[1] * __builtin_amdgcn_rcpf(1.0f + __expf(-o1));
        const float y2 = d[2] * rstd * gn[2] * __builtin_amdgcn_rcpf(1.0f + __expf(-o2)), y3 = d[3] * rstd * gn[3] * __builtin_amdgcn_rcpf(1.0f + __expf(-o3));
        u32x2 o; o.x = cvt_pk_bf16(y0, y1); o.y = cvt_pk_bf16(y2, y3);
        *(u32x2*)(y + (size_t)row * DM + WCONV + hh * 256 + lane * 4) = o;
    }
}

__device__ __forceinline__ void phase_ln(float* io, const float* gam, const float* bet, bf16_t* ob) {
    const int lane = threadIdx.x & 63, gw = blockIdx.x * 8 + (threadIdx.x >> 6), nw = gridDim.x * 8;
    for (int row = gw; row < MT; row += nw) {
        float* rp = io + (size_t)row * DM;
        f32x4 v[8]; float s = 0.f;
#pragma unroll
        for (int i = 0; i < 8; ++i) { v[i] = *(const f32x4*)(rp + i * 256 + lane * 4); s += (v[i][0] + v[i][1]) + (v[i][2] + v[i][3]); }
#pragma unroll
        for (int off = 32; off >= 1; off >>= 1) s += __shfl_xor(s, off);
        const float mu = s * (1.0f / DM);
        float q = 0.f;
#pragma unroll
        for (int i = 0; i < 8; ++i) { v[i] = v[i] - mu; q += (v[i][0] * v[i][0] + v[i][1] * v[i][1]) + (v[i][2] * v[i][2] + v[i][3] * v[i][3]); }
#pragma unroll
        for (int off = 32; off >= 1; off >>= 1) q += __shfl_xor(q, off);
        const float rstd = rsqrtf(q * (1.0f / DM) + 1e-5f);
#pragma unroll
        for (int i = 0; i < 8; ++i) { const f32x4 gg = *(const f32x4*)(gam + i * 256 + lane * 4), bb = *(const f32x4*)(bet + i * 256 + lane * 4);
            const f32x4 o = v[i] * rstd * gg + bb;
            *(f32x4*)(rp + i * 256 + lane * 4) = o;
            if (ob) { u32x2 p; p.x = cvt_pk_bf16(o[0], o[1]); p.y = cvt_pk_bf16(o[2], o[3]); *(u32x2*)(ob + (size_t)row * DM + i * 256 + lane * 4) = p; } }
    }
}

__device__ __forceinline__ void phase_fixup(const Args& A) {
    const float* halo = (const float*)(A.ws + WS_HALO); bf16_t* act = (bf16_t*)(A.ws + WS_ACT);
    for (int idx = blockIdx.x * 512 + threadIdx.x; idx < 64 * 2 * (DFF / 4); idx += gridDim.x * 512) {
        const int f = (idx % (DFF / 4)) * 4, br = idx / (DFF / 4), rr = br & 1, B = br >> 1;
        const bool first = (B & 15) == 0;
        const float* hc = halo + (size_t)B * 4 * NUP; const float* hp = hc - 4 * NUP;
        f32x4 hv[2];
#pragma unroll
        for (int bj = 0; bj < 2; ++bj) {
            const int col = bj * DFF + f;
            const f32x4 cur = *(const f32x4*)(hc + (size_t)(2 + rr) * NUP + col);
            f32x4 p1, p2; const f32x4 z = (f32x4){0.f, 0.f, 0.f, 0.f};
            if (rr == 0) { p1 = first ? z : *(const f32x4*)(hp + (size_t)1 * NUP + col); p2 = first ? z : *(const f32x4*)(hp + col); }
            else { p1 = *(const f32x4*)(hc + (size_t)2 * NUP + col); p2 = first ? z : *(const f32x4*)(hp + (size_t)1 * NUP + col); }
            const f32x4 w0 = *(const f32x4*)(A.w_fc + col), w1 = *(const f32x4*)(A.w_fc + NUP + col), w2 = *(const f32x4*)(A.w_fc + 2 * NUP + col), bb = *(const f32x4*)(A.b_fc + col);
            hv[bj] = w2 * cur + w1 * p1 + w0 * p2 + bb;
        }
        float av[4];
#pragma unroll
        for (int j = 0; j < 4; ++j) { const float gt = hv[1][j]; av[j] = hv[0][j] * gt / (1.0f + __expf(-gt)); }
        u32x2 o; o.x = cvt_pk_bf16(av[0], av[1]); o.y = cvt_pk_bf16(av[2], av[3]);
        *(u32x2*)(act + (size_t)(B * 128 + rr) * DFF + f) = o;
    }
}

__device__ __forceinline__ void phase_dump(const bf16_t* src, int ld, int c0, float* out) {
    for (size_t idx = (size_t)blockIdx.x * 512 + threadIdx.x; idx < (size_t)MT * DM; idx += (size_t)gridDim.x * 512) {
        const size_t row = idx / DM, col = idx % DM; out[idx] = bflo((unsigned)src[row * ld + c0 + col]); }
}
#ifndef DBG_STOP
#define DBG_STOP -1
#endif
#define XB_TMO      128
#define XB_XCNT(j)  (256  + 64 * (j))
#define XB_XSUB(j)  (1280 + 64 * (j))
#define XB_XGEN(j)  (2304 + 64 * (j))
#define XB_TOP      3328
#define XB_TOPGEN   3392
#define XCD_BAR_WORDS 3456
#define XB_SPIN_CAP (1u << 22)
__device__ __forceinline__ unsigned xb_ld(unsigned* p)              { return __hip_atomic_load(p, __ATOMIC_RELAXED, __HIP_MEMORY_SCOPE_AGENT); }
__device__ __forceinline__ unsigned xb_add(unsigned* p, unsigned v) { return __hip_atomic_fetch_add(p, v, __ATOMIC_RELAXED, __HIP_MEMORY_SCOPE_AGENT); }
__device__ __forceinline__ unsigned xb_xcc_id() { return (unsigned)__builtin_amdgcn_s_getreg((3 << 11) | 20) & 0xFu; }
#define XB_SPIN(cond, bar) do { unsigned _sp = 0; while (cond) { __builtin_amdgcn_s_sleep(1); \
    if ((++_sp & 255u) == 0u) { if (xb_ld(&(bar)[XB_TMO])) break; if (_sp > XB_SPIN_CAP) { atomicAdd(&(bar)[XB_TMO], 1u); break; } } } } while (0)
struct XcdBarrier { unsigned* bar; unsigned x; volatile LAS unsigned* st; };
__device__ __forceinline__ XcdBarrier xcd_barrier_post(unsigned* bar, volatile LAS unsigned* st) {
    XcdBarrier b; b.bar = bar; b.x = xb_xcc_id(); b.st = st;
    if (threadIdx.x == 0) (void)xb_add(&bar[XB_XCNT(b.x)], 1u);
    return b;
}
__device__ __forceinline__ void xcd_barrier_complete(unsigned* bar, unsigned x, unsigned& nloc, unsigned& nx) {
    const unsigned G = gridDim.x * gridDim.y * gridDim.z;
    unsigned sum, cnt, mine, sp = 0u;
    for (;;) {
        sum = 0u; cnt = 0u; mine = 0u;
#pragma unroll
        for (unsigned j = 0; j < 16; ++j) { const unsigned c = xb_ld(&bar[XB_XCNT(j)]); sum += c; cnt += (c > 0u) ? 1u : 0u; mine = (j == x) ? c : mine; }
        if (sum == G) break;
        __builtin_amdgcn_s_sleep(1);
        if ((++sp & 255u) == 0u) { if (xb_ld(&bar[XB_TMO])) break; if (sp > XB_SPIN_CAP) { atomicAdd(&bar[XB_TMO], 1u); break; } }
    }
    nloc = mine > 0u ? mine : 1u; nx = cnt > 0u ? cnt : 1u;
}
__device__ __forceinline__ void xcd_barrier(const XcdBarrier& b) {
    asm volatile("s_waitcnt vmcnt(0)" ::: "memory");
    __syncthreads();
    if (threadIdx.x == 0) {
        unsigned* bar = b.bar;
        __builtin_amdgcn_s_waitcnt(0);
        unsigned nloc = b.st[0], nx = b.st[1];
        if (nloc == 0u) { xcd_barrier_complete(bar, b.x, nloc, nx); b.st[0] = nloc; b.st[1] = nx; }
        const unsigned old = xb_add(&bar[XB_XSUB(b.x)], 1u);
        const unsigned gen = old / nloc;
        if (old + 1u == (gen + 1u) * nloc) {
            __builtin_amdgcn_fence(__ATOMIC_RELEASE, "agent");
            asm volatile("s_waitcnt vmcnt(0)" ::: "memory");
            const unsigned og = xb_add(&bar[XB_TOP], 1u);
            const unsigned tg = og / nx;
            if (og + 1u == (tg + 1u) * nx) xb_add(&bar[XB_TOPGEN], 1u);
            else XB_SPIN(xb_ld(&bar[XB_TOPGEN]) == tg, bar);
            __builtin_amdgcn_fence(__ATOMIC_ACQUIRE, "agent");
            xb_add(&bar[XB_XGEN(b.x)], 1u);
            asm volatile("s_waitcnt vmcnt(0)" ::: "memory");
        } else {
            XB_SPIN(xb_ld(&bar[XB_XGEN(b.x)]) == gen, bar);
            __builtin_amdgcn_fence(__ATOMIC_ACQUIRE, "agent");
            asm volatile("s_waitcnt vmcnt(0)" ::: "memory");
        }
    }
    __syncthreads();
}

constexpr int N_PHASES = 10;
#ifndef ONLY_PH
#define ONLY_PH -1
#endif
#define PH_ON(x) (ONLY_PH < 0 || ONLY_PH == (x))
__global__ void __launch_bounds__(512, 2) mega(Args a) {
    extern __shared__ __attribute__((aligned(16))) unsigned char lds[];
    cg::grid_group grid = cg::this_grid();
    unsigned char* ws = a.ws;
#define PH_RUN(x) (PH_ON(x) && a.ph_lo <= (x) && (x) < a.ph_hi)
#define PH_SYNC(x) do { if (a.ph_lo <= (x) && (x) + 1 < a.ph_hi) xcd_barrier(xb); } while (0)
    volatile LAS unsigned* xst = (volatile LAS unsigned*)((LAS unsigned char*)lds + 131072);
    if (threadIdx.x == 0) { xst[0] = 0u; xst[1] = 0u; }
    __syncthreads();
    const XcdBarrier xb = xcd_barrier_post((unsigned*)(ws + WS_BAR), xst);
    if (a.ph_hi > 1000) grid.sync();
#ifndef REP0
#define REP0 1
#endif
#ifndef REP2
#define REP2 1
#endif
#ifndef REP6
#define REP6 1
#endif
    if (PH_RUN(0)) for (int rep = 0; rep < REP0; ++rep) phase_prologue(a, lds);
    PH_SYNC(0);
    if (PH_RUN(1)) { pg8::Gemm g{(const bf16_t*)(ws + WS_XB), (const bf16_t*)(ws + WS_WIN), MT, NP, DM}; pg8::StaticOrder S; S.init(MT, NP, gridDim.x, blockIdx.x);
        pg8::EpiBf16 E{(bf16_t*)(ws + WS_PROJ), NP}; pg8::gemm_phase<pg8::EpiBf16, true>((LAS unsigned char*)lds, g, S, E);
        const int rem = ((MT / 256) * (NP / 256)) % (int)gridDim.x;
        if (rem == 0) phase_transposes(a, lds, TM_IN, TM_IN + TM_OUT + TM_UP, blockIdx.x, gridDim.x);
        else if ((int)blockIdx.x >= rem) phase_transposes(a, lds, TM_IN, TM_IN + TM_OUT + TM_UP, blockIdx.x - rem, gridDim.x - rem); }
    PH_SYNC(1);
    if (PH_RUN(2)) for (int rep = 0; rep < REP2; ++rep) { phase_yconv(a); phase_mlstm(a, lds, a.out); }
    PH_SYNC(2);
    if (PH_RUN(3)) phase_headnorm(a, a.out);
    PH_SYNC(3);
    if (PH_RUN(4)) { pg8::Gemm g{(const bf16_t*)(ws + WS_Y), (const bf16_t*)(ws + WS_WOUT), MT, DM, DM}; pg8::StaticOrder S; S.init(MT, DM, gridDim.x, blockIdx.x);
        if (a.fuse_ln) { pg8::EpiResLn E{a.x, a.out, (bf16_t*)(ws + WS_X1B), a.ln1_g, a.ln1_b, (float*)(ws + WS_RS1), (unsigned*)(ws + WS_CNT)}; pg8::gemm_phase((LAS unsigned char*)lds, g, S, E); }
        else { pg8::EpiResF32 E{a.x, a.out, DM}; pg8::gemm_phase((LAS unsigned char*)lds, g, S, E); } }
    PH_SYNC(4);
    if (PH_RUN(5) && !a.fuse_ln) phase_ln(a.out, a.ln1_g, a.ln1_b, (bf16_t*)(ws + WS_X1B));
    if (!a.fuse_ln) PH_SYNC(5);
    if (PH_RUN(6)) { pg8::Gemm g{(const bf16_t*)(ws + WS_X1B), (const bf16_t*)(ws + WS_WUP), MT, NUP, DM}; pg8::StaticOrder S; S.init(MT, NUP, gridDim.x, blockIdx.x);
        pg8::EpiConvFfn E{(bf16_t*)(ws + WS_ACT), (float*)(ws + WS_HALO), a.w_fc, a.b_fc}; pg8::gemm_phase<pg8::EpiConvFfn, true>((LAS unsigned char*)lds, g, S, E);
        const int rem = ((MT / 256) * (NUP / 256)) % (int)gridDim.x; const int t0 = TM_IN + TM_OUT + TM_UP, t1 = t0 + TM_DN;
        if (rem == 0) phase_transposes(a, lds, t0, t1, blockIdx.x, gridDim.x);
        else if ((int)blockIdx.x >= rem) phase_transposes(a, lds, t0, t1, blockIdx.x - rem, gridDim.x - rem); }
    PH_SYNC(6);
    if (PH_RUN(7)) phase_fixup(a);
    PH_SYNC(7);
    if (PH_RUN(8)) { pg8::Gemm g{(const bf16_t*)(ws + WS_ACT), (const bf16_t*)(ws + WS_WDN), MT, DM, DFF}; pg8::StaticOrder S; S.init(MT, DM, gridDim.x, blockIdx.x);
        if (a.fuse_ln) { pg8::EpiResLn E{a.out, a.out, nullptr, a.ln2_g, a.ln2_b, (float*)(ws + WS_RS2), (unsigned*)(ws + WS_CNT) + 32 * 64}; pg8::gemm_phase((LAS unsigned char*)lds, g, S, E); }
        else { pg8::EpiResF32 E{a.out, a.out, DM}; pg8::gemm_phase((LAS unsigned char*)lds, g, S, E); } }
    if (!a.fuse_ln) PH_SYNC(8);
    if (PH_RUN(9) && !a.fuse_ln) phase_ln(a.out, a.ln2_g, a.ln2_b, nullptr);
    if (DBG_STOP == 1 && a.ph_lo == 101) phase_dump((const bf16_t*)(ws + WS_PROJ), NP, 3072, a.out);
    if (DBG_STOP == 3 && a.ph_lo == 103) phase_dump((const bf16_t*)(ws + WS_Y), DM, 0, a.out);
    if (DBG_STOP == 7 && a.ph_lo == 107) phase_dump((const bf16_t*)(ws + WS_ACT), DFF, 0, a.out);
}

extern "C" void kernel_launch(void* const* d_in, const int* in_sizes, int n_in, void* d_out, int out_size, void* d_ws, size_t ws_size, hipStream_t stream) {
    static int grid = 0;
    if (grid == 0) {
        if (n_in != 14 || ws_size < WS_END) { fprintf(stderr, "kernel_launch: unexpected n_in %d / ws_size %zu (need %zu)\n", n_in, ws_size, (size_t)WS_END); grid = -1; return; }
        int dev = 0, cus = 0, per_cu = 0;
        hipGetDevice(&dev); hipDeviceGetAttribute(&cus, hipDeviceAttributeMultiprocessorCount, dev);
        if (hipFuncSetAttribute((const void*)mega, hipFuncAttributeMaxDynamicSharedMemorySize, LDS_BYTES) != hipSuccess) { fprintf(stderr, "kernel_launch: hipFuncSetAttribute failed\n"); grid = -1; return; }
        if (hipOccupancyMaxActiveBlocksPerMultiprocessor(&per_cu, (const void*)mega, 512, LDS_BYTES) != hipSuccess || per_cu < 1) { fprintf(stderr, "kernel_launch: occupancy query failed (%d)\n", per_cu); (void)hipGetLastError(); per_cu = 1; }
        grid = cus * 1;
        fprintf(stderr, "kernel_launch: cus %d per_cu %d grid %d\n", cus, per_cu, grid);
    }
    if (grid < 0) return;
    if (hipMemsetAsync((char*)d_ws + WS_BAR, 0, WS_END - WS_BAR, stream)     != hipSuccess) { fprintf(stderr, "kernel_launch: memset failed\n"); return; }
    Args a{};
    a.x = (const float*)d_in[0]; a.w_in = (const float*)d_in[1]; a.b_gates = (const float*)d_in[2]; a.w_sc = (const float*)d_in[3]; a.mh_gain = (const float*)d_in[4]; a.w_out = (const float*)d_in[5];
    a.ln1_g = (const float*)d_in[6]; a.ln1_b = (const float*)d_in[7]; a.w_up = (const float*)d_in[8]; a.w_fc = (const float*)d_in[9]; a.b_fc = (const float*)d_in[10]; a.w_down = (const float*)d_in[11];
    a.ln2_g = (const float*)d_in[12]; a.ln2_b = (const float*)d_in[13];
    a.out = (float*)d_out; a.ws = (unsigned char*)d_ws;
    a.fuse_ln = (MK_SINGLE && grid == 256) ? 1 : 0;
#if MK_SINGLE
    a.ph_lo = 0; a.ph_hi = N_PHASES;
    void* args[] = {&a};
    hipError_t e = hipLaunchCooperativeKernel((const void*)mega, dim3(grid), dim3(512), args, LDS_BYTES, stream);
    if (e != hipSuccess) fprintf(stderr, "cooperative launch failed: %s (grid %d)\n", hipGetErrorString(e), grid);
#else
    for (int ph = 0; ph < N_PHASES; ++ph) { if (DBG_STOP >= 0 && ph > DBG_STOP) break; a.ph_lo = ph; a.ph_hi = ph + 1; hipLaunchKernelGGL(mega, dim3(grid), dim3(512), LDS_BYTES, stream, a); }
    if (DBG_STOP >= 0) { a.ph_lo = 100 + DBG_STOP; a.ph_hi = 101 + DBG_STOP; hipLaunchKernelGGL(mega, dim3(grid), dim3(512), LDS_BYTES, stream, a); }
#endif
}
```

```cpp
#include <hip/hip_runtime.h>
#include <hip/hip_cooperative_groups.h>
#include <cstdio>
#include <cstdint>
namespace cg = cooperative_groups;

#ifndef MK_SINGLE
#define MK_SINGLE 1
#endif

#define LAS __attribute__((address_space(3)))
typedef unsigned short bf16_t;
typedef short bf16x8 __attribute__((ext_vector_type(8)));
typedef float f32x4 __attribute__((ext_vector_type(4)));
typedef unsigned u32x4 __attribute__((ext_vector_type(4)));
typedef unsigned u32x2 __attribute__((ext_vector_type(2)));
typedef short s16x4 __attribute__((ext_vector_type(4)));

constexpr int MT = 8192, DM = 2048, SEQ = 2048, NIN = 7176, NP = 7168, DFF = 5632, NUP = 11264, WCONV = 1024;
constexpr float ALPHA = 1.189207115002721f;
constexpr size_t WS_WIN = 0;
constexpr size_t WS_WOUT = WS_WIN + (size_t)NP * DM * 2;
constexpr size_t WS_WUP = WS_WOUT + (size_t)DM * DM * 2;
constexpr size_t WS_WDN = WS_WUP + (size_t)NUP * DM * 2;
constexpr size_t WS_X1B = WS_WDN + (size_t)DM * DFF * 2;
constexpr size_t WS_GATES = WS_X1B + (size_t)MT * DM * 2;
constexpr size_t WS_C = WS_GATES + (size_t)MT * 8 * 4;
constexpr size_t WS_PROJ = WS_C;
constexpr size_t WS_Y = WS_PROJ + (size_t)MT * NP * 2;
constexpr size_t WS_XB = WS_Y + (size_t)MT * DM * 2;
constexpr size_t WS_ACT = WS_C;
constexpr size_t WS_HALO = WS_ACT + (size_t)MT * DFF * 2;
constexpr size_t WS_BAR = WS_XB + (size_t)MT * DM * 2;
constexpr size_t WS_RS1 = WS_BAR + 16384;
constexpr size_t WS_RS2 = WS_RS1 + (size_t)MT * 8;
constexpr size_t WS_CNT = WS_RS2 + (size_t)MT * 8;
constexpr size_t WS_END = WS_CNT + 2 * 32 * 256;
constexpr int LDS_BYTES = 131072 + 16 + 3 * 32 * 64 * 4;

struct Args {
    const float* x; const float* w_in; const float* b_gates; const float* w_sc; const float* mh_gain; const float* w_out;
    const float* ln1_g; const float* ln1_b; const float* w_up; const float* w_fc; const float* b_fc; const float* w_down;
    const float* ln2_g; const float* ln2_b;
    float* out; unsigned char* ws; int ph_lo, ph_hi, fuse_ln, pad0;
};

typedef __bf16 bf16v2 __attribute__((ext_vector_type(2)));
typedef float f32x2 __attribute__((ext_vector_type(2)));
__device__ __forceinline__ unsigned cvt_pk_bf16(float lo, float hi) { const f32x2 v = {lo, hi}; const bf16v2 r = __builtin_convertvector(v, bf16v2); return __builtin_bit_cast(unsigned, r); }
__device__ __forceinline__ unsigned cvt_pk_bf16_asm(float lo, float hi) { unsigned r; asm volatile("v_cvt_pk_bf16_f32 %0, %1, %2" : "=v"(r) : "v"(lo), "v"(hi)); return r; }
__device__ __forceinline__ float bflo(unsigned u) { return __uint_as_float(u << 16); }
__device__ __forceinline__ float bfhi(unsigned u) { return __uint_as_float(u & 0xffff0000u); }
__device__ __forceinline__ bf16_t f2bf(float f) { unsigned u = __float_as_uint(f); u += 0x7FFFu + ((u >> 16) & 1u); return (bf16_t)(u >> 16); }

namespace pg8 {
constexpr int BM = 256, BK = 64, HALF = 128, HTB = HALF * BK * 2, STAGE_BYTES = 8 * HTB, NXCD = 8, WGM = 8;
__host__ __device__ __forceinline__ int lds_byte(int r, int c) { const int st = (r >> 4) * 2 + (c >> 5), rr = r & 15, cc = c & 31, ob = rr * 64 + cc * 2; return st * 1024 + (ob ^ (((ob >> 9) & 1) << 5)); }
__host__ __device__ __forceinline__ void stage_rc(int b, int& R, int& C) { const int st = b / 1024, sb = b % 1024, swz = sb ^ (((sb >> 9) & 1) << 5); R = (st >> 1) * 16 + swz / 64; C = (st & 1) * 32 + (swz % 64) / 2; }
__host__ __device__ __forceinline__ int perm32(int rho) { const int n = rho >> 4, i = rho & 15; return 8 * (i >> 2) + 4 * n + (i & 3); }
struct Unit { int pm, pn; };
struct Gemm { const bf16_t* A; const bf16_t* Bt; int M, N, K; };
struct StaticOrder {
    int nM, nN, nwg, G, c;
    __device__ void init(int M, int N, int G_, int c_) { nM = M / BM; nN = N / BM; nwg = nM * nN; G = G_; c = c_; }
    __device__ bool next(int i, Unit& u) const {
        const long L = (long)i * G + c; if (L >= nwg) return false;
        int wgid = (int)L; { const int q = nwg / NXCD, r = nwg % NXCD, xcd = wgid % NXCD, off = wgid / NXCD; wgid = (xcd < r ? xcd * (q + 1) : r * (q + 1) + (xcd - r) * q) + off; }
        const int nig = WGM * nN, gid = wgid / nig, fm = gid * WGM, gsz = (nM - fm) < WGM ? (nM - fm) : WGM;
        u.pm = fm + ((wgid % nig) % gsz); u.pn = (wgid % nig) / gsz; return true;
    }
};

template <class Epi, bool ALIGN_EPI = false, bool SP2 = true>
__device__ __forceinline__ void gemm_phase(LAS unsigned char* lds, const Gemm g, const StaticOrder& S, const Epi& E) {
    const int tid = threadIdx.x, wid = __builtin_amdgcn_readfirstlane(tid >> 6), lane = tid & 63, wr = wid >> 2, wc = wid & 3, fr = lane & 15, fq = lane >> 4;
    const int K = g.K, nt = K / BK;
    unsigned voffA[2], voffB[2];
#pragma unroll
    for (int i = 0; i < 2; ++i) { int R, C; stage_rc(tid * 16 + i * 8192, R, C); const int Rb = Epi::PERM ? ((R & ~31) + perm32(R & 31)) : R;
        const int Ra = Epi::AROWPERM ? (128 * (R >> 6) + 8 * (R & 15) + ((R >> 4) & 3)) : R;
        voffA[i] = (unsigned)(Ra * K + C) * 2u; voffB[i] = (unsigned)(Rb * K + C) * 2u; }
    const size_t kstep = (size_t)(BK * 2);
    const size_t hstep = (size_t)HALF * K * 2;
    const size_t hstepA = Epi::AROWPERM ? (size_t)4 * K * 2 : hstep;
    const size_t tstep = 2 * hstep;
    const unsigned ldsw = (unsigned)wid * 1024u;
    const int aoff = lds_byte(wr * 64 + fr, fq * 8), boff = lds_byte(wc * 32 + fr, fq * 8);
#define PG8_SA(b, h) (((b) * 2 + (h)) * HTB)
#define PG8_SB(b, h) ((4 + (b) * 2 + (h)) * HTB)
#define PG8_STAGE(bufoff, gbase, voff) do { _Pragma("unroll") for (int _i = 0; _i < 2; ++_i) \
        __builtin_amdgcn_global_load_lds((const unsigned*)((const char*)(gbase) + (voff)[_i]), (LAS unsigned*)(lds + (bufoff) + ldsw + _i * 8192), 16, 0, 0); } while (0)
#define PG8_LDA(dst, b, h) do { _Pragma("unroll") for (int m = 0; m < 4; ++m) _Pragma("unroll") for (int k = 0; k < 2; ++k) dst[m][k] = *(const LAS bf16x8*)(lds + PG8_SA(b, h) + aoff + m * 2048 + k * 1024); } while (0)
#define PG8_LDB(dst, b, h) do { _Pragma("unroll") for (int n = 0; n < 2; ++n) _Pragma("unroll") for (int k = 0; k < 2; ++k) dst[n][k] = *(const LAS bf16x8*)(lds + PG8_SB(b, h) + boff + n * 2048 + k * 1024); } while (0)
#define PG8_MMA(ai, bj, At, Bt) do { __builtin_amdgcn_s_setprio(1); _Pragma("unroll") for (int m = 0; m < 4; ++m) _Pragma("unroll") for (int n = 0; n < 2; ++n) _Pragma("unroll") for (int k = 0; k < 2; ++k) \
        acc[ai][bj][m][n] = __builtin_amdgcn_mfma_f32_16x16x32_bf16(Bt[n][k], At[m][k], acc[ai][bj][m][n], 0, 0, 0); __builtin_amdgcn_s_setprio(0); } while (0)
#define PG8_WAIT_V(n) asm volatile("s_waitcnt vmcnt(" #n ")" ::: "memory")
#define PG8_WAIT_L(n) asm volatile("s_waitcnt lgkmcnt(" #n ")" ::: "memory")
#define PG8_BAR __builtin_amdgcn_s_barrier()
#define PG8_SCHED __builtin_amdgcn_sched_barrier(0)
    Unit cur, nxt; int ui = 0;
    if (!S.next(0, cur)) return;
    f32x4 acc[2][2][4][2];
#pragma unroll
    for (int a = 0; a < 2; ++a)
#pragma unroll
        for (int b = 0; b < 2; ++b)
#pragma unroll
            for (int m = 0; m < 4; ++m)
#pragma unroll
                for (int n = 0; n < 2; ++n) acc[a][b][m][n] = (f32x4){0.f, 0.f, 0.f, 0.f};
    bf16x8 At[4][2], B0[2][2], B1[2][2];
    const char* cA = (const char*)g.A + (size_t)cur.pm * tstep; const char* cB = (const char*)g.Bt + (size_t)cur.pn * tstep;
    if constexpr (SP2) {
        PG8_STAGE(PG8_SB(0, 0), cB, voffB); PG8_STAGE(PG8_SB(0, 1), cB + hstep, voffB); PG8_STAGE(PG8_SA(0, 0), cA, voffA); PG8_STAGE(PG8_SA(0, 1), cA + hstepA, voffA);
        if (wr == 1) PG8_BAR;
        PG8_WAIT_V(2); PG8_BAR;
        PG8_STAGE(PG8_SB(1, 0), cB + kstep, voffB); PG8_STAGE(PG8_SA(1, 0), cA + kstep, voffA); PG8_STAGE(PG8_SB(1, 1), cB + hstep + kstep, voffB);
        PG8_WAIT_V(6); PG8_BAR;
    } else {
        PG8_STAGE(PG8_SB(0, 0), cB, voffB); PG8_STAGE(PG8_SA(0, 0), cA, voffA); PG8_STAGE(PG8_SB(0, 1), cB + hstep, voffB); PG8_STAGE(PG8_SA(0, 1), cA + hstepA, voffA);
        if (wr == 1) PG8_BAR;
        PG8_WAIT_V(4); PG8_BAR;
        PG8_STAGE(PG8_SB(1, 0), cB + kstep, voffB); PG8_STAGE(PG8_SA(1, 0), cA + kstep, voffA); PG8_STAGE(PG8_SB(1, 1), cB + hstep + kstep, voffB);
        PG8_WAIT_V(6); PG8_BAR;
    }
    for (;;) {
        const bool has_next = S.next(ui + 1, nxt);
        const char* nA = has_next ? (const char*)g.A + (size_t)nxt.pm * tstep : cA; const char* nB = has_next ? (const char*)g.Bt + (size_t)nxt.pn * tstep : cB;
        for (int t = 0; t < nt; t += 2) {
            const bool last = (t == nt - 2);
            const char* a1 = cA + (size_t)(t + 1) * kstep;
            const char* a2 = last ? nA : cA + (size_t)(t + 2) * kstep; const char* b2 = last ? nB : cB + (size_t)(t + 2) * kstep;
            const char* a3 = a2 + kstep; const char* b3 = b2 + kstep;
            if constexpr (SP2) {
            PG8_LDB(B0, 0, 0); PG8_LDB(B1, 0, 1); PG8_SCHED; PG8_LDA(At, 0, 0); PG8_STAGE(PG8_SA(1, 1), a1 + hstepA, voffA);
            PG8_WAIT_V(8); PG8_WAIT_L(0); PG8_BAR; PG8_MMA(0, 0, At, B0); PG8_MMA(0, 1, At, B1); PG8_BAR; PG8_SCHED;
            PG8_LDA(At, 0, 1); PG8_STAGE(PG8_SB(0, 0), b2, voffB); PG8_STAGE(PG8_SB(0, 1), b2 + hstep, voffB); PG8_STAGE(PG8_SA(0, 0), a2, voffA);
            PG8_WAIT_V(8); PG8_WAIT_L(0); PG8_BAR; PG8_MMA(1, 0, At, B0); PG8_MMA(1, 1, At, B1); PG8_BAR; PG8_SCHED;
            PG8_LDB(B0, 1, 0); PG8_LDB(B1, 1, 1); PG8_SCHED; PG8_LDA(At, 1, 0); PG8_STAGE(PG8_SA(0, 1), a2 + hstepA, voffA);
            PG8_WAIT_V(8); PG8_WAIT_L(0); PG8_BAR; PG8_MMA(0, 0, At, B0); PG8_MMA(0, 1, At, B1); PG8_BAR; PG8_SCHED;
            PG8_LDA(At, 1, 1); PG8_STAGE(PG8_SB(1, 0), b3, voffB); PG8_STAGE(PG8_SB(1, 1), b3 + hstep, voffB); PG8_STAGE(PG8_SA(1, 0), a3, voffA);
            PG8_WAIT_V(8); PG8_WAIT_L(0); PG8_BAR; PG8_MMA(1, 0, At, B0); PG8_MMA(1, 1, At, B1); PG8_BAR; PG8_SCHED;
            } else {
            PG8_LDB(B0, 0, 0); PG8_SCHED; PG8_LDA(At, 0, 0); PG8_STAGE(PG8_SA(1, 1), a1 + hstepA, voffA);
            PG8_WAIT_L(8); PG8_BAR; PG8_WAIT_L(0); PG8_MMA(0, 0, At, B0); PG8_BAR; PG8_SCHED;
            PG8_LDB(B1, 0, 1); PG8_STAGE(PG8_SB(0, 0), b2, voffB);
            PG8_BAR; PG8_WAIT_L(0); PG8_MMA(0, 1, At, B1); PG8_BAR;
            PG8_LDA(At, 0, 1); PG8_STAGE(PG8_SA(0, 0), a2, voffA);
            PG8_BAR; PG8_WAIT_L(0); PG8_MMA(1, 0, At, B0); PG8_BAR; PG8_SCHED;
            PG8_STAGE(PG8_SB(0, 1), b2 + hstep, voffB);
            PG8_WAIT_V(6); PG8_BAR; PG8_MMA(1, 1, At, B1); PG8_BAR;
            PG8_LDB(B0, 1, 0); PG8_SCHED; PG8_LDA(At, 1, 0); PG8_STAGE(PG8_SA(0, 1), a2 + hstepA, voffA);
            PG8_WAIT_L(8); PG8_BAR; PG8_WAIT_L(0); PG8_MMA(0, 0, At, B0); PG8_BAR; PG8_SCHED;
            PG8_LDB(B1, 1, 1); PG8_STAGE(PG8_SB(1, 0), b3, voffB);
            PG8_BAR; PG8_WAIT_L(0); PG8_MMA(0, 1, At, B1); PG8_BAR;
            PG8_LDA(At, 1, 1); PG8_STAGE(PG8_SA(1, 0), a3, voffA);
            PG8_BAR; PG8_WAIT_L(0); PG8_MMA(1, 0, At, B0); PG8_BAR; PG8_SCHED;
            PG8_STAGE(PG8_SB(1, 1), b3 + hstep, voffB);
            PG8_WAIT_V(6); PG8_BAR; PG8_MMA(1, 1, At, B1); PG8_BAR;

            }
        }
        if constexpr (ALIGN_EPI) { if (wr == 0) PG8_BAR; }
        if constexpr (!Epi::AFTER_DRAIN) E(acc, cur, wr, wc, fr, fq);
        if (!has_next) break;
#pragma unroll
        for (int a = 0; a < 2; ++a)
#pragma unroll
            for (int b = 0; b < 2; ++b)
#pragma unroll
                for (int m = 0; m < 4; ++m)
#pragma unroll
                    for (int n = 0; n < 2; ++n) acc[a][b][m][n] = (f32x4){0.f, 0.f, 0.f, 0.f};
        cur = nxt; cA = nA; cB = nB; ++ui;
        if constexpr (ALIGN_EPI) { if (wr == 1) PG8_BAR; }
    }
    PG8_WAIT_V(0);
    if constexpr (!ALIGN_EPI) { if (wr == 0) PG8_BAR; }
    PG8_BAR;
    if constexpr (Epi::AFTER_DRAIN) E(acc, cur, wr, wc, fr, fq);
#undef PG8_SA
#undef PG8_SB
#undef PG8_STAGE
#undef PG8_LDA
#undef PG8_LDB
#undef PG8_MMA
#undef PG8_WAIT_V
#undef PG8_WAIT_L
#undef PG8_BAR
#undef PG8_SCHED
}

struct EpiBf16 {
    static constexpr bool PERM = true, AFTER_DRAIN = false, AROWPERM = false;
    bf16_t* O; int ldc;
    __device__ __forceinline__ void operator()(f32x4 (&acc)[2][2][4][2], const Unit& u, int wr, int wc, int fr, int fq) const {
        const int row0 = u.pm * BM + wr * 64 + fr, col0 = u.pn * BM + wc * 32 + 8 * fq;
#pragma unroll
        for (int ai = 0; ai < 2; ++ai)
#pragma unroll
            for (int m = 0; m < 4; ++m) { bf16_t* rowp = O + (size_t)(row0 + ai * HALF + m * 16) * ldc + col0;
#pragma unroll
                for (int bj = 0; bj < 2; ++bj) { const f32x4 v0 = acc[ai][bj][m][0], v1 = acc[ai][bj][m][1];
                    u32x4 w; w.x = cvt_pk_bf16_asm(v0[0], v0[1]); w.y = cvt_pk_bf16_asm(v0[2], v0[3]); w.z = cvt_pk_bf16_asm(v1[0], v1[1]); w.w = cvt_pk_bf16_asm(v1[2], v1[3]);
                    *(u32x4*)(rowp + bj * HALF) = w; } }
    }
};
struct EpiResF32 {
    static constexpr bool PERM = false, AFTER_DRAIN = false, AROWPERM = false;
    const float* X; float* O; int ldc;
    __device__ __forceinline__ void operator()(f32x4 (&acc)[2][2][4][2], const Unit& u, int wr, int wc, int fr, int fq) const {
        const int row0 = u.pm * BM + wr * 64 + fr, col0 = u.pn * BM + wc * 32 + 4 * fq;
#pragma unroll
        for (int ai = 0; ai < 2; ++ai)
#pragma unroll
            for (int m = 0; m < 4; ++m) { const size_t ro = (size_t)(row0 + ai * HALF + m * 16) * ldc + col0;
#pragma unroll
                for (int bj = 0; bj < 2; ++bj)
#pragma unroll
                    for (int n = 0; n < 2; ++n) { const f32x4 xv = *(const f32x4*)(X + ro + bj * HALF + n * 16);
                        *(f32x4*)(O + ro + bj * HALF + n * 16) = xv * ALPHA + acc[ai][bj][m][n]; } }
    }
};
template <bool XBF  , bool WF32  > struct EpiResLn {
    static constexpr bool PERM = false, AFTER_DRAIN = true, AROWPERM = false;
    const float* X; const bf16_t* XB; float* O; bf16_t* OB; const float* gam; const float* bet; float* rs; unsigned* cnt;
    __device__ __forceinline__ void operator()(f32x4 (&acc)[2][2][4][2], const Unit& u, int wr, int wc, int fr, int fq) const {
        const int row0 = u.pm * BM + wr * 64 + fr, col0 = u.pn * BM + wc * 32 + 4 * fq;
#pragma unroll
        for (int ai = 0; ai < 2; ++ai)
#pragma unroll
            for (int m = 0; m < 4; ++m) { const int row = row0 + ai * HALF + m * 16; const size_t ro = (size_t)row * DM + col0;
                float s = 0.f, q = 0.f;
#pragma unroll
                for (int bj = 0; bj < 2; ++bj)
#pragma unroll
                    for (int n = 0; n < 2; ++n) { f32x4 xv;
                        if constexpr (XBF) { const u32x2 xb2 = *(const u32x2*)(XB + ro + bj * HALF + n * 16); xv = (f32x4){bflo(xb2.x), bfhi(xb2.x), bflo(xb2.y), bfhi(xb2.y)}; }
                        else xv = *(const f32x4*)(X + ro + bj * HALF + n * 16);
                        const f32x4 z = xv * ALPHA + acc[ai][bj][m][n]; acc[ai][bj][m][n] = z;
                        s += (z[0] + z[1]) + (z[2] + z[3]); q += (z[0] * z[0] + z[1] * z[1]) + (z[2] * z[2] + z[3] * z[3]); }
                s += __shfl_xor(s, 16); s += __shfl_xor(s, 32); q += __shfl_xor(q, 16); q += __shfl_xor(q, 32);
                if (fq == 0) { (void)__hip_atomic_fetch_add(rs + 2 * row, s, __ATOMIC_RELAXED, __HIP_MEMORY_SCOPE_AGENT); (void)__hip_atomic_fetch_add(rs + 2 * row + 1, q, __ATOMIC_RELAXED, __HIP_MEMORY_SCOPE_AGENT); } }
        asm volatile("s_waitcnt vmcnt(0)" ::: "memory");
        unsigned* cp = cnt + 64 * u.pm;
        if ((threadIdx.x & 63) == 0) (void)__hip_atomic_fetch_add(cp, 1u, __ATOMIC_RELAXED, __HIP_MEMORY_SCOPE_AGENT);
        { unsigned sp = 0; while ((unsigned)__builtin_amdgcn_readfirstlane(__hip_atomic_load(cp, __ATOMIC_RELAXED, __HIP_MEMORY_SCOPE_AGENT)) < 64u) { __builtin_amdgcn_s_sleep(2); if (++sp > (1u << 22)) break; } }
        f32x4 gg[2][2], bb[2][2];
#pragma unroll
        for (int bj = 0; bj < 2; ++bj)
#pragma unroll
            for (int n = 0; n < 2; ++n) { gg[bj][n] = *(const f32x4*)(gam + col0 + bj * HALF + n * 16); bb[bj][n] = *(const f32x4*)(bet + col0 + bj * HALF + n * 16); }
#pragma unroll
        for (int ai = 0; ai < 2; ++ai)
#pragma unroll
            for (int m = 0; m < 4; ++m) { const int row = row0 + ai * HALF + m * 16; const size_t ro = (size_t)row * DM + col0;
                const float s = __hip_atomic_load(rs + 2 * row, __ATOMIC_RELAXED, __HIP_MEMORY_SCOPE_AGENT), q = __hip_atomic_load(rs + 2 * row + 1, __ATOMIC_RELAXED, __HIP_MEMORY_SCOPE_AGENT);
                const float mu = s * (1.0f / DM), rstd = rsqrtf(fmaxf(q * (1.0f / DM) - mu * mu, 0.f) + 1e-5f);
#pragma unroll
                for (int bj = 0; bj < 2; ++bj)
#pragma unroll
                    for (int n = 0; n < 2; ++n) { const f32x4 o = (acc[ai][bj][m][n] - mu) * rstd * gg[bj][n] + bb[bj][n];
                        if constexpr (WF32) *(f32x4*)(O + ro + bj * HALF + n * 16) = o;
                        if (OB) { u32x2 p; p.x = cvt_pk_bf16_asm(o[0], o[1]); p.y = cvt_pk_bf16_asm(o[2], o[3]); *(u32x2*)(OB + ro + bj * HALF + n * 16) = p; } } }
    }
};
__device__ __forceinline__ float dpp_shr1(float x) { return __builtin_bit_cast(float, __builtin_amdgcn_update_dpp(0, __builtin_bit_cast(int, x), 0x111, 0xf, 0xf, true)); }
struct EpiConvFfn {
    static constexpr bool PERM = true, AFTER_DRAIN = false, AROWPERM = true;
    bf16_t* act; float* halo; const float* cw; const float* cb;
    __device__ __forceinline__ void operator()(f32x4 (&acc)[2][2][4][2], const Unit& u, int wr, int wc, int fr, int fq) const {
        const int fcol = u.pn * 128 + wc * 32 + 8 * fq;
        const int rbase = u.pm * BM + wr * 128;
        {
            float* hb = halo + (size_t)(rbase >> 7) * 4 * NUP + fcol;
            if (fr == 0) {
#pragma unroll
                for (int bj = 0; bj < 2; ++bj)
#pragma unroll
                    for (int n = 0; n < 2; ++n) { *(f32x4*)(hb + (size_t)2 * NUP + bj * DFF + 4 * n) = acc[0][bj][0][n]; *(f32x4*)(hb + (size_t)3 * NUP + bj * DFF + 4 * n) = acc[0][bj][1][n]; }
            }
            if (fr == 15) {
#pragma unroll
                for (int bj = 0; bj < 2; ++bj)
#pragma unroll
                    for (int n = 0; n < 2; ++n) { *(f32x4*)(hb + bj * DFF + 4 * n) = acc[1][bj][2][n]; *(f32x4*)(hb + (size_t)1 * NUP + bj * DFF + 4 * n) = acc[1][bj][3][n]; }
            }
        }
        u32x2 pk0[8];
#pragma unroll
        for (int n = 0; n < 2; ++n) {
            f32x4 W0[2], W1[2], W2[2], Bb[2];
#pragma unroll
            for (int bj = 0; bj < 2; ++bj) { const int hc = bj * DFF + fcol + 4 * n;
                W0[bj] = *(const f32x4*)(cw + hc); W1[bj] = *(const f32x4*)(cw + NUP + hc); W2[bj] = *(const f32x4*)(cw + 2 * NUP + hc); Bb[bj] = *(const f32x4*)(cb + hc); }
            f32x4 E6[2], E7[2];
#pragma unroll
            for (int bj = 0; bj < 2; ++bj) { const f32x4 s6 = acc[1][bj][2][n], s7 = acc[1][bj][3][n];
                E6[bj][0] = dpp_shr1(s6[0]); E6[bj][1] = dpp_shr1(s6[1]); E6[bj][2] = dpp_shr1(s6[2]); E6[bj][3] = dpp_shr1(s6[3]);
                E7[bj][0] = dpp_shr1(s7[0]); E7[bj][1] = dpp_shr1(s7[1]); E7[bj][2] = dpp_shr1(s7[2]); E7[bj][3] = dpp_shr1(s7[3]); }
            float av[8][4];
#pragma unroll
            for (int j = 0; j < 4; ++j) {
                float hc[2][8];
#pragma unroll
                for (int bj = 0; bj < 2; ++bj) {
                    const float e6 = E6[bj][j], e7 = E7[bj][j];
#pragma unroll
                    for (int i = 0; i < 8; ++i) {
                        const float cur = acc[i >> 2][bj][i & 3][n][j];
                        const float p1 = (i >= 1) ? acc[(i - 1 >= 0 ? i - 1 : 0) >> 2][bj][(i - 1 >= 0 ? i - 1 : 0) & 3][n][j] : e7;
                        const float p2 = (i >= 2) ? acc[(i - 2 >= 0 ? i - 2 : 0) >> 2][bj][(i - 2 >= 0 ? i - 2 : 0) & 3][n][j] : (i == 1 ? e7 : e6);
                        hc[bj][i] = W2[bj][j] * cur + W1[bj][j] * p1 + W0[bj][j] * p2 + Bb[bj][j];
                    }
                }
#pragma unroll
                for (int i = 0; i < 8; ++i) { const float gt = hc[1][i]; av[i][j] = hc[0][i] * gt * __builtin_amdgcn_rcpf(1.0f + __expf(-gt)); }
            }
#pragma unroll
            for (int i = 0; i < 8; ++i) {
                u32x2 pk; pk.x = cvt_pk_bf16_asm(av[i][0], av[i][1]); pk.y = cvt_pk_bf16_asm(av[i][2], av[i][3]);
                if (n == 0) pk0[i] = pk;
                else if (i >= 2 || fr > 0) { u32x4 w; w.x = pk0[i].x; w.y = pk0[i].y; w.z = pk.x; w.w = pk.y;
                    *(u32x4*)(act + (size_t)(rbase + 8 * fr + i) * DFF + fcol) = w; }
            }
            asm volatile("" ::: "memory");
        }
    }
};
}

template <bool UPMAP>
__device__ __forceinline__ void transpose_macro(const float* W, int ldw, int k0, int n0, bf16_t* Wt, int ldt, unsigned char* lds) {
    bf16_t* sT = (bf16_t*)lds; const int tid = threadIdx.x;
    float4 v[2][4];
#pragma unroll
    for (int i = 0; i < 2; ++i)
#pragma unroll
        for (int j = 0; j < 4; ++j) v[i][j] = *(const float4*)(W + (size_t)(k0 + (tid >> 4) + 32 * i) * ldw + n0 + 64 * j + (tid & 15) * 4);
#pragma unroll
    for (int i = 0; i < 2; ++i)
#pragma unroll
        for (int j = 0; j < 4; ++j) { const int k = (tid >> 4) + 32 * i, n = 64 * j + (tid & 15) * 4;
            sT[(n + 0) * 66 + k] = f2bf(v[i][j].x); sT[(n + 1) * 66 + k] = f2bf(v[i][j].y); sT[(n + 2) * 66 + k] = f2bf(v[i][j].z); sT[(n + 3) * 66 + k] = f2bf(v[i][j].w); }
    __syncthreads();
#pragma unroll
    for (int j = 0; j < 4; ++j) { const int n = 64 * j + (tid >> 3), ks = (tid & 7) * 8; const unsigned* p = (const unsigned*)(sT + n * 66 + ks);
        u32x4 o; o.x = p[0]; o.y = p[1]; o.z = p[2]; o.w = p[3];
        int drow = n0 + n;
        if (UPMAP) { const int f = (drow < DFF) ? drow : drow - DFF; drow = 256 * (f >> 7) + (f & 127) + ((drow < DFF) ? 0 : 128); }
        *(u32x4*)(Wt + (size_t)drow * ldt + k0 + ks) = o; }
    __syncthreads();
}
constexpr int TM_IN = 32 * 28, TM_OUT = 32 * 8, TM_UP = 32 * 44, TM_DN = 88 * 8;
__device__ __forceinline__ void phase_transposes(const Args& A, unsigned char* lds, int g0, int g1, int worker, int nworkers) {
    unsigned char* ws = A.ws;
    for (int g = g0 + worker; g < g1; g += nworkers) {
        if (g < TM_IN) { const int tk = g / 28, tn = g % 28; transpose_macro<false>(A.w_in, NIN, tk * 64, tn * 256, (bf16_t*)(ws + WS_WIN), DM, lds); }
        else if (g < TM_IN + TM_OUT) { const int h = g - TM_IN, tk = h / 8, tn = h % 8; transpose_macro<false>(A.w_out, DM, tk * 64, tn * 256, (bf16_t*)(ws + WS_WOUT), DM, lds); }
        else if (g < TM_IN + TM_OUT + TM_UP) { const int h = g - TM_IN - TM_OUT, tk = h / 44, tn = h % 44; transpose_macro<true>(A.w_up, NUP, tk * 64, tn * 256, (bf16_t*)(ws + WS_WUP), DM, lds); }
        else { const int h = g - TM_IN - TM_OUT - TM_UP, tk = h / 8, tn = h % 8; transpose_macro<false>(A.w_down, DM, tk * 64, tn * 256, (bf16_t*)(ws + WS_WDN), DFF, lds); }
    }
}
__device__ __forceinline__ void phase_prologue(const Args& A, unsigned char* lds) {
    unsigned char* ws = A.ws;
    phase_transposes(A, lds, 0, TM_IN, blockIdx.x, gridDim.x);
    const int lane = threadIdx.x & 63, gw = blockIdx.x * 8 + (threadIdx.x >> 6), nw = gridDim.x * 8;
    bf16_t* xb = (bf16_t*)(ws + WS_XB); float* gates = (float*)(ws + WS_GATES);
    for (int it = gw; it < MT / 4; it += nw) {
        const int r0 = it * 4;
        float acc[4][8];
#pragma unroll
        for (int r = 0; r < 4; ++r)
#pragma unroll
            for (int q = 0; q < 8; ++q) acc[r][q] = 0.f;
#pragma unroll 1
        for (int i = 0; i < 8; ++i) {
            const int kb = i * 256 + lane * 4;
            f32x4 xv[4];
#pragma unroll
            for (int r = 0; r < 4; ++r) { xv[r] = *(const f32x4*)(A.x + (size_t)(r0 + r) * DM + kb);
                u32x2 o; o.x = cvt_pk_bf16(xv[r][0], xv[r][1]); o.y = cvt_pk_bf16(xv[r][2], xv[r][3]); *(u32x2*)(xb + (size_t)(r0 + r) * DM + kb) = o; }
#pragma unroll
            for (int j = 0; j < 4; ++j) {
                const f32x4* wp = (const f32x4*)(A.w_in + (size_t)(kb + j) * NIN + NP);
                const f32x4 w0 = wp[0], w1 = wp[1];
#pragma unroll
                for (int r = 0; r < 4; ++r) { const float xs = xv[r][j];
                    acc[r][0] += xs * w0[0]; acc[r][1] += xs * w0[1]; acc[r][2] += xs * w0[2]; acc[r][3] += xs * w0[3];
                    acc[r][4] += xs * w1[0]; acc[r][5] += xs * w1[1]; acc[r][6] += xs * w1[2]; acc[r][7] += xs * w1[3]; }
            }
        }
#pragma unroll
        for (int r = 0; r < 4; ++r)
#pragma unroll
            for (int q = 0; q < 8; ++q) { float v = acc[r][q];
#pragma unroll
                for (int off = 32; off >= 1; off >>= 1) v += __shfl_xor(v, off);
                acc[r][q] = v; }
        if (lane == 0) {
            const f32x4 b0 = *(const f32x4*)(A.b_gates), b1 = *(const f32x4*)(A.b_gates + 4);
#pragma unroll
            for (int r = 0; r < 4; ++r) {
                *(f32x4*)(gates + (size_t)(r0 + r) * 8) = (f32x4){acc[r][0] + b0[0], acc[r][1] + b0[1], acc[r][2] + b0[2], acc[r][3] + b0[3]};
                *(f32x4*)(gates + (size_t)(r0 + r) * 8 + 4) = (f32x4){acc[r][4] + b1[0], acc[r][5] + b1[1], acc[r][6] + b1[2], acc[r][7] + b1[3]}; }
        }
    }
}

__device__ __forceinline__ void phase_yconv(const Args& A) {
    const bf16_t* proj = (const bf16_t*)(A.ws + WS_PROJ); bf16_t* y = (bf16_t*)(A.ws + WS_Y);
    for (int idx = blockIdx.x * 512 + threadIdx.x; idx < MT * 128; idx += gridDim.x * 512) {
        const int row = idx >> 7, c = (idx & 127) * 8, t = row & (SEQ - 1);
        const bf16_t* pr = proj + (size_t)row * NP + c;
        const u32x4 bv = *(const u32x4*)pr;
        float cv[8];
#pragma unroll
        for (int i = 0; i < 8; ++i) cv[i] = 0.f;
#pragma unroll
        for (int j = 0; j < 3; ++j) {
            const int dt = 2 - j;
            if (t - dt >= 0) {
                const u32x4 cc = *(const u32x4*)(pr - (size_t)dt * NP + WCONV), hh = *(const u32x4*)(pr - (size_t)dt * NP + 2 * WCONV);
                const f32x4 w0 = *(const f32x4*)(A.w_sc + j * WCONV + c), w1 = *(const f32x4*)(A.w_sc + j * WCONV + c + 4);
                const float wv[8] = {w0[0], w0[1], w0[2], w0[3], w1[0], w1[1], w1[2], w1[3]};
#pragma unroll
                for (int q = 0; q < 4; ++q) { cv[2 * q] += wv[2 * q] * bflo(cc[q]) * bflo(hh[q]); cv[2 * q + 1] += wv[2 * q + 1] * bfhi(cc[q]) * bfhi(hh[q]); }
            }
        }
        u32x4 o;
#pragma unroll
        for (int q = 0; q < 4; ++q) o[q] = cvt_pk_bf16(bflo(bv[q]) * cv[2 * q], bfhi(bv[q]) * cv[2 * q + 1]);
        *(u32x4*)(y + (size_t)row * DM + c) = o;
    }
}

__device__ __forceinline__ void phase_mlstm(const Args& A, unsigned char* lds, float* hbuf) {
    const int tid = threadIdx.x, lane = tid & 63, w = tid >> 6, g = lane >> 4, l15 = lane & 15;
    const int a = w >> 2, ti = w & 3;
    unsigned char* QS = lds; unsigned char* KS = lds + 33792; unsigned char* VT = lds + 67584; unsigned char* WVT = VT + 4608; unsigned char* CT = WVT + 4608; unsigned char* XCH = CT + 33792;
    const bf16_t* proj = (const bf16_t*)(A.ws + WS_PROJ); const float* gates = (const float*)(A.ws + WS_GATES);
    float* TBC = (float*)(lds + 131088); float* TUV = TBC + 2048; float* TCM = TUV + 2048;
    for (int item = blockIdx.x; item < 256; item += gridDim.x) {
        const int xcd = item & 7, idx = item >> 3; const int bh = xcd * 2 + (idx >> 4), es = idx & 15;
        const int b = bh >> 2, hh = bh & 3, e0 = es * 16;
        const size_t row0 = (size_t)b * SEQ;
        __syncthreads();
        for (int i = tid; i < 16896 / 4; i += 512) ((unsigned*)CT)[i] = 0u;
        for (int i = tid; i < 16 * 72; i += 512) { const int r = 16 + i / 72, ci = i % 72; ((bf16_t*)VT)[r * 72 + ci] = (r == 16) ? (bf16_t)0x3F80 : (bf16_t)0; ((bf16_t*)WVT)[r * 72 + ci] = 0; }
        f32x4 Cst[2][2];
#pragma unroll
        for (int x = 0; x < 2; ++x)
#pragma unroll
            for (int et = 0; et < 2; ++et) Cst[x][et] = (f32x4){0.f, 0.f, 0.f, 0.f};
        float m_state = 0.f;
        u32x4 qr[4], kr[4], vr = (u32x4){0u, 0u, 0u, 0u};
        const bf16_t* qbase = proj + row0 * NP + 3072 + hh * 256;
#define ML_LOAD(c) do { _Pragma("unroll") for (int i = 0; i < 4; ++i) { const int p = tid + 512 * i, r = p >> 5, c16 = p & 31; const bf16_t* rp = qbase + (size_t)((c) * 64 + r) * NP + c16 * 8; \
            qr[i] = *(const u32x4*)rp; kr[i] = *(const u32x4*)(rp + 1024); } \
            if (tid < 128) vr = *(const u32x4*)(qbase + (size_t)((c) * 64 + (tid >> 1)) * NP + 2048 + e0 + (tid & 1) * 8); } while (0)
        ML_LOAD(0);
#pragma unroll 1
        for (int cc = 4 * w; cc < 4 * w + 4; ++cc) {
            const float* gp = gates + (row0 + cc * 64 + lane) * 8 + hh; const float gi = gp[0], gf = gp[4];
            const float lf = fminf(gf, 0.f) - log1pf(__expf(-fabsf(gf)));
            float bc = lf;
#pragma unroll
            for (int off = 1; off < 64; off <<= 1) { const float t = __shfl_up(bc, off); if (lane >= off) bc += t; }
            const float uv = gi - bc;
            float cm = uv;
#pragma unroll
            for (int off = 1; off < 64; off <<= 1) { const float t = __shfl_up(cm, off); if (lane >= off) cm = fmaxf(cm, t); }
            TBC[cc * 64 + lane] = bc; TUV[cc * 64 + lane] = uv; TCM[cc * 64 + lane] = cm;
        }
        __syncthreads();
#pragma unroll 1
        for (int c = 0; c < 32; ++c) {
            const float* tbc = TBC + c * 64; const float* tuv = TUV + c * 64; const float* tcm = TCM + c * 64;
            const float g_tot = tbc[63], cm63 = tcm[63];
            const float M63 = fmaxf(m_state, cm63), decay = __expf(m_state - M63);
            const float m_old = m_state;
            m_state = g_tot + M63;
#pragma unroll
            for (int i = 0; i < 4; ++i) { const int p = tid + 512 * i, r = p >> 5, c16 = p & 31; *(u32x4*)(QS + r * 528 + c16 * 16) = qr[i]; *(u32x4*)(KS + r * 528 + c16 * 16) = kr[i]; }
            { if (tid < 128) { const int s = tid >> 1, hf = tid & 1; const float wv = __expf(tuv[s] - M63);
#pragma unroll
                  for (int q = 0; q < 4; ++q) { const float v0 = bflo(vr[q]), v1 = bfhi(vr[q]);
                      ((bf16_t*)VT)[(8 * hf + 2 * q) * 72 + s] = (bf16_t)(vr[q] & 0xffffu); ((bf16_t*)VT)[(8 * hf + 2 * q + 1) * 72 + s] = (bf16_t)(vr[q] >> 16);
                      ((bf16_t*)WVT)[(8 * hf + 2 * q) * 72 + s] = f2bf(v0 * wv); ((bf16_t*)WVT)[(8 * hf + 2 * q + 1) * 72 + s] = f2bf(v1 * wv); } }
              if (w == 2) ((bf16_t*)WVT)[16 * 72 + lane] = f2bf(__expf(tuv[lane] - M63)); }
            if (c + 1 < 32) ML_LOAD(c + 1);
            __syncthreads();
            bf16x8 qf[8]; f32x4 S0 = (f32x4){0.f, 0.f, 0.f, 0.f}, S1 = S0;
#pragma unroll
            for (int kk = 0; kk < 8; ++kk) {
                qf[kk] = *(const bf16x8*)(QS + (16 * ti + l15) * 528 + kk * 64 + g * 16);
                const bf16x8 kf0 = *(const bf16x8*)(KS + (32 * a + l15) * 528 + kk * 64 + g * 16), kf1 = *(const bf16x8*)(KS + (32 * a + 16 + l15) * 528 + kk * 64 + g * 16);
                S0 = __builtin_amdgcn_mfma_f32_16x16x32_bf16(kf0, qf[kk], S0, 0, 0, 0); S1 = __builtin_amdgcn_mfma_f32_16x16x32_bf16(kf1, qf[kk], S1, 0, 0, 0);
            }
            const int tcol = 16 * ti + l15;
            const float Mt = fmaxf(m_old, tcm[tcol]);
            const f32x4 u0v = *(const f32x4*)(tuv + 32 * a + 4 * g), u1v = *(const f32x4*)(tuv + 32 * a + 16 + 4 * g);
            float p[8];
#pragma unroll
            for (int r = 0; r < 4; ++r) { const int s0 = 32 * a + 4 * g + r, s1 = s0 + 16;
                p[r] = (s0 <= tcol) ? S0[r] * 0.0625f * __expf(u0v[r] - Mt) : 0.f; p[4 + r] = (s1 <= tcol) ? S1[r] * 0.0625f * __expf(u1v[r] - Mt) : 0.f; }
            u32x4 pau; pau.x = cvt_pk_bf16(p[0], p[1]); pau.y = cvt_pk_bf16(p[2], p[3]); pau.z = cvt_pk_bf16(p[4], p[5]); pau.w = cvt_pk_bf16(p[6], p[7]);
            const bf16x8 pa = __builtin_bit_cast(bf16x8, pau);
            f32x4 rr[2];
#pragma unroll
            for (int et = 0; et < 2; ++et) { const unsigned char* vp = VT + (16 * et + l15) * 144 + (32 * a + 4 * g) * 2;
                const u32x2 lo = *(const u32x2*)vp, hi = *(const u32x2*)(vp + 32);
                u32x4 vbu; vbu.x = lo.x; vbu.y = lo.y; vbu.z = hi.x; vbu.w = hi.y;
                rr[et] = __builtin_amdgcn_mfma_f32_16x16x32_bf16(pa, __builtin_bit_cast(bf16x8, vbu), (f32x4){0.f, 0.f, 0.f, 0.f}, 0, 0, 0); }
            const f32x4 cmr = *(const f32x4*)(tcm + 16 * ti + 4 * g), bcr = *(const f32x4*)(tbc + 16 * ti + 4 * g);
            {
                const unsigned char* CTc = CT + (c & 1) * 16896;
                f32x4 in0 = (f32x4){0.f, 0.f, 0.f, 0.f}, in1 = in0;
#pragma unroll
                for (int k2 = 0; k2 < 4; ++k2) {
                    const bf16x8 qa = a ? qf[4 + k2] : qf[k2];
                    const bf16x8 c0 = *(const bf16x8*)(CTc + (l15) * 528 + (128 * a + 32 * k2 + 8 * g) * 2), c1 = *(const bf16x8*)(CTc + (16 + l15) * 528 + (128 * a + 32 * k2 + 8 * g) * 2);
                    in0 = __builtin_amdgcn_mfma_f32_16x16x32_bf16(qa, c0, in0, 0, 0, 0); in1 = __builtin_amdgcn_mfma_f32_16x16x32_bf16(qa, c1, in1, 0, 0, 0);
                }
#pragma unroll
                for (int r = 0; r < 4; ++r) { const float iw = __expf(m_old - fmaxf(m_old, cmr[r])) * 0.0625f; rr[0][r] += in0[r] * iw; rr[1][r] += in1[r] * iw; }
            }
            if (a == 1) { *(f32x4*)(XCH + ((ti * 2 + 0) * 64 + lane) * 16) = rr[0]; *(f32x4*)(XCH + ((ti * 2 + 1) * 64 + lane) * 16) = rr[1]; }
            {
                unsigned char* CTn = CT + ((c + 1) & 1) * 16896;
#pragma unroll
                for (int x = 0; x < 2; ++x) {
                    const int dt = 2 * w + x;
#pragma unroll
                    for (int et = 0; et < 2; ++et) Cst[x][et] *= decay;
#pragma unroll
                    for (int ks = 0; ks < 2; ++ks) {
                        const s16x4 klo = __builtin_amdgcn_ds_read_tr16_b64_v4i16((LAS s16x4*)(KS + (32 * ks + 8 * g + (l15 >> 2)) * 528 + (16 * dt + 4 * (l15 & 3)) * 2));
                        const s16x4 khi = __builtin_amdgcn_ds_read_tr16_b64_v4i16((LAS s16x4*)(KS + (32 * ks + 8 * g + 4 + (l15 >> 2)) * 528 + (16 * dt + 4 * (l15 & 3)) * 2));
                        const bf16x8 ka = {klo[0], klo[1], klo[2], klo[3], khi[0], khi[1], khi[2], khi[3]};
#pragma unroll
                        for (int et = 0; et < 2; ++et) { const bf16x8 wvb = *(const bf16x8*)(WVT + (16 * et + l15) * 144 + (32 * ks + 8 * g) * 2);
                            Cst[x][et] = __builtin_amdgcn_mfma_f32_16x16x32_bf16(ka, wvb, Cst[x][et], 0, 0, 0); }
                    }
#pragma unroll
                    for (int et = 0; et < 2; ++et) { u32x2 o; o.x = cvt_pk_bf16(Cst[x][et][0], Cst[x][et][1]); o.y = cvt_pk_bf16(Cst[x][et][2], Cst[x][et][3]);
                        *(u32x2*)(CTn + (16 * et + l15) * 528 + (16 * dt + 4 * g) * 2) = o; }
                }
            }
            __syncthreads();
            if (a == 0) {
                const f32x4 o0 = *(const f32x4*)(XCH + ((ti * 2 + 0) * 64 + lane) * 16), o1 = *(const f32x4*)(XCH + ((ti * 2 + 1) * 64 + lane) * 16);
#pragma unroll
                for (int r = 0; r < 4; ++r) {
                    const float den = __shfl(rr[1][r] + o1[r], lane & 48), fl = __expf(-(bcr[r] + fmaxf(m_old, cmr[r])));
                    const float hv = (rr[0][r] + o0[r]) * __builtin_amdgcn_rcpf(fmaxf(fabsf(den), fl));
                    hbuf[(row0 + c * 64 + 16 * ti + 4 * g + r) * 1024 + hh * 256 + e0 + l15] = hv;
                }
            }
        }
#undef ML_LOAD
    }
}

__device__ __forceinline__ void phase_headnorm(const Args& A, const float* hbuf) {
    const bf16_t* proj = (const bf16_t*)(A.ws + WS_PROJ); bf16_t* y = (bf16_t*)(A.ws + WS_Y);
    const int lane = threadIdx.x & 63, gw = blockIdx.x * 8 + (threadIdx.x >> 6), nw = gridDim.x * 8;
    for (int it = gw; it < MT * 4; it += nw) {
        const int row = it >> 2, hh = it & 3;
        const f32x4 hv = *(const f32x4*)(hbuf + (size_t)row * 1024 + hh * 256 + lane * 4);
        float s = (hv[0] + hv[1]) + (hv[2] + hv[3]);
#pragma unroll
        for (int off = 32; off >= 1; off >>= 1) s += __shfl_xor(s, off);
        const float mu = s * (1.0f / 256.0f);
        const f32x4 d = hv - mu;
        float q = (d[0] * d[0] + d[1] * d[1]) + (d[2] * d[2] + d[3] * d[3]);
#pragma unroll
        for (int off = 32; off >= 1; off >>= 1) q += __shfl_xor(q, off);
        const float rstd = rsqrtf(q * (1.0f / 256.0f) + 1e-6f);
        const f32x4 gn = *(const f32x4*)(A.mh_gain + hh * 256 + lane * 4);
        const u32x2 ov = *(const u32x2*)(proj + (size_t)row * NP + 6144 + hh * 256 + lane * 4);
        const float o0 = bflo(ov.x), o1 = bfhi(ov.x), o2 = bflo(ov.y), o3 = bfhi(ov.y);
        const float y0 = d[0] * rstd * gn[0] * __builtin_amdgcn_rcpf(1.0f + __expf(-o0)), y1 = d[1] * rstd * gn[1] * __builtin_amdgcn_rcpf(1.0f + __expf(-o1));
        const float y2 = d[2] * rstd * gn[2] * __builtin_amdgcn_rcpf(1.0f + __expf(-o2)), y3 = d[3] * rstd * gn[3] * __builtin_amdgcn_rcpf(1.0f + __expf(-o3));
        u32x2 o; o.x = cvt_pk_bf16(y0, y1); o.y = cvt_pk_bf16(y2, y3);
        *(u32x2*)(y + (size_t)row * DM + WCONV + hh * 256 + lane * 4) = o;
    }
}

__device__ __forceinline__ void phase_ln(float* io, const float* gam, const float* bet, bf16_t* ob) {
    const int lane = threadIdx.x & 63, gw = blockIdx.x * 8 + (threadIdx.x >> 6), nw = gridDim.x * 8;
    for (int row = gw; row < MT; row += nw) {
        float* rp = io + (size_t)row * DM;
        f32x4 v[8]; float s = 0.f;
#pragma unroll
        for (int i = 0; i < 8; ++i) { v[i] = *(const f32x4*)(rp + i * 256 + lane * 4); s += (v[i][0] + v[i][1]) + (v[i][2] + v[i][3]); }
#pragma unroll
        for (int off = 32; off >= 1; off >>= 1) s += __shfl_xor(s, off);
        const float mu = s * (1.0f / DM);
        float q = 0.f;
#pragma unroll
        for (int i = 0; i < 8; ++i) { v[i] = v[i] - mu; q += (v[i][0] * v[i][0] + v[i][1] * v[i][1]) + (v[i][2] * v[i][2] + v[i][3] * v[i][3]); }
#pragma unroll
        for (int off = 32; off >= 1; off >>= 1) q += __shfl_xor(q, off);
        const float rstd = rsqrtf(q * (1.0f / DM) + 1e-5f);
#pragma unroll
        for (int i = 0; i < 8; ++i) { const f32x4 gg = *(const f32x4*)(gam + i * 256 + lane * 4), bb = *(const f32x4*)(bet + i * 256 + lane * 4);
            const f32x4 o = v[i] * rstd * gg + bb;
            *(f32x4*)(rp + i * 256 + lane * 4) = o;
            if (ob) { u32x2 p; p.x = cvt_pk_bf16(o[0], o[1]); p.y = cvt_pk_bf16(o[2], o[3]); *(u32x2*)(ob + (size_t)row * DM + i * 256 + lane * 4) = p; } }
    }
}

__device__ __forceinline__ void phase_fixup(const Args& A) {
    const float* halo = (const float*)(A.ws + WS_HALO); bf16_t* act = (bf16_t*)(A.ws + WS_ACT);
    for (int idx = blockIdx.x * 512 + threadIdx.x; idx < 64 * 2 * (DFF / 4); idx += gridDim.x * 512) {
        const int f = (idx % (DFF / 4)) * 4, br = idx / (DFF / 4), rr = br & 1, B = br >> 1;
        const bool first = (B & 15) == 0;
        const float* hc = halo + (size_t)B * 4 * NUP; const float* hp = hc - 4 * NUP;
        f32x4 hv[2];
#pragma unroll
        for (int bj = 0; bj < 2; ++bj) {
            const int col = bj * DFF + f;
            const f32x4 cur = *(const f32x4*)(hc + (size_t)(2 + rr) * NUP + col);
            f32x4 p1, p2; const f32x4 z = (f32x4){0.f, 0.f, 0.f, 0.f};
            if (rr == 0) { p1 = first ? z : *(const f32x4*)(hp + (size_t)1 * NUP + col); p2 = first ? z : *(const f32x4*)(hp + col); }
            else { p1 = *(const f32x4*)(hc + (size_t)2 * NUP + col); p2 = first ? z : *(const f32x4*)(hp + (size_t)1 * NUP + col); }
            const f32x4 w0 = *(const f32x4*)(A.w_fc + col), w1 = *(const f32x4*)(A.w_fc + NUP + col), w2 = *(const f32x4*)(A.w_fc + 2 * NUP + col), bb = *(const f32x4*)(A.b_fc + col);
            hv[bj] = w2 * cur + w1 * p1 + w0 * p2 + bb;
        }
        float av[4];
#pragma unroll
        for (int j = 0; j < 4; ++j) { const float gt = hv[1][j]; av[j] = hv[0][j] * gt / (1.0f + __expf(-gt)); }
        u32x2 o; o.x = cvt_pk_bf16(av[0], av[1]); o.y = cvt_pk_bf16(av[2], av[3]);
        *(u32x2*)(act + (size_t)(B * 128 + rr) * DFF + f) = o;
    }
}

__device__ __forceinline__ void phase_dump(const bf16_t* src, int ld, int c0, float* out) {
    for (size_t idx = (size_t)blockIdx.x * 512 + threadIdx.x; idx < (size_t)MT * DM; idx += (size_t)gridDim.x * 512) {
        const size_t row = idx / DM, col = idx % DM; out[idx] = bflo((unsigned)src[row * ld + c0 + col]); }
}
#ifndef DBG_STOP
#define DBG_STOP -1
#endif
#define XB_TMO      128
#define XB_XCNT(j)  (256  + 64 * (j))
#define XB_XSUB(j)  (1280 + 64 * (j))
#define XB_XGEN(j)  (2304 + 64 * (j))
#define XB_TOP      3328
#define XB_TOPGEN   3392
#define XCD_BAR_WORDS 3456
#define XB_SPIN_CAP (1u << 22)
__device__ __forceinline__ unsigned xb_ld(unsigned* p)              { return __hip_atomic_load(p, __ATOMIC_RELAXED, __HIP_MEMORY_SCOPE_AGENT); }
__device__ __forceinline__ unsigned xb_add(unsigned* p, unsigned v) { return __hip_atomic_fetch_add(p, v, __ATOMIC_RELAXED, __HIP_MEMORY_SCOPE_AGENT); }
__device__ __forceinline__ unsigned xb_xcc_id() { return (unsigned)__builtin_amdgcn_s_getreg((3 << 11) | 20) & 0xFu; }
#define XB_SPIN(cond, bar) do { unsigned _sp = 0; while (cond) { __builtin_amdgcn_s_sleep(1); \
    if ((++_sp & 255u) == 0u) { if (xb_ld(&(bar)[XB_TMO])) break; if (_sp > XB_SPIN_CAP) { atomicAdd(&(bar)[XB_TMO], 1u); break; } } } } while (0)
struct XcdBarrier { unsigned* bar; unsigned x; volatile LAS unsigned* st; };
__device__ __forceinline__ XcdBarrier xcd_barrier_post(unsigned* bar, volatile LAS unsigned* st) {
    XcdBarrier b; b.bar = bar; b.x = xb_xcc_id(); b.st = st;
    if (threadIdx.x == 0) (void)xb_add(&bar[XB_XCNT(b.x)], 1u);
    return b;
}
__device__ __forceinline__ void xcd_barrier_complete(unsigned* bar, unsigned x, unsigned& nloc, unsigned& nx) {
    const unsigned G = gridDim.x * gridDim.y * gridDim.z;
    unsigned sum, cnt, mine, sp = 0u;
    for (;;) {
        sum = 0u; cnt = 0u; mine = 0u;
#pragma unroll
        for (unsigned j = 0; j < 16; ++j) { const unsigned c = xb_ld(&bar[XB_XCNT(j)]); sum += c; cnt += (c > 0u) ? 1u : 0u; mine = (j == x) ? c : mine; }
        if (sum == G) break;
        __builtin_amdgcn_s_sleep(1);
        if ((++sp & 255u) == 0u) { if (xb_ld(&bar[XB_TMO])) break; if (sp > XB_SPIN_CAP) { atomicAdd(&bar[XB_TMO], 1u); break; } }
    }
    nloc = mine > 0u ? mine : 1u; nx = cnt > 0u ? cnt : 1u;
}
__device__ __forceinline__ void xcd_barrier(const XcdBarrier& b) {
    asm volatile("s_waitcnt vmcnt(0)" ::: "memory");
    __syncthreads();
    if (threadIdx.x == 0) {
        unsigned* bar = b.bar;
        __builtin_amdgcn_s_waitcnt(0);
        unsigned nloc = b.st[0], nx = b.st[1];
        if (nloc == 0u) { xcd_barrier_complete(bar, b.x, nloc, nx); b.st[0] = nloc; b.st[1] = nx; }
        const unsigned old = xb_add(&bar[XB_XSUB(b.x)], 1u);
        const unsigned gen = old / nloc;
        if (old + 1u == (gen + 1u) * nloc) {
            __builtin_amdgcn_fence(__ATOMIC_RELEASE, "agent");
            asm volatile("s_waitcnt vmcnt(0)" ::: "memory");
            const unsigned og = xb_add(&bar[XB_TOP], 1u);
            const unsigned tg = og / nx;
            if (og + 1u == (tg + 1u) * nx) xb_add(&bar[XB_TOPGEN], 1u);
            else XB_SPIN(xb_ld(&bar[XB_TOPGEN]) == tg, bar);
            __builtin_amdgcn_fence(__ATOMIC_ACQUIRE, "agent");
            xb_add(&bar[XB_XGEN(b.x)], 1u);
            asm volatile("s_waitcnt vmcnt(0)" ::: "memory");
        } else {
            XB_SPIN(xb_ld(&bar[XB_XGEN(b.x)]) == gen, bar);
            __builtin_amdgcn_fence(__ATOMIC_ACQUIRE, "agent");
            asm volatile("s_waitcnt vmcnt(0)" ::: "memory");
        }
    }
    __syncthreads();
}

constexpr int N_PHASES = 10;
#ifndef ONLY_PH
#define ONLY_PH -1
#endif
#define PH_ON(x) (ONLY_PH < 0 || ONLY_PH == (x))
__global__ void __launch_bounds__(512, 2) mega(Args a) {
    extern __shared__ __attribute__((aligned(16))) unsigned char lds[];
    cg::grid_group grid = cg::this_grid();
    unsigned char* ws = a.ws;
#define PH_RUN(x) (PH_ON(x) && a.ph_lo <= (x) && (x) < a.ph_hi)
#define PH_SYNC(x) do { if (a.ph_lo <= (x) && (x) + 1 < a.ph_hi) xcd_barrier(xb); } while (0)
    volatile LAS unsigned* xst = (volatile LAS unsigned*)((LAS unsigned char*)lds + 131072);
    if (threadIdx.x == 0) { xst[0] = 0u; xst[1] = 0u; }
    __syncthreads();
    const XcdBarrier xb = xcd_barrier_post((unsigned*)(ws + WS_BAR), xst);
    if (a.ph_hi > 1000) grid.sync();
#ifndef REP0
#define REP0 1
#endif
#ifndef REP2
#define REP2 1
#endif
#ifndef REP6
#define REP6 1
#endif
    if (PH_RUN(0)) for (int rep = 0; rep < REP0; ++rep) phase_prologue(a, lds);
    PH_SYNC(0);
    if (PH_RUN(1)) { pg8::Gemm g{(const bf16_t*)(ws + WS_XB), (const bf16_t*)(ws + WS_WIN), MT, NP, DM}; pg8::StaticOrder S; S.init(MT, NP, gridDim.x, blockIdx.x);
        pg8::EpiBf16 E{(bf16_t*)(ws + WS_PROJ), NP}; pg8::gemm_phase<pg8::EpiBf16, true>((LAS unsigned char*)lds, g, S, E);
        const int rem = ((MT / 256) * (NP / 256)) % (int)gridDim.x;
        if (rem == 0) phase_transposes(a, lds, TM_IN, TM_IN + TM_OUT + TM_UP, blockIdx.x, gridDim.x);
        else if ((int)blockIdx.x >= rem) phase_transposes(a, lds, TM_IN, TM_IN + TM_OUT + TM_UP, blockIdx.x - rem, gridDim.x - rem); }
    PH_SYNC(1);
    if (PH_RUN(2)) for (int rep = 0; rep < REP2; ++rep) { phase_yconv(a); phase_mlstm(a, lds, a.out); }
    PH_SYNC(2);
    if (PH_RUN(3)) phase_headnorm(a, a.out);
    PH_SYNC(3);
    if (PH_RUN(4)) { pg8::Gemm g{(const bf16_t*)(ws + WS_Y), (const bf16_t*)(ws + WS_WOUT), MT, DM, DM}; pg8::StaticOrder S; S.init(MT, DM, gridDim.x, blockIdx.x);
        if (a.fuse_ln) { pg8::EpiResLn<false, false> E{a.x, nullptr, nullptr, (bf16_t*)(ws + WS_X1B), a.ln1_g, a.ln1_b, (float*)(ws + WS_RS1), (unsigned*)(ws + WS_CNT)}; pg8::gemm_phase((LAS unsigned char*)lds, g, S, E); }
        else { pg8::EpiResF32 E{a.x, a.out, DM}; pg8::gemm_phase((LAS unsigned char*)lds, g, S, E); } }
    PH_SYNC(4);
    if (PH_RUN(5) && !a.fuse_ln) phase_ln(a.out, a.ln1_g, a.ln1_b, (bf16_t*)(ws + WS_X1B));
    if (!a.fuse_ln) PH_SYNC(5);
    if (PH_RUN(6)) { pg8::Gemm g{(const bf16_t*)(ws + WS_X1B), (const bf16_t*)(ws + WS_WUP), MT, NUP, DM}; pg8::StaticOrder S; S.init(MT, NUP, gridDim.x, blockIdx.x);
        pg8::EpiConvFfn E{(bf16_t*)(ws + WS_ACT), (float*)(ws + WS_HALO), a.w_fc, a.b_fc}; pg8::gemm_phase<pg8::EpiConvFfn, true>((LAS unsigned char*)lds, g, S, E);
        const int rem = ((MT / 256) * (NUP / 256)) % (int)gridDim.x; const int t0 = TM_IN + TM_OUT + TM_UP, t1 = t0 + TM_DN;
        if (rem == 0) phase_transposes(a, lds, t0, t1, blockIdx.x, gridDim.x);
        else if ((int)blockIdx.x >= rem) phase_transposes(a, lds, t0, t1, blockIdx.x - rem, gridDim.x - rem); }
    PH_SYNC(6);
    if (PH_RUN(7)) phase_fixup(a);
    PH_SYNC(7);
    if (PH_RUN(8)) { pg8::Gemm g{(const bf16_t*)(ws + WS_ACT), (const bf16_t*)(ws + WS_WDN), MT, DM, DFF}; pg8::StaticOrder S; S.init(MT, DM, gridDim.x, blockIdx.x);
        if (a.fuse_ln) { pg8::EpiResLn<true, true> E{nullptr, (const bf16_t*)(ws + WS_X1B), a.out, nullptr, a.ln2_g, a.ln2_b, (float*)(ws + WS_RS2), (unsigned*)(ws + WS_CNT) + 32 * 64}; pg8::gemm_phase((LAS unsigned char*)lds, g, S, E); }
        else { pg8::EpiResF32 E{a.out, a.out, DM}; pg8::gemm_phase((LAS unsigned char*)lds, g, S, E); } }
    if (!a.fuse_ln) PH_SYNC(8);
    if (PH_RUN(9) && !a.fuse_ln) phase_ln(a.out, a.ln2_g, a.ln2_b, nullptr);
    if (DBG_STOP == 1 && a.ph_lo == 101) phase_dump((const bf16_t*)(ws + WS_PROJ), NP, 3072, a.out);
    if (DBG_STOP == 3 && a.ph_lo == 103) phase_dump((const bf16_t*)(ws + WS_Y), DM, 0, a.out);
    if (DBG_STOP == 7 && a.ph_lo == 107) phase_dump((const bf16_t*)(ws + WS_ACT), DFF, 0, a.out);
}

extern "C" void kernel_launch(void* const* d_in, const int* in_sizes, int n_in, void* d_out, int out_size, void* d_ws, size_t ws_size, hipStream_t stream) {
    static int grid = 0;
    if (grid == 0) {
        if (n_in != 14 || ws_size < WS_END) { fprintf(stderr, "kernel_launch: unexpected n_in %d / ws_size %zu (need %zu)\n", n_in, ws_size, (size_t)WS_END); grid = -1; return; }
        int dev = 0, cus = 0, per_cu = 0;
        hipGetDevice(&dev); hipDeviceGetAttribute(&cus, hipDeviceAttributeMultiprocessorCount, dev);
        if (hipFuncSetAttribute((const void*)mega, hipFuncAttributeMaxDynamicSharedMemorySize, LDS_BYTES) != hipSuccess) { fprintf(stderr, "kernel_launch: hipFuncSetAttribute failed\n"); grid = -1; return; }
        if (hipOccupancyMaxActiveBlocksPerMultiprocessor(&per_cu, (const void*)mega, 512, LDS_BYTES) != hipSuccess || per_cu < 1) { fprintf(stderr, "kernel_launch: occupancy query failed (%d)\n", per_cu); (void)hipGetLastError(); per_cu = 1; }
        grid = cus * 1;
        fprintf(stderr, "kernel_launch: cus %d per_cu %d grid %d\n", cus, per_cu, grid);
    }
    if (grid < 0) return;
    if (hipMemsetAsync((char*)d_ws + WS_BAR, 0, WS_END - WS_BAR, stream)     != hipSuccess) { fprintf(stderr, "kernel_launch: memset failed\n"); return; }
    Args a{};
    a.x = (const float*)d_in[0]; a.w_in = (const float*)d_in[1]; a.b_gates = (const float*)d_in[2]; a.w_sc = (const float*)d_in[3]; a.mh_gain = (const float*)d_in[4]; a.w_out = (const float*)d_in[5];
    a.ln1_g = (const float*)d_in[6]; a.ln1_b = (const float*)d_in[7]; a.w_up = (const float*)d_in[8]; a.w_fc = (const float*)d_in[9]; a.b_fc = (const float*)d_in[10]; a.w_down = (const float*)d_in[11];
    a.ln2_g = (const float*)d_in[12]; a.ln2_b = (const float*)d_in[13];
    a.out = (float*)d_out; a.ws = (unsigned char*)d_ws;
    a.fuse_ln = (MK_SINGLE && grid == 256) ? 1 : 0;
#if MK_SINGLE
    a.ph_lo = 0; a.ph_hi = N_PHASES;
    void* args[] = {&a};
    hipError_t e = hipLaunchCooperativeKernel((const void*)mega, dim3(grid), dim3(512), args, LDS_BYTES, stream);
    if (e != hipSuccess) fprintf(stderr, "cooperative launch failed: %s (grid %d)\n", hipGetErrorString(e), grid);
#else
    for (int ph = 0; ph < N_PHASES; ++ph) { if (DBG_STOP >= 0 && ph > DBG_STOP) break; a.ph_lo = ph; a.ph_hi = ph + 1; hipLaunchKernelGGL(mega, dim3(grid), dim3(512), LDS_BYTES, stream, a); }
    if (DBG_STOP >= 0) { a.ph_lo = 100 + DBG_STOP; a.ph_hi = 101 + DBG_STOP; hipLaunchKernelGGL(mega, dim3(grid), dim3(512), LDS_BYTES, stream, a); }
#endif
}
```

```cpp
#include <hip/hip_runtime.h>
#include <hip/hip_cooperative_groups.h>
#include <cstdio>
#include <cstdint>
namespace cg = cooperative_groups;

#ifndef MK_SINGLE
#define MK_SINGLE 1
#endif

#define LAS __attribute__((address_space(3)))
typedef unsigned short bf16_t;
typedef short bf16x8 __attribute__((ext_vector_type(8)));
typedef float f32x4 __attribute__((ext_vector_type(4)));
typedef unsigned u32x4 __attribute__((ext_vector_type(4)));
typedef unsigned u32x2 __attribute__((ext_vector_type(2)));
typedef short s16x4 __attribute__((ext_vector_type(4)));

constexpr int MT = 8192, DM = 2048, SEQ = 2048, NIN = 7176, NP = 7168, DFF = 5632, NUP = 11264, WCONV = 1024;
constexpr float ALPHA = 1.189207115002721f;
constexpr size_t WS_WIN = 0;
constexpr size_t WS_WOUT = WS_WIN + (size_t)NP * DM * 2;
constexpr size_t WS_WUP = WS_WOUT + (size_t)DM * DM * 2;
constexpr size_t WS_WDN = WS_WUP + (size_t)NUP * DM * 2;
constexpr size_t WS_X1B = WS_WDN + (size_t)DM * DFF * 2;
constexpr size_t WS_GATES = WS_X1B + (size_t)MT * DM * 2;
constexpr size_t WS_C = WS_GATES + (size_t)MT * 8 * 4;
constexpr size_t WS_PROJ = WS_C;
constexpr size_t WS_Y = WS_PROJ + (size_t)MT * NP * 2;
constexpr size_t WS_XB = WS_Y + (size_t)MT * DM * 2;
constexpr size_t WS_ACT = WS_C;
constexpr size_t WS_HALO = WS_ACT + (size_t)MT * DFF * 2;
constexpr size_t WS_BAR = WS_XB + (size_t)MT * DM * 2;
constexpr size_t WS_RS1 = WS_BAR + 16384;
constexpr size_t WS_RS2 = WS_RS1 + (size_t)MT * 8;
constexpr size_t WS_CNT = WS_RS2 + (size_t)MT * 8;
constexpr size_t WS_END = WS_CNT + 2 * 32 * 256;
constexpr int LDS_BYTES = 131072 + 16 + 3 * 32 * 64 * 4;

struct Args {
    const float* x; const float* w_in; const float* b_gates; const float* w_sc; const float* mh_gain; const float* w_out;
    const float* ln1_g; const float* ln1_b; const float* w_up; const float* w_fc; const float* b_fc; const float* w_down;
    const float* ln2_g; const float* ln2_b;
    float* out; unsigned char* ws; int ph_lo, ph_hi, fuse_ln, pad0;
};

typedef __bf16 bf16v2 __attribute__((ext_vector_type(2)));
typedef float f32x2 __attribute__((ext_vector_type(2)));
__device__ __forceinline__ unsigned cvt_pk_bf16(float lo, float hi) { const f32x2 v = {lo, hi}; const bf16v2 r = __builtin_convertvector(v, bf16v2); return __builtin_bit_cast(unsigned, r); }
__device__ __forceinline__ unsigned cvt_pk_bf16_asm(float lo, float hi) { unsigned r; asm volatile("v_cvt_pk_bf16_f32 %0, %1, %2" : "=v"(r) : "v"(lo), "v"(hi)); return r; }
__device__ __forceinline__ float bflo(unsigned u) { return __uint_as_float(u << 16); }
__device__ __forceinline__ float bfhi(unsigned u) { return __uint_as_float(u & 0xffff0000u); }
__device__ __forceinline__ bf16_t f2bf(float f) { unsigned u = __float_as_uint(f); u += 0x7FFFu + ((u >> 16) & 1u); return (bf16_t)(u >> 16); }

namespace pg8 {
constexpr int BM = 256, BK = 64, HALF = 128, HTB = HALF * BK * 2, STAGE_BYTES = 8 * HTB, NXCD = 8, WGM = 8;
__host__ __device__ __forceinline__ int lds_byte(int r, int c) { const int st = (r >> 4) * 2 + (c >> 5), rr = r & 15, cc = c & 31, ob = rr * 64 + cc * 2; return st * 1024 + (ob ^ (((ob >> 9) & 1) << 5)); }
__host__ __device__ __forceinline__ void stage_rc(int b, int& R, int& C) { const int st = b / 1024, sb = b % 1024, swz = sb ^ (((sb >> 9) & 1) << 5); R = (st >> 1) * 16 + swz / 64; C = (st & 1) * 32 + (swz % 64) / 2; }
__host__ __device__ __forceinline__ int perm32(int rho) { const int n = rho >> 4, i = rho & 15; return 8 * (i >> 2) + 4 * n + (i & 3); }
struct Unit { int pm, pn; };
struct Gemm { const bf16_t* A; const bf16_t* Bt; int M, N, K; };
struct StaticOrder {
    int nM, nN, nwg, G, c;
    __device__ void init(int M, int N, int G_, int c_) { nM = M / BM; nN = N / BM; nwg = nM * nN; G = G_; c = c_; }
    __device__ bool next(int i, Unit& u) const {
        const long L = (long)i * G + c; if (L >= nwg) return false;
        int wgid = (int)L; { const int q = nwg / NXCD, r = nwg % NXCD, xcd = wgid % NXCD, off = wgid / NXCD; wgid = (xcd < r ? xcd * (q + 1) : r * (q + 1) + (xcd - r) * q) + off; }
        const int nig = WGM * nN, gid = wgid / nig, fm = gid * WGM, gsz = (nM - fm) < WGM ? (nM - fm) : WGM;
        u.pm = fm + ((wgid % nig) % gsz); u.pn = (wgid % nig) / gsz; return true;
    }
};

template <class Epi, bool ALIGN_EPI = false, bool SP2 = true>
__device__ __forceinline__ void gemm_phase(LAS unsigned char* lds, const Gemm g, const StaticOrder& S, const Epi& E) {
    const int tid = threadIdx.x, wid = __builtin_amdgcn_readfirstlane(tid >> 6), lane = tid & 63, wr = wid >> 2, wc = wid & 3, fr = lane & 15, fq = lane >> 4;
    const int K = g.K, nt = K / BK;
    unsigned voffA[2], voffB[2];
#pragma unroll
    for (int i = 0; i < 2; ++i) { int R, C; stage_rc(tid * 16 + i * 8192, R, C); const int Rb = Epi::PERM ? ((R & ~31) + perm32(R & 31)) : R;
        const int Ra = Epi::AROWPERM ? (128 * (R >> 6) + 8 * (R & 15) + ((R >> 4) & 3)) : R;
        voffA[i] = (unsigned)(Ra * K + C) * 2u; voffB[i] = (unsigned)(Rb * K + C) * 2u; }
    const size_t kstep = (size_t)(BK * 2);
    const size_t hstep = (size_t)HALF * K * 2;
    const size_t hstepA = Epi::AROWPERM ? (size_t)4 * K * 2 : hstep;
    const size_t tstep = 2 * hstep;
    const unsigned ldsw = (unsigned)wid * 1024u;
    const int aoff = lds_byte(wr * 64 + fr, fq * 8), boff = lds_byte(wc * 32 + fr, fq * 8);
#define PG8_SA(b, h) (((b) * 2 + (h)) * HTB)
#define PG8_SB(b, h) ((4 + (b) * 2 + (h)) * HTB)
#define PG8_STAGE(bufoff, gbase, voff) do { _Pragma("unroll") for (int _i = 0; _i < 2; ++_i) \
        __builtin_amdgcn_global_load_lds((const unsigned*)((const char*)(gbase) + (voff)[_i]), (LAS unsigned*)(lds + (bufoff) + ldsw + _i * 8192), 16, 0, 0); } while (0)
#define PG8_LDA(dst, b, h) do { _Pragma("unroll") for (int m = 0; m < 4; ++m) _Pragma("unroll") for (int k = 0; k < 2; ++k) dst[m][k] = *(const LAS bf16x8*)(lds + PG8_SA(b, h) + aoff + m * 2048 + k * 1024); } while (0)
#define PG8_LDB(dst, b, h) do { _Pragma("unroll") for (int n = 0; n < 2; ++n) _Pragma("unroll") for (int k = 0; k < 2; ++k) dst[n][k] = *(const LAS bf16x8*)(lds + PG8_SB(b, h) + boff + n * 2048 + k * 1024); } while (0)
#define PG8_MMA(ai, bj, At, Bt) do { __builtin_amdgcn_s_setprio(1); _Pragma("unroll") for (int m = 0; m < 4; ++m) _Pragma("unroll") for (int n = 0; n < 2; ++n) _Pragma("unroll") for (int k = 0; k < 2; ++k) \
        acc[ai][bj][m][n] = __builtin_amdgcn_mfma_f32_16x16x32_bf16(Bt[n][k], At[m][k], acc[ai][bj][m][n], 0, 0, 0); __builtin_amdgcn_s_setprio(0); } while (0)
#define PG8_WAIT_V(n) asm volatile("s_waitcnt vmcnt(" #n ")" ::: "memory")
#define PG8_WAIT_L(n) asm volatile("s_waitcnt lgkmcnt(" #n ")" ::: "memory")
#define PG8_BAR __builtin_amdgcn_s_barrier()
#define PG8_SCHED __builtin_amdgcn_sched_barrier(0)
    Unit cur, nxt; int ui = 0;
    if (!S.next(0, cur)) return;
    f32x4 acc[2][2][4][2];
#pragma unroll
    for (int a = 0; a < 2; ++a)
#pragma unroll
        for (int b = 0; b < 2; ++b)
#pragma unroll
            for (int m = 0; m < 4; ++m)
#pragma unroll
                for (int n = 0; n < 2; ++n) acc[a][b][m][n] = (f32x4){0.f, 0.f, 0.f, 0.f};
    bf16x8 At[4][2], B0[2][2], B1[2][2];
    const char* cA = (const char*)g.A + (size_t)cur.pm * tstep; const char* cB = (const char*)g.Bt + (size_t)cur.pn * tstep;
    if constexpr (SP2) {
        PG8_STAGE(PG8_SB(0, 0), cB, voffB); PG8_STAGE(PG8_SB(0, 1), cB + hstep, voffB); PG8_STAGE(PG8_SA(0, 0), cA, voffA); PG8_STAGE(PG8_SA(0, 1), cA + hstepA, voffA);
        if (wr == 1) PG8_BAR;
        PG8_WAIT_V(2); PG8_BAR;
        PG8_STAGE(PG8_SB(1, 0), cB + kstep, voffB); PG8_STAGE(PG8_SA(1, 0), cA + kstep, voffA); PG8_STAGE(PG8_SB(1, 1), cB + hstep + kstep, voffB);
        PG8_WAIT_V(6); PG8_BAR;
    } else {
        PG8_STAGE(PG8_SB(0, 0), cB, voffB); PG8_STAGE(PG8_SA(0, 0), cA, voffA); PG8_STAGE(PG8_SB(0, 1), cB + hstep, voffB); PG8_STAGE(PG8_SA(0, 1), cA + hstepA, voffA);
        if (wr == 1) PG8_BAR;
        PG8_WAIT_V(4); PG8_BAR;
        PG8_STAGE(PG8_SB(1, 0), cB + kstep, voffB); PG8_STAGE(PG8_SA(1, 0), cA + kstep, voffA); PG8_STAGE(PG8_SB(1, 1), cB + hstep + kstep, voffB);
        PG8_WAIT_V(6); PG8_BAR;
    }
    for (;;) {
        const bool has_next = S.next(ui + 1, nxt);
        const char* nA = has_next ? (const char*)g.A + (size_t)nxt.pm * tstep : cA; const char* nB = has_next ? (const char*)g.Bt + (size_t)nxt.pn * tstep : cB;
        for (int t = 0; t < nt; t += 2) {
            const bool last = (t == nt - 2);
            const char* a1 = cA + (size_t)(t + 1) * kstep;
            const char* a2 = last ? nA : cA + (size_t)(t + 2) * kstep; const char* b2 = last ? nB : cB + (size_t)(t + 2) * kstep;
            const char* a3 = a2 + kstep; const char* b3 = b2 + kstep;
            if constexpr (SP2) {
            PG8_LDB(B0, 0, 0); PG8_LDB(B1, 0, 1); PG8_SCHED; PG8_LDA(At, 0, 0); PG8_STAGE(PG8_SA(1, 1), a1 + hstepA, voffA);
            PG8_WAIT_V(8); PG8_WAIT_L(0); PG8_BAR; PG8_MMA(0, 0, At, B0); PG8_MMA(0, 1, At, B1); PG8_BAR; PG8_SCHED;
            PG8_LDA(At, 0, 1); PG8_STAGE(PG8_SB(0, 0), b2, voffB); PG8_STAGE(PG8_SB(0, 1), b2 + hstep, voffB); PG8_STAGE(PG8_SA(0, 0), a2, voffA);
            PG8_WAIT_V(8); PG8_WAIT_L(0); PG8_BAR; PG8_MMA(1, 0, At, B0); PG8_MMA(1, 1, At, B1); PG8_BAR; PG8_SCHED;
            PG8_LDB(B0, 1, 0); PG8_LDB(B1, 1, 1); PG8_SCHED; PG8_LDA(At, 1, 0); PG8_STAGE(PG8_SA(0, 1), a2 + hstepA, voffA);
            PG8_WAIT_V(8); PG8_WAIT_L(0); PG8_BAR; PG8_MMA(0, 0, At, B0); PG8_MMA(0, 1, At, B1); PG8_BAR; PG8_SCHED;
            PG8_LDA(At, 1, 1); PG8_STAGE(PG8_SB(1, 0), b3, voffB); PG8_STAGE(PG8_SB(1, 1), b3 + hstep, voffB); PG8_STAGE(PG8_SA(1, 0), a3, voffA);
            PG8_WAIT_V(8); PG8_WAIT_L(0); PG8_BAR; PG8_MMA(1, 0, At, B0); PG8_MMA(1, 1, At, B1); PG8_BAR; PG8_SCHED;
            } else {
            PG8_LDB(B0, 0, 0); PG8_SCHED; PG8_LDA(At, 0, 0); PG8_STAGE(PG8_SA(1, 1), a1 + hstepA, voffA);
            PG8_WAIT_L(8); PG8_BAR; PG8_WAIT_L(0); PG8_MMA(0, 0, At, B0); PG8_BAR; PG8_SCHED;
            PG8_LDB(B1, 0, 1); PG8_STAGE(PG8_SB(0, 0), b2, voffB);
            PG8_BAR; PG8_WAIT_L(0); PG8_MMA(0, 1, At, B1); PG8_BAR;
            PG8_LDA(At, 0, 1); PG8_STAGE(PG8_SA(0, 0), a2, voffA);
            PG8_BAR; PG8_WAIT_L(0); PG8_MMA(1, 0, At, B0); PG8_BAR; PG8_SCHED;
            PG8_STAGE(PG8_SB(0, 1), b2 + hstep, voffB);
            PG8_WAIT_V(6); PG8_BAR; PG8_MMA(1, 1, At, B1); PG8_BAR;
            PG8_LDB(B0, 1, 0); PG8_SCHED; PG8_LDA(At, 1, 0); PG8_STAGE(PG8_SA(0, 1), a2 + hstepA, voffA);
            PG8_WAIT_L(8); PG8_BAR; PG8_WAIT_L(0); PG8_MMA(0, 0, At, B0); PG8_BAR; PG8_SCHED;
            PG8_LDB(B1, 1, 1); PG8_STAGE(PG8_SB(1, 0), b3, voffB);
            PG8_BAR; PG8_WAIT_L(0); PG8_MMA(0, 1, At, B1); PG8_BAR;
            PG8_LDA(At, 1, 1); PG8_STAGE(PG8_SA(1, 0), a3, voffA);
            PG8_BAR; PG8_WAIT_L(0); PG8_MMA(1, 0, At, B0); PG8_BAR; PG8_SCHED;
            PG8_STAGE(PG8_SB(1, 1), b3 + hstep, voffB);
            PG8_WAIT_V(6); PG8_BAR; PG8_MMA(1, 1, At, B1); PG8_BAR;

            }
        }
        if constexpr (ALIGN_EPI) { if (wr == 0) PG8_BAR; }
        if constexpr (!Epi::AFTER_DRAIN) E(acc, cur, wr, wc, fr, fq);
        if (!has_next) break;
#pragma unroll
        for (int a = 0; a < 2; ++a)
#pragma unroll
            for (int b = 0; b < 2; ++b)
#pragma unroll
                for (int m = 0; m < 4; ++m)
#pragma unroll
                    for (int n = 0; n < 2; ++n) acc[a][b][m][n] = (f32x4){0.f, 0.f, 0.f, 0.f};
        cur = nxt; cA = nA; cB = nB; ++ui;
        if constexpr (ALIGN_EPI) { if (wr == 1) PG8_BAR; }
    }
    PG8_WAIT_V(0);
    if constexpr (!ALIGN_EPI) { if (wr == 0) PG8_BAR; }
    PG8_BAR;
    if constexpr (Epi::AFTER_DRAIN) E(acc, cur, wr, wc, fr, fq);
#undef PG8_SA
#undef PG8_SB
#undef PG8_STAGE
#undef PG8_LDA
#undef PG8_LDB
#undef PG8_MMA
#undef PG8_WAIT_V
#undef PG8_WAIT_L
#undef PG8_BAR
#undef PG8_SCHED
}

struct EpiBf16 {
    static constexpr bool PERM = true, AFTER_DRAIN = false, AROWPERM = false;
    bf16_t* O; int ldc;
    __device__ __forceinline__ void operator()(f32x4 (&acc)[2][2][4][2], const Unit& u, int wr, int wc, int fr, int fq) const {
        const int row0 = u.pm * BM + wr * 64 + fr, col0 = u.pn * BM + wc * 32 + 8 * fq;
#pragma unroll
        for (int ai = 0; ai < 2; ++ai)
#pragma unroll
            for (int m = 0; m < 4; ++m) { bf16_t* rowp = O + (size_t)(row0 + ai * HALF + m * 16) * ldc + col0;
#pragma unroll
                for (int bj = 0; bj < 2; ++bj) { const f32x4 v0 = acc[ai][bj][m][0], v1 = acc[ai][bj][m][1];
                    u32x4 w; w.x = cvt_pk_bf16_asm(v0[0], v0[1]); w.y = cvt_pk_bf16_asm(v0[2], v0[3]); w.z = cvt_pk_bf16_asm(v1[0], v1[1]); w.w = cvt_pk_bf16_asm(v1[2], v1[3]);
                    *(u32x4*)(rowp + bj * HALF) = w; } }
    }
};
struct EpiResF32 {
    static constexpr bool PERM = false, AFTER_DRAIN = false, AROWPERM = false;
    const float* X; float* O; int ldc;
    __device__ __forceinline__ void operator()(f32x4 (&acc)[2][2][4][2], const Unit& u, int wr, int wc, int fr, int fq) const {
        const int row0 = u.pm * BM + wr * 64 + fr, col0 = u.pn * BM + wc * 32 + 4 * fq;
#pragma unroll
        for (int ai = 0; ai < 2; ++ai)
#pragma unroll
            for (int m = 0; m < 4; ++m) { const size_t ro = (size_t)(row0 + ai * HALF + m * 16) * ldc + col0;
#pragma unroll
                for (int bj = 0; bj < 2; ++bj)
#pragma unroll
                    for (int n = 0; n < 2; ++n) { const f32x4 xv = *(const f32x4*)(X + ro + bj * HALF + n * 16);
                        *(f32x4*)(O + ro + bj * HALF + n * 16) = xv * ALPHA + acc[ai][bj][m][n]; } }
    }
};
template <bool XBF  , bool WF32  > struct EpiResLn {
    static constexpr bool PERM = false, AFTER_DRAIN = true, AROWPERM = false;
    const float* X; const bf16_t* XB; float* O; bf16_t* OB; const float* gam; const float* bet; float* rs; unsigned* cnt;
    __device__ __forceinline__ void operator()(f32x4 (&acc)[2][2][4][2], const Unit& u, int wr, int wc, int fr, int fq) const {
        const int row0 = u.pm * BM + wr * 64 + fr, col0 = u.pn * BM + wc * 32 + 4 * fq;
#pragma unroll
        for (int ai = 0; ai < 2; ++ai)
#pragma unroll
            for (int m = 0; m < 4; ++m) { const int row = row0 + ai * HALF + m * 16; const size_t ro = (size_t)row * DM + col0;
                float s = 0.f, q = 0.f;
#pragma unroll
                for (int bj = 0; bj < 2; ++bj)
#pragma unroll
                    for (int n = 0; n < 2; ++n) { f32x4 xv;
                        if constexpr (XBF) { const u32x2 xb2 = *(const u32x2*)(XB + ro + bj * HALF + n * 16); xv = (f32x4){bflo(xb2.x), bfhi(xb2.x), bflo(xb2.y), bfhi(xb2.y)}; }
                        else xv = *(const f32x4*)(X + ro + bj * HALF + n * 16);
                        const f32x4 z = xv * ALPHA + acc[ai][bj][m][n]; acc[ai][bj][m][n] = z;
                        s += (z[0] + z[1]) + (z[2] + z[3]); q += (z[0] * z[0] + z[1] * z[1]) + (z[2] * z[2] + z[3] * z[3]); }
                s += __shfl_xor(s, 16); s += __shfl_xor(s, 32); q += __shfl_xor(q, 16); q += __shfl_xor(q, 32);
                if (fq == 0) { (void)__hip_atomic_fetch_add(rs + 2 * row, s, __ATOMIC_RELAXED, __HIP_MEMORY_SCOPE_AGENT); (void)__hip_atomic_fetch_add(rs + 2 * row + 1, q, __ATOMIC_RELAXED, __HIP_MEMORY_SCOPE_AGENT); } }
        asm volatile("s_waitcnt vmcnt(0)" ::: "memory");
        unsigned* cp = cnt + 64 * u.pm;
        if ((threadIdx.x & 63) == 0) (void)__hip_atomic_fetch_add(cp, 1u, __ATOMIC_RELAXED, __HIP_MEMORY_SCOPE_AGENT);
        { unsigned sp = 0; while ((unsigned)__builtin_amdgcn_readfirstlane(__hip_atomic_load(cp, __ATOMIC_RELAXED, __HIP_MEMORY_SCOPE_AGENT)) < 64u) { __builtin_amdgcn_s_sleep(2); if (++sp > (1u << 22)) break; } }
        f32x4 gg[2][2], bb[2][2];
#pragma unroll
        for (int bj = 0; bj < 2; ++bj)
#pragma unroll
            for (int n = 0; n < 2; ++n) { gg[bj][n] = *(const f32x4*)(gam + col0 + bj * HALF + n * 16); bb[bj][n] = *(const f32x4*)(bet + col0 + bj * HALF + n * 16); }
#pragma unroll
        for (int ai = 0; ai < 2; ++ai)
#pragma unroll
            for (int m = 0; m < 4; ++m) { const int row = row0 + ai * HALF + m * 16; const size_t ro = (size_t)row * DM + col0;
                const float s = __hip_atomic_load(rs + 2 * row, __ATOMIC_RELAXED, __HIP_MEMORY_SCOPE_AGENT), q = __hip_atomic_load(rs + 2 * row + 1, __ATOMIC_RELAXED, __HIP_MEMORY_SCOPE_AGENT);
                const float mu = s * (1.0f / DM), rstd = rsqrtf(fmaxf(q * (1.0f / DM) - mu * mu, 0.f) + 1e-5f);
#pragma unroll
                for (int bj = 0; bj < 2; ++bj)
#pragma unroll
                    for (int n = 0; n < 2; ++n) { const f32x4 o = (acc[ai][bj][m][n] - mu) * rstd * gg[bj][n] + bb[bj][n];
                        if constexpr (WF32) *(f32x4*)(O + ro + bj * HALF + n * 16) = o;
                        if (OB) { u32x2 p; p.x = cvt_pk_bf16_asm(o[0], o[1]); p.y = cvt_pk_bf16_asm(o[2], o[3]); *(u32x2*)(OB + ro + bj * HALF + n * 16) = p; } } }
    }
};
__device__ __forceinline__ float dpp_shr1(float x) { return __builtin_bit_cast(float, __builtin_amdgcn_update_dpp(0, __builtin_bit_cast(int, x), 0x111, 0xf, 0xf, true)); }
struct EpiConvFfn {
    static constexpr bool PERM = true, AFTER_DRAIN = false, AROWPERM = true;
    bf16_t* act; float* halo; const float* cw; const float* cb;
    __device__ __forceinline__ void operator()(f32x4 (&acc)[2][2][4][2], const Unit& u, int wr, int wc, int fr, int fq) const {
        const int fcol = u.pn * 128 + wc * 32 + 8 * fq;
        const int rbase = u.pm * BM + wr * 128;
        {
            float* hb = halo + (size_t)(rbase >> 7) * 4 * NUP + fcol;
            if (fr == 0) {
#pragma unroll
                for (int bj = 0; bj < 2; ++bj)
#pragma unroll
                    for (int n = 0; n < 2; ++n) { *(f32x4*)(hb + (size_t)2 * NUP + bj * DFF + 4 * n) = acc[0][bj][0][n]; *(f32x4*)(hb + (size_t)3 * NUP + bj * DFF + 4 * n) = acc[0][bj][1][n]; }
            }
            if (fr == 15) {
#pragma unroll
                for (int bj = 0; bj < 2; ++bj)
#pragma unroll
                    for (int n = 0; n < 2; ++n) { *(f32x4*)(hb + bj * DFF + 4 * n) = acc[1][bj][2][n]; *(f32x4*)(hb + (size_t)1 * NUP + bj * DFF + 4 * n) = acc[1][bj][3][n]; }
            }
        }
        u32x2 pk0[8];
#pragma unroll
        for (int n = 0; n < 2; ++n) {
            f32x4 W0[2], W1[2], W2[2], Bb[2];
#pragma unroll
            for (int bj = 0; bj < 2; ++bj) { const int hc = bj * DFF + fcol + 4 * n;
                W0[bj] = *(const f32x4*)(cw + hc); W1[bj] = *(const f32x4*)(cw + NUP + hc); W2[bj] = *(const f32x4*)(cw + 2 * NUP + hc); Bb[bj] = *(const f32x4*)(cb + hc); }
            f32x4 E6[2], E7[2];
#pragma unroll
            for (int bj = 0; bj < 2; ++bj) { const f32x4 s6 = acc[1][bj][2][n], s7 = acc[1][bj][3][n];
                E6[bj][0] = dpp_shr1(s6[0]); E6[bj][1] = dpp_shr1(s6[1]); E6[bj][2] = dpp_shr1(s6[2]); E6[bj][3] = dpp_shr1(s6[3]);
                E7[bj][0] = dpp_shr1(s7[0]); E7[bj][1] = dpp_shr1(s7[1]); E7[bj][2] = dpp_shr1(s7[2]); E7[bj][3] = dpp_shr1(s7[3]); }
            float av[8][4];
#pragma unroll
            for (int j = 0; j < 4; ++j) {
                float hc[2][8];
#pragma unroll
                for (int bj = 0; bj < 2; ++bj) {
                    const float e6 = E6[bj][j], e7 = E7[bj][j];
#pragma unroll
                    for (int i = 0; i < 8; ++i) {
                        const float cur = acc[i >> 2][bj][i & 3][n][j];
                        const float p1 = (i >= 1) ? acc[(i - 1 >= 0 ? i - 1 : 0) >> 2][bj][(i - 1 >= 0 ? i - 1 : 0) & 3][n][j] : e7;
                        const float p2 = (i >= 2) ? acc[(i - 2 >= 0 ? i - 2 : 0) >> 2][bj][(i - 2 >= 0 ? i - 2 : 0) & 3][n][j] : (i == 1 ? e7 : e6);
                        hc[bj][i] = W2[bj][j] * cur + W1[bj][j] * p1 + W0[bj][j] * p2 + Bb[bj][j];
                    }
                }
#pragma unroll
                for (int i = 0; i < 8; ++i) { const float gt = hc[1][i]; av[i][j] = hc[0][i] * gt * __builtin_amdgcn_rcpf(1.0f + __expf(-gt)); }
            }
#pragma unroll
            for (int i = 0; i < 8; ++i) {
                u32x2 pk; pk.x = cvt_pk_bf16_asm(av[i][0], av[i][1]); pk.y = cvt_pk_bf16_asm(av[i][2], av[i][3]);
                if (n == 0) pk0[i] = pk;
                else if (i >= 2 || fr > 0) { u32x4 w; w.x = pk0[i].x; w.y = pk0[i].y; w.z = pk.x; w.w = pk.y;
                    *(u32x4*)(act + (size_t)(rbase + 8 * fr + i) * DFF + fcol) = w; }
            }
            asm volatile("" ::: "memory");
        }
    }
};
}

template <bool UPMAP>
__device__ __forceinline__ void transpose_macro(const float* W, int ldw, int k0, int n0, bf16_t* Wt, int ldt, unsigned char* lds) {
    bf16_t* sT = (bf16_t*)lds; const int tid = threadIdx.x;
    float4 v[2][4];
#pragma unroll
    for (int i = 0; i < 2; ++i)
#pragma unroll
        for (int j = 0; j < 4; ++j) v[i][j] = *(const float4*)(W + (size_t)(k0 + (tid >> 4) + 32 * i) * ldw + n0 + 64 * j + (tid & 15) * 4);
#pragma unroll
    for (int i = 0; i < 2; ++i)
#pragma unroll
        for (int j = 0; j < 4; ++j) { const int k = (tid >> 4) + 32 * i, n = 64 * j + (tid & 15) * 4;
            sT[(n + 0) * 66 + k] = f2bf(v[i][j].x); sT[(n + 1) * 66 + k] = f2bf(v[i][j].y); sT[(n + 2) * 66 + k] = f2bf(v[i][j].z); sT[(n + 3) * 66 + k] = f2bf(v[i][j].w); }
    __syncthreads();
#pragma unroll
    for (int j = 0; j < 4; ++j) { const int n = 64 * j + (tid >> 3), ks = (tid & 7) * 8; const unsigned* p = (const unsigned*)(sT + n * 66 + ks);
        u32x4 o; o.x = p[0]; o.y = p[1]; o.z = p[2]; o.w = p[3];
        int drow = n0 + n;
        if (UPMAP) { const int f = (drow < DFF) ? drow : drow - DFF; drow = 256 * (f >> 7) + (f & 127) + ((drow < DFF) ? 0 : 128); }
        *(u32x4*)(Wt + (size_t)drow * ldt + k0 + ks) = o; }
    __syncthreads();
}
constexpr int TM_IN = 32 * 28, TM_OUT = 32 * 8, TM_UP = 32 * 44, TM_DN = 88 * 8;
__device__ __forceinline__ void phase_transposes(const Args& A, unsigned char* lds, int g0, int g1, int worker, int nworkers) {
    unsigned char* ws = A.ws;
    for (int g = g0 + worker; g < g1; g += nworkers) {
        if (g < TM_IN) { const int tk = g / 28, tn = g % 28; transpose_macro<false>(A.w_in, NIN, tk * 64, tn * 256, (bf16_t*)(ws + WS_WIN), DM, lds); }
        else if (g < TM_IN + TM_OUT) { const int h = g - TM_IN, tk = h / 8, tn = h % 8; transpose_macro<false>(A.w_out, DM, tk * 64, tn * 256, (bf16_t*)(ws + WS_WOUT), DM, lds); }
        else if (g < TM_IN + TM_OUT + TM_UP) { const int h = g - TM_IN - TM_OUT, tk = h / 44, tn = h % 44; transpose_macro<true>(A.w_up, NUP, tk * 64, tn * 256, (bf16_t*)(ws + WS_WUP), DM, lds); }
        else { const int h = g - TM_IN - TM_OUT - TM_UP, tk = h / 8, tn = h % 8; transpose_macro<false>(A.w_down, DM, tk * 64, tn * 256, (bf16_t*)(ws + WS_WDN), DFF, lds); }
    }
}
__device__ __forceinline__ void phase_prologue(const Args& A, unsigned char* lds) {
    unsigned char* ws = A.ws;
    const int lane = threadIdx.x & 63, gw = blockIdx.x * 8 + (threadIdx.x >> 6), nw = gridDim.x * 8;
    bf16_t* xb = (bf16_t*)(ws + WS_XB); float* gates = (float*)(ws + WS_GATES);
    phase_transposes(A, lds, 0, TM_IN, blockIdx.x, gridDim.x);
    for (int it = gw; it < MT / 4; it += nw) {
        const int r0 = it * 4;
        float acc[4][8];
#pragma unroll
        for (int r = 0; r < 4; ++r)
#pragma unroll
            for (int q = 0; q < 8; ++q) acc[r][q] = 0.f;
#pragma unroll 1
        for (int ih = 0; ih < 2; ++ih) {
        f32x4 xq[4][4];
#pragma unroll
        for (int i = 0; i < 4; ++i)
#pragma unroll
            for (int r = 0; r < 4; ++r) xq[i][r] = *(const f32x4*)(A.x + (size_t)(r0 + r) * DM + (ih * 4 + i) * 256 + lane * 4);
#pragma unroll
        for (int i = 0; i < 4; ++i) {
            const int kb = (ih * 4 + i) * 256 + lane * 4;
            f32x4 xv[4];
#pragma unroll
            for (int r = 0; r < 4; ++r) { xv[r] = xq[i][r];
                u32x2 o; o.x = cvt_pk_bf16(xv[r][0], xv[r][1]); o.y = cvt_pk_bf16(xv[r][2], xv[r][3]); *(u32x2*)(xb + (size_t)(r0 + r) * DM + kb) = o; }
#pragma unroll
            for (int j = 0; j < 4; ++j) {
                const f32x4* wp = (const f32x4*)(A.w_in + (size_t)(kb + j) * NIN + NP);
                const f32x4 w0 = wp[0], w1 = wp[1];
#pragma unroll
                for (int r = 0; r < 4; ++r) { const float xs = xv[r][j];
                    acc[r][0] += xs * w0[0]; acc[r][1] += xs * w0[1]; acc[r][2] += xs * w0[2]; acc[r][3] += xs * w0[3];
                    acc[r][4] += xs * w1[0]; acc[r][5] += xs * w1[1]; acc[r][6] += xs * w1[2]; acc[r][7] += xs * w1[3]; }
            }
        }
        }
#pragma unroll
        for (int r = 0; r < 4; ++r)
#pragma unroll
            for (int q = 0; q < 8; ++q) { float v = acc[r][q];
#pragma unroll
                for (int off = 32; off >= 1; off >>= 1) v += __shfl_xor(v, off);
                acc[r][q] = v; }
        if (lane == 0) {
            const f32x4 b0 = *(const f32x4*)(A.b_gates), b1 = *(const f32x4*)(A.b_gates + 4);
#pragma unroll
            for (int r = 0; r < 4; ++r) {
                *(f32x4*)(gates + (size_t)(r0 + r) * 8) = (f32x4){acc[r][0] + b0[0], acc[r][1] + b0[1], acc[r][2] + b0[2], acc[r][3] + b0[3]};
                *(f32x4*)(gates + (size_t)(r0 + r) * 8 + 4) = (f32x4){acc[r][4] + b1[0], acc[r][5] + b1[1], acc[r][6] + b1[2], acc[r][7] + b1[3]}; }
        }
    }
}

__device__ __forceinline__ void phase_yconv(const Args& A) {
    const bf16_t* proj = (const bf16_t*)(A.ws + WS_PROJ); bf16_t* y = (bf16_t*)(A.ws + WS_Y);
    for (int idx = blockIdx.x * 512 + threadIdx.x; idx < MT * 128; idx += gridDim.x * 512) {
        const int row = idx >> 7, c = (idx & 127) * 8, t = row & (SEQ - 1);
        const bf16_t* pr = proj + (size_t)row * NP + c;
        const u32x4 bv = *(const u32x4*)pr;
        float cv[8];
#pragma unroll
        for (int i = 0; i < 8; ++i) cv[i] = 0.f;
#pragma unroll
        for (int j = 0; j < 3; ++j) {
            const int dt = 2 - j;
            if (t - dt >= 0) {
                const u32x4 cc = *(const u32x4*)(pr - (size_t)dt * NP + WCONV), hh = *(const u32x4*)(pr - (size_t)dt * NP + 2 * WCONV);
                const f32x4 w0 = *(const f32x4*)(A.w_sc + j * WCONV + c), w1 = *(const f32x4*)(A.w_sc + j * WCONV + c + 4);
                const float wv[8] = {w0[0], w0[1], w0[2], w0[3], w1[0], w1[1], w1[2], w1[3]};
#pragma unroll
                for (int q = 0; q < 4; ++q) { cv[2 * q] += wv[2 * q] * bflo(cc[q]) * bflo(hh[q]); cv[2 * q + 1] += wv[2 * q + 1] * bfhi(cc[q]) * bfhi(hh[q]); }
            }
        }
        u32x4 o;
#pragma unroll
        for (int q = 0; q < 4; ++q) o[q] = cvt_pk_bf16(bflo(bv[q]) * cv[2 * q], bfhi(bv[q]) * cv[2 * q + 1]);
        *(u32x4*)(y + (size_t)row * DM + c) = o;
    }
}

__device__ __forceinline__ void phase_mlstm(const Args& A, unsigned char* lds, float* hbuf) {
    const int tid = threadIdx.x, lane = tid & 63, w = tid >> 6, g = lane >> 4, l15 = lane & 15;
    const int a = w >> 2, ti = w & 3;
    unsigned char* QS = lds; unsigned char* KS = lds + 33792; unsigned char* VT = lds + 67584; unsigned char* WVT = VT + 4608; unsigned char* CT = WVT + 4608; unsigned char* XCH = CT + 33792;
    const bf16_t* proj = (const bf16_t*)(A.ws + WS_PROJ); const float* gates = (const float*)(A.ws + WS_GATES);
    float* TBC = (float*)(lds + 131088); float* TUV = TBC + 2048; float* TCM = TUV + 2048;
    for (int item = blockIdx.x; item < 256; item += gridDim.x) {
        const int xcd = item & 7, idx = item >> 3; const int bh = xcd * 2 + (idx >> 4), es = idx & 15;
        const int b = bh >> 2, hh = bh & 3, e0 = es * 16;
        const size_t row0 = (size_t)b * SEQ;
        __syncthreads();
        for (int i = tid; i < 16896 / 4; i += 512) ((unsigned*)CT)[i] = 0u;
        for (int i = tid; i < 16 * 72; i += 512) { const int r = 16 + i / 72, ci = i % 72; ((bf16_t*)VT)[r * 72 + ci] = (r == 16) ? (bf16_t)0x3F80 : (bf16_t)0; ((bf16_t*)WVT)[r * 72 + ci] = 0; }
        f32x4 Cst[2][2];
#pragma unroll
        for (int x = 0; x < 2; ++x)
#pragma unroll
            for (int et = 0; et < 2; ++et) Cst[x][et] = (f32x4){0.f, 0.f, 0.f, 0.f};
        float m_state = 0.f;
        u32x4 qr[4], kr[4], vr = (u32x4){0u, 0u, 0u, 0u};
        const bf16_t* qbase = proj + row0 * NP + 3072 + hh * 256;
#define ML_LOAD(c) do { _Pragma("unroll") for (int i = 0; i < 4; ++i) { const int p = tid + 512 * i, r = p >> 5, c16 = p & 31; const bf16_t* rp = qbase + (size_t)((c) * 64 + r) * NP + c16 * 8; \
            qr[i] = *(const u32x4*)rp; kr[i] = *(const u32x4*)(rp + 1024); } \
            if (tid < 128) vr = *(const u32x4*)(qbase + (size_t)((c) * 64 + (tid >> 1)) * NP + 2048 + e0 + (tid & 1) * 8); } while (0)
        ML_LOAD(0);
#pragma unroll 1
        for (int cc = 4 * w; cc < 4 * w + 4; ++cc) {
            const float* gp = gates + (row0 + cc * 64 + lane) * 8 + hh; const float gi = gp[0], gf = gp[4];
            const float lf = fminf(gf, 0.f) - log1pf(__expf(-fabsf(gf)));
            float bc = lf;
#pragma unroll
            for (int off = 1; off < 64; off <<= 1) { const float t = __shfl_up(bc, off); if (lane >= off) bc += t; }
            const float uv = gi - bc;
            float cm = uv;
#pragma unroll
            for (int off = 1; off < 64; off <<= 1) { const float t = __shfl_up(cm, off); if (lane >= off) cm = fmaxf(cm, t); }
            TBC[cc * 64 + lane] = bc; TUV[cc * 64 + lane] = uv; TCM[cc * 64 + lane] = cm;
        }
        __syncthreads();
#pragma unroll 1
        for (int c = 0; c < 32; ++c) {
            const float* tbc = TBC + c * 64; const float* tuv = TUV + c * 64; const float* tcm = TCM + c * 64;
            const float g_tot = tbc[63], cm63 = tcm[63];
            const float M63 = fmaxf(m_state, cm63), decay = __expf(m_state - M63);
            const float m_old = m_state;
            m_state = g_tot + M63;
#pragma unroll
            for (int i = 0; i < 4; ++i) { const int p = tid + 512 * i, r = p >> 5, c16 = p & 31; *(u32x4*)(QS + r * 528 + c16 * 16) = qr[i]; *(u32x4*)(KS + r * 528 + c16 * 16) = kr[i]; }
            { if (tid < 128) { const int s = tid >> 1, hf = tid & 1; const float wv = __expf(tuv[s] - M63);
#pragma unroll
                  for (int q = 0; q < 4; ++q) { const float v0 = bflo(vr[q]), v1 = bfhi(vr[q]);
                      ((bf16_t*)VT)[(8 * hf + 2 * q) * 72 + s] = (bf16_t)(vr[q] & 0xffffu); ((bf16_t*)VT)[(8 * hf + 2 * q + 1) * 72 + s] = (bf16_t)(vr[q] >> 16);
                      ((bf16_t*)WVT)[(8 * hf + 2 * q) * 72 + s] = f2bf(v0 * wv); ((bf16_t*)WVT)[(8 * hf + 2 * q + 1) * 72 + s] = f2bf(v1 * wv); } }
              if (w == 2) ((bf16_t*)WVT)[16 * 72 + lane] = f2bf(__expf(tuv[lane] - M63)); }
            if (c + 1 < 32) ML_LOAD(c + 1);
            __syncthreads();
            bf16x8 qf[8]; f32x4 S0 = (f32x4){0.f, 0.f, 0.f, 0.f}, S1 = S0;
#pragma unroll
            for (int kk = 0; kk < 8; ++kk) {
                qf[kk] = *(const bf16x8*)(QS + (16 * ti + l15) * 528 + kk * 64 + g * 16);
                const bf16x8 kf0 = *(const bf16x8*)(KS + (32 * a + l15) * 528 + kk * 64 + g * 16), kf1 = *(const bf16x8*)(KS + (32 * a + 16 + l15) * 528 + kk * 64 + g * 16);
                S0 = __builtin_amdgcn_mfma_f32_16x16x32_bf16(kf0, qf[kk], S0, 0, 0, 0); S1 = __builtin_amdgcn_mfma_f32_16x16x32_bf16(kf1, qf[kk], S1, 0, 0, 0);
            }
            const int tcol = 16 * ti + l15;
            const float Mt = fmaxf(m_old, tcm[tcol]);
            const f32x4 u0v = *(const f32x4*)(tuv + 32 * a + 4 * g), u1v = *(const f32x4*)(tuv + 32 * a + 16 + 4 * g);
            float p[8];
#pragma unroll
            for (int r = 0; r < 4; ++r) { const int s0 = 32 * a + 4 * g + r, s1 = s0 + 16;
                p[r] = (s0 <= tcol) ? S0[r] * 0.0625f * __expf(u0v[r] - Mt) : 0.f; p[4 + r] = (s1 <= tcol) ? S1[r] * 0.0625f * __expf(u1v[r] - Mt) : 0.f; }
            u32x4 pau; pau.x = cvt_pk_bf16(p[0], p[1]); pau.y = cvt_pk_bf16(p[2], p[3]); pau.z = cvt_pk_bf16(p[4], p[5]); pau.w = cvt_pk_bf16(p[6], p[7]);
            const bf16x8 pa = __builtin_bit_cast(bf16x8, pau);
            f32x4 rr[2];
#pragma unroll
            for (int et = 0; et < 2; ++et) { const unsigned char* vp = VT + (16 * et + l15) * 144 + (32 * a + 4 * g) * 2;
                const u32x2 lo = *(const u32x2*)vp, hi = *(const u32x2*)(vp + 32);
                u32x4 vbu; vbu.x = lo.x; vbu.y = lo.y; vbu.z = hi.x; vbu.w = hi.y;
                rr[et] = __builtin_amdgcn_mfma_f32_16x16x32_bf16(pa, __builtin_bit_cast(bf16x8, vbu), (f32x4){0.f, 0.f, 0.f, 0.f}, 0, 0, 0); }
            const f32x4 cmr = *(const f32x4*)(tcm + 16 * ti + 4 * g), bcr = *(const f32x4*)(tbc + 16 * ti + 4 * g);
            {
                const unsigned char* CTc = CT + (c & 1) * 16896;
                f32x4 in0 = (f32x4){0.f, 0.f, 0.f, 0.f}, in1 = in0;
#pragma unroll
                for (int k2 = 0; k2 < 4; ++k2) {
                    const bf16x8 qa = a ? qf[4 + k2] : qf[k2];
                    const bf16x8 c0 = *(const bf16x8*)(CTc + (l15) * 528 + (128 * a + 32 * k2 + 8 * g) * 2), c1 = *(const bf16x8*)(CTc + (16 + l15) * 528 + (128 * a + 32 * k2 + 8 * g) * 2);
                    in0 = __builtin_amdgcn_mfma_f32_16x16x32_bf16(qa, c0, in0, 0, 0, 0); in1 = __builtin_amdgcn_mfma_f32_16x16x32_bf16(qa, c1, in1, 0, 0, 0);
                }
#pragma unroll
                for (int r = 0; r < 4; ++r) { const float iw = __expf(m_old - fmaxf(m_old, cmr[r])) * 0.0625f; rr[0][r] += in0[r] * iw; rr[1][r] += in1[r] * iw; }
            }
            if (a == 1) { *(f32x4*)(XCH + ((ti * 2 + 0) * 64 + lane) * 16) = rr[0]; *(f32x4*)(XCH + ((ti * 2 + 1) * 64 + lane) * 16) = rr[1]; }
            {
                unsigned char* CTn = CT + ((c + 1) & 1) * 16896;
#pragma unroll
                for (int x = 0; x < 2; ++x) {
                    const int dt = 2 * w + x;
#pragma unroll
                    for (int et = 0; et < 2; ++et) Cst[x][et] *= decay;
#pragma unroll
                    for (int ks = 0; ks < 2; ++ks) {
                        const s16x4 klo = __builtin_amdgcn_ds_read_tr16_b64_v4i16((LAS s16x4*)(KS + (32 * ks + 8 * g + (l15 >> 2)) * 528 + (16 * dt + 4 * (l15 & 3)) * 2));
                        const s16x4 khi = __builtin_amdgcn_ds_read_tr16_b64_v4i16((LAS s16x4*)(KS + (32 * ks + 8 * g + 4 + (l15 >> 2)) * 528 + (16 * dt + 4 * (l15 & 3)) * 2));
                        const bf16x8 ka = {klo[0], klo[1], klo[2], klo[3], khi[0], khi[1], khi[2], khi[3]};
#pragma unroll
                        for (int et = 0; et < 2; ++et) { const bf16x8 wvb = *(const bf16x8*)(WVT + (16 * et + l15) * 144 + (32 * ks + 8 * g) * 2);
                            Cst[x][et] = __builtin_amdgcn_mfma_f32_16x16x32_bf16(ka, wvb, Cst[x][et], 0, 0, 0); }
                    }
#pragma unroll
                    for (int et = 0; et < 2; ++et) { u32x2 o; o.x = cvt_pk_bf16(Cst[x][et][0], Cst[x][et][1]); o.y = cvt_pk_bf16(Cst[x][et][2], Cst[x][et][3]);
                        *(u32x2*)(CTn + (16 * et + l15) * 528 + (16 * dt + 4 * g) * 2) = o; }
                }
            }
            __syncthreads();
            if (a == 0) {
                const f32x4 o0 = *(const f32x4*)(XCH + ((ti * 2 + 0) * 64 + lane) * 16), o1 = *(const f32x4*)(XCH + ((ti * 2 + 1) * 64 + lane) * 16);
#pragma unroll
                for (int r = 0; r < 4; ++r) {
                    const float den = __shfl(rr[1][r] + o1[r], lane & 48), fl = __expf(-(bcr[r] + fmaxf(m_old, cmr[r])));
                    const float hv = (rr[0][r] + o0[r]) * __builtin_amdgcn_rcpf(fmaxf(fabsf(den), fl));
                    hbuf[(row0 + c * 64 + 16 * ti + 4 * g + r) * 1024 + hh * 256 + e0 + l15] = hv;
                }
            }
        }
#undef ML_LOAD
    }
}

__device__ __forceinline__ void phase_headnorm(const Args& A, const float* hbuf) {
    const bf16_t* proj = (const bf16_t*)(A.ws + WS_PROJ); bf16_t* y = (bf16_t*)(A.ws + WS_Y);
    const int lane = threadIdx.x & 63, gw = blockIdx.x * 8 + (threadIdx.x >> 6), nw = gridDim.x * 8;
    f32x4 gn[4];
#pragma unroll
    for (int hh = 0; hh < 4; ++hh) gn[hh] = *(const f32x4*)(A.mh_gain + hh * 256 + lane * 4);
    for (int row = gw; row < MT; row += nw) {
        f32x4 hv[4]; u32x2 ov[4]; float s[4], q[4];
#pragma unroll
        for (int hh = 0; hh < 4; ++hh) { hv[hh] = *(const f32x4*)(hbuf + (size_t)row * 1024 + hh * 256 + lane * 4); ov[hh] = *(const u32x2*)(proj + (size_t)row * NP + 6144 + hh * 256 + lane * 4); }
#pragma unroll
        for (int hh = 0; hh < 4; ++hh) s[hh] = (hv[hh][0] + hv[hh][1]) + (hv[hh][2] + hv[hh][3]);
#pragma unroll
        for (int off = 32; off >= 1; off >>= 1)
#pragma unroll
            for (int hh = 0; hh < 4; ++hh) s[hh] += __shfl_xor(s[hh], off);
#pragma unroll
        for (int hh = 0; hh < 4; ++hh) { const float mu = s[hh] * (1.0f / 256.0f); hv[hh] = hv[hh] - mu; q[hh] = (hv[hh][0] * hv[hh][0] + hv[hh][1] * hv[hh][1]) + (hv[hh][2] * hv[hh][2] + hv[hh][3] * hv[hh][3]); }
#pragma unroll
        for (int off = 32; off >= 1; off >>= 1)
#pragma unroll
            for (int hh = 0; hh < 4; ++hh) q[hh] += __shfl_xor(q[hh], off);
#pragma unroll
        for (int hh = 0; hh < 4; ++hh) {
            const float rstd = rsqrtf(q[hh] * (1.0f / 256.0f) + 1e-6f);
            const float o0 = bflo(ov[hh].x), o1 = bfhi(ov[hh].x), o2 = bflo(ov[hh].y), o3 = bfhi(ov[hh].y);
            const float y0 = hv[hh][0] * rstd * gn[hh][0] * __builtin_amdgcn_rcpf(1.0f + __expf(-o0)), y1 = hv[hh][1] * rstd * gn[hh][1] * __builtin_amdgcn_rcpf(1.0f + __expf(-o1));
            const float y2 = hv[hh][2] * rstd * gn[hh][2] * __builtin_amdgcn_rcpf(1.0f + __expf(-o2)), y3 = hv[hh][3] * rstd * gn[hh][3] * __builtin_amdgcn_rcpf(1.0f + __expf(-o3));
            u32x2 o; o.x = cvt_pk_bf16(y0, y1); o.y = cvt_pk_bf16(y2, y3);
            *(u32x2*)(y + (size_t)row * DM + WCONV + hh * 256 + lane * 4) = o;
        }
    }
}

__device__ __forceinline__ void phase_ln(float* io, const float* gam, const float* bet, bf16_t* ob) {
    const int lane = threadIdx.x & 63, gw = blockIdx.x * 8 + (threadIdx.x >> 6), nw = gridDim.x * 8;
    for (int row = gw; row < MT; row += nw) {
        float* rp = io + (size_t)row * DM;
        f32x4 v[8]; float s = 0.f;
#pragma unroll
        for (int i = 0; i < 8; ++i) { v[i] = *(const f32x4*)(rp + i * 256 + lane * 4); s += (v[i][0] + v[i][1]) + (v[i][2] + v[i][3]); }
#pragma unroll
        for (int off = 32; off >= 1; off >>= 1) s += __shfl_xor(s, off);
        const float mu = s * (1.0f / DM);
        float q = 0.f;
#pragma unroll
        for (int i = 0; i < 8; ++i) { v[i] = v[i] - mu; q += (v[i][0] * v[i][0] + v[i][1] * v[i][1]) + (v[i][2] * v[i][2] + v[i][3] * v[i][3]); }
#pragma unroll
        for (int off = 32; off >= 1; off >>= 1) q += __shfl_xor(q, off);
        const float rstd = rsqrtf(q * (1.0f / DM) + 1e-5f);
#pragma unroll
        for (int i = 0; i < 8; ++i) { const f32x4 gg = *(const f32x4*)(gam + i * 256 + lane * 4), bb = *(const f32x4*)(bet + i * 256 + lane * 4);
            const f32x4 o = v[i] * rstd * gg + bb;
            *(f32x4*)(rp + i * 256 + lane * 4) = o;
            if (ob) { u32x2 p; p.x = cvt_pk_bf16(o[0], o[1]); p.y = cvt_pk_bf16(o[2], o[3]); *(u32x2*)(ob + (size_t)row * DM + i * 256 + lane * 4) = p; } }
    }
}

__device__ __forceinline__ void phase_fixup(const Args& A) {
    const float* halo = (const float*)(A.ws + WS_HALO); bf16_t* act = (bf16_t*)(A.ws + WS_ACT);
    for (int idx = blockIdx.x * 512 + threadIdx.x; idx < 64 * 2 * (DFF / 4); idx += gridDim.x * 512) {
        const int f = (idx % (DFF / 4)) * 4, br = idx / (DFF / 4), rr = br & 1, B = br >> 1;
        const bool first = (B & 15) == 0;
        const float* hc = halo + (size_t)B * 4 * NUP; const float* hp = hc - 4 * NUP;
        f32x4 hv[2];
#pragma unroll
        for (int bj = 0; bj < 2; ++bj) {
            const int col = bj * DFF + f;
            const f32x4 cur = *(const f32x4*)(hc + (size_t)(2 + rr) * NUP + col);
            f32x4 p1, p2; const f32x4 z = (f32x4){0.f, 0.f, 0.f, 0.f};
            if (rr == 0) { p1 = first ? z : *(const f32x4*)(hp + (size_t)1 * NUP + col); p2 = first ? z : *(const f32x4*)(hp + col); }
            else { p1 = *(const f32x4*)(hc + (size_t)2 * NUP + col); p2 = first ? z : *(const f32x4*)(hp + (size_t)1 * NUP + col); }
            const f32x4 w0 = *(const f32x4*)(A.w_fc + col), w1 = *(const f32x4*)(A.w_fc + NUP + col), w2 = *(const f32x4*)(A.w_fc + 2 * NUP + col), bb = *(const f32x4*)(A.b_fc + col);
            hv[bj] = w2 * cur + w1 * p1 + w0 * p2 + bb;
        }
        float av[4];
#pragma unroll
        for (int j = 0; j < 4; ++j) { const float gt = hv[1][j]; av[j] = hv[0][j] * gt / (1.0f + __expf(-gt)); }
        u32x2 o; o.x = cvt_pk_bf16(av[0], av[1]); o.y = cvt_pk_bf16(av[2], av[3]);
        *(u32x2*)(act + (size_t)(B * 128 + rr) * DFF + f) = o;
    }
}

__device__ __forceinline__ void phase_dump(const bf16_t* src, int ld, int c0, float* out) {
    for (size_t idx = (size_t)blockIdx.x * 512 + threadIdx.x; idx < (size_t)MT * DM; idx += (size_t)gridDim.x * 512) {
        const size_t row = idx / DM, col = idx % DM; out[idx] = bflo((unsigned)src[row * ld + c0 + col]); }
}
#ifndef DBG_STOP
#define DBG_STOP -1
#endif
#define XB_TMO      128
#define XB_XCNT(j)  (256  + 64 * (j))
#define XB_XSUB(j)  (1280 + 64 * (j))
#define XB_XGEN(j)  (2304 + 64 * (j))
#define XB_TOP      3328
#define XB_TOPGEN   3392
#define XCD_BAR_WORDS 3456
#define XB_SPIN_CAP (1u << 22)
__device__ __forceinline__ unsigned xb_ld(unsigned* p)              { return __hip_atomic_load(p, __ATOMIC_RELAXED, __HIP_MEMORY_SCOPE_AGENT); }
__device__ __forceinline__ unsigned xb_add(unsigned* p, unsigned v) { return __hip_atomic_fetch_add(p, v, __ATOMIC_RELAXED, __HIP_MEMORY_SCOPE_AGENT); }
__device__ __forceinline__ unsigned xb_xcc_id() { return (unsigned)__builtin_amdgcn_s_getreg((3 << 11) | 20) & 0xFu; }
#define XB_SPIN(cond, bar) do { unsigned _sp = 0; while (cond) { __builtin_amdgcn_s_sleep(1); \
    if ((++_sp & 255u) == 0u) { if (xb_ld(&(bar)[XB_TMO])) break; if (_sp > XB_SPIN_CAP) { atomicAdd(&(bar)[XB_TMO], 1u); break; } } } } while (0)
struct XcdBarrier { unsigned* bar; unsigned x; volatile LAS unsigned* st; };
__device__ __forceinline__ XcdBarrier xcd_barrier_post(unsigned* bar, volatile LAS unsigned* st) {
    XcdBarrier b; b.bar = bar; b.x = xb_xcc_id(); b.st = st;
    if (threadIdx.x == 0) (void)xb_add(&bar[XB_XCNT(b.x)], 1u);
    return b;
}
__device__ __forceinline__ void xcd_barrier_complete(unsigned* bar, unsigned x, unsigned& nloc, unsigned& nx) {
    const unsigned G = gridDim.x * gridDim.y * gridDim.z;
    unsigned sum, cnt, mine, sp = 0u;
    for (;;) {
        sum = 0u; cnt = 0u; mine = 0u;
#pragma unroll
        for (unsigned j = 0; j < 16; ++j) { const unsigned c = xb_ld(&bar[XB_XCNT(j)]); sum += c; cnt += (c > 0u) ? 1u : 0u; mine = (j == x) ? c : mine; }
        if (sum == G) break;
        __builtin_amdgcn_s_sleep(1);
        if ((++sp & 255u) == 0u) { if (xb_ld(&bar[XB_TMO])) break; if (sp > XB_SPIN_CAP) { atomicAdd(&bar[XB_TMO], 1u); break; } }
    }
    nloc = mine > 0u ? mine : 1u; nx = cnt > 0u ? cnt : 1u;
}
__device__ __forceinline__ void xcd_barrier(const XcdBarrier& b) {
    asm volatile("s_waitcnt vmcnt(0)" ::: "memory");
    __syncthreads();
    if (threadIdx.x == 0) {
        unsigned* bar = b.bar;
        __builtin_amdgcn_s_waitcnt(0);
        unsigned nloc = b.st[0], nx = b.st[1];
        if (nloc == 0u) { xcd_barrier_complete(bar, b.x, nloc, nx); b.st[0] = nloc; b.st[1] = nx; }
        const unsigned old = xb_add(&bar[XB_XSUB(b.x)], 1u);
        const unsigned gen = old / nloc;
        if (old + 1u == (gen + 1u) * nloc) {
            __builtin_amdgcn_fence(__ATOMIC_RELEASE, "agent");
            asm volatile("s_waitcnt vmcnt(0)" ::: "memory");
            const unsigned og = xb_add(&bar[XB_TOP], 1u);
            const unsigned tg = og / nx;
            if (og + 1u == (tg + 1u) * nx) xb_add(&bar[XB_TOPGEN], 1u);
            else XB_SPIN(xb_ld(&bar[XB_TOPGEN]) == tg, bar);
            __builtin_amdgcn_fence(__ATOMIC_ACQUIRE, "agent");
            xb_add(&bar[XB_XGEN(b.x)], 1u);
            asm volatile("s_waitcnt vmcnt(0)" ::: "memory");
        } else {
            XB_SPIN(xb_ld(&bar[XB_XGEN(b.x)]) == gen, bar);
            __builtin_amdgcn_fence(__ATOMIC_ACQUIRE, "agent");
            asm volatile("s_waitcnt vmcnt(0)" ::: "memory");
        }
    }
    __syncthreads();
}

constexpr int N_PHASES = 10;
#ifndef ONLY_PH
#define ONLY_PH -1
#endif
#define PH_ON(x) (ONLY_PH < 0 || ONLY_PH == (x))
__global__ void __launch_bounds__(512, 2) mega(Args a) {
    extern __shared__ __attribute__((aligned(16))) unsigned char lds[];
    cg::grid_group grid = cg::this_grid();
    unsigned char* ws = a.ws;
#define PH_RUN(x) (PH_ON(x) && a.ph_lo <= (x) && (x) < a.ph_hi)
#define PH_SYNC(x) do { if (a.ph_lo <= (x) && (x) + 1 < a.ph_hi) xcd_barrier(xb); } while (0)
    volatile LAS unsigned* xst = (volatile LAS unsigned*)((LAS unsigned char*)lds + 131072);
    if (threadIdx.x == 0) { xst[0] = 0u; xst[1] = 0u; }
    __syncthreads();
    const XcdBarrier xb = xcd_barrier_post((unsigned*)(ws + WS_BAR), xst);
    if (a.ph_hi > 1000) grid.sync();
#ifndef REP0
#define REP0 1
#endif
#ifndef REP2
#define REP2 1
#endif
#ifndef REP6
#define REP6 1
#endif
    if (PH_RUN(0)) for (int rep = 0; rep < REP0; ++rep) phase_prologue(a, lds);
    PH_SYNC(0);
    if (PH_RUN(1)) { pg8::Gemm g{(const bf16_t*)(ws + WS_XB), (const bf16_t*)(ws + WS_WIN), MT, NP, DM}; pg8::StaticOrder S; S.init(MT, NP, gridDim.x, blockIdx.x);
        pg8::EpiBf16 E{(bf16_t*)(ws + WS_PROJ), NP}; pg8::gemm_phase<pg8::EpiBf16, true>((LAS unsigned char*)lds, g, S, E);
        const int rem = ((MT / 256) * (NP / 256)) % (int)gridDim.x;
        if (rem == 0) phase_transposes(a, lds, TM_IN, TM_IN + TM_OUT + TM_UP, blockIdx.x, gridDim.x);
        else if ((int)blockIdx.x >= rem) phase_transposes(a, lds, TM_IN, TM_IN + TM_OUT + TM_UP, blockIdx.x - rem, gridDim.x - rem); }
    PH_SYNC(1);
    if (PH_RUN(2)) for (int rep = 0; rep < REP2; ++rep) { phase_yconv(a); phase_mlstm(a, lds, a.out); }
    PH_SYNC(2);
    if (PH_RUN(3)) phase_headnorm(a, a.out);
    PH_SYNC(3);
    if (PH_RUN(4)) { pg8::Gemm g{(const bf16_t*)(ws + WS_Y), (const bf16_t*)(ws + WS_WOUT), MT, DM, DM}; pg8::StaticOrder S; S.init(MT, DM, gridDim.x, blockIdx.x);
        if (a.fuse_ln) { pg8::EpiResLn<false, false> E{a.x, nullptr, nullptr, (bf16_t*)(ws + WS_X1B), a.ln1_g, a.ln1_b, (float*)(ws + WS_RS1), (unsigned*)(ws + WS_CNT)}; pg8::gemm_phase((LAS unsigned char*)lds, g, S, E); }
        else { pg8::EpiResF32 E{a.x, a.out, DM}; pg8::gemm_phase((LAS unsigned char*)lds, g, S, E); } }
    PH_SYNC(4);
    if (PH_RUN(5) && !a.fuse_ln) phase_ln(a.out, a.ln1_g, a.ln1_b, (bf16_t*)(ws + WS_X1B));
    if (!a.fuse_ln) PH_SYNC(5);
    if (PH_RUN(6)) { pg8::Gemm g{(const bf16_t*)(ws + WS_X1B), (const bf16_t*)(ws + WS_WUP), MT, NUP, DM}; pg8::StaticOrder S; S.init(MT, NUP, gridDim.x, blockIdx.x);
        pg8::EpiConvFfn E{(bf16_t*)(ws + WS_ACT), (float*)(ws + WS_HALO), a.w_fc, a.b_fc}; pg8::gemm_phase<pg8::EpiConvFfn, true>((LAS unsigned char*)lds, g, S, E);
        const int rem = ((MT / 256) * (NUP / 256)) % (int)gridDim.x; const int t0 = TM_IN + TM_OUT + TM_UP, t1 = t0 + TM_DN;
        if (rem == 0) phase_transposes(a, lds, t0, t1, blockIdx.x, gridDim.x);
        else if ((int)blockIdx.x >= rem) phase_transposes(a, lds, t0, t1, blockIdx.x - rem, gridDim.x - rem); }
    PH_SYNC(6);
    if (PH_RUN(7)) phase_fixup(a);
    PH_SYNC(7);
    if (PH_RUN(8)) { pg8::Gemm g{(const bf16_t*)(ws + WS_ACT), (const bf16_t*)(ws + WS_WDN), MT, DM, DFF}; pg8::StaticOrder S; S.init(MT, DM, gridDim.x, blockIdx.x);
        if (a.fuse_ln) { pg8::EpiResLn<true, true> E{nullptr, (const bf16_t*)(ws + WS_X1B), a.out, nullptr, a.ln2_g, a.ln2_b, (float*)(ws + WS_RS2), (unsigned*)(ws + WS_CNT) + 32 * 64}; pg8::gemm_phase((LAS unsigned char*)lds, g, S, E); }
        else { pg8::EpiResF32 E{a.out, a.out, DM}; pg8::gemm_phase((LAS unsigned char*)lds, g, S, E); } }
    if (!a.fuse_ln) PH_SYNC(8);
    if (PH_RUN(9) && !a.fuse_ln) phase_ln(a.out, a.ln2_g, a.ln2_b, nullptr);
    if (DBG_STOP == 1 && a.ph_lo == 101) phase_dump((const bf16_t*)(ws + WS_PROJ), NP, 3072, a.out);
    if (DBG_STOP == 3 && a.ph_lo == 103) phase_dump((const bf16_t*)(ws + WS_Y), DM, 0, a.out);
    if (DBG_STOP == 7 && a.ph_lo == 107) phase_dump((const bf16_t*)(ws + WS_ACT), DFF, 0, a.out);
}

extern "C" void kernel_launch(void* const* d_in, const int* in_sizes, int n_in, void* d_out, int out_size, void* d_ws, size_t ws_size, hipStream_t stream) {
    static int grid = 0;
    if (grid == 0) {
        if (n_in != 14 || ws_size < WS_END) { fprintf(stderr, "kernel_launch: unexpected n_in %d / ws_size %zu (need %zu)\n", n_in, ws_size, (size_t)WS_END); grid = -1; return; }
        int dev = 0, cus = 0, per_cu = 0;
        hipGetDevice(&dev); hipDeviceGetAttribute(&cus, hipDeviceAttributeMultiprocessorCount, dev);
        if (hipFuncSetAttribute((const void*)mega, hipFuncAttributeMaxDynamicSharedMemorySize, LDS_BYTES) != hipSuccess) { fprintf(stderr, "kernel_launch: hipFuncSetAttribute failed\n"); grid = -1; return; }
        if (hipOccupancyMaxActiveBlocksPerMultiprocessor(&per_cu, (const void*)mega, 512, LDS_BYTES) != hipSuccess || per_cu < 1) { fprintf(stderr, "kernel_launch: occupancy query failed (%d)\n", per_cu); (void)hipGetLastError(); per_cu = 1; }
        grid = cus * 1;
        fprintf(stderr, "kernel_launch: cus %d per_cu %d grid %d\n", cus, per_cu, grid);
    }
    if (grid < 0) return;
    if (hipMemsetAsync((char*)d_ws + WS_BAR, 0, WS_END - WS_BAR, stream)     != hipSuccess) { fprintf(stderr, "kernel_launch: memset failed\n"); return; }
    Args a{};
    a.x = (const float*)d_in[0]; a.w_in = (const float*)d_in[1]; a.b_gates = (const float*)d_in[2]; a.w_sc = (const float*)d_in[3]; a.mh_gain = (const float*)d_in[4]; a.w_out = (const float*)d_in[5];
    a.ln1_g = (const float*)d_in[6]; a.ln1_b = (const float*)d_in[7]; a.w_up = (const float*)d_in[8]; a.w_fc = (const float*)d_in[9]; a.b_fc = (const float*)d_in[10]; a.w_down = (const float*)d_in[11];
    a.ln2_g = (const float*)d_in[12]; a.ln2_b = (const float*)d_in[13];
    a.out = (float*)d_out; a.ws = (unsigned char*)d_ws;
    a.fuse_ln = (MK_SINGLE && grid == 256) ? 1 : 0;
#if MK_SINGLE
    a.ph_lo = 0; a.ph_hi = N_PHASES;
    void* args[] = {&a};
    hipError_t e = hipLaunchCooperativeKernel((const void*)mega, dim3(grid), dim3(512), args, LDS_BYTES, stream);
    if (e != hipSuccess) fprintf(stderr, "cooperative launch failed: %s (grid %d)\n", hipGetErrorString(e), grid);
#else
    for (int ph = 0; ph < N_PHASES; ++ph) { if (DBG_STOP >= 0 && ph > DBG_STOP) break; a.ph_lo = ph; a.ph_hi = ph + 1; hipLaunchKernelGGL(mega, dim3(grid), dim3(512), LDS_BYTES, stream, a); }
    if (DBG_STOP >= 0) { a.ph_lo = 100 + DBG_STOP; a.ph_hi = 101 + DBG_STOP; hipLaunchKernelGGL(mega, dim3(grid), dim3(512), LDS_BYTES, stream, a); }
#endif
}
```

```cpp
#include <hip/hip_runtime.h>
#include <hip/hip_cooperative_groups.h>
#include <cstdio>
#include <cstdint>
namespace cg = cooperative_groups;

#ifndef MK_SINGLE
#define MK_SINGLE 1
#endif

#define LAS __attribute__((address_space(3)))
typedef unsigned short bf16_t;
typedef short bf16x8 __attribute__((ext_vector_type(8)));
typedef float f32x4 __attribute__((ext_vector_type(4)));
typedef unsigned u32x4 __attribute__((ext_vector_type(4)));
typedef unsigned u32x2 __attribute__((ext_vector_type(2)));
typedef short s16x4 __attribute__((ext_vector_type(4)));

constexpr int MT = 8192, DM = 2048, SEQ = 2048, NIN = 7176, NP = 7168, DFF = 5632, NUP = 11264, WCONV = 1024;
constexpr float ALPHA = 1.189207115002721f;
constexpr size_t WS_WIN = 0;
constexpr size_t WS_WOUT = WS_WIN + (size_t)NP * DM * 2;
constexpr size_t WS_WUP = WS_WOUT + (size_t)DM * DM * 2;
constexpr size_t WS_WDN = WS_WUP + (size_t)NUP * DM * 2;
constexpr size_t WS_X1B = WS_WDN + (size_t)DM * DFF * 2;
constexpr size_t WS_GATES = WS_X1B + (size_t)MT * DM * 2;
constexpr size_t WS_C = WS_GATES + (size_t)MT * 8 * 4;
constexpr size_t WS_PROJ = WS_C;
constexpr size_t WS_Y = WS_PROJ + (size_t)MT * NP * 2;
constexpr size_t WS_XB = WS_Y + (size_t)MT * DM * 2;
constexpr size_t WS_ACT = WS_C;
constexpr size_t WS_HALO = WS_ACT + (size_t)MT * DFF * 2;
constexpr size_t WS_BAR = WS_XB + (size_t)MT * DM * 2;
constexpr size_t WS_RS1 = WS_BAR + 16384;
constexpr size_t WS_RS2 = WS_RS1 + (size_t)MT * 8;
constexpr size_t WS_CNT = WS_RS2 + (size_t)MT * 8;
constexpr size_t WS_END = WS_CNT + 2 * 32 * 256;
constexpr int LDS_BYTES = 131072 + 16 + 3 * 32 * 64 * 4;

struct Args {
    const float* x; const float* w_in; const float* b_gates; const float* w_sc; const float* mh_gain; const float* w_out;
    const float* ln1_g; const float* ln1_b; const float* w_up; const float* w_fc; const float* b_fc; const float* w_down;
    const float* ln2_g; const float* ln2_b;
    float* out; unsigned char* ws; int ph_lo, ph_hi, fuse_ln, pad0;
};

typedef __bf16 bf16v2 __attribute__((ext_vector_type(2)));
typedef float f32x2 __attribute__((ext_vector_type(2)));
__device__ __forceinline__ unsigned cvt_pk_bf16(float lo, float hi) { const f32x2 v = {lo, hi}; const bf16v2 r = __builtin_convertvector(v, bf16v2); return __builtin_bit_cast(unsigned, r); }
__device__ __forceinline__ unsigned cvt_pk_bf16_asm(float lo, float hi) { unsigned r; asm volatile("v_cvt_pk_bf16_f32 %0, %1, %2" : "=v"(r) : "v"(lo), "v"(hi)); return r; }
__device__ __forceinline__ float bflo(unsigned u) { return __uint_as_float(u << 16); }
__device__ __forceinline__ float bfhi(unsigned u) { return __uint_as_float(u & 0xffff0000u); }
__device__ __forceinline__ bf16_t f2bf(float f) { unsigned u = __float_as_uint(f); u += 0x7FFFu + ((u >> 16) & 1u); return (bf16_t)(u >> 16); }

namespace pg8 {
constexpr int BM = 256, BK = 64, HALF = 128, HTB = HALF * BK * 2, STAGE_BYTES = 8 * HTB, NXCD = 8, WGM = 8;
__host__ __device__ __forceinline__ int lds_byte(int r, int c) { const int st = (r >> 4) * 2 + (c >> 5), rr = r & 15, cc = c & 31, ob = rr * 64 + cc * 2; return st * 1024 + (ob ^ (((ob >> 9) & 1) << 5)); }
__host__ __device__ __forceinline__ void stage_rc(int b, int& R, int& C) { const int st = b / 1024, sb = b % 1024, swz = sb ^ (((sb >> 9) & 1) << 5); R = (st >> 1) * 16 + swz / 64; C = (st & 1) * 32 + (swz % 64) / 2; }
__host__ __device__ __forceinline__ int perm32(int rho) { const int n = rho >> 4, i = rho & 15; return 8 * (i >> 2) + 4 * n + (i & 3); }
struct Unit { int pm, pn; };
struct Gemm { const bf16_t* A; const bf16_t* Bt; int M, N, K; };
struct StaticOrder {
    int nM, nN, nwg, G, c;
    __device__ void init(int M, int N, int G_, int c_) { nM = M / BM; nN = N / BM; nwg = nM * nN; G = G_; c = c_; }
    __device__ bool next(int i, Unit& u) const {
        const long L = (long)i * G + c; if (L >= nwg) return false;
        int wgid = (int)L; { const int q = nwg / NXCD, r = nwg % NXCD, xcd = wgid % NXCD, off = wgid / NXCD; wgid = (xcd < r ? xcd * (q + 1) : r * (q + 1) + (xcd - r) * q) + off; }
        const int nig = WGM * nN, gid = wgid / nig, fm = gid * WGM, gsz = (nM - fm) < WGM ? (nM - fm) : WGM;
        u.pm = fm + ((wgid % nig) % gsz); u.pn = (wgid % nig) / gsz; return true;
    }
};

template <class Epi, bool ALIGN_EPI = false, bool SP2 = true>
__device__ __forceinline__ void gemm_phase(LAS unsigned char* lds, const Gemm g, const StaticOrder& S, const Epi& E) {
    const int tid = threadIdx.x, wid = __builtin_amdgcn_readfirstlane(tid >> 6), lane = tid & 63, wr = wid >> 2, wc = wid & 3, fr = lane & 15, fq = lane >> 4;
    const int K = g.K, nt = K / BK;
    unsigned voffA[2], voffB[2];
#pragma unroll
    for (int i = 0; i < 2; ++i) { int R, C; stage_rc(tid * 16 + i * 8192, R, C); const int Rb = Epi::PERM ? ((R & ~31) + perm32(R & 31)) : R;
        const int Ra = Epi::AROWPERM ? (128 * (R >> 6) + 8 * (R & 15) + ((R >> 4) & 3)) : R;
        voffA[i] = (unsigned)(Ra * K + C) * 2u; voffB[i] = (unsigned)(Rb * K + C) * 2u; }
    const size_t kstep = (size_t)(BK * 2);
    const size_t hstep = (size_t)HALF * K * 2;
    const size_t hstepA = Epi::AROWPERM ? (size_t)4 * K * 2 : hstep;
    const size_t tstep = 2 * hstep;
    const unsigned ldsw = (unsigned)wid * 1024u;
    const int aoff = lds_byte(wr * 64 + fr, fq * 8), boff = lds_byte(wc * 32 + fr, fq * 8);
#define PG8_SA(b, h) (((b) * 2 + (h)) * HTB)
#define PG8_SB(b, h) ((4 + (b) * 2 + (h)) * HTB)
#define PG8_STAGE(bufoff, gbase, voff) do { _Pragma("unroll") for (int _i = 0; _i < 2; ++_i) \
        __builtin_amdgcn_global_load_lds((const unsigned*)((const char*)(gbase) + (voff)[_i]), (LAS unsigned*)(lds + (bufoff) + ldsw + _i * 8192), 16, 0, 0); } while (0)
#define PG8_LDA(dst, b, h) do { _Pragma("unroll") for (int m = 0; m < 4; ++m) _Pragma("unroll") for (int k = 0; k < 2; ++k) dst[m][k] = *(const LAS bf16x8*)(lds + PG8_SA(b, h) + aoff + m * 2048 + k * 1024); } while (0)
#define PG8_LDB(dst, b, h) do { _Pragma("unroll") for (int n = 0; n < 2; ++n) _Pragma("unroll") for (int k = 0; k < 2; ++k) dst[n][k] = *(const LAS bf16x8*)(lds + PG8_SB(b, h) + boff + n * 2048 + k * 1024); } while (0)
#define PG8_MMA(ai, bj, At, Bt) do { __builtin_amdgcn_s_setprio(1); _Pragma("unroll") for (int m = 0; m < 4; ++m) _Pragma("unroll") for (int n = 0; n < 2; ++n) _Pragma("unroll") for (int k = 0; k < 2; ++k) \
        acc[ai][bj][m][n] = __builtin_amdgcn_mfma_f32_16x16x32_bf16(Bt[n][k], At[m][k], acc[ai][bj][m][n], 0, 0, 0); __builtin_amdgcn_s_setprio(0); } while (0)
#define PG8_WAIT_V(n) asm volatile("s_waitcnt vmcnt(" #n ")" ::: "memory")
#define PG8_WAIT_L(n) asm volatile("s_waitcnt lgkmcnt(" #n ")" ::: "memory")
#define PG8_BAR __builtin_amdgcn_s_barrier()
#define PG8_SCHED __builtin_amdgcn_sched_barrier(0)
    Unit cur, nxt; int ui = 0;
    if (!S.next(0, cur)) return;
    f32x4 acc[2][2][4][2];
#pragma unroll
    for (int a = 0; a < 2; ++a)
#pragma unroll
        for (int b = 0; b < 2; ++b)
#pragma unroll
            for (int m = 0; m < 4; ++m)
#pragma unroll
                for (int n = 0; n < 2; ++n) acc[a][b][m][n] = (f32x4){0.f, 0.f, 0.f, 0.f};
    bf16x8 At[4][2], B0[2][2], B1[2][2];
    const char* cA = (const char*)g.A + (size_t)cur.pm * tstep; const char* cB = (const char*)g.Bt + (size_t)cur.pn * tstep;
    if constexpr (SP2) {
        PG8_STAGE(PG8_SB(0, 0), cB, voffB); PG8_STAGE(PG8_SB(0, 1), cB + hstep, voffB); PG8_STAGE(PG8_SA(0, 0), cA, voffA); PG8_STAGE(PG8_SA(0, 1), cA + hstepA, voffA);
        if (wr == 1) PG8_BAR;
        PG8_WAIT_V(2); PG8_BAR;
        PG8_STAGE(PG8_SB(1, 0), cB + kstep, voffB); PG8_STAGE(PG8_SA(1, 0), cA + kstep, voffA); PG8_STAGE(PG8_SB(1, 1), cB + hstep + kstep, voffB);
        PG8_WAIT_V(6); PG8_BAR;
    } else {
        PG8_STAGE(PG8_SB(0, 0), cB, voffB); PG8_STAGE(PG8_SA(0, 0), cA, voffA); PG8_STAGE(PG8_SB(0, 1), cB + hstep, voffB); PG8_STAGE(PG8_SA(0, 1), cA + hstepA, voffA);
        if (wr == 1) PG8_BAR;
        PG8_WAIT_V(4); PG8_BAR;
        PG8_STAGE(PG8_SB(1, 0), cB + kstep, voffB); PG8_STAGE(PG8_SA(1, 0), cA + kstep, voffA); PG8_STAGE(PG8_SB(1, 1), cB + hstep + kstep, voffB);
        PG8_WAIT_V(6); PG8_BAR;
    }
    for (;;) {
        const bool has_next = S.next(ui + 1, nxt);
        const char* nA = has_next ? (const char*)g.A + (size_t)nxt.pm * tstep : cA; const char* nB = has_next ? (const char*)g.Bt + (size_t)nxt.pn * tstep : cB;
        for (int t = 0; t < nt; t += 2) {
            const bool last = (t == nt - 2);
            const char* a1 = cA + (size_t)(t + 1) * kstep;
            const char* a2 = last ? nA : cA + (size_t)(t + 2) * kstep; const char* b2 = last ? nB : cB + (size_t)(t + 2) * kstep;
            const char* a3 = a2 + kstep; const char* b3 = b2 + kstep;
            if constexpr (SP2) {
            PG8_LDB(B0, 0, 0); PG8_LDB(B1, 0, 1); PG8_SCHED; PG8_LDA(At, 0, 0); PG8_STAGE(PG8_SA(1, 1), a1 + hstepA, voffA);
            PG8_WAIT_V(8); PG8_WAIT_L(0); PG8_BAR; PG8_MMA(0, 0, At, B0); PG8_MMA(0, 1, At, B1); PG8_BAR; PG8_SCHED;
            PG8_LDA(At, 0, 1); PG8_STAGE(PG8_SB(0, 0), b2, voffB); PG8_STAGE(PG8_SB(0, 1), b2 + hstep, voffB); PG8_STAGE(PG8_SA(0, 0), a2, voffA);
            PG8_WAIT_V(8); PG8_WAIT_L(0); PG8_BAR; PG8_MMA(1, 0, At, B0); PG8_MMA(1, 1, At, B1); PG8_BAR; PG8_SCHED;
            PG8_LDB(B0, 1, 0); PG8_LDB(B1, 1, 1); PG8_SCHED; PG8_LDA(At, 1, 0); PG8_STAGE(PG8_SA(0, 1), a2 + hstepA, voffA);
            PG8_WAIT_V(8); PG8_WAIT_L(0); PG8_BAR; PG8_MMA(0, 0, At, B0); PG8_MMA(0, 1, At, B1); PG8_BAR; PG8_SCHED;
            PG8_LDA(At, 1, 1); PG8_STAGE(PG8_SB(1, 0), b3, voffB); PG8_STAGE(PG8_SB(1, 1), b3 + hstep, voffB); PG8_STAGE(PG8_SA(1, 0), a3, voffA);
            PG8_WAIT_V(8); PG8_WAIT_L(0); PG8_BAR; PG8_MMA(1, 0, At, B0); PG8_MMA(1, 1, At, B1); PG8_BAR; PG8_SCHED;
            } else {
            PG8_LDB(B0, 0, 0); PG8_SCHED; PG8_LDA(At, 0, 0); PG8_STAGE(PG8_SA(1, 1), a1 + hstepA, voffA);
            PG8_WAIT_L(8); PG8_BAR; PG8_WAIT_L(0); PG8_MMA(0, 0, At, B0); PG8_BAR; PG8_SCHED;
            PG8_LDB(B1, 0, 1); PG8_STAGE(PG8_SB(0, 0), b2, voffB);
            PG8_BAR; PG8_WAIT_L(0); PG8_MMA(0, 1, At, B1); PG8_BAR;
            PG8_LDA(At, 0, 1); PG8_STAGE(PG8_SA(0, 0), a2, voffA);
            PG8_BAR; PG8_WAIT_L(0); PG8_MMA(1, 0, At, B0); PG8_BAR; PG8_SCHED;
            PG8_STAGE(PG8_SB(0, 1), b2 + hstep, voffB);
            PG8_WAIT_V(6); PG8_BAR; PG8_MMA(1, 1, At, B1); PG8_BAR;
            PG8_LDB(B0, 1, 0); PG8_SCHED; PG8_LDA(At, 1, 0); PG8_STAGE(PG8_SA(0, 1), a2 + hstepA, voffA);
            PG8_WAIT_L(8); PG8_BAR; PG8_WAIT_L(0); PG8_MMA(0, 0, At, B0); PG8_BAR; PG8_SCHED;
            PG8_LDB(B1, 1, 1); PG8_STAGE(PG8_SB(1, 0), b3, voffB);
            PG8_BAR; PG8_WAIT_L(0); PG8_MMA(0, 1, At, B1); PG8_BAR;
            PG8_LDA(At, 1, 1); PG8_STAGE(PG8_SA(1, 0), a3, voffA);
            PG8_BAR; PG8_WAIT_L(0); PG8_MMA(1, 0, At, B0); PG8_BAR; PG8_SCHED;
            PG8_STAGE(PG8_SB(1, 1), b3 + hstep, voffB);
            PG8_WAIT_V(6); PG8_BAR; PG8_MMA(1, 1, At, B1); PG8_BAR;

            }
        }
        if constexpr (ALIGN_EPI) { if (wr == 0) PG8_BAR; }
        if constexpr (!Epi::AFTER_DRAIN) E(acc, cur, wr, wc, fr, fq);
        if (!has_next) break;
#pragma unroll
        for (int a = 0; a < 2; ++a)
#pragma unroll
            for (int b = 0; b < 2; ++b)
#pragma unroll
                for (int m = 0; m < 4; ++m)
#pragma unroll
                    for (int n = 0; n < 2; ++n) acc[a][b][m][n] = (f32x4){0.f, 0.f, 0.f, 0.f};
        cur = nxt; cA = nA; cB = nB; ++ui;
        if constexpr (ALIGN_EPI) { if (wr == 1) PG8_BAR; }
    }
    PG8_WAIT_V(0);
    if constexpr (!ALIGN_EPI) { if (wr == 0) PG8_BAR; }
    PG8_BAR;
    if constexpr (Epi::AFTER_DRAIN) E(acc, cur, wr, wc, fr, fq);
#undef PG8_SA
#undef PG8_SB
#undef PG8_STAGE
#undef PG8_LDA
#undef PG8_LDB
#undef PG8_MMA
#undef PG8_WAIT_V
#undef PG8_WAIT_L
#undef PG8_BAR
#undef PG8_SCHED
}

struct EpiBf16 {
    static constexpr bool PERM = true, AFTER_DRAIN = false, AROWPERM = false;
    bf16_t* O; int ldc;
    __device__ __forceinline__ void operator()(f32x4 (&acc)[2][2][4][2], const Unit& u, int wr, int wc, int fr, int fq) const {
        const int row0 = u.pm * BM + wr * 64 + fr, col0 = u.pn * BM + wc * 32 + 8 * fq;
#pragma unroll
        for (int ai = 0; ai < 2; ++ai)
#pragma unroll
            for (int m = 0; m < 4; ++m) { bf16_t* rowp = O + (size_t)(row0 + ai * HALF + m * 16) * ldc + col0;
#pragma unroll
                for (int bj = 0; bj < 2; ++bj) { const f32x4 v0 = acc[ai][bj][m][0], v1 = acc[ai][bj][m][1];
                    u32x4 w; w.x = cvt_pk_bf16_asm(v0[0], v0[1]); w.y = cvt_pk_bf16_asm(v0[2], v0[3]); w.z = cvt_pk_bf16_asm(v1[0], v1[1]); w.w = cvt_pk_bf16_asm(v1[2], v1[3]);
                    *(u32x4*)(rowp + bj * HALF) = w; } }
    }
};
struct EpiResF32 {
    static constexpr bool PERM = false, AFTER_DRAIN = false, AROWPERM = false;
    const float* X; float* O; int ldc;
    __device__ __forceinline__ void operator()(f32x4 (&acc)[2][2][4][2], const Unit& u, int wr, int wc, int fr, int fq) const {
        const int row0 = u.pm * BM + wr * 64 + fr, col0 = u.pn * BM + wc * 32 + 4 * fq;
#pragma unroll
        for (int ai = 0; ai < 2; ++ai)
#pragma unroll
            for (int m = 0; m < 4; ++m) { const size_t ro = (size_t)(row0 + ai * HALF + m * 16) * ldc + col0;
#pragma unroll
                for (int bj = 0; bj < 2; ++bj)
#pragma unroll
                    for (int n = 0; n < 2; ++n) { const f32x4 xv = *(const f32x4*)(X + ro + bj * HALF + n * 16);
                        *(f32x4*)(O + ro + bj * HALF + n * 16) = xv * ALPHA + acc[ai][bj][m][n]; } }
    }
};
template <bool XBF  , bool WF32  > struct EpiResLn {
    static constexpr bool PERM = true, AFTER_DRAIN = true, AROWPERM = false;
    const float* X; const bf16_t* XB; float* O; bf16_t* OB; const float* gam; const float* bet; float* rs; unsigned* cnt;
    __device__ __forceinline__ void operator()(f32x4 (&acc)[2][2][4][2], const Unit& u, int wr, int wc, int fr, int fq) const {
        const int row0 = u.pm * BM + wr * 64 + fr, col0 = u.pn * BM + wc * 32 + 8 * fq;
#pragma unroll
        for (int ai = 0; ai < 2; ++ai)
#pragma unroll
            for (int m = 0; m < 4; ++m) { const int row = row0 + ai * HALF + m * 16; const size_t ro = (size_t)row * DM + col0;
                float s = 0.f, q = 0.f;
#pragma unroll
                for (int bj = 0; bj < 2; ++bj)
#pragma unroll
                    for (int n = 0; n < 2; ++n) { f32x4 xv;
                        if constexpr (XBF) { const u32x2 xb2 = *(const u32x2*)(XB + ro + bj * HALF + n * 4); xv = (f32x4){bflo(xb2.x), bfhi(xb2.x), bflo(xb2.y), bfhi(xb2.y)}; }
                        else xv = *(const f32x4*)(X + ro + bj * HALF + n * 4);
                        const f32x4 z = xv * ALPHA + acc[ai][bj][m][n]; acc[ai][bj][m][n] = z;
                        s += (z[0] + z[1]) + (z[2] + z[3]); q += (z[0] * z[0] + z[1] * z[1]) + (z[2] * z[2] + z[3] * z[3]); }
                s += __shfl_xor(s, 16); s += __shfl_xor(s, 32); q += __shfl_xor(q, 16); q += __shfl_xor(q, 32);
                if (fq == 0) { (void)__hip_atomic_fetch_add(rs + 2 * row, s, __ATOMIC_RELAXED, __HIP_MEMORY_SCOPE_AGENT); (void)__hip_atomic_fetch_add(rs + 2 * row + 1, q, __ATOMIC_RELAXED, __HIP_MEMORY_SCOPE_AGENT); } }
        asm volatile("s_waitcnt vmcnt(0)" ::: "memory");
        unsigned* cp = cnt + 64 * u.pm;
        if ((threadIdx.x & 63) == 0) (void)__hip_atomic_fetch_add(cp, 1u, __ATOMIC_RELAXED, __HIP_MEMORY_SCOPE_AGENT);
        { unsigned sp = 0; while ((unsigned)__builtin_amdgcn_readfirstlane(__hip_atomic_load(cp, __ATOMIC_RELAXED, __HIP_MEMORY_SCOPE_AGENT)) < 64u) { __builtin_amdgcn_s_sleep(2); if (++sp > (1u << 22)) break; } }
        f32x4 gg[2][2], bb[2][2];
#pragma unroll
        for (int bj = 0; bj < 2; ++bj)
#pragma unroll
            for (int n = 0; n < 2; ++n) { gg[bj][n] = *(const f32x4*)(gam + col0 + bj * HALF + n * 4); bb[bj][n] = *(const f32x4*)(bet + col0 + bj * HALF + n * 4); }
#pragma unroll
        for (int ai = 0; ai < 2; ++ai)
#pragma unroll
            for (int m = 0; m < 4; ++m) { const int row = row0 + ai * HALF + m * 16; const size_t ro = (size_t)row * DM + col0;
                const float s = __hip_atomic_load(rs + 2 * row, __ATOMIC_RELAXED, __HIP_MEMORY_SCOPE_AGENT), q = __hip_atomic_load(rs + 2 * row + 1, __ATOMIC_RELAXED, __HIP_MEMORY_SCOPE_AGENT);
                const float mu = s * (1.0f / DM), rstd = rsqrtf(fmaxf(q * (1.0f / DM) - mu * mu, 0.f) + 1e-5f);
#pragma unroll
                for (int bj = 0; bj < 2; ++bj)
#pragma unroll
                    for (int n = 0; n < 2; ++n) { const f32x4 o = (acc[ai][bj][m][n] - mu) * rstd * gg[bj][n] + bb[bj][n];
                        if constexpr (WF32) *(f32x4*)(O + ro + bj * HALF + n * 4) = o;
                        if (OB) { u32x2 p; p.x = cvt_pk_bf16_asm(o[0], o[1]); p.y = cvt_pk_bf16_asm(o[2], o[3]); *(u32x2*)(OB + ro + bj * HALF + n * 4) = p; } } }
    }
};
__device__ __forceinline__ float dpp_shr1(float x) { return __builtin_bit_cast(float, __builtin_amdgcn_update_dpp(0, __builtin_bit_cast(int, x), 0x111, 0xf, 0xf, true)); }
struct EpiConvFfn {
    static constexpr bool PERM = true, AFTER_DRAIN = false, AROWPERM = true;
    bf16_t* act; float* halo; const float* cw; const float* cb;
    __device__ __forceinline__ void operator()(f32x4 (&acc)[2][2][4][2], const Unit& u, int wr, int wc, int fr, int fq) const {
        const int fcol = u.pn * 128 + wc * 32 + 8 * fq;
        const int rbase = u.pm * BM + wr * 128;
        {
            float* hb = halo + (size_t)(rbase >> 7) * 4 * NUP + fcol;
            if (fr == 0) {
#pragma unroll
                for (int bj = 0; bj < 2; ++bj)
#pragma unroll
                    for (int n = 0; n < 2; ++n) { *(f32x4*)(hb + (size_t)2 * NUP + bj * DFF + 4 * n) = acc[0][bj][0][n]; *(f32x4*)(hb + (size_t)3 * NUP + bj * DFF + 4 * n) = acc[0][bj][1][n]; }
            }
            if (fr == 15) {
#pragma unroll
                for (int bj = 0; bj < 2; ++bj)
#pragma unroll
                    for (int n = 0; n < 2; ++n) { *(f32x4*)(hb + bj * DFF + 4 * n) = acc[1][bj][2][n]; *(f32x4*)(hb + (size_t)1 * NUP + bj * DFF + 4 * n) = acc[1][bj][3][n]; }
            }
        }
        u32x2 pk0[8];
#pragma unroll
        for (int n = 0; n < 2; ++n) {
            f32x4 W0[2], W1[2], W2[2], Bb[2];
#pragma unroll
            for (int bj = 0; bj < 2; ++bj) { const int hc = bj * DFF + fcol + 4 * n;
                W0[bj] = *(const f32x4*)(cw + hc); W1[bj] = *(const f32x4*)(cw + NUP + hc); W2[bj] = *(const f32x4*)(cw + 2 * NUP + hc); Bb[bj] = *(const f32x4*)(cb + hc); }
            f32x4 E6[2], E7[2];
#pragma unroll
            for (int bj = 0; bj < 2; ++bj) { const f32x4 s6 = acc[1][bj][2][n], s7 = acc[1][bj][3][n];
                E6[bj][0] = dpp_shr1(s6[0]); E6[bj][1] = dpp_shr1(s6[1]); E6[bj][2] = dpp_shr1(s6[2]); E6[bj][3] = dpp_shr1(s6[3]);
                E7[bj][0] = dpp_shr1(s7[0]); E7[bj][1] = dpp_shr1(s7[1]); E7[bj][2] = dpp_shr1(s7[2]); E7[bj][3] = dpp_shr1(s7[3]); }
            float av[8][4];
#pragma unroll
            for (int j = 0; j < 4; ++j) {
                float hc[2][8];
#pragma unroll
                for (int bj = 0; bj < 2; ++bj) {
                    const float e6 = E6[bj][j], e7 = E7[bj][j];
#pragma unroll
                    for (int i = 0; i < 8; ++i) {
                        const float cur = acc[i >> 2][bj][i & 3][n][j];
                        const float p1 = (i >= 1) ? acc[(i - 1 >= 0 ? i - 1 : 0) >> 2][bj][(i - 1 >= 0 ? i - 1 : 0) & 3][n][j] : e7;
                        const float p2 = (i >= 2) ? acc[(i - 2 >= 0 ? i - 2 : 0) >> 2][bj][(i - 2 >= 0 ? i - 2 : 0) & 3][n][j] : (i == 1 ? e7 : e6);
                        hc[bj][i] = W2[bj][j] * cur + W1[bj][j] * p1 + W0[bj][j] * p2 + Bb[bj][j];
                    }
                }
#pragma unroll
                for (int i = 0; i < 8; ++i) { const float gt = hc[1][i]; av[i][j] = hc[0][i] * gt * __builtin_amdgcn_rcpf(1.0f + __expf(-gt)); }
            }
#pragma unroll
            for (int i = 0; i < 8; ++i) {
                u32x2 pk; pk.x = cvt_pk_bf16_asm(av[i][0], av[i][1]); pk.y = cvt_pk_bf16_asm(av[i][2], av[i][3]);
                if (n == 0) pk0[i] = pk;
                else if (i >= 2 || fr > 0) { u32x4 w; w.x = pk0[i].x; w.y = pk0[i].y; w.z = pk.x; w.w = pk.y;
                    *(u32x4*)(act + (size_t)(rbase + 8 * fr + i) * DFF + fcol) = w; }
            }
            asm volatile("" ::: "memory");
        }
    }
};
}

template <bool UPMAP>
__device__ __forceinline__ void transpose_macro(const float* W, int ldw, int k0, int n0, bf16_t* Wt, int ldt, unsigned char* lds) {
    bf16_t* sT = (bf16_t*)lds; const int tid = threadIdx.x;
    float4 v[2][4];
#pragma unroll
    for (int i = 0; i < 2; ++i)
#pragma unroll
        for (int j = 0; j < 4; ++j) v[i][j] = *(const float4*)(W + (size_t)(k0 + (tid >> 4) + 32 * i) * ldw + n0 + 64 * j + (tid & 15) * 4);
#pragma unroll
    for (int i = 0; i < 2; ++i)
#pragma unroll
        for (int j = 0; j < 4; ++j) { const int k = (tid >> 4) + 32 * i, n = 64 * j + (tid & 15) * 4;
            sT[(n + 0) * 66 + k] = f2bf(v[i][j].x); sT[(n + 1) * 66 + k] = f2bf(v[i][j].y); sT[(n + 2) * 66 + k] = f2bf(v[i][j].z); sT[(n + 3) * 66 + k] = f2bf(v[i][j].w); }
    __syncthreads();
#pragma unroll
    for (int j = 0; j < 4; ++j) { const int n = 64 * j + (tid >> 3), ks = (tid & 7) * 8; const unsigned* p = (const unsigned*)(sT + n * 66 + ks);
        u32x4 o; o.x = p[0]; o.y = p[1]; o.z = p[2]; o.w = p[3];
        int drow = n0 + n;
        if (UPMAP) { const int f = (drow < DFF) ? drow : drow - DFF; drow = 256 * (f >> 7) + (f & 127) + ((drow < DFF) ? 0 : 128); }
        *(u32x4*)(Wt + (size_t)drow * ldt + k0 + ks) = o; }
    __syncthreads();
}
constexpr int TM_IN = 32 * 28, TM_OUT = 32 * 8, TM_UP = 32 * 44, TM_DN = 88 * 8;
__device__ __forceinline__ void phase_transposes(const Args& A, unsigned char* lds, int g0, int g1, int worker, int nworkers) {
    unsigned char* ws = A.ws;
    for (int g = g0 + worker; g < g1; g += nworkers) {
        if (g < TM_IN) { const int tk = g / 28, tn = g % 28; transpose_macro<false>(A.w_in, NIN, tk * 64, tn * 256, (bf16_t*)(ws + WS_WIN), DM, lds); }
        else if (g < TM_IN + TM_OUT) { const int h = g - TM_IN, tk = h / 8, tn = h % 8; transpose_macro<false>(A.w_out, DM, tk * 64, tn * 256, (bf16_t*)(ws + WS_WOUT), DM, lds); }
        else if (g < TM_IN + TM_OUT + TM_UP) { const int h = g - TM_IN - TM_OUT, tk = h / 44, tn = h % 44; transpose_macro<true>(A.w_up, NUP, tk * 64, tn * 256, (bf16_t*)(ws + WS_WUP), DM, lds); }
        else { const int h = g - TM_IN - TM_OUT - TM_UP, tk = h / 8, tn = h % 8; transpose_macro<false>(A.w_down, DM, tk * 64, tn * 256, (bf16_t*)(ws + WS_WDN), DFF, lds); }
    }
}
__device__ __forceinline__ void phase_prologue(const Args& A, unsigned char* lds) {
    unsigned char* ws = A.ws;
    const int lane = threadIdx.x & 63, gw = blockIdx.x * 8 + (threadIdx.x >> 6), nw = gridDim.x * 8;
    bf16_t* xb = (bf16_t*)(ws + WS_XB); float* gates = (float*)(ws + WS_GATES);
    phase_transposes(A, lds, 0, TM_IN, blockIdx.x, gridDim.x);
    for (int it = gw; it < MT / 4; it += nw) {
        const int r0 = it * 4;
        float acc[4][8];
#pragma unroll
        for (int r = 0; r < 4; ++r)
#pragma unroll
            for (int q = 0; q < 8; ++q) acc[r][q] = 0.f;
#pragma unroll 1
        for (int ih = 0; ih < 2; ++ih) {
        f32x4 xq[4][4];
#pragma unroll
        for (int i = 0; i < 4; ++i)
#pragma unroll
            for (int r = 0; r < 4; ++r) xq[i][r] = *(const f32x4*)(A.x + (size_t)(r0 + r) * DM + (ih * 4 + i) * 256 + lane * 4);
#pragma unroll
        for (int i = 0; i < 4; ++i) {
            const int kb = (ih * 4 + i) * 256 + lane * 4;
            f32x4 xv[4];
#pragma unroll
            for (int r = 0; r < 4; ++r) { xv[r] = xq[i][r];
                u32x2 o; o.x = cvt_pk_bf16(xv[r][0], xv[r][1]); o.y = cvt_pk_bf16(xv[r][2], xv[r][3]); *(u32x2*)(xb + (size_t)(r0 + r) * DM + kb) = o; }
#pragma unroll
            for (int j = 0; j < 4; ++j) {
                const f32x4* wp = (const f32x4*)(A.w_in + (size_t)(kb + j) * NIN + NP);
                const f32x4 w0 = wp[0], w1 = wp[1];
#pragma unroll
                for (int r = 0; r < 4; ++r) { const float xs = xv[r][j];
                    acc[r][0] += xs * w0[0]; acc[r][1] += xs * w0[1]; acc[r][2] += xs * w0[2]; acc[r][3] += xs * w0[3];
                    acc[r][4] += xs * w1[0]; acc[r][5] += xs * w1[1]; acc[r][6] += xs * w1[2]; acc[r][7] += xs * w1[3]; }
            }
        }
        }
#pragma unroll
        for (int r = 0; r < 4; ++r)
#pragma unroll
            for (int q = 0; q < 8; ++q) { float v = acc[r][q];
#pragma unroll
                for (int off = 32; off >= 1; off >>= 1) v += __shfl_xor(v, off);
                acc[r][q] = v; }
        if (lane == 0) {
            const f32x4 b0 = *(const f32x4*)(A.b_gates), b1 = *(const f32x4*)(A.b_gates + 4);
#pragma unroll
            for (int r = 0; r < 4; ++r) {
                *(f32x4*)(gates + (size_t)(r0 + r) * 8) = (f32x4){acc[r][0] + b0[0], acc[r][1] + b0[1], acc[r][2] + b0[2], acc[r][3] + b0[3]};
                *(f32x4*)(gates + (size_t)(r0 + r) * 8 + 4) = (f32x4){acc[r][4] + b1[0], acc[r][5] + b1[1], acc[r][6] + b1[2], acc[r][7] + b1[3]}; }
        }
    }
}

__device__ __forceinline__ void phase_yconv(const Args& A) {
    const bf16_t* proj = (const bf16_t*)(A.ws + WS_PROJ); bf16_t* y = (bf16_t*)(A.ws + WS_Y);
    for (int idx = blockIdx.x * 512 + threadIdx.x; idx < MT * 128; idx += gridDim.x * 512) {
        const int row = idx >> 7, c = (idx & 127) * 8, t = row & (SEQ - 1);
        const bf16_t* pr = proj + (size_t)row * NP + c;
        const u32x4 bv = *(const u32x4*)pr;
        float cv[8];
#pragma unroll
        for (int i = 0; i < 8; ++i) cv[i] = 0.f;
#pragma unroll
        for (int j = 0; j < 3; ++j) {
            const int dt = 2 - j;
            if (t - dt >= 0) {
                const u32x4 cc = *(const u32x4*)(pr - (size_t)dt * NP + WCONV), hh = *(const u32x4*)(pr - (size_t)dt * NP + 2 * WCONV);
                const f32x4 w0 = *(const f32x4*)(A.w_sc + j * WCONV + c), w1 = *(const f32x4*)(A.w_sc + j * WCONV + c + 4);
                const float wv[8] = {w0[0], w0[1], w0[2], w0[3], w1[0], w1[1], w1[2], w1[3]};
#pragma unroll
                for (int q = 0; q < 4; ++q) { cv[2 * q] += wv[2 * q] * bflo(cc[q]) * bflo(hh[q]); cv[2 * q + 1] += wv[2 * q + 1] * bfhi(cc[q]) * bfhi(hh[q]); }
            }
        }
        u32x4 o;
#pragma unroll
        for (int q = 0; q < 4; ++q) o[q] = cvt_pk_bf16(bflo(bv[q]) * cv[2 * q], bfhi(bv[q]) * cv[2 * q + 1]);
        *(u32x4*)(y + (size_t)row * DM + c) = o;
    }
}

__device__ __forceinline__ void phase_mlstm(const Args& A, unsigned char* lds, float* hbuf) {
    const int tid = threadIdx.x, lane = tid & 63, w = tid >> 6, g = lane >> 4, l15 = lane & 15;
    const int a = w >> 2, ti = w & 3;
    unsigned char* QS = lds; unsigned char* KS = lds + 33792; unsigned char* VT = lds + 67584; unsigned char* WVT = VT + 4608; unsigned char* CT = WVT + 4608; unsigned char* XCH = CT + 33792;
    const bf16_t* proj = (const bf16_t*)(A.ws + WS_PROJ); const float* gates = (const float*)(A.ws + WS_GATES);
    float* TBC = (float*)(lds + 131088); float* TUV = TBC + 2048; float* TCM = TUV + 2048;
    for (int item = blockIdx.x; item < 256; item += gridDim.x) {
        const int xcd = item & 7, idx = item >> 3; const int bh = xcd * 2 + (idx >> 4), es = idx & 15;
        const int b = bh >> 2, hh = bh & 3, e0 = es * 16;
        const size_t row0 = (size_t)b * SEQ;
        __syncthreads();
        for (int i = tid; i < 16896 / 4; i += 512) ((unsigned*)CT)[i] = 0u;
        for (int i = tid; i < 16 * 72; i += 512) { const int r = 16 + i / 72, ci = i % 72; ((bf16_t*)VT)[r * 72 + ci] = (r == 16) ? (bf16_t)0x3F80 : (bf16_t)0; ((bf16_t*)WVT)[r * 72 + ci] = 0; }
        f32x4 Cst[2][2];
#pragma unroll
        for (int x = 0; x < 2; ++x)
#pragma unroll
            for (int et = 0; et < 2; ++et) Cst[x][et] = (f32x4){0.f, 0.f, 0.f, 0.f};
        float m_state = 0.f;
        u32x4 qr[4], kr[4]; unsigned vr;
        const bf16_t* qbase = proj + row0 * NP + 3072 + hh * 256;
#define ML_LOAD(c) do { _Pragma("unroll") for (int i = 0; i < 4; ++i) { const int p = tid + 512 * i, r = p >> 5, c16 = p & 31; const bf16_t* rp = qbase + (size_t)((c) * 64 + r) * NP + c16 * 8; \
            qr[i] = *(const u32x4*)rp; kr[i] = *(const u32x4*)(rp + 1024); } \
            vr = *(const unsigned*)(qbase + (size_t)((c) * 64 + (tid >> 3)) * NP + 2048 + e0 + (tid & 7) * 2); } while (0)
        ML_LOAD(0);
#pragma unroll 1
        for (int cc = 4 * w; cc < 4 * w + 4; ++cc) {
            const float* gp = gates + (row0 + cc * 64 + lane) * 8 + hh; const float gi = gp[0], gf = gp[4];
            const float lf = fminf(gf, 0.f) - log1pf(__expf(-fabsf(gf)));
            float bc = lf;
#pragma unroll
            for (int off = 1; off < 64; off <<= 1) { const float t = __shfl_up(bc, off); if (lane >= off) bc += t; }
            const float uv = gi - bc;
            float cm = uv;
#pragma unroll
            for (int off = 1; off < 64; off <<= 1) { const float t = __shfl_up(cm, off); if (lane >= off) cm = fmaxf(cm, t); }
            TBC[cc * 64 + lane] = bc; TUV[cc * 64 + lane] = uv; TCM[cc * 64 + lane] = cm;
        }
        __syncthreads();
#pragma unroll 1
        for (int c = 0; c < 32; ++c) {
            const float* tbc = TBC + c * 64; const float* tuv = TUV + c * 64; const float* tcm = TCM + c * 64;
            const float g_tot = tbc[63], cm63 = tcm[63];
            const float M63 = fmaxf(m_state, cm63), decay = __expf(m_state - M63);
            const float m_old = m_state;
            m_state = g_tot + M63;
#pragma unroll
            for (int i = 0; i < 4; ++i) { const int p = tid + 512 * i, r = p >> 5, c16 = p & 31; *(u32x4*)(QS + r * 528 + c16 * 16) = qr[i]; *(u32x4*)(KS + r * 528 + c16 * 16) = kr[i]; }
            { const int s = tid >> 3, ep = tid & 7; const float wv = __expf(tuv[s] - M63);
              ((bf16_t*)VT)[(2 * ep) * 72 + s] = (bf16_t)(vr & 0xffffu); ((bf16_t*)VT)[(2 * ep + 1) * 72 + s] = (bf16_t)(vr >> 16);
              ((bf16_t*)WVT)[(2 * ep) * 72 + s] = f2bf(bflo(vr) * wv); ((bf16_t*)WVT)[(2 * ep + 1) * 72 + s] = f2bf(bfhi(vr) * wv);
              if (ep == 0) ((bf16_t*)WVT)[16 * 72 + s] = f2bf(wv); }
            if (c + 1 < 32) ML_LOAD(c + 1);
            __syncthreads();
            bf16x8 qf[8]; f32x4 S0 = (f32x4){0.f, 0.f, 0.f, 0.f}, S1 = S0;
#pragma unroll
            for (int kk = 0; kk < 8; ++kk) {
                const int ko = ((kk + 4 * a) & 7) * 64 + g * 16;
                qf[kk] = *(const bf16x8*)(QS + (16 * ti + l15) * 528 + ko);
                const bf16x8 kf0 = *(const bf16x8*)(KS + (32 * a + l15) * 528 + ko), kf1 = *(const bf16x8*)(KS + (32 * a + 16 + l15) * 528 + ko);
                S0 = __builtin_amdgcn_mfma_f32_16x16x32_bf16(kf0, qf[kk], S0, 0, 0, 0); S1 = __builtin_amdgcn_mfma_f32_16x16x32_bf16(kf1, qf[kk], S1, 0, 0, 0);
            }
            const int tcol = 16 * ti + l15;
            const float Mt = fmaxf(m_old, tcm[tcol]);
            const f32x4 u0v = *(const f32x4*)(tuv + 32 * a + 4 * g), u1v = *(const f32x4*)(tuv + 32 * a + 16 + 4 * g);
            float p[8];
#pragma unroll
            for (int r = 0; r < 4; ++r) { const int s0 = 32 * a + 4 * g + r, s1 = s0 + 16;
                p[r] = (s0 <= tcol) ? S0[r] * 0.0625f * __expf(u0v[r] - Mt) : 0.f; p[4 + r] = (s1 <= tcol) ? S1[r] * 0.0625f * __expf(u1v[r] - Mt) : 0.f; }
            u32x4 pau; pau.x = cvt_pk_bf16(p[0], p[1]); pau.y = cvt_pk_bf16(p[2], p[3]); pau.z = cvt_pk_bf16(p[4], p[5]); pau.w = cvt_pk_bf16(p[6], p[7]);
            const bf16x8 pa = __builtin_bit_cast(bf16x8, pau);
            f32x4 rr[2];
#pragma unroll
            for (int et = 0; et < 2; ++et) { const unsigned char* vp = VT + (16 * et + l15) * 144 + (32 * a + 4 * g) * 2;
                const u32x2 lo = *(const u32x2*)vp, hi = *(const u32x2*)(vp + 32);
                u32x4 vbu; vbu.x = lo.x; vbu.y = lo.y; vbu.z = hi.x; vbu.w = hi.y;
                rr[et] = __builtin_amdgcn_mfma_f32_16x16x32_bf16(pa, __builtin_bit_cast(bf16x8, vbu), (f32x4){0.f, 0.f, 0.f, 0.f}, 0, 0, 0); }
            const f32x4 cmr = *(const f32x4*)(tcm + 16 * ti + 4 * g), bcr = *(const f32x4*)(tbc + 16 * ti + 4 * g);
            {
                const unsigned char* CTc = CT + (c & 1) * 16896;
                f32x4 in0 = (f32x4){0.f, 0.f, 0.f, 0.f}, in1 = in0;
#pragma unroll
                for (int k2 = 0; k2 < 4; ++k2) {
                    const bf16x8 qa = qf[k2];
                    const bf16x8 c0 = *(const bf16x8*)(CTc + (l15) * 528 + (128 * a + 32 * k2 + 8 * g) * 2), c1 = *(const bf16x8*)(CTc + (16 + l15) * 528 + (128 * a + 32 * k2 + 8 * g) * 2);
                    in0 = __builtin_amdgcn_mfma_f32_16x16x32_bf16(qa, c0, in0, 0, 0, 0); in1 = __builtin_amdgcn_mfma_f32_16x16x32_bf16(qa, c1, in1, 0, 0, 0);
                }
#pragma unroll
                for (int r = 0; r < 4; ++r) { const float iw = __expf(m_old - fmaxf(m_old, cmr[r])) * 0.0625f; rr[0][r] += in0[r] * iw; rr[1][r] += in1[r] * iw; }
            }
            if (a == 1) { *(f32x4*)(XCH + ((ti * 2 + 0) * 64 + lane) * 16) = rr[0]; *(f32x4*)(XCH + ((ti * 2 + 1) * 64 + lane) * 16) = rr[1]; }
            {
                unsigned char* CTn = CT + ((c + 1) & 1) * 16896;
#pragma unroll
                for (int x = 0; x < 2; ++x) {
                    const int dt = 2 * w + x;
#pragma unroll
                    for (int et = 0; et < 2; ++et) Cst[x][et] *= decay;
#pragma unroll
                    for (int ks = 0; ks < 2; ++ks) {
                        const s16x4 klo = __builtin_amdgcn_ds_read_tr16_b64_v4i16((LAS s16x4*)(KS + (32 * ks + 8 * g + (l15 >> 2)) * 528 + (16 * dt + 4 * (l15 & 3)) * 2));
                        const s16x4 khi = __builtin_amdgcn_ds_read_tr16_b64_v4i16((LAS s16x4*)(KS + (32 * ks + 8 * g + 4 + (l15 >> 2)) * 528 + (16 * dt + 4 * (l15 & 3)) * 2));
                        const bf16x8 ka = {klo[0], klo[1], klo[2], klo[3], khi[0], khi[1], khi[2], khi[3]};
#pragma unroll
                        for (int et = 0; et < 2; ++et) { const bf16x8 wvb = *(const bf16x8*)(WVT + (16 * et + l15) * 144 + (32 * ks + 8 * g) * 2);
                            Cst[x][et] = __builtin_amdgcn_mfma_f32_16x16x32_bf16(ka, wvb, Cst[x][et], 0, 0, 0); }
                    }
#pragma unroll
                    for (int et = 0; et < 2; ++et) { u32x2 o; o.x = cvt_pk_bf16(Cst[x][et][0], Cst[x][et][1]); o.y = cvt_pk_bf16(Cst[x][et][2], Cst[x][et][3]);
                        *(u32x2*)(CTn + (16 * et + l15) * 528 + (16 * dt + 4 * g) * 2) = o; }
                }
            }
            __syncthreads();
            if (a == 0) {
                const f32x4 o0 = *(const f32x4*)(XCH + ((ti * 2 + 0) * 64 + lane) * 16), o1 = *(const f32x4*)(XCH + ((ti * 2 + 1) * 64 + lane) * 16);
#pragma unroll
                for (int r = 0; r < 4; ++r) {
                    const float den = __shfl(rr[1][r] + o1[r], lane & 48), fl = __expf(-(bcr[r] + fmaxf(m_old, cmr[r])));
                    const float hv = (rr[0][r] + o0[r]) * __builtin_amdgcn_rcpf(fmaxf(fabsf(den), fl));
                    hbuf[(row0 + c * 64 + 16 * ti + 4 * g + r) * 1024 + hh * 256 + e0 + l15] = hv;
                }
            }
        }
#undef ML_LOAD
    }
}

__device__ __forceinline__ void phase_headnorm(const Args& A, const float* hbuf) {
    const bf16_t* proj = (const bf16_t*)(A.ws + WS_PROJ); bf16_t* y = (bf16_t*)(A.ws + WS_Y);
    const int lane = threadIdx.x & 63, gw = blockIdx.x * 8 + (threadIdx.x >> 6), nw = gridDim.x * 8;
    f32x4 gn[4];
#pragma unroll
    for (int hh = 0; hh < 4; ++hh) gn[hh] = *(const f32x4*)(A.mh_gain + hh * 256 + lane * 4);
    for (int row = gw; row < MT; row += nw) {
        f32x4 hv[4]; u32x2 ov[4]; float s[4], q[4];
#pragma unroll
        for (int hh = 0; hh < 4; ++hh) { hv[hh] = *(const f32x4*)(hbuf + (size_t)row * 1024 + hh * 256 + lane * 4); ov[hh] = *(const u32x2*)(proj + (size_t)row * NP + 6144 + hh * 256 + lane * 4); }
#pragma unroll
        for (int hh = 0; hh < 4; ++hh) s[hh] = (hv[hh][0] + hv[hh][1]) + (hv[hh][2] + hv[hh][3]);
#pragma unroll
        for (int off = 32; off >= 1; off >>= 1)
#pragma unroll
            for (int hh = 0; hh < 4; ++hh) s[hh] += __shfl_xor(s[hh], off);
#pragma unroll
        for (int hh = 0; hh < 4; ++hh) { const float mu = s[hh] * (1.0f / 256.0f); hv[hh] = hv[hh] - mu; q[hh] = (hv[hh][0] * hv[hh][0] + hv[hh][1] * hv[hh][1]) + (hv[hh][2] * hv[hh][2] + hv[hh][3] * hv[hh][3]); }
#pragma unroll
        for (int off = 32; off >= 1; off >>= 1)
#pragma unroll
            for (int hh = 0; hh < 4; ++hh) q[hh] += __shfl_xor(q[hh], off);
#pragma unroll
        for (int hh = 0; hh < 4; ++hh) {
            const float rstd = rsqrtf(q[hh] * (1.0f / 256.0f) + 1e-6f);
            const float o0 = bflo(ov[hh].x), o1 = bfhi(ov[hh].x), o2 = bflo(ov[hh].y), o3 = bfhi(ov[hh].y);
            const float y0 = hv[hh][0] * rstd * gn[hh][0] * __builtin_amdgcn_rcpf(1.0f + __expf(-o0)), y1 = hv[hh][1] * rstd * gn[hh][1] * __builtin_amdgcn_rcpf(1.0f + __expf(-o1));
            const float y2 = hv[hh][2] * rstd * gn[hh][2] * __builtin_amdgcn_rcpf(1.0f + __expf(-o2)), y3 = hv[hh][3] * rstd * gn[hh][3] * __builtin_amdgcn_rcpf(1.0f + __expf(-o3));
            u32x2 o; o.x = cvt_pk_bf16(y0, y1); o.y = cvt_pk_bf16(y2, y3);
            *(u32x2*)(y + (size_t)row * DM + WCONV + hh * 256 + lane * 4) = o;
        }
    }
}

__device__ __forceinline__ void phase_ln(float* io, const float* gam, const float* bet, bf16_t* ob) {
    const int lane = threadIdx.x & 63, gw = blockIdx.x * 8 + (threadIdx.x >> 6), nw = gridDim.x * 8;
    for (int row = gw; row < MT; row += nw) {
        float* rp = io + (size_t)row * DM;
        f32x4 v[8]; float s = 0.f;
#pragma unroll
        for (int i = 0; i < 8; ++i) { v[i] = *(const f32x4*)(rp + i * 256 + lane * 4); s += (v[i][0] + v[i][1]) + (v[i][2] + v[i][3]); }
#pragma unroll
        for (int off = 32; off >= 1; off >>= 1) s += __shfl_xor(s, off);
        const float mu = s * (1.0f / DM);
        float q = 0.f;
#pragma unroll
        for (int i = 0; i < 8; ++i) { v[i] = v[i] - mu; q += (v[i][0] * v[i][0] + v[i][1] * v[i][1]) + (v[i][2] * v[i][2] + v[i][3] * v[i][3]); }
#pragma unroll
        for (int off = 32; off >= 1; off >>= 1) q += __shfl_xor(q, off);
        const float rstd = rsqrtf(q * (1.0f / DM) + 1e-5f);
#pragma unroll
        for (int i = 0; i < 8; ++i) { const f32x4 gg = *(const f32x4*)(gam + i * 256 + lane * 4), bb = *(const f32x4*)(bet + i * 256 + lane * 4);
            const f32x4 o = v[i] * rstd * gg + bb;
            *(f32x4*)(rp + i * 256 + lane * 4) = o;
            if (ob) { u32x2 p; p.x = cvt_pk_bf16(o[0], o[1]); p.y = cvt_pk_bf16(o[2], o[3]); *(u32x2*)(ob + (size_t)row * DM + i * 256 + lane * 4) = p; } }
    }
}

__device__ __forceinline__ void phase_fixup(const Args& A) {
    const float* halo = (const float*)(A.ws + WS_HALO); bf16_t* act = (bf16_t*)(A.ws + WS_ACT);
    for (int idx = blockIdx.x * 512 + threadIdx.x; idx < 64 * 2 * (DFF / 4); idx += gridDim.x * 512) {
        const int f = (idx % (DFF / 4)) * 4, br = idx / (DFF / 4), rr = br & 1, B = br >> 1;
        const bool first = (B & 15) == 0;
        const float* hc = halo + (size_t)B * 4 * NUP; const float* hp = hc - 4 * NUP;
        f32x4 hv[2];
#pragma unroll
        for (int bj = 0; bj < 2; ++bj) {
            const int col = bj * DFF + f;
            const f32x4 cur = *(const f32x4*)(hc + (size_t)(2 + rr) * NUP + col);
            f32x4 p1, p2; const f32x4 z = (f32x4){0.f, 0.f, 0.f, 0.f};
            if (rr == 0) { p1 = first ? z : *(const f32x4*)(hp + (size_t)1 * NUP + col); p2 = first ? z : *(const f32x4*)(hp + col); }
            else { p1 = *(const f32x4*)(hc + (size_t)2 * NUP + col); p2 = first ? z : *(const f32x4*)(hp + (size_t)1 * NUP + col); }
            const f32x4 w0 = *(const f32x4*)(A.w_fc + col), w1 = *(const f32x4*)(A.w_fc + NUP + col), w2 = *(const f32x4*)(A.w_fc + 2 * NUP + col), bb = *(const f32x4*)(A.b_fc + col);
            hv[bj] = w2 * cur + w1 * p1 + w0 * p2 + bb;
        }
        float av[4];
#pragma unroll
        for (int j = 0; j < 4; ++j) { const float gt = hv[1][j]; av[j] = hv[0][j] * gt / (1.0f + __expf(-gt)); }
        u32x2 o; o.x = cvt_pk_bf16(av[0], av[1]); o.y = cvt_pk_bf16(av[2], av[3]);
        *(u32x2*)(act + (size_t)(B * 128 + rr) * DFF + f) = o;
    }
}

__device__ __forceinline__ void phase_dump(const bf16_t* src, int ld, int c0, float* out) {
    for (size_t idx = (size_t)blockIdx.x * 512 + threadIdx.x; idx < (size_t)MT * DM; idx += (size_t)gridDim.x * 512) {
        const size_t row = idx / DM, col = idx % DM; out[idx] = bflo((unsigned)src[row * ld + c0 + col]); }
}
#ifndef DBG_STOP
#define DBG_STOP -1
#endif
#define XB_TMO      128
#define XB_XCNT(j)  (256  + 64 * (j))
#define XB_XSUB(j)  (1280 + 64 * (j))
#define XB_XGEN(j)  (2304 + 64 * (j))
#define XB_TOP      3328
#define XB_TOPGEN   3392
#define XCD_BAR_WORDS 3456
#define XB_SPIN_CAP (1u << 22)
__device__ __forceinline__ unsigned xb_ld(unsigned* p)              { return __hip_atomic_load(p, __ATOMIC_RELAXED, __HIP_MEMORY_SCOPE_AGENT); }
__device__ __forceinline__ unsigned xb_add(unsigned* p, unsigned v) { return __hip_atomic_fetch_add(p, v, __ATOMIC_RELAXED, __HIP_MEMORY_SCOPE_AGENT); }
__device__ __forceinline__ unsigned xb_xcc_id() { return (unsigned)__builtin_amdgcn_s_getreg((3 << 11) | 20) & 0xFu; }
#define XB_SPIN(cond, bar) do { unsigned _sp = 0; while (cond) { __builtin_amdgcn_s_sleep(1); \
    if ((++_sp & 255u) == 0u) { if (xb_ld(&(bar)[XB_TMO])) break; if (_sp > XB_SPIN_CAP) { atomicAdd(&(bar)[XB_TMO], 1u); break; } } } } while (0)
struct XcdBarrier { unsigned* bar; unsigned x; volatile LAS unsigned* st; };
__device__ __forceinline__ XcdBarrier xcd_barrier_post(unsigned* bar, volatile LAS unsigned* st) {
    XcdBarrier b; b.bar = bar; b.x = xb_xcc_id(); b.st = st;
    if (threadIdx.x == 0) (void)xb_add(&bar[XB_XCNT(b.x)], 1u);
    return b;
}
__device__ __forceinline__ void xcd_barrier_complete(unsigned* bar, unsigned x, unsigned& nloc, unsigned& nx) {
    const unsigned G = gridDim.x * gridDim.y * gridDim.z;
    unsigned sum, cnt, mine, sp = 0u;
    for (;;) {
        sum = 0u; cnt = 0u; mine = 0u;
#pragma unroll
        for (unsigned j = 0; j < 16; ++j) { const unsigned c = xb_ld(&bar[XB_XCNT(j)]); sum += c; cnt += (c > 0u) ? 1u : 0u; mine = (j == x) ? c : mine; }
        if (sum == G) break;
        __builtin_amdgcn_s_sleep(1);
        if ((++sp & 255u) == 0u) { if (xb_ld(&bar[XB_TMO])) break; if (sp > XB_SPIN_CAP) { atomicAdd(&bar[XB_TMO], 1u); break; } }
    }
    nloc = mine > 0u ? mine : 1u; nx = cnt > 0u ? cnt : 1u;
}
__device__ __forceinline__ void xcd_barrier(const XcdBarrier& b) {
    asm volatile("s_waitcnt vmcnt(0)" ::: "memory");
    __syncthreads();
    if (threadIdx.x == 0) {
        unsigned* bar = b.bar;
        __builtin_amdgcn_s_waitcnt(0);
        unsigned nloc = b.st[0], nx = b.st[1];
        if (nloc == 0u) { xcd_barrier_complete(bar, b.x, nloc, nx); b.st[0] = nloc; b.st[1] = nx; }
        const unsigned old = xb_add(&bar[XB_XSUB(b.x)], 1u);
        const unsigned gen = old / nloc;
        if (old + 1u == (gen + 1u) * nloc) {
            __builtin_amdgcn_fence(__ATOMIC_RELEASE, "agent");
            asm volatile("s_waitcnt vmcnt(0)" ::: "memory");
            const unsigned og = xb_add(&bar[XB_TOP], 1u);
            const unsigned tg = og / nx;
            if (og + 1u == (tg + 1u) * nx) xb_add(&bar[XB_TOPGEN], 1u);
            else XB_SPIN(xb_ld(&bar[XB_TOPGEN]) == tg, bar);
            __builtin_amdgcn_fence(__ATOMIC_ACQUIRE, "agent");
            xb_add(&bar[XB_XGEN(b.x)], 1u);
            asm volatile("s_waitcnt vmcnt(0)" ::: "memory");
        } else {
            XB_SPIN(xb_ld(&bar[XB_XGEN(b.x)]) == gen, bar);
            __builtin_amdgcn_fence(__ATOMIC_ACQUIRE, "agent");
            asm volatile("s_waitcnt vmcnt(0)" ::: "memory");
        }
    }
    __syncthreads();
}

constexpr int N_PHASES = 10;
#ifndef ONLY_PH
#define ONLY_PH -1
#endif
#define PH_ON(x) (ONLY_PH < 0 || ONLY_PH == (x))
__global__ void __launch_bounds__(512, 2) mega(Args a) {
    extern __shared__ __attribute__((aligned(16))) unsigned char lds[];
    cg::grid_group grid = cg::this_grid();
    unsigned char* ws = a.ws;
#define PH_RUN(x) (PH_ON(x) && a.ph_lo <= (x) && (x) < a.ph_hi)
#define PH_SYNC(x) do { if (a.ph_lo <= (x) && (x) + 1 < a.ph_hi) xcd_barrier(xb); } while (0)
    volatile LAS unsigned* xst = (volatile LAS unsigned*)((LAS unsigned char*)lds + 131072);
    if (threadIdx.x == 0) { xst[0] = 0u; xst[1] = 0u; }
    __syncthreads();
    const XcdBarrier xb = xcd_barrier_post((unsigned*)(ws + WS_BAR), xst);
    if (a.ph_hi > 1000) grid.sync();
#ifndef REP0
#define REP0 1
#endif
#ifndef REP2
#define REP2 1
#endif
#ifndef REP6
#define REP6 1
#endif
    if (PH_RUN(0)) for (int rep = 0; rep < REP0; ++rep) phase_prologue(a, lds);
    PH_SYNC(0);
    if (PH_RUN(1)) { pg8::Gemm g{(const bf16_t*)(ws + WS_XB), (const bf16_t*)(ws + WS_WIN), MT, NP, DM}; pg8::StaticOrder S; S.init(MT, NP, gridDim.x, blockIdx.x);
        pg8::EpiBf16 E{(bf16_t*)(ws + WS_PROJ), NP}; pg8::gemm_phase<pg8::EpiBf16, true>((LAS unsigned char*)lds, g, S, E);
        const int rem = ((MT / 256) * (NP / 256)) % (int)gridDim.x;
        if (rem == 0) phase_transposes(a, lds, TM_IN, TM_IN + TM_OUT + TM_UP, blockIdx.x, gridDim.x);
        else if ((int)blockIdx.x >= rem) phase_transposes(a, lds, TM_IN, TM_IN + TM_OUT + TM_UP, blockIdx.x - rem, gridDim.x - rem); }
    PH_SYNC(1);
    if (PH_RUN(2)) for (int rep = 0; rep < REP2; ++rep) { phase_yconv(a); phase_mlstm(a, lds, a.out); }
    PH_SYNC(2);
    if (PH_RUN(3)) phase_headnorm(a, a.out);
    PH_SYNC(3);
    if (PH_RUN(4)) { pg8::Gemm g{(const bf16_t*)(ws + WS_Y), (const bf16_t*)(ws + WS_WOUT), MT, DM, DM}; pg8::StaticOrder S; S.init(MT, DM, gridDim.x, blockIdx.x);
        if (a.fuse_ln) { pg8::EpiResLn<false, false> E{a.x, nullptr, nullptr, (bf16_t*)(ws + WS_X1B), a.ln1_g, a.ln1_b, (float*)(ws + WS_RS1), (unsigned*)(ws + WS_CNT)}; pg8::gemm_phase((LAS unsigned char*)lds, g, S, E); }
        else { pg8::EpiResF32 E{a.x, a.out, DM}; pg8::gemm_phase((LAS unsigned char*)lds, g, S, E); } }
    PH_SYNC(4);
    if (PH_RUN(5) && !a.fuse_ln) phase_ln(a.out, a.ln1_g, a.ln1_b, (bf16_t*)(ws + WS_X1B));
    if (!a.fuse_ln) PH_SYNC(5);
    if (PH_RUN(6)) { pg8::Gemm g{(const bf16_t*)(ws + WS_X1B), (const bf16_t*)(ws + WS_WUP), MT, NUP, DM}; pg8::StaticOrder S; S.init(MT, NUP, gridDim.x, blockIdx.x);
        pg8::EpiConvFfn E{(bf16_t*)(ws + WS_ACT), (float*)(ws + WS_HALO), a.w_fc, a.b_fc}; pg8::gemm_phase<pg8::EpiConvFfn, true>((LAS unsigned char*)lds, g, S, E);
        const int rem = ((MT / 256) * (NUP / 256)) % (int)gridDim.x; const int t0 = TM_IN + TM_OUT + TM_UP, t1 = t0 + TM_DN;
        if (rem == 0) phase_transposes(a, lds, t0, t1, blockIdx.x, gridDim.x);
        else if ((int)blockIdx.x >= rem) phase_transposes(a, lds, t0, t1, blockIdx.x - rem, gridDim.x - rem); }
    PH_SYNC(6);
    if (PH_RUN(7)) phase_fixup(a);
    PH_SYNC(7);
    if (PH_RUN(8)) { pg8::Gemm g{(const bf16_t*)(ws + WS_ACT), (const bf16_t*)(ws + WS_WDN), MT, DM, DFF}; pg8::StaticOrder S; S.init(MT, DM, gridDim.x, blockIdx.x);
        if (a.fuse_ln) { pg8::EpiResLn<true, true> E{nullptr, (const bf16_t*)(ws + WS_X1B), a.out, nullptr, a.ln2_g, a.ln2_b, (float*)(ws + WS_RS2), (unsigned*)(ws + WS_CNT) + 32 * 64}; pg8::gemm_phase((LAS unsigned char*)lds, g, S, E); }
        else { pg8::EpiResF32 E{a.out, a.out, DM}; pg8::gemm_phase((LAS unsigned char*)lds, g, S, E); } }
    if (!a.fuse_ln) PH_SYNC(8);
    if (PH_RUN(9) && !a.fuse_ln) phase_ln(a.out, a.ln2_g, a.ln2_b, nullptr);
    if (DBG_STOP == 1 && a.ph_lo == 101) phase_dump((const bf16_t*)(ws + WS_PROJ), NP, 3072, a.out);
    if (DBG_STOP == 3 && a.ph_lo == 103) phase_dump((const bf16_t*)(ws + WS_Y), DM, 0, a.out);
    if (DBG_STOP == 7 && a.ph_lo == 107) phase_dump((const bf16_t*)(ws + WS_ACT), DFF, 0, a.out);
}

extern "C" void kernel_launch(void* const* d_in, const int* in_sizes, int n_in, void* d_out, int out_size, void* d_ws, size_t ws_size, hipStream_t stream) {
    static int grid = 0;
    if (grid == 0) {
        if (n_in != 14 || ws_size < WS_END) { fprintf(stderr, "kernel_launch: unexpected n_in %d / ws_size %zu (need %zu)\n", n_in, ws_size, (size_t)WS_END); grid = -1; return; }
        int dev = 0, cus = 0, per_cu = 0;
        hipGetDevice(&dev); hipDeviceGetAttribute(&cus, hipDeviceAttributeMultiprocessorCount, dev);
        if (hipFuncSetAttribute((const void*)mega, hipFuncAttributeMaxDynamicSharedMemorySize, LDS_BYTES) != hipSuccess) { fprintf(stderr, "kernel_launch: hipFuncSetAttribute failed\n"); grid = -1; return; }
        if (hipOccupancyMaxActiveBlocksPerMultiprocessor(&per_cu, (const void*)mega, 512, LDS_BYTES) != hipSuccess || per_cu < 1) { fprintf(stderr, "kernel_launch: occupancy query failed (%d)\n", per_cu); (void)hipGetLastError(); per_cu = 1; }
        grid = cus * 1;
        fprintf(stderr, "kernel_launch: cus %d per_cu %d grid %d\n", cus, per_cu, grid);
    }
    if (grid < 0) return;
    if (hipMemsetAsync((char*)d_ws + WS_BAR, 0, WS_END - WS_BAR, stream)     != hipSuccess) { fprintf(stderr, "kernel_launch: memset failed\n"); return; }
    Args a{};
    a.x = (const float*)d_in[0]; a.w_in = (const float*)d_in[1]; a.b_gates = (const float*)d_in[2]; a.w_sc = (const float*)d_in[3]; a.mh_gain = (const float*)d_in[4]; a.w_out = (const float*)d_in[5];
    a.ln1_g = (const float*)d_in[6]; a.ln1_b = (const float*)d_in[7]; a.w_up = (const float*)d_in[8]; a.w_fc = (const float*)d_in[9]; a.b_fc = (const float*)d_in[10]; a.w_down = (const float*)d_in[11];
    a.ln2_g = (const float*)d_in[12]; a.ln2_b = (const float*)d_in[13];
    a.out = (float*)d_out; a.ws = (unsigned char*)d_ws;
    a.fuse_ln = (MK_SINGLE && grid == 256) ? 1 : 0;
#if MK_SINGLE
    a.ph_lo = 0; a.ph_hi = N_PHASES;
    void* args[] = {&a};
    hipError_t e = hipLaunchCooperativeKernel((const void*)mega, dim3(grid), dim3(512), args, LDS_BYTES, stream);
    if (e != hipSuccess) fprintf(stderr, "cooperative launch failed: %s (grid %d)\n", hipGetErrorString(e), grid);
#else
    for (int ph = 0; ph < N_PHASES; ++ph) { if (DBG_STOP >= 0 && ph > DBG_STOP) break; a.ph_lo = ph; a.ph_hi = ph + 1; hipLaunchKernelGGL(mega, dim3(grid), dim3(512), LDS_BYTES, stream, a); }
    if (DBG_STOP >= 0) { a.ph_lo = 100 + DBG_STOP; a.ph_hi = 101 + DBG_STOP; hipLaunchKernelGGL(mega, dim3(grid), dim3(512), LDS_BYTES, stream, a); }
#endif
}
```

```cpp
#include <hip/hip_runtime.h>
#include <hip/hip_cooperative_groups.h>
#include <cstdio>
#include <cstdint>
namespace cg = cooperative_groups;

#ifndef MK_SINGLE
#define MK_SINGLE 1
#endif

#define LAS __attribute__((address_space(3)))
typedef unsigned short bf16_t;
typedef short bf16x8 __attribute__((ext_vector_type(8)));
typedef float f32x4 __attribute__((ext_vector_type(4)));
typedef unsigned u32x4 __attribute__((ext_vector_type(4)));
typedef unsigned u32x2 __attribute__((ext_vector_type(2)));
typedef short s16x4 __attribute__((ext_vector_type(4)));

constexpr int MT = 8192, DM = 2048, SEQ = 2048, NIN = 7176, NP = 7168, DFF = 5632, NUP = 11264, WCONV = 1024;
constexpr float ALPHA = 1.189207115002721f;
constexpr size_t WS_WIN = 0;
constexpr size_t WS_WOUT = WS_WIN + (size_t)NP * DM * 2;
constexpr size_t WS_WUP = WS_WOUT + (size_t)DM * DM * 2;
constexpr size_t WS_WDN = WS_WUP + (size_t)NUP * DM * 2;
constexpr size_t WS_X1B = WS_WDN + (size_t)DM * DFF * 2;
constexpr size_t WS_GATES = WS_X1B + (size_t)MT * DM * 2;
constexpr size_t WS_C = WS_GATES + (size_t)MT * 8 * 4;
constexpr size_t WS_PROJ = WS_C;
constexpr size_t WS_Y = WS_PROJ + (size_t)MT * NP * 2;
constexpr size_t WS_XB = WS_Y + (size_t)MT * DM * 2;
constexpr size_t WS_ACT = WS_C;
constexpr size_t WS_HALO = WS_ACT + (size_t)MT * DFF * 2;
constexpr size_t WS_BAR = WS_XB + (size_t)MT * DM * 2;
constexpr size_t WS_RS1 = WS_BAR + 16384;
constexpr size_t WS_RS2 = WS_RS1 + (size_t)MT * 8;
constexpr size_t WS_CNT = WS_RS2 + (size_t)MT * 8;
constexpr size_t WS_END = WS_CNT + 2 * 32 * 256;
constexpr int LDS_BYTES = 131072 + 16 + 3 * 32 * 64 * 4;

struct Args {
    const float* x; const float* w_in; const float* b_gates; const float* w_sc; const float* mh_gain; const float* w_out;
    const float* ln1_g; const float* ln1_b; const float* w_up; const float* w_fc; const float* b_fc; const float* w_down;
    const float* ln2_g; const float* ln2_b;
    float* out; unsigned char* ws; int ph_lo, ph_hi, fuse_ln, pad0;
};

typedef __bf16 bf16v2 __attribute__((ext_vector_type(2)));
typedef float f32x2 __attribute__((ext_vector_type(2)));
__device__ __forceinline__ unsigned cvt_pk_bf16(float lo, float hi) { const f32x2 v = {lo, hi}; const bf16v2 r = __builtin_convertvector(v, bf16v2); return __builtin_bit_cast(unsigned, r); }
__device__ __forceinline__ unsigned cvt_pk_bf16_asm(float lo, float hi) { unsigned r; asm volatile("v_cvt_pk_bf16_f32 %0, %1, %2" : "=v"(r) : "v"(lo), "v"(hi)); return r; }
__device__ __forceinline__ float bflo(unsigned u) { return __uint_as_float(u << 16); }
__device__ __forceinline__ float bfhi(unsigned u) { return __uint_as_float(u & 0xffff0000u); }
__device__ __forceinline__ bf16_t f2bf(float f) { unsigned u = __float_as_uint(f); u += 0x7FFFu + ((u >> 16) & 1u); return (bf16_t)(u >> 16); }

namespace pg8 {
constexpr int BM = 256, BK = 64, HALF = 128, HTB = HALF * BK * 2, STAGE_BYTES = 8 * HTB, NXCD = 8, WGM = 8;
__host__ __device__ __forceinline__ int lds_byte(int r, int c) { const int st = (r >> 4) * 2 + (c >> 5), rr = r & 15, cc = c & 31, ob = rr * 64 + cc * 2; return st * 1024 + (ob ^ (((ob >> 9) & 1) << 5)); }
__host__ __device__ __forceinline__ void stage_rc(int b, int& R, int& C) { const int st = b / 1024, sb = b % 1024, swz = sb ^ (((sb >> 9) & 1) << 5); R = (st >> 1) * 16 + swz / 64; C = (st & 1) * 32 + (swz % 64) / 2; }
__host__ __device__ __forceinline__ int perm32(int rho) { const int n = rho >> 4, i = rho & 15; return 8 * (i >> 2) + 4 * n + (i & 3); }
struct Unit { int pm, pn; };
struct Gemm { const bf16_t* A; const bf16_t* Bt; int M, N, K; };
struct StaticOrder {
    int nM, nN, nwg, G, c;
    __device__ void init(int M, int N, int G_, int c_) { nM = M / BM; nN = N / BM; nwg = nM * nN; G = G_; c = c_; }
    __device__ bool next(int i, Unit& u) const {
        const long L = (long)i * G + c; if (L >= nwg) return false;
        int wgid = (int)L; { const int q = nwg / NXCD, r = nwg % NXCD, xcd = wgid % NXCD, off = wgid / NXCD; wgid = (xcd < r ? xcd * (q + 1) : r * (q + 1) + (xcd - r) * q) + off; }
        const int nig = WGM * nN, gid = wgid / nig, fm = gid * WGM, gsz = (nM - fm) < WGM ? (nM - fm) : WGM;
        u.pm = fm + ((wgid % nig) % gsz); u.pn = (wgid % nig) / gsz; return true;
    }
};

template <class Epi, bool ALIGN_EPI = false, bool SP2 = true>
__device__ __forceinline__ void gemm_phase(LAS unsigned char* lds, const Gemm g, const StaticOrder& S, const Epi& E) {
    const int tid = threadIdx.x, wid = __builtin_amdgcn_readfirstlane(tid >> 6), lane = tid & 63, wr = wid >> 2, wc = wid & 3, fr = lane & 15, fq = lane >> 4;
    const int K = g.K, nt = K / BK;
    unsigned voffA[2], voffB[2];
#pragma unroll
    for (int i = 0; i < 2; ++i) { int R, C; stage_rc(tid * 16 + i * 8192, R, C); const int Rb = Epi::PERM ? ((R & ~31) + perm32(R & 31)) : R;
        const int Ra = Epi::AROWPERM ? (128 * (R >> 6) + 8 * (R & 15) + ((R >> 4) & 3)) : R;
        voffA[i] = (unsigned)(Ra * K + C) * 2u; voffB[i] = (unsigned)(Rb * K + C) * 2u; }
    const size_t kstep = (size_t)(BK * 2);
    const size_t hstep = (size_t)HALF * K * 2;
    const size_t hstepA = Epi::AROWPERM ? (size_t)4 * K * 2 : hstep;
    const size_t tstep = 2 * hstep;
    const unsigned ldsw = (unsigned)wid * 1024u;
    const int aoff = lds_byte(wr * 64 + fr, fq * 8), boff = lds_byte(wc * 32 + fr, fq * 8);
#define PG8_SA(b, h) (((b) * 2 + (h)) * HTB)
#define PG8_SB(b, h) ((4 + (b) * 2 + (h)) * HTB)
#define PG8_STAGE(bufoff, gbase, voff) do { _Pragma("unroll") for (int _i = 0; _i < 2; ++_i) \
        __builtin_amdgcn_global_load_lds((const unsigned*)((const char*)(gbase) + (voff)[_i]), (LAS unsigned*)(lds + (bufoff) + ldsw + _i * 8192), 16, 0, 0); } while (0)
#define PG8_LDA(dst, b, h) do { _Pragma("unroll") for (int m = 0; m < 4; ++m) _Pragma("unroll") for (int k = 0; k < 2; ++k) dst[m][k] = *(const LAS bf16x8*)(lds + PG8_SA(b, h) + aoff + m * 2048 + k * 1024); } while (0)
#define PG8_LDB(dst, b, h) do { _Pragma("unroll") for (int n = 0; n < 2; ++n) _Pragma("unroll") for (int k = 0; k < 2; ++k) dst[n][k] = *(const LAS bf16x8*)(lds + PG8_SB(b, h) + boff + n * 2048 + k * 1024); } while (0)
#define PG8_MMA(ai, bj, At, Bt) do { __builtin_amdgcn_s_setprio(1); _Pragma("unroll") for (int m = 0; m < 4; ++m) _Pragma("unroll") for (int n = 0; n < 2; ++n) _Pragma("unroll") for (int k = 0; k < 2; ++k) \
        acc[ai][bj][m][n] = __builtin_amdgcn_mfma_f32_16x16x32_bf16(Bt[n][k], At[m][k], acc[ai][bj][m][n], 0, 0, 0); __builtin_amdgcn_s_setprio(0); } while (0)
#define PG8_WAIT_V(n) asm volatile("s_waitcnt vmcnt(" #n ")" ::: "memory")
#define PG8_WAIT_L(n) asm volatile("s_waitcnt lgkmcnt(" #n ")" ::: "memory")
#define PG8_BAR __builtin_amdgcn_s_barrier()
#define PG8_SCHED __builtin_amdgcn_sched_barrier(0)
    Unit cur, nxt; int ui = 0;
    if (!S.next(0, cur)) return;
    f32x4 acc[2][2][4][2];
#pragma unroll
    for (int a = 0; a < 2; ++a)
#pragma unroll
        for (int b = 0; b < 2; ++b)
#pragma unroll
            for (int m = 0; m < 4; ++m)
#pragma unroll
                for (int n = 0; n < 2; ++n) acc[a][b][m][n] = (f32x4){0.f, 0.f, 0.f, 0.f};
    bf16x8 At[4][2], B0[2][2], B1[2][2];
    const char* cA = (const char*)g.A + (size_t)cur.pm * tstep; const char* cB = (const char*)g.Bt + (size_t)cur.pn * tstep;
    if constexpr (SP2) {
        PG8_STAGE(PG8_SB(0, 0), cB, voffB); PG8_STAGE(PG8_SB(0, 1), cB + hstep, voffB); PG8_STAGE(PG8_SA(0, 0), cA, voffA); PG8_STAGE(PG8_SA(0, 1), cA + hstepA, voffA);
        if (wr == 1) PG8_BAR;
        PG8_WAIT_V(2); PG8_BAR;
        PG8_STAGE(PG8_SB(1, 0), cB + kstep, voffB); PG8_STAGE(PG8_SA(1, 0), cA + kstep, voffA); PG8_STAGE(PG8_SB(1, 1), cB + hstep + kstep, voffB);
        PG8_WAIT_V(6); PG8_BAR;
    } else {
        PG8_STAGE(PG8_SB(0, 0), cB, voffB); PG8_STAGE(PG8_SA(0, 0), cA, voffA); PG8_STAGE(PG8_SB(0, 1), cB + hstep, voffB); PG8_STAGE(PG8_SA(0, 1), cA + hstepA, voffA);
        if (wr == 1) PG8_BAR;
        PG8_WAIT_V(4); PG8_BAR;
        PG8_STAGE(PG8_SB(1, 0), cB + kstep, voffB); PG8_STAGE(PG8_SA(1, 0), cA + kstep, voffA); PG8_STAGE(PG8_SB(1, 1), cB + hstep + kstep, voffB);
        PG8_WAIT_V(6); PG8_BAR;
    }
    for (;;) {
        const bool has_next = S.next(ui + 1, nxt);
        const char* nA = has_next ? (const char*)g.A + (size_t)nxt.pm * tstep : cA; const char* nB = has_next ? (const char*)g.Bt + (size_t)nxt.pn * tstep : cB;
        for (int t = 0; t < nt; t += 2) {
            const bool last = (t == nt - 2);
            const char* a1 = cA + (size_t)(t + 1) * kstep;
            const char* a2 = last ? nA : cA + (size_t)(t + 2) * kstep; const char* b2 = last ? nB : cB + (size_t)(t + 2) * kstep;
            const char* a3 = a2 + kstep; const char* b3 = b2 + kstep;
            if constexpr (SP2) {
            PG8_LDB(B0, 0, 0); PG8_LDB(B1, 0, 1); PG8_SCHED; PG8_LDA(At, 0, 0); PG8_STAGE(PG8_SA(1, 1), a1 + hstepA, voffA);
            PG8_WAIT_V(8); PG8_WAIT_L(0); PG8_BAR; PG8_MMA(0, 0, At, B0); PG8_MMA(0, 1, At, B1); PG8_BAR; PG8_SCHED;
            PG8_LDA(At, 0, 1); PG8_STAGE(PG8_SB(0, 0), b2, voffB); PG8_STAGE(PG8_SB(0, 1), b2 + hstep, voffB); PG8_STAGE(PG8_SA(0, 0), a2, voffA);
            PG8_WAIT_V(8); PG8_WAIT_L(0); PG8_BAR; PG8_MMA(1, 0, At, B0); PG8_MMA(1, 1, At, B1); PG8_BAR; PG8_SCHED;
            PG8_LDB(B0, 1, 0); PG8_LDB(B1, 1, 1); PG8_SCHED; PG8_LDA(At, 1, 0); PG8_STAGE(PG8_SA(0, 1), a2 + hstepA, voffA);
            PG8_WAIT_V(8); PG8_WAIT_L(0); PG8_BAR; PG8_MMA(0, 0, At, B0); PG8_MMA(0, 1, At, B1); PG8_BAR; PG8_SCHED;
            PG8_LDA(At, 1, 1); PG8_STAGE(PG8_SB(1, 0), b3, voffB); PG8_STAGE(PG8_SB(1, 1), b3 + hstep, voffB); PG8_STAGE(PG8_SA(1, 0), a3, voffA);
            PG8_WAIT_V(8); PG8_WAIT_L(0); PG8_BAR; PG8_MMA(1, 0, At, B0); PG8_MMA(1, 1, At, B1); PG8_BAR; PG8_SCHED;
            } else {
            PG8_LDB(B0, 0, 0); PG8_SCHED; PG8_LDA(At, 0, 0); PG8_STAGE(PG8_SA(1, 1), a1 + hstepA, voffA);
            PG8_WAIT_L(8); PG8_BAR; PG8_WAIT_L(0); PG8_MMA(0, 0, At, B0); PG8_BAR; PG8_SCHED;
            PG8_LDB(B1, 0, 1); PG8_STAGE(PG8_SB(0, 0), b2, voffB);
            PG8_BAR; PG8_WAIT_L(0); PG8_MMA(0, 1, At, B1); PG8_BAR;
            PG8_LDA(At, 0, 1); PG8_STAGE(PG8_SA(0, 0), a2, voffA);
            PG8_BAR; PG8_WAIT_L(0); PG8_MMA(1, 0, At, B0); PG8_BAR; PG8_SCHED;
            PG8_STAGE(PG8_SB(0, 1), b2 + hstep, voffB);
            PG8_WAIT_V(6); PG8_BAR; PG8_MMA(1, 1, At, B1); PG8_BAR;
            PG8_LDB(B0, 1, 0); PG8_SCHED; PG8_LDA(At, 1, 0); PG8_STAGE(PG8_SA(0, 1), a2 + hstepA, voffA);
            PG8_WAIT_L(8); PG8_BAR; PG8_WAIT_L(0); PG8_MMA(0, 0, At, B0); PG8_BAR; PG8_SCHED;
            PG8_LDB(B1, 1, 1); PG8_STAGE(PG8_SB(1, 0), b3, voffB);
            PG8_BAR; PG8_WAIT_L(0); PG8_MMA(0, 1, At, B1); PG8_BAR;
            PG8_LDA(At, 1, 1); PG8_STAGE(PG8_SA(1, 0), a3, voffA);
            PG8_BAR; PG8_WAIT_L(0); PG8_MMA(1, 0, At, B0); PG8_BAR; PG8_SCHED;
            PG8_STAGE(PG8_SB(1, 1), b3 + hstep, voffB);
            PG8_WAIT_V(6); PG8_BAR; PG8_MMA(1, 1, At, B1); PG8_BAR;

            }
        }
        if constexpr (ALIGN_EPI) { if (wr == 0) PG8_BAR; }
        if constexpr (!Epi::AFTER_DRAIN) E(acc, cur, wr, wc, fr, fq);
        if (!has_next) break;
#pragma unroll
        for (int a = 0; a < 2; ++a)
#pragma unroll
            for (int b = 0; b < 2; ++b)
#pragma unroll
                for (int m = 0; m < 4; ++m)
#pragma unroll
                    for (int n = 0; n < 2; ++n) acc[a][b][m][n] = (f32x4){0.f, 0.f, 0.f, 0.f};
        cur = nxt; cA = nA; cB = nB; ++ui;
        if constexpr (ALIGN_EPI) { if (wr == 1) PG8_BAR; }
    }
    PG8_WAIT_V(0);
    if constexpr (!ALIGN_EPI) { if (wr == 0) PG8_BAR; }
    PG8_BAR;
    if constexpr (Epi::AFTER_DRAIN) E(acc, cur, wr, wc, fr, fq);
#undef PG8_SA
#undef PG8_SB
#undef PG8_STAGE
#undef PG8_LDA
#undef PG8_LDB
#undef PG8_MMA
#undef PG8_WAIT_V
#undef PG8_WAIT_L
#undef PG8_BAR
#undef PG8_SCHED
}

struct EpiBf16 {
    static constexpr bool PERM = true, AFTER_DRAIN = false, AROWPERM = false;
    bf16_t* O; int ldc;
    __device__ __forceinline__ void operator()(f32x4 (&acc)[2][2][4][2], const Unit& u, int wr, int wc, int fr, int fq) const {
        const int row0 = u.pm * BM + wr * 64 + fr, col0 = u.pn * BM + wc * 32 + 8 * fq;
#pragma unroll
        for (int ai = 0; ai < 2; ++ai)
#pragma unroll
            for (int m = 0; m < 4; ++m) { bf16_t* rowp = O + (size_t)(row0 + ai * HALF + m * 16) * ldc + col0;
#pragma unroll
                for (int bj = 0; bj < 2; ++bj) { const f32x4 v0 = acc[ai][bj][m][0], v1 = acc[ai][bj][m][1];
                    u32x4 w; w.x = cvt_pk_bf16_asm(v0[0], v0[1]); w.y = cvt_pk_bf16_asm(v0[2], v0[3]); w.z = cvt_pk_bf16_asm(v1[0], v1[1]); w.w = cvt_pk_bf16_asm(v1[2], v1[3]);
                    *(u32x4*)(rowp + bj * HALF) = w; } }
    }
};
struct EpiResF32 {
    static constexpr bool PERM = false, AFTER_DRAIN = false, AROWPERM = false;
    const float* X; float* O; int ldc;
    __device__ __forceinline__ void operator()(f32x4 (&acc)[2][2][4][2], const Unit& u, int wr, int wc, int fr, int fq) const {
        const int row0 = u.pm * BM + wr * 64 + fr, col0 = u.pn * BM + wc * 32 + 4 * fq;
#pragma unroll
        for (int ai = 0; ai < 2; ++ai)
#pragma unroll
            for (int m = 0; m < 4; ++m) { const size_t ro = (size_t)(row0 + ai * HALF + m * 16) * ldc + col0;
#pragma unroll
                for (int bj = 0; bj < 2; ++bj)
#pragma unroll
                    for (int n = 0; n < 2; ++n) { const f32x4 xv = *(const f32x4*)(X + ro + bj * HALF + n * 16);
                        *(f32x4*)(O + ro + bj * HALF + n * 16) = xv * ALPHA + acc[ai][bj][m][n]; } }
    }
};
template <bool XBF  , bool WF32  > struct EpiResLn {
    static constexpr bool PERM = true, AFTER_DRAIN = true, AROWPERM = false;
    const float* X; const bf16_t* XB; float* O; bf16_t* OB; const float* gam; const float* bet; float* rs; unsigned* cnt;
    __device__ __forceinline__ void operator()(f32x4 (&acc)[2][2][4][2], const Unit& u, int wr, int wc, int fr, int fq) const {
        const int row0 = u.pm * BM + wr * 64 + fr, col0 = u.pn * BM + wc * 32 + 8 * fq;
#pragma unroll
        for (int ai = 0; ai < 2; ++ai)
#pragma unroll
            for (int m = 0; m < 4; ++m) { const int row = row0 + ai * HALF + m * 16; const size_t ro = (size_t)row * DM + col0;
                float s = 0.f, q = 0.f;
#pragma unroll
                for (int bj = 0; bj < 2; ++bj)
#pragma unroll
                    for (int n = 0; n < 2; ++n) { f32x4 xv;
                        if constexpr (XBF) { const u32x2 xb2 = *(const u32x2*)(XB + ro + bj * HALF + n * 4); xv = (f32x4){bflo(xb2.x), bfhi(xb2.x), bflo(xb2.y), bfhi(xb2.y)}; }
                        else xv = *(const f32x4*)(X + ro + bj * HALF + n * 4);
                        const f32x4 z = xv * ALPHA + acc[ai][bj][m][n]; acc[ai][bj][m][n] = z;
                        s += (z[0] + z[1]) + (z[2] + z[3]); q += (z[0] * z[0] + z[1] * z[1]) + (z[2] * z[2] + z[3] * z[3]); }
                s += __shfl_xor(s, 16); s += __shfl_xor(s, 32); q += __shfl_xor(q, 16); q += __shfl_xor(q, 32);
                if (fq == 0) { (void)__hip_atomic_fetch_add(rs + 2 * row, s, __ATOMIC_RELAXED, __HIP_MEMORY_SCOPE_AGENT); (void)__hip_atomic_fetch_add(rs + 2 * row + 1, q, __ATOMIC_RELAXED, __HIP_MEMORY_SCOPE_AGENT); } }
        asm volatile("s_waitcnt vmcnt(0)" ::: "memory");
        unsigned* cp = cnt + 64 * u.pm;
        if ((threadIdx.x & 63) == 0) (void)__hip_atomic_fetch_add(cp, 1u, __ATOMIC_RELAXED, __HIP_MEMORY_SCOPE_AGENT);
        { unsigned sp = 0; while ((unsigned)__builtin_amdgcn_readfirstlane(__hip_atomic_load(cp, __ATOMIC_RELAXED, __HIP_MEMORY_SCOPE_AGENT)) < 64u) { __builtin_amdgcn_s_sleep(2); if (++sp > (1u << 22)) break; } }
        f32x4 gg[2][2], bb[2][2];
#pragma unroll
        for (int bj = 0; bj < 2; ++bj)
#pragma unroll
            for (int n = 0; n < 2; ++n) { gg[bj][n] = *(const f32x4*)(gam + col0 + bj * HALF + n * 4); bb[bj][n] = *(const f32x4*)(bet + col0 + bj * HALF + n * 4); }
#pragma unroll
        for (int ai = 0; ai < 2; ++ai)
#pragma unroll
            for (int m = 0; m < 4; ++m) { const int row = row0 + ai * HALF + m * 16; const size_t ro = (size_t)row * DM + col0;
                const float s = __hip_atomic_load(rs + 2 * row, __ATOMIC_RELAXED, __HIP_MEMORY_SCOPE_AGENT), q = __hip_atomic_load(rs + 2 * row + 1, __ATOMIC_RELAXED, __HIP_MEMORY_SCOPE_AGENT);
                const float mu = s * (1.0f / DM), rstd = rsqrtf(fmaxf(q * (1.0f / DM) - mu * mu, 0.f) + 1e-5f);
#pragma unroll
                for (int bj = 0; bj < 2; ++bj)
#pragma unroll
                    for (int n = 0; n < 2; ++n) { const f32x4 o = (acc[ai][bj][m][n] - mu) * rstd * gg[bj][n] + bb[bj][n];
                        if constexpr (WF32) *(f32x4*)(O + ro + bj * HALF + n * 4) = o;
                        if (OB) { u32x2 p; p.x = cvt_pk_bf16_asm(o[0], o[1]); p.y = cvt_pk_bf16_asm(o[2], o[3]); *(u32x2*)(OB + ro + bj * HALF + n * 4) = p; } } }
    }
};
__device__ __forceinline__ float dpp_shr1(float x) { return __builtin_bit_cast(float, __builtin_amdgcn_update_dpp(0, __builtin_bit_cast(int, x), 0x111, 0xf, 0xf, true)); }
struct EpiConvFfn {
    static constexpr bool PERM = true, AFTER_DRAIN = false, AROWPERM = true;
    bf16_t* act; float* halo; const float* cw; const float* cb;
    __device__ __forceinline__ void operator()(f32x4 (&acc)[2][2][4][2], const Unit& u, int wr, int wc, int fr, int fq) const {
        const int fcol = u.pn * 128 + wc * 32 + 8 * fq;
        const int rbase = u.pm * BM + wr * 128;
        {
            float* hb = halo + (size_t)(rbase >> 7) * 4 * NUP + fcol;
            if (fr == 0) {
#pragma unroll
                for (int bj = 0; bj < 2; ++bj)
#pragma unroll
                    for (int n = 0; n < 2; ++n) { *(f32x4*)(hb + (size_t)2 * NUP + bj * DFF + 4 * n) = acc[0][bj][0][n]; *(f32x4*)(hb + (size_t)3 * NUP + bj * DFF + 4 * n) = acc[0][bj][1][n]; }
            }
            if (fr == 15) {
#pragma unroll
                for (int bj = 0; bj < 2; ++bj)
#pragma unroll
                    for (int n = 0; n < 2; ++n) { *(f32x4*)(hb + bj * DFF + 4 * n) = acc[1][bj][2][n]; *(f32x4*)(hb + (size_t)1 * NUP + bj * DFF + 4 * n) = acc[1][bj][3][n]; }
            }
        }
        u32x2 pk0[8];
#pragma unroll
        for (int n = 0; n < 2; ++n) {
            f32x4 W0[2], W1[2], W2[2], Bb[2];
#pragma unroll
            for (int bj = 0; bj < 2; ++bj) { const int hc = bj * DFF + fcol + 4 * n;
                W0[bj] = *(const f32x4*)(cw + hc); W1[bj] = *(const f32x4*)(cw + NUP + hc); W2[bj] = *(const f32x4*)(cw + 2 * NUP + hc); Bb[bj] = *(const f32x4*)(cb + hc); }
            f32x4 E6[2], E7[2];
#pragma unroll
            for (int bj = 0; bj < 2; ++bj) { const f32x4 s6 = acc[1][bj][2][n], s7 = acc[1][bj][3][n];
                E6[bj][0] = dpp_shr1(s6[0]); E6[bj][1] = dpp_shr1(s6[1]); E6[bj][2] = dpp_shr1(s6[2]); E6[bj][3] = dpp_shr1(s6[3]);
                E7[bj][0] = dpp_shr1(s7[0]); E7[bj][1] = dpp_shr1(s7[1]); E7[bj][2] = dpp_shr1(s7[2]); E7[bj][3] = dpp_shr1(s7[3]); }
#pragma unroll
            for (int i = 0; i < 8; ++i) {
                f32x4 h[2];
#pragma unroll
                for (int bj = 0; bj < 2; ++bj) {
                    const f32x4 cur = acc[i >> 2][bj][i & 3][n];
                    const f32x4 p1 = (i >= 1) ? acc[(i - 1 >= 0 ? i - 1 : 0) >> 2][bj][(i - 1 >= 0 ? i - 1 : 0) & 3][n] : E7[bj];
                    const f32x4 p2 = (i >= 2) ? acc[(i - 2 >= 0 ? i - 2 : 0) >> 2][bj][(i - 2 >= 0 ? i - 2 : 0) & 3][n] : (i == 1 ? E7[bj] : E6[bj]);
                    h[bj] = W2[bj] * cur + W1[bj] * p1 + W0[bj] * p2 + Bb[bj];
                }
                const f32x4 gt = h[1], ng = gt * (-1.4426950408889634f);
                f32x4 r;
#pragma unroll
                for (int j = 0; j < 4; ++j) r[j] = __builtin_amdgcn_rcpf(1.0f + __builtin_amdgcn_exp2f(ng[j]));
                const f32x4 av = h[0] * gt * r;
                u32x2 pk; pk.x = cvt_pk_bf16_asm(av[0], av[1]); pk.y = cvt_pk_bf16_asm(av[2], av[3]);
                if (n == 0) pk0[i] = pk;
                else if (i >= 2 || fr > 0) { u32x4 w; w.x = pk0[i].x; w.y = pk0[i].y; w.z = pk.x; w.w = pk.y;
                    *(u32x4*)(act + (size_t)(rbase + 8 * fr + i) * DFF + fcol) = w; }
            }
            asm volatile("" ::: "memory");
        }
    }
};
}

template <bool UPMAP>
__device__ __forceinline__ void transpose_macro(const float* W, int ldw, int k0, int n0, bf16_t* Wt, int ldt, unsigned char* lds) {
    bf16_t* sT = (bf16_t*)lds; const int tid = threadIdx.x;
    float4 v[2][4];
#pragma unroll
    for (int i = 0; i < 2; ++i)
#pragma unroll
        for (int j = 0; j < 4; ++j) v[i][j] = *(const float4*)(W + (size_t)(k0 + (tid >> 4) + 32 * i) * ldw + n0 + 64 * j + (tid & 15) * 4);
#pragma unroll
    for (int i = 0; i < 2; ++i)
#pragma unroll
        for (int j = 0; j < 4; ++j) { const int k = (tid >> 4) + 32 * i, n = 64 * j + (tid & 15) * 4;
            sT[(n + 0) * 66 + k] = f2bf(v[i][j].x); sT[(n + 1) * 66 + k] = f2bf(v[i][j].y); sT[(n + 2) * 66 + k] = f2bf(v[i][j].z); sT[(n + 3) * 66 + k] = f2bf(v[i][j].w); }
    __syncthreads();
#pragma unroll
    for (int j = 0; j < 4; ++j) { const int n = 64 * j + (tid >> 3), ks = (tid & 7) * 8; const unsigned* p = (const unsigned*)(sT + n * 66 + ks);
        u32x4 o; o.x = p[0]; o.y = p[1]; o.z = p[2]; o.w = p[3];
        int drow = n0 + n;
        if (UPMAP) { const int f = (drow < DFF) ? drow : drow - DFF; drow = 256 * (f >> 7) + (f & 127) + ((drow < DFF) ? 0 : 128); }
        *(u32x4*)(Wt + (size_t)drow * ldt + k0 + ks) = o; }
    __syncthreads();
}
constexpr int TM_IN = 32 * 28, TM_OUT = 32 * 8, TM_UP = 32 * 44, TM_DN = 88 * 8;
__device__ __forceinline__ void phase_transposes(const Args& A, unsigned char* lds, int g0, int g1, int worker, int nworkers) {
    unsigned char* ws = A.ws;
    for (int g = g0 + worker; g < g1; g += nworkers) {
        if (g < TM_IN) { const int tk = g / 28, tn = g % 28; transpose_macro<false>(A.w_in, NIN, tk * 64, tn * 256, (bf16_t*)(ws + WS_WIN), DM, lds); }
        else if (g < TM_IN + TM_OUT) { const int h = g - TM_IN, tk = h / 8, tn = h % 8; transpose_macro<false>(A.w_out, DM, tk * 64, tn * 256, (bf16_t*)(ws + WS_WOUT), DM, lds); }
        else if (g < TM_IN + TM_OUT + TM_UP) { const int h = g - TM_IN - TM_OUT, tk = h / 44, tn = h % 44; transpose_macro<true>(A.w_up, NUP, tk * 64, tn * 256, (bf16_t*)(ws + WS_WUP), DM, lds); }
        else { const int h = g - TM_IN - TM_OUT - TM_UP, tk = h / 8, tn = h % 8; transpose_macro<false>(A.w_down, DM, tk * 64, tn * 256, (bf16_t*)(ws + WS_WDN), DFF, lds); }
    }
}
__device__ __forceinline__ void phase_prologue(const Args& A, unsigned char* lds) {
    unsigned char* ws = A.ws;
    const int lane = threadIdx.x & 63, gw = blockIdx.x * 8 + (threadIdx.x >> 6), nw = gridDim.x * 8;
    bf16_t* xb = (bf16_t*)(ws + WS_XB); float* gates = (float*)(ws + WS_GATES);
    phase_transposes(A, lds, 0, TM_IN, blockIdx.x, gridDim.x);
    for (int it = gw; it < MT / 4; it += nw) {
        const int r0 = it * 4;
        float acc[4][8];
#pragma unroll
        for (int r = 0; r < 4; ++r)
#pragma unroll
            for (int q = 0; q < 8; ++q) acc[r][q] = 0.f;
#pragma unroll 1
        for (int ih = 0; ih < 2; ++ih) {
        f32x4 xq[4][4];
#pragma unroll
        for (int i = 0; i < 4; ++i)
#pragma unroll
            for (int r = 0; r < 4; ++r) xq[i][r] = *(const f32x4*)(A.x + (size_t)(r0 + r) * DM + (ih * 4 + i) * 256 + lane * 4);
#pragma unroll
        for (int i = 0; i < 4; ++i) {
            const int kb = (ih * 4 + i) * 256 + lane * 4;
            f32x4 xv[4];
#pragma unroll
            for (int r = 0; r < 4; ++r) { xv[r] = xq[i][r];
                u32x2 o; o.x = cvt_pk_bf16(xv[r][0], xv[r][1]); o.y = cvt_pk_bf16(xv[r][2], xv[r][3]); *(u32x2*)(xb + (size_t)(r0 + r) * DM + kb) = o; }
#pragma unroll
            for (int j = 0; j < 4; ++j) {
                const f32x4* wp = (const f32x4*)(A.w_in + (size_t)(kb + j) * NIN + NP);
                const f32x4 w0 = wp[0], w1 = wp[1];
#pragma unroll
                for (int r = 0; r < 4; ++r) { const float xs = xv[r][j];
                    acc[r][0] += xs * w0[0]; acc[r][1] += xs * w0[1]; acc[r][2] += xs * w0[2]; acc[r][3] += xs * w0[3];
                    acc[r][4] += xs * w1[0]; acc[r][5] += xs * w1[1]; acc[r][6] += xs * w1[2]; acc[r][7] += xs * w1[3]; }
            }
        }
        }
#pragma unroll
        for (int r = 0; r < 4; ++r)
#pragma unroll
            for (int q = 0; q < 8; ++q) { float v = acc[r][q];
#pragma unroll
                for (int off = 32; off >= 1; off >>= 1) v += __shfl_xor(v, off);
                acc[r][q] = v; }
        if (lane == 0) {
            const f32x4 b0 = *(const f32x4*)(A.b_gates), b1 = *(const f32x4*)(A.b_gates + 4);
#pragma unroll
            for (int r = 0; r < 4; ++r) {
                *(f32x4*)(gates + (size_t)(r0 + r) * 8) = (f32x4){acc[r][0] + b0[0], acc[r][1] + b0[1], acc[r][2] + b0[2], acc[r][3] + b0[3]};
                *(f32x4*)(gates + (size_t)(r0 + r) * 8 + 4) = (f32x4){acc[r][4] + b1[0], acc[r][5] + b1[1], acc[r][6] + b1[2], acc[r][7] + b1[3]}; }
        }
    }
}

__device__ __forceinline__ void phase_yconv(const Args& A) {
    const bf16_t* proj = (const bf16_t*)(A.ws + WS_PROJ); bf16_t* y = (bf16_t*)(A.ws + WS_Y);
    for (int idx = blockIdx.x * 512 + threadIdx.x; idx < MT * 128; idx += gridDim.x * 512) {
        const int row = idx >> 7, c = (idx & 127) * 8, t = row & (SEQ - 1);
        const bf16_t* pr = proj + (size_t)row * NP + c;
        const u32x4 bv = *(const u32x4*)pr;
        float cv[8];
#pragma unroll
        for (int i = 0; i < 8; ++i) cv[i] = 0.f;
#pragma unroll
        for (int j = 0; j < 3; ++j) {
            const int dt = 2 - j;
            if (t - dt >= 0) {
                const u32x4 cc = *(const u32x4*)(pr - (size_t)dt * NP + WCONV), hh = *(const u32x4*)(pr - (size_t)dt * NP + 2 * WCONV);
                const f32x4 w0 = *(const f32x4*)(A.w_sc + j * WCONV + c), w1 = *(const f32x4*)(A.w_sc + j * WCONV + c + 4);
                const float wv[8] = {w0[0], w0[1], w0[2], w0[3], w1[0], w1[1], w1[2], w1[3]};
#pragma unroll
                for (int q = 0; q < 4; ++q) { cv[2 * q] += wv[2 * q] * bflo(cc[q]) * bflo(hh[q]); cv[2 * q + 1] += wv[2 * q + 1] * bfhi(cc[q]) * bfhi(hh[q]); }
            }
        }
        u32x4 o;
#pragma unroll
        for (int q = 0; q < 4; ++q) o[q] = cvt_pk_bf16(bflo(bv[q]) * cv[2 * q], bfhi(bv[q]) * cv[2 * q + 1]);
        *(u32x4*)(y + (size_t)row * DM + c) = o;
    }
}

__device__ __forceinline__ void phase_mlstm(const Args& A, unsigned char* lds, float* hbuf) {
    const int tid = threadIdx.x, lane = tid & 63, w = tid >> 6, g = lane >> 4, l15 = lane & 15;
    const int a = w >> 2, ti = w & 3;
    unsigned char* QS = lds; unsigned char* KS = lds + 33792; unsigned char* VT = lds + 67584; unsigned char* WVT = VT + 4608; unsigned char* CT = WVT + 4608; unsigned char* XCH = CT + 33792;
    const bf16_t* proj = (const bf16_t*)(A.ws + WS_PROJ); const float* gates = (const float*)(A.ws + WS_GATES);
    float* TBC = (float*)(lds + 131088); float* TUV = TBC + 2048; float* TCM = TUV + 2048;
    for (int item = blockIdx.x; item < 256; item += gridDim.x) {
        const int xcd = item & 7, idx = item >> 3; const int bh = xcd * 2 + (idx >> 4), es = idx & 15;
        const int b = bh >> 2, hh = bh & 3, e0 = es * 16;
        const size_t row0 = (size_t)b * SEQ;
        __syncthreads();
        for (int i = tid; i < 16896 / 4; i += 512) ((unsigned*)CT)[i] = 0u;
        for (int i = tid; i < 16 * 72; i += 512) { const int r = 16 + i / 72, ci = i % 72; ((bf16_t*)VT)[r * 72 + ci] = (r == 16) ? (bf16_t)0x3F80 : (bf16_t)0; ((bf16_t*)WVT)[r * 72 + ci] = 0; }
        f32x4 Cst[2][2];
#pragma unroll
        for (int x = 0; x < 2; ++x)
#pragma unroll
            for (int et = 0; et < 2; ++et) Cst[x][et] = (f32x4){0.f, 0.f, 0.f, 0.f};
        float m_state = 0.f;
        u32x4 qr[4], kr[4]; unsigned vr;
        const bf16_t* qbase = proj + row0 * NP + 3072 + hh * 256;
#define ML_LOAD(c) do { _Pragma("unroll") for (int i = 0; i < 4; ++i) { const int p = tid + 512 * i, r = p >> 5, c16 = p & 31; const bf16_t* rp = qbase + (size_t)((c) * 64 + r) * NP + c16 * 8; \
            qr[i] = *(const u32x4*)rp; kr[i] = *(const u32x4*)(rp + 1024); } \
            vr = *(const unsigned*)(qbase + (size_t)((c) * 64 + (tid >> 3)) * NP + 2048 + e0 + (tid & 7) * 2); } while (0)
        ML_LOAD(0);
#pragma unroll 1
        for (int cc = 4 * w; cc < 4 * w + 4; ++cc) {
            const float* gp = gates + (row0 + cc * 64 + lane) * 8 + hh; const float gi = gp[0], gf = gp[4];
            const float lf = fminf(gf, 0.f) - log1pf(__expf(-fabsf(gf)));
            float bc = lf;
#pragma unroll
            for (int off = 1; off < 64; off <<= 1) { const float t = __shfl_up(bc, off); if (lane >= off) bc += t; }
            const float uv = gi - bc;
            float cm = uv;
#pragma unroll
            for (int off = 1; off < 64; off <<= 1) { const float t = __shfl_up(cm, off); if (lane >= off) cm = fmaxf(cm, t); }
            TBC[cc * 64 + lane] = bc; TUV[cc * 64 + lane] = uv; TCM[cc * 64 + lane] = cm;
        }
        __syncthreads();
#pragma unroll 1
        for (int c = 0; c < 32; ++c) {
            const float* tbc = TBC + c * 64; const float* tuv = TUV + c * 64; const float* tcm = TCM + c * 64;
            const float g_tot = tbc[63], cm63 = tcm[63];
            const float M63 = fmaxf(m_state, cm63), decay = __expf(m_state - M63);
            const float m_old = m_state;
            m_state = g_tot + M63;
#pragma unroll
            for (int i = 0; i < 4; ++i) { const int p = tid + 512 * i, r = p >> 5, c16 = p & 31; *(u32x4*)(QS + r * 528 + c16 * 16) = qr[i]; *(u32x4*)(KS + r * 528 + c16 * 16) = kr[i]; }
            { const int s = tid >> 3, ep = tid & 7; const float wv = __expf(tuv[s] - M63);
              ((bf16_t*)VT)[(2 * ep) * 72 + s] = (bf16_t)(vr & 0xffffu); ((bf16_t*)VT)[(2 * ep + 1) * 72 + s] = (bf16_t)(vr >> 16);
              ((bf16_t*)WVT)[(2 * ep) * 72 + s] = f2bf(bflo(vr) * wv); ((bf16_t*)WVT)[(2 * ep + 1) * 72 + s] = f2bf(bfhi(vr) * wv);
              if (ep == 0) ((bf16_t*)WVT)[16 * 72 + s] = f2bf(wv); }
            if (c + 1 < 32) ML_LOAD(c + 1);
            __syncthreads();
            bf16x8 qf[8]; f32x4 S0 = (f32x4){0.f, 0.f, 0.f, 0.f}, S1 = S0;
#pragma unroll
            for (int kk = 0; kk < 8; ++kk) {
                const int ko = ((kk + 4 * a) & 7) * 64 + g * 16;
                qf[kk] = *(const bf16x8*)(QS + (16 * ti + l15) * 528 + ko);
                const bf16x8 kf0 = *(const bf16x8*)(KS + (32 * a + l15) * 528 + ko), kf1 = *(const bf16x8*)(KS + (32 * a + 16 + l15) * 528 + ko);
                S0 = __builtin_amdgcn_mfma_f32_16x16x32_bf16(kf0, qf[kk], S0, 0, 0, 0); S1 = __builtin_amdgcn_mfma_f32_16x16x32_bf16(kf1, qf[kk], S1, 0, 0, 0);
            }
            const int tcol = 16 * ti + l15;
            const float Mt = fmaxf(m_old, tcm[tcol]);
            const f32x4 u0v = *(const f32x4*)(tuv + 32 * a + 4 * g), u1v = *(const f32x4*)(tuv + 32 * a + 16 + 4 * g);
            float p[8];
#pragma unroll
            for (int r = 0; r < 4; ++r) { const int s0 = 32 * a + 4 * g + r, s1 = s0 + 16;
                p[r] = (s0 <= tcol) ? S0[r] * 0.0625f * __expf(u0v[r] - Mt) : 0.f; p[4 + r] = (s1 <= tcol) ? S1[r] * 0.0625f * __expf(u1v[r] - Mt) : 0.f; }
            u32x4 pau; pau.x = cvt_pk_bf16(p[0], p[1]); pau.y = cvt_pk_bf16(p[2], p[3]); pau.z = cvt_pk_bf16(p[4], p[5]); pau.w = cvt_pk_bf16(p[6], p[7]);
            const bf16x8 pa = __builtin_bit_cast(bf16x8, pau);
            f32x4 rr[2];
#pragma unroll
            for (int et = 0; et < 2; ++et) { const unsigned char* vp = VT + (16 * et + l15) * 144 + (32 * a + 4 * g) * 2;
                const u32x2 lo = *(const u32x2*)vp, hi = *(const u32x2*)(vp + 32);
                u32x4 vbu; vbu.x = lo.x; vbu.y = lo.y; vbu.z = hi.x; vbu.w = hi.y;
                rr[et] = __builtin_amdgcn_mfma_f32_16x16x32_bf16(pa, __builtin_bit_cast(bf16x8, vbu), (f32x4){0.f, 0.f, 0.f, 0.f}, 0, 0, 0); }
            const f32x4 cmr = *(const f32x4*)(tcm + 16 * ti + 4 * g), bcr = *(const f32x4*)(tbc + 16 * ti + 4 * g);
            {
                const unsigned char* CTc = CT + (c & 1) * 16896;
                f32x4 in0 = (f32x4){0.f, 0.f, 0.f, 0.f}, in1 = in0;
#pragma unroll
                for (int k2 = 0; k2 < 4; ++k2) {
                    const bf16x8 qa = qf[k2];
                    const bf16x8 c0 = *(const bf16x8*)(CTc + (l15) * 528 + (128 * a + 32 * k2 + 8 * g) * 2), c1 = *(const bf16x8*)(CTc + (16 + l15) * 528 + (128 * a + 32 * k2 + 8 * g) * 2);
                    in0 = __builtin_amdgcn_mfma_f32_16x16x32_bf16(qa, c0, in0, 0, 0, 0); in1 = __builtin_amdgcn_mfma_f32_16x16x32_bf16(qa, c1, in1, 0, 0, 0);
                }
#pragma unroll
                for (int r = 0; r < 4; ++r) { const float iw = __expf(m_old - fmaxf(m_old, cmr[r])) * 0.0625f; rr[0][r] += in0[r] * iw; rr[1][r] += in1[r] * iw; }
            }
            if (a == 1) { *(f32x4*)(XCH + ((ti * 2 + 0) * 64 + lane) * 16) = rr[0]; *(f32x4*)(XCH + ((ti * 2 + 1) * 64 + lane) * 16) = rr[1]; }
            {
                unsigned char* CTn = CT + ((c + 1) & 1) * 16896;
#pragma unroll
                for (int x = 0; x < 2; ++x) {
                    const int dt = 2 * w + x;
#pragma unroll
                    for (int et = 0; et < 2; ++et) Cst[x][et] *= decay;
#pragma unroll
                    for (int ks = 0; ks < 2; ++ks) {
                        const s16x4 klo = __builtin_amdgcn_ds_read_tr16_b64_v4i16((LAS s16x4*)(KS + (32 * ks + 8 * g + (l15 >> 2)) * 528 + (16 * dt + 4 * (l15 & 3)) * 2));
                        const s16x4 khi = __builtin_amdgcn_ds_read_tr16_b64_v4i16((LAS s16x4*)(KS + (32 * ks + 8 * g + 4 + (l15 >> 2)) * 528 + (16 * dt + 4 * (l15 & 3)) * 2));
                        const bf16x8 ka = {klo[0], klo[1], klo[2], klo[3], khi[0], khi[1], khi[2], khi[3]};
#pragma unroll
                        for (int et = 0; et < 2; ++et) { const bf16x8 wvb = *(const bf16x8*)(WVT + (16 * et + l15) * 144 + (32 * ks + 8 * g) * 2);
                            Cst[x][et] = __builtin_amdgcn_mfma_f32_16x16x32_bf16(ka, wvb, Cst[x][et], 0, 0, 0); }
                    }
#pragma unroll
                    for (int et = 0; et < 2; ++et) { u32x2 o; o.x = cvt_pk_bf16(Cst[x][et][0], Cst[x][et][1]); o.y = cvt_pk_bf16(Cst[x][et][2], Cst[x][et][3]);
                        *(u32x2*)(CTn + (16 * et + l15) * 528 + (16 * dt + 4 * g) * 2) = o; }
                }
            }
            __syncthreads();
            if (a == 0) {
                const f32x4 o0 = *(const f32x4*)(XCH + ((ti * 2 + 0) * 64 + lane) * 16), o1 = *(const f32x4*)(XCH + ((ti * 2 + 1) * 64 + lane) * 16);
#pragma unroll
                for (int r = 0; r < 4; ++r) {
                    const float den = __shfl(rr[1][r] + o1[r], lane & 48), fl = __expf(-(bcr[r] + fmaxf(m_old, cmr[r])));
                    const float hv = (rr[0][r] + o0[r]) * __builtin_amdgcn_rcpf(fmaxf(fabsf(den), fl));
                    hbuf[(row0 + c * 64 + 16 * ti + 4 * g + r) * 1024 + hh * 256 + e0 + l15] = hv;
                }
            }
        }
#undef ML_LOAD
    }
}

__device__ __forceinline__ void phase_headnorm(const Args& A, const float* hbuf) {
    const bf16_t* proj = (const bf16_t*)(A.ws + WS_PROJ); bf16_t* y = (bf16_t*)(A.ws + WS_Y);
    const int lane = threadIdx.x & 63, gw = blockIdx.x * 8 + (threadIdx.x >> 6), nw = gridDim.x * 8;
    f32x4 gn[4];
#pragma unroll
    for (int hh = 0; hh < 4; ++hh) gn[hh] = *(const f32x4*)(A.mh_gain + hh * 256 + lane * 4);
    for (int row = gw; row < MT; row += nw) {
        f32x4 hv[4]; u32x2 ov[4]; float s[4], q[4];
#pragma unroll
        for (int hh = 0; hh < 4; ++hh) { hv[hh] = *(const f32x4*)(hbuf + (size_t)row * 1024 + hh * 256 + lane * 4); ov[hh] = *(const u32x2*)(proj + (size_t)row * NP + 6144 + hh * 256 + lane * 4); }
#pragma unroll
        for (int hh = 0; hh < 4; ++hh) s[hh] = (hv[hh][0] + hv[hh][1]) + (hv[hh][2] + hv[hh][3]);
#pragma unroll
        for (int off = 32; off >= 1; off >>= 1)
#pragma unroll
            for (int hh = 0; hh < 4; ++hh) s[hh] += __shfl_xor(s[hh], off);
#pragma unroll
        for (int hh = 0; hh < 4; ++hh) { const float mu = s[hh] * (1.0f / 256.0f); hv[hh] = hv[hh] - mu; q[hh] = (hv[hh][0] * hv[hh][0] + hv[hh][1] * hv[hh][1]) + (hv[hh][2] * hv[hh][2] + hv[hh][3] * hv[hh][3]); }
#pragma unroll
        for (int off = 32; off >= 1; off >>= 1)
#pragma unroll
            for (int hh = 0; hh < 4; ++hh) q[hh] += __shfl_xor(q[hh], off);
#pragma unroll
        for (int hh = 0; hh < 4; ++hh) {
            const float rstd = rsqrtf(q[hh] * (1.0f / 256.0f) + 1e-6f);
            const float o0 = bflo(ov[hh].x), o1 = bfhi(ov[hh].x), o2 = bflo(ov[hh].y), o3 = bfhi(ov[hh].y);
            const float y0 = hv[hh][0] * rstd * gn[hh][0] * __builtin_amdgcn_rcpf(1.0f + __expf(-o0)), y1 = hv[hh][1] * rstd * gn[hh][1] * __builtin_amdgcn_rcpf(1.0f + __expf(-o1));
            const float y2 = hv[hh][2] * rstd * gn[hh][2] * __builtin_amdgcn_rcpf(1.0f + __expf(-o2)), y3 = hv[hh][3] * rstd * gn[hh][3] * __builtin_amdgcn_rcpf(1.0f + __expf(-o3));
            u32x2 o; o.x = cvt_pk_bf16(y0, y1); o.y = cvt_pk_bf16(y2, y3);
            *(u32x2*)(y + (size_t)row * DM + WCONV + hh * 256 + lane * 4) = o;
        }
    }
}

__device__ __forceinline__ void phase_ln(float* io, const float* gam, const float* bet, bf16_t* ob) {
    const int lane = threadIdx.x & 63, gw = blockIdx.x * 8 + (threadIdx.x >> 6), nw = gridDim.x * 8;
    for (int row = gw; row < MT; row += nw) {
        float* rp = io + (size_t)row * DM;
        f32x4 v[8]; float s = 0.f;
#pragma unroll
        for (int i = 0; i < 8; ++i) { v[i] = *(const f32x4*)(rp + i * 256 + lane * 4); s += (v[i][0] + v[i][1]) + (v[i][2] + v[i][3]); }
#pragma unroll
        for (int off = 32; off >= 1; off >>= 1) s += __shfl_xor(s, off);
        const float mu = s * (1.0f / DM);
        float q = 0.f;
#pragma unroll
        for (int i = 0; i < 8; ++i) { v[i] = v[i] - mu; q += (v[i][0] * v[i][0] + v[i][1] * v[i][1]) + (v[i][2] * v[i][2] + v[i][3] * v[i][3]); }
#pragma unroll
        for (int off = 32; off >= 1; off >>= 1) q += __shfl_xor(q, off);
        const float rstd = rsqrtf(q * (1.0f / DM) + 1e-5f);
#pragma unroll
        for (int i = 0; i < 8; ++i) { const f32x4 gg = *(const f32x4*)(gam + i * 256 + lane * 4), bb = *(const f32x4*)(bet + i * 256 + lane * 4);
            const f32x4 o = v[i] * rstd * gg + bb;
            *(f32x4*)(rp + i * 256 + lane * 4) = o;
            if (ob) { u32x2 p; p.x = cvt_pk_bf16(o[0], o[1]); p.y = cvt_pk_bf16(o[2], o[3]); *(u32x2*)(ob + (size_t)row * DM + i * 256 + lane * 4) = p; } }
    }
}

__device__ __forceinline__ void phase_fixup(const Args& A) {
    const float* halo = (const float*)(A.ws + WS_HALO); bf16_t* act = (bf16_t*)(A.ws + WS_ACT);
    for (int idx = blockIdx.x * 512 + threadIdx.x; idx < 64 * 2 * (DFF / 4); idx += gridDim.x * 512) {
        const int f = (idx % (DFF / 4)) * 4, br = idx / (DFF / 4), rr = br & 1, B = br >> 1;
        const bool first = (B & 15) == 0;
        const float* hc = halo + (size_t)B * 4 * NUP; const float* hp = hc - 4 * NUP;
        f32x4 hv[2];
#pragma unroll
        for (int bj = 0; bj < 2; ++bj) {
            const int col = bj * DFF + f;
            const f32x4 cur = *(const f32x4*)(hc + (size_t)(2 + rr) * NUP + col);
            f32x4 p1, p2; const f32x4 z = (f32x4){0.f, 0.f, 0.f, 0.f};
            if (rr == 0) { p1 = first ? z : *(const f32x4*)(hp + (size_t)1 * NUP + col); p2 = first ? z : *(const f32x4*)(hp + col); }
            else { p1 = *(const f32x4*)(hc + (size_t)2 * NUP + col); p2 = first ? z : *(const f32x4*)(hp + (size_t)1 * NUP + col); }
            const f32x4 w0 = *(const f32x4*)(A.w_fc + col), w1 = *(const f32x4*)(A.w_fc + NUP + col), w2 = *(const f32x4*)(A.w_fc + 2 * NUP + col), bb = *(const f32x4*)(A.b_fc + col);
            hv[bj] = w2 * cur + w1 * p1 + w0 * p2 + bb;
        }
        float av[4];
#pragma unroll
        for (int j = 0; j < 4; ++j) { const float gt = hv[1][j]; av[j] = hv[0][j] * gt / (1.0f + __expf(-gt)); }
        u32x2 o; o.x = cvt_pk_bf16(av[0], av[1]); o.y = cvt_pk_bf16(av[2], av[3]);
        *(u32x2*)(act + (size_t)(B * 128 + rr) * DFF + f) = o;
    }
}

__device__ __forceinline__ void phase_dump(const bf16_t* src, int ld, int c0, float* out) {
    for (size_t idx = (size_t)blockIdx.x * 512 + threadIdx.x; idx < (size_t)MT * DM; idx += (size_t)gridDim.x * 512) {
        const size_t row = idx / DM, col = idx % DM; out[idx] = bflo((unsigned)src[row * ld + c0 + col]); }
}
#ifndef DBG_STOP
#define DBG_STOP -1
#endif
#define XB_TMO      128
#define XB_XCNT(j)  (256  + 64 * (j))
#define XB_XSUB(j)  (1280 + 64 * (j))
#define XB_XGEN(j)  (2304 + 64 * (j))
#define XB_TOP      3328
#define XB_TOPGEN   3392
#define XCD_BAR_WORDS 3456
#define XB_SPIN_CAP (1u << 22)
__device__ __forceinline__ unsigned xb_ld(unsigned* p)              { return __hip_atomic_load(p, __ATOMIC_RELAXED, __HIP_MEMORY_SCOPE_AGENT); }
__device__ __forceinline__ unsigned xb_add(unsigned* p, unsigned v) { return __hip_atomic_fetch_add(p, v, __ATOMIC_RELAXED, __HIP_MEMORY_SCOPE_AGENT); }
__device__ __forceinline__ unsigned xb_xcc_id() { return (unsigned)__builtin_amdgcn_s_getreg((3 << 11) | 20) & 0xFu; }
#define XB_SPIN(cond, bar) do { unsigned _sp = 0; while (cond) { __builtin_amdgcn_s_sleep(1); \
    if ((++_sp & 255u) == 0u) { if (xb_ld(&(bar)[XB_TMO])) break; if (_sp > XB_SPIN_CAP) { atomicAdd(&(bar)[XB_TMO], 1u); break; } } } } while (0)
struct XcdBarrier { unsigned* bar; unsigned x; volatile LAS unsigned* st; };
__device__ __forceinline__ XcdBarrier xcd_barrier_post(unsigned* bar, volatile LAS unsigned* st) {
    XcdBarrier b; b.bar = bar; b.x = xb_xcc_id(); b.st = st;
    if (threadIdx.x == 0) (void)xb_add(&bar[XB_XCNT(b.x)], 1u);
    return b;
}
__device__ __forceinline__ void xcd_barrier_complete(unsigned* bar, unsigned x, unsigned& nloc, unsigned& nx) {
    const unsigned G = gridDim.x * gridDim.y * gridDim.z;
    unsigned sum, cnt, mine, sp = 0u;
    for (;;) {
        sum = 0u; cnt = 0u; mine = 0u;
#pragma unroll
        for (unsigned j = 0; j < 16; ++j) { const unsigned c = xb_ld(&bar[XB_XCNT(j)]); sum += c; cnt += (c > 0u) ? 1u : 0u; mine = (j == x) ? c : mine; }
        if (sum == G) break;
        __builtin_amdgcn_s_sleep(1);
        if ((++sp & 255u) == 0u) { if (xb_ld(&bar[XB_TMO])) break; if (sp > XB_SPIN_CAP) { atomicAdd(&bar[XB_TMO], 1u); break; } }
    }
    nloc = mine > 0u ? mine : 1u; nx = cnt > 0u ? cnt : 1u;
}
__device__ __forceinline__ void xcd_barrier(const XcdBarrier& b) {
    asm volatile("s_waitcnt vmcnt(0)" ::: "memory");
    __syncthreads();
    if (threadIdx.x == 0) {
        unsigned* bar = b.bar;
        __builtin_amdgcn_s_waitcnt(0);
        unsigned nloc = b.st[0], nx = b.st[1];
        if (nloc == 0u) { xcd_barrier_complete(bar, b.x, nloc, nx); b.st[0] = nloc; b.st[1] = nx; }
        const unsigned old = xb_add(&bar[XB_XSUB(b.x)], 1u);
        const unsigned gen = old / nloc;
        if (old + 1u == (gen + 1u) * nloc) {
            __builtin_amdgcn_fence(__ATOMIC_RELEASE, "agent");
            asm volatile("s_waitcnt vmcnt(0)" ::: "memory");
            const unsigned og = xb_add(&bar[XB_TOP], 1u);
            const unsigned tg = og / nx;
            if (og + 1u == (tg + 1u) * nx) xb_add(&bar[XB_TOPGEN], 1u);
            else XB_SPIN(xb_ld(&bar[XB_TOPGEN]) == tg, bar);
            __builtin_amdgcn_fence(__ATOMIC_ACQUIRE, "agent");
            xb_add(&bar[XB_XGEN(b.x)], 1u);
            asm volatile("s_waitcnt vmcnt(0)" ::: "memory");
        } else {
            XB_SPIN(xb_ld(&bar[XB_XGEN(b.x)]) == gen, bar);
            __builtin_amdgcn_fence(__ATOMIC_ACQUIRE, "agent");
            asm volatile("s_waitcnt vmcnt(0)" ::: "memory");
        }
    }
    __syncthreads();
}

constexpr int N_PHASES = 10;
#ifndef ONLY_PH
#define ONLY_PH -1
#endif
#define PH_ON(x) (ONLY_PH < 0 || ONLY_PH == (x))
__global__ void __launch_bounds__(512, 2) mega(Args a) {
    extern __shared__ __attribute__((aligned(16))) unsigned char lds[];
    cg::grid_group grid = cg::this_grid();
    unsigned char* ws = a.ws;
#define PH_RUN(x) (PH_ON(x) && a.ph_lo <= (x) && (x) < a.ph_hi)
#define PH_SYNC(x) do { if (a.ph_lo <= (x) && (x) + 1 < a.ph_hi) xcd_barrier(xb); } while (0)
    volatile LAS unsigned* xst = (volatile LAS unsigned*)((LAS unsigned char*)lds + 131072);
    if (threadIdx.x == 0) { xst[0] = 0u; xst[1] = 0u; }
    __syncthreads();
    const XcdBarrier xb = xcd_barrier_post((unsigned*)(ws + WS_BAR), xst);
    if (a.ph_hi > 1000) grid.sync();
#ifndef REP0
#define REP0 1
#endif
#ifndef REP2
#define REP2 1
#endif
#ifndef REP6
#define REP6 1
#endif
    if (PH_RUN(0)) for (int rep = 0; rep < REP0; ++rep) phase_prologue(a, lds);
    PH_SYNC(0);
    if (PH_RUN(1)) { pg8::Gemm g{(const bf16_t*)(ws + WS_XB), (const bf16_t*)(ws + WS_WIN), MT, NP, DM}; pg8::StaticOrder S; S.init(MT, NP, gridDim.x, blockIdx.x);
        pg8::EpiBf16 E{(bf16_t*)(ws + WS_PROJ), NP}; pg8::gemm_phase<pg8::EpiBf16, true>((LAS unsigned char*)lds, g, S, E);
        const int rem = ((MT / 256) * (NP / 256)) % (int)gridDim.x;
        if (rem == 0) phase_transposes(a, lds, TM_IN, TM_IN + TM_OUT + TM_UP, blockIdx.x, gridDim.x);
        else if ((int)blockIdx.x >= rem) phase_transposes(a, lds, TM_IN, TM_IN + TM_OUT + TM_UP, blockIdx.x - rem, gridDim.x - rem); }
    PH_SYNC(1);
    if (PH_RUN(2)) for (int rep = 0; rep < REP2; ++rep) { phase_yconv(a); phase_mlstm(a, lds, a.out); }
    PH_SYNC(2);
    if (PH_RUN(3)) phase_headnorm(a, a.out);
    PH_SYNC(3);
    if (PH_RUN(4)) { pg8::Gemm g{(const bf16_t*)(ws + WS_Y), (const bf16_t*)(ws + WS_WOUT), MT, DM, DM}; pg8::StaticOrder S; S.init(MT, DM, gridDim.x, blockIdx.x);
        if (a.fuse_ln) { pg8::EpiResLn<false, false> E{a.x, nullptr, nullptr, (bf16_t*)(ws + WS_X1B), a.ln1_g, a.ln1_b, (float*)(ws + WS_RS1), (unsigned*)(ws + WS_CNT)}; pg8::gemm_phase((LAS unsigned char*)lds, g, S, E); }
        else { pg8::EpiResF32 E{a.x, a.out, DM}; pg8::gemm_phase((LAS unsigned char*)lds, g, S, E); } }
    PH_SYNC(4);
    if (PH_RUN(5) && !a.fuse_ln) phase_ln(a.out, a.ln1_g, a.ln1_b, (bf16_t*)(ws + WS_X1B));
    if (!a.fuse_ln) PH_SYNC(5);
    if (PH_RUN(6)) { pg8::Gemm g{(const bf16_t*)(ws + WS_X1B), (const bf16_t*)(ws + WS_WUP), MT, NUP, DM}; pg8::StaticOrder S; S.init(MT, NUP, gridDim.x, blockIdx.x);
        pg8::EpiConvFfn E{(bf16_t*)(ws + WS_ACT), (float*)(ws + WS_HALO), a.w_fc, a.b_fc}; pg8::gemm_phase<pg8::EpiConvFfn, true>((LAS unsigned char*)lds, g, S, E);
        const int rem = ((MT / 256) * (NUP / 256)) % (int)gridDim.x; const int t0 = TM_IN + TM_OUT + TM_UP, t1 = t0 + TM_DN;
        if (rem == 0) phase_transposes(a, lds, t0, t1, blockIdx.x, gridDim.x);
        else if ((int)blockIdx.x >= rem) phase_transposes(a, lds, t0, t1, blockIdx.x - rem, gridDim.x - rem); }
    PH_SYNC(6);
    if (PH_RUN(7)) phase_fixup(a);
    PH_SYNC(7);
    if (PH_RUN(8)) { pg8::Gemm g{(const bf16_t*)(ws + WS_ACT), (const bf16_t*)(ws + WS_WDN), MT, DM, DFF}; pg8::StaticOrder S; S.init(MT, DM, gridDim.x, blockIdx.x);
        if (a.fuse_ln) { pg8::EpiResLn<true, true> E{nullptr, (const bf16_t*)(ws + WS_X1B), a.out, nullptr, a.ln2_g, a.ln2_b, (float*)(ws + WS_RS2), (unsigned*)(ws + WS_CNT) + 32 * 64}; pg8::gemm_phase((LAS unsigned char*)lds, g, S, E); }
        else { pg8::EpiResF32 E{a.out, a.out, DM}; pg8::gemm_phase((LAS unsigned char*)lds, g, S, E); } }
    if (!a.fuse_ln) PH_SYNC(8);
    if (PH_RUN(9) && !a.fuse_ln) phase_ln(a.out, a.ln2_g, a.ln2_b, nullptr);
    if (DBG_STOP == 1 && a.ph_lo == 101) phase_dump((const bf16_t*)(ws + WS_PROJ), NP, 3072, a.out);
    if (DBG_STOP == 3 && a.ph_lo == 103) phase_dump((const bf16_t*)(ws + WS_Y), DM, 0, a.out);
    if (DBG_STOP == 7 && a.ph_lo == 107) phase_dump((const bf16_t*)(ws + WS_ACT), DFF, 0, a.out);
}

extern "C" void kernel_launch(void* const* d_in, const int* in_sizes, int n_in, void* d_out, int out_size, void* d_ws, size_t ws_size, hipStream_t stream) {
    static int grid = 0;
    if (grid == 0) {
        if (n_in != 14 || ws_size < WS_END) { fprintf(stderr, "kernel_launch: unexpected n_in %d / ws_size %zu (need %zu)\n", n_in, ws_size, (size_t)WS_END); grid = -1; return; }
        int dev = 0, cus = 0, per_cu = 0;
        hipGetDevice(&dev); hipDeviceGetAttribute(&cus, hipDeviceAttributeMultiprocessorCount, dev);
        if (hipFuncSetAttribute((const void*)mega, hipFuncAttributeMaxDynamicSharedMemorySize, LDS_BYTES) != hipSuccess) { fprintf(stderr, "kernel_launch: hipFuncSetAttribute failed\n"); grid = -1; return; }
        if (hipOccupancyMaxActiveBlocksPerMultiprocessor(&per_cu, (const void*)mega, 512, LDS_BYTES) != hipSuccess || per_cu < 1) { fprintf(stderr, "kernel_launch: occupancy query failed (%d)\n", per_cu); (void)hipGetLastError(); per_cu = 1; }
        grid = cus * 1;
        fprintf(stderr, "kernel_launch: cus %d per_cu %d grid %d\n", cus, per_cu, grid);
    }
    if (grid < 0) return;
    if (hipMemsetAsync((char*)d_ws + WS_BAR, 0, WS_END - WS_BAR, stream)     != hipSuccess) { fprintf(stderr, "kernel_launch: memset failed\n"); return; }
    Args a{};
    a.x = (const float*)d_in[0]; a.w_in = (const float*)d_in[1]; a.b_gates = (const float*)d_in[2]; a.w_sc = (const float*)d_in[3]; a.mh_gain = (const float*)d_in[4]; a.w_out = (const float*)d_in[5];
    a.ln1_g = (const float*)d_in[6]; a.ln1_b = (const float*)d_in[7]; a.w_up = (const float*)d_in[8]; a.w_fc = (const float*)d_in[9]; a.b_fc = (const float*)d_in[10]; a.w_down = (const float*)d_in[11];
    a.ln2_g = (const float*)d_in[12]; a.ln2_b = (const float*)d_in[13];
    a.out = (float*)d_out; a.ws = (unsigned char*)d_ws;
    a.fuse_ln = (MK_SINGLE && grid == 256) ? 1 : 0;
#if MK_SINGLE
    a.ph_lo = 0; a.ph_hi = N_PHASES;
    void* args[] = {&a};
    hipError_t e = hipLaunchCooperativeKernel((const void*)mega, dim3(grid), dim3(512), args, LDS_BYTES, stream);
    if (e != hipSuccess) fprintf(stderr, "cooperative launch failed: %s (grid %d)\n", hipGetErrorString(e), grid);
#else
    for (int ph = 0; ph < N_PHASES; ++ph) { if (DBG_STOP >= 0 && ph > DBG_STOP) break; a.ph_lo = ph; a.ph_hi = ph + 1; hipLaunchKernelGGL(mega, dim3(grid), dim3(512), LDS_BYTES, stream, a); }
    if (DBG_STOP >= 0) { a.ph_lo = 100 + DBG_STOP; a.ph_hi = 101 + DBG_STOP; hipLaunchKernelGGL(mega, dim3(grid), dim3(512), LDS_BYTES, stream, a); }
#endif
}
```

```cpp
#include <hip/hip_runtime.h>
#include <hip/hip_cooperative_groups.h>
#include <cstdio>
#include <cstdint>
namespace cg = cooperative_groups;

#ifndef MK_SINGLE
#define MK_SINGLE 1
#endif

#define LAS __attribute__((address_space(3)))
typedef unsigned short bf16_t;
typedef short bf16x8 __attribute__((ext_vector_type(8)));
typedef float f32x4 __attribute__((ext_vector_type(4)));
typedef unsigned u32x4 __attribute__((ext_vector_type(4)));
typedef unsigned u32x2 __attribute__((ext_vector_type(2)));
typedef short s16x4 __attribute__((ext_vector_type(4)));

constexpr int MT = 8192, DM = 2048, SEQ = 2048, NIN = 7176, NP = 7168, DFF = 5632, NUP = 11264, WCONV = 1024;
constexpr float ALPHA = 1.189207115002721f;
constexpr size_t WS_WIN = 0;
constexpr size_t WS_WOUT = WS_WIN + (size_t)NP * DM * 2;
constexpr size_t WS_WUP = WS_WOUT + (size_t)DM * DM * 2;
constexpr size_t WS_WDN = WS_WUP + (size_t)NUP * DM * 2;
constexpr size_t WS_X1B = WS_WDN + (size_t)DM * DFF * 2;
constexpr size_t WS_GATES = WS_X1B + (size_t)MT * DM * 2;
constexpr size_t WS_C = WS_GATES + (size_t)MT * 8 * 4;
constexpr size_t WS_PROJ = WS_C;
constexpr size_t WS_Y = WS_PROJ + (size_t)MT * NP * 2;
constexpr size_t WS_XB = WS_Y + (size_t)MT * DM * 2;
constexpr size_t WS_ACT = WS_C;
constexpr size_t WS_HALO = WS_ACT + (size_t)MT * DFF * 2;
constexpr size_t WS_BAR = WS_XB + (size_t)MT * DM * 2;
constexpr size_t WS_RS1 = WS_BAR + 16384;
constexpr size_t WS_RS2 = WS_RS1 + (size_t)MT * 8;
constexpr size_t WS_CNT = WS_RS2 + (size_t)MT * 8;
constexpr size_t WS_END = WS_CNT + 2 * 32 * 256;
constexpr int LDS_BYTES = 131072 + 16 + 3 * 32 * 64 * 4;

struct Args {
    const float* x; const float* w_in; const float* b_gates; const float* w_sc; const float* mh_gain; const float* w_out;
    const float* ln1_g; const float* ln1_b; const float* w_up; const float* w_fc; const float* b_fc; const float* w_down;
    const float* ln2_g; const float* ln2_b;
    float* out; unsigned char* ws; int ph_lo, ph_hi, fuse_ln, pad0;
};

typedef __bf16 bf16v2 __attribute__((ext_vector_type(2)));
typedef float f32x2 __attribute__((ext_vector_type(2)));
__device__ __forceinline__ unsigned cvt_pk_bf16(float lo, float hi) { const f32x2 v = {lo, hi}; const bf16v2 r = __builtin_convertvector(v, bf16v2); return __builtin_bit_cast(unsigned, r); }
__device__ __forceinline__ unsigned cvt_pk_bf16_asm(float lo, float hi) { unsigned r; asm volatile("v_cvt_pk_bf16_f32 %0, %1, %2" : "=v"(r) : "v"(lo), "v"(hi)); return r; }
__device__ __forceinline__ float bflo(unsigned u) { return __uint_as_float(u << 16); }
__device__ __forceinline__ float bfhi(unsigned u) { return __uint_as_float(u & 0xffff0000u); }
__device__ __forceinline__ bf16_t f2bf(float f) { unsigned u = __float_as_uint(f); u += 0x7FFFu + ((u >> 16) & 1u); return (bf16_t)(u >> 16); }

namespace pg8 {
constexpr int BM = 256, BK = 64, HALF = 128, HTB = HALF * BK * 2, STAGE_BYTES = 8 * HTB, NXCD = 8, WGM = 8;
__host__ __device__ __forceinline__ int lds_byte(int r, int c) { const int st = (r >> 4) * 2 + (c >> 5), rr = r & 15, cc = c & 31, ob = rr * 64 + cc * 2; return st * 1024 + (ob ^ (((ob >> 9) & 1) << 5)); }
__host__ __device__ __forceinline__ void stage_rc(int b, int& R, int& C) { const int st = b / 1024, sb = b % 1024, swz = sb ^ (((sb >> 9) & 1) << 5); R = (st >> 1) * 16 + swz / 64; C = (st & 1) * 32 + (swz % 64) / 2; }
__host__ __device__ __forceinline__ int perm32(int rho) { const int n = rho >> 4, i = rho & 15; return 8 * (i >> 2) + 4 * n + (i & 3); }
struct Unit { int pm, pn; };
struct Gemm { const bf16_t* A; const bf16_t* Bt; int M, N, K; };
struct StaticOrder {
    int nM, nN, nwg, G, c;
    __device__ void init(int M, int N, int G_, int c_) { nM = M / BM; nN = N / BM; nwg = nM * nN; G = G_; c = c_; }
    __device__ bool next(int i, Unit& u) const {
        const long L = (long)i * G + c; if (L >= nwg) return false;
        int wgid = (int)L; { const int q = nwg / NXCD, r = nwg % NXCD, xcd = wgid % NXCD, off = wgid / NXCD; wgid = (xcd < r ? xcd * (q + 1) : r * (q + 1) + (xcd - r) * q) + off; }
        const int nig = WGM * nN, gid = wgid / nig, fm = gid * WGM, gsz = (nM - fm) < WGM ? (nM - fm) : WGM;
        u.pm = fm + ((wgid % nig) % gsz); u.pn = (wgid % nig) / gsz; return true;
    }
};

template <class Epi, bool ALIGN_EPI = false, bool SP2 = true>
__device__ __forceinline__ void gemm_phase(LAS unsigned char* lds, const Gemm g, const StaticOrder& S, const Epi& E) {
    const int tid = threadIdx.x, wid = __builtin_amdgcn_readfirstlane(tid >> 6), lane = tid & 63, wr = wid >> 2, wc = wid & 3, fr = lane & 15, fq = lane >> 4;
    const int K = g.K, nt = K / BK;
    unsigned voffA[2], voffB[2];
#pragma unroll
    for (int i = 0; i < 2; ++i) { int R, C; stage_rc(tid * 16 + i * 8192, R, C); const int Rb = Epi::PERM ? ((R & ~31) + perm32(R & 31)) : R;
        const int Ra = Epi::AROWPERM ? (128 * (R >> 6) + 8 * (R & 15) + ((R >> 4) & 3)) : R;
        const int Rbb = Epi::BCOLPERM ? (64 * (R >> 5) + perm32(R & 31)) : Rb;
        voffA[i] = (unsigned)(Ra * K + C) * 2u; voffB[i] = (unsigned)(Rbb * K + C) * 2u; }
    const size_t kstep = (size_t)(BK * 2);
    const size_t hstep = (size_t)HALF * K * 2;
    const size_t hstepA = Epi::AROWPERM ? (size_t)4 * K * 2 : hstep;
    const size_t hstepB = Epi::BCOLPERM ? (size_t)32 * K * 2 : hstep;
    const size_t tstep = 2 * hstep;
    const unsigned ldsw = (unsigned)wid * 1024u;
    const int aoff = lds_byte(wr * 64 + fr, fq * 8), boff = lds_byte(wc * 32 + fr, fq * 8);
#define PG8_SA(b, h) (((b) * 2 + (h)) * HTB)
#define PG8_SB(b, h) ((4 + (b) * 2 + (h)) * HTB)
#define PG8_STAGE(bufoff, gbase, voff) do { _Pragma("unroll") for (int _i = 0; _i < 2; ++_i) \
        __builtin_amdgcn_global_load_lds((const unsigned*)((const char*)(gbase) + (voff)[_i]), (LAS unsigned*)(lds + (bufoff) + ldsw + _i * 8192), 16, 0, 0); } while (0)
#define PG8_LDA(dst, b, h) do { _Pragma("unroll") for (int m = 0; m < 4; ++m) _Pragma("unroll") for (int k = 0; k < 2; ++k) dst[m][k] = *(const LAS bf16x8*)(lds + PG8_SA(b, h) + aoff + m * 2048 + k * 1024); } while (0)
#define PG8_LDB(dst, b, h) do { _Pragma("unroll") for (int n = 0; n < 2; ++n) _Pragma("unroll") for (int k = 0; k < 2; ++k) dst[n][k] = *(const LAS bf16x8*)(lds + PG8_SB(b, h) + boff + n * 2048 + k * 1024); } while (0)
#define PG8_MMA(ai, bj, At, Bt) do { __builtin_amdgcn_s_setprio(1); _Pragma("unroll") for (int m = 0; m < 4; ++m) _Pragma("unroll") for (int n = 0; n < 2; ++n) _Pragma("unroll") for (int k = 0; k < 2; ++k) \
        acc[ai][bj][m][n] = __builtin_amdgcn_mfma_f32_16x16x32_bf16(Bt[n][k], At[m][k], acc[ai][bj][m][n], 0, 0, 0); __builtin_amdgcn_s_setprio(0); } while (0)
#define PG8_WAIT_V(n) asm volatile("s_waitcnt vmcnt(" #n ")" ::: "memory")
#define PG8_WAIT_L(n) asm volatile("s_waitcnt lgkmcnt(" #n ")" ::: "memory")
#define PG8_BAR __builtin_amdgcn_s_barrier()
#define PG8_SCHED __builtin_amdgcn_sched_barrier(0)
    Unit cur, nxt; int ui = 0;
    if (!S.next(0, cur)) return;
    f32x4 acc[2][2][4][2];
#pragma unroll
    for (int a = 0; a < 2; ++a)
#pragma unroll
        for (int b = 0; b < 2; ++b)
#pragma unroll
            for (int m = 0; m < 4; ++m)
#pragma unroll
                for (int n = 0; n < 2; ++n) acc[a][b][m][n] = (f32x4){0.f, 0.f, 0.f, 0.f};
    bf16x8 At[4][2], B0[2][2], B1[2][2];
    const char* cA = (const char*)g.A + (size_t)cur.pm * tstep; const char* cB = (const char*)g.Bt + (size_t)cur.pn * tstep;
    if constexpr (SP2) {
        PG8_STAGE(PG8_SB(0, 0), cB, voffB); PG8_STAGE(PG8_SB(0, 1), cB + hstepB, voffB); PG8_STAGE(PG8_SA(0, 0), cA, voffA); PG8_STAGE(PG8_SA(0, 1), cA + hstepA, voffA);
        if (wr == 1) PG8_BAR;
        PG8_WAIT_V(2); PG8_BAR;
        PG8_STAGE(PG8_SB(1, 0), cB + kstep, voffB); PG8_STAGE(PG8_SA(1, 0), cA + kstep, voffA); PG8_STAGE(PG8_SB(1, 1), cB + hstepB + kstep, voffB);
        PG8_WAIT_V(6); PG8_BAR;
    } else {
        PG8_STAGE(PG8_SB(0, 0), cB, voffB); PG8_STAGE(PG8_SA(0, 0), cA, voffA); PG8_STAGE(PG8_SB(0, 1), cB + hstepB, voffB); PG8_STAGE(PG8_SA(0, 1), cA + hstepA, voffA);
        if (wr == 1) PG8_BAR;
        PG8_WAIT_V(4); PG8_BAR;
        PG8_STAGE(PG8_SB(1, 0), cB + kstep, voffB); PG8_STAGE(PG8_SA(1, 0), cA + kstep, voffA); PG8_STAGE(PG8_SB(1, 1), cB + hstepB + kstep, voffB);
        PG8_WAIT_V(6); PG8_BAR;
    }
    for (;;) {
        const bool has_next = S.next(ui + 1, nxt);
        const char* nA = has_next ? (const char*)g.A + (size_t)nxt.pm * tstep : cA; const char* nB = has_next ? (const char*)g.Bt + (size_t)nxt.pn * tstep : cB;
        for (int t = 0; t < nt; t += 2) {
            const bool last = (t == nt - 2);
            const char* a1 = cA + (size_t)(t + 1) * kstep;
            const char* a2 = last ? nA : cA + (size_t)(t + 2) * kstep; const char* b2 = last ? nB : cB + (size_t)(t + 2) * kstep;
            const char* a3 = a2 + kstep; const char* b3 = b2 + kstep;
            if constexpr (SP2) {
            PG8_LDB(B0, 0, 0); PG8_LDB(B1, 0, 1); PG8_SCHED; PG8_LDA(At, 0, 0); PG8_STAGE(PG8_SA(1, 1), a1 + hstepA, voffA);
            PG8_WAIT_V(8); PG8_WAIT_L(0); PG8_BAR; PG8_MMA(0, 0, At, B0); PG8_MMA(0, 1, At, B1); PG8_BAR; PG8_SCHED;
            PG8_LDA(At, 0, 1); PG8_STAGE(PG8_SB(0, 0), b2, voffB); PG8_STAGE(PG8_SB(0, 1), b2 + hstepB, voffB); PG8_STAGE(PG8_SA(0, 0), a2, voffA);
            PG8_WAIT_V(8); PG8_WAIT_L(0); PG8_BAR; PG8_MMA(1, 0, At, B0); PG8_MMA(1, 1, At, B1); PG8_BAR; PG8_SCHED;
            PG8_LDB(B0, 1, 0); PG8_LDB(B1, 1, 1); PG8_SCHED; PG8_LDA(At, 1, 0); PG8_STAGE(PG8_SA(0, 1), a2 + hstepA, voffA);
            PG8_WAIT_V(8); PG8_WAIT_L(0); PG8_BAR; PG8_MMA(0, 0, At, B0); PG8_MMA(0, 1, At, B1); PG8_BAR; PG8_SCHED;
            PG8_LDA(At, 1, 1); PG8_STAGE(PG8_SB(1, 0), b3, voffB); PG8_STAGE(PG8_SB(1, 1), b3 + hstepB, voffB); PG8_STAGE(PG8_SA(1, 0), a3, voffA);
            PG8_WAIT_V(8); PG8_WAIT_L(0); PG8_BAR; PG8_MMA(1, 0, At, B0); PG8_MMA(1, 1, At, B1); PG8_BAR; PG8_SCHED;
            } else {
            PG8_LDB(B0, 0, 0); PG8_SCHED; PG8_LDA(At, 0, 0); PG8_STAGE(PG8_SA(1, 1), a1 + hstepA, voffA);
            PG8_WAIT_L(8); PG8_BAR; PG8_WAIT_L(0); PG8_MMA(0, 0, At, B0); PG8_BAR; PG8_SCHED;
            PG8_LDB(B1, 0, 1); PG8_STAGE(PG8_SB(0, 0), b2, voffB);
            PG8_BAR; PG8_WAIT_L(0); PG8_MMA(0, 1, At, B1); PG8_BAR;
            PG8_LDA(At, 0, 1); PG8_STAGE(PG8_SA(0, 0), a2, voffA);
            PG8_BAR; PG8_WAIT_L(0); PG8_MMA(1, 0, At, B0); PG8_BAR; PG8_SCHED;
            PG8_STAGE(PG8_SB(0, 1), b2 + hstepB, voffB);
            PG8_WAIT_V(6); PG8_BAR; PG8_MMA(1, 1, At, B1); PG8_BAR;
            PG8_LDB(B0, 1, 0); PG8_SCHED; PG8_LDA(At, 1, 0); PG8_STAGE(PG8_SA(0, 1), a2 + hstepA, voffA);
            PG8_WAIT_L(8); PG8_BAR; PG8_WAIT_L(0); PG8_MMA(0, 0, At, B0); PG8_BAR; PG8_SCHED;
            PG8_LDB(B1, 1, 1); PG8_STAGE(PG8_SB(1, 0), b3, voffB);
            PG8_BAR; PG8_WAIT_L(0); PG8_MMA(0, 1, At, B1); PG8_BAR;
            PG8_LDA(At, 1, 1); PG8_STAGE(PG8_SA(1, 0), a3, voffA);
            PG8_BAR; PG8_WAIT_L(0); PG8_MMA(1, 0, At, B0); PG8_BAR; PG8_SCHED;
            PG8_STAGE(PG8_SB(1, 1), b3 + hstepB, voffB);
            PG8_WAIT_V(6); PG8_BAR; PG8_MMA(1, 1, At, B1); PG8_BAR;

            }
        }
        if constexpr (ALIGN_EPI) { if (wr == 0) PG8_BAR; }
        if constexpr (!Epi::AFTER_DRAIN) E(acc, cur, wr, wc, fr, fq);
        if (!has_next) break;
#pragma unroll
        for (int a = 0; a < 2; ++a)
#pragma unroll
            for (int b = 0; b < 2; ++b)
#pragma unroll
                for (int m = 0; m < 4; ++m)
#pragma unroll
                    for (int n = 0; n < 2; ++n) acc[a][b][m][n] = (f32x4){0.f, 0.f, 0.f, 0.f};
        cur = nxt; cA = nA; cB = nB; ++ui;
        if constexpr (ALIGN_EPI) { if (wr == 1) PG8_BAR; }
    }
    PG8_WAIT_V(0);
    if constexpr (!ALIGN_EPI) { if (wr == 0) PG8_BAR; }
    PG8_BAR;
    if constexpr (Epi::AFTER_DRAIN) E(acc, cur, wr, wc, fr, fq);
#undef PG8_SA
#undef PG8_SB
#undef PG8_STAGE
#undef PG8_LDA
#undef PG8_LDB
#undef PG8_MMA
#undef PG8_WAIT_V
#undef PG8_WAIT_L
#undef PG8_BAR
#undef PG8_SCHED
}

struct EpiBf16 {
    static constexpr bool PERM = true, AFTER_DRAIN = false, AROWPERM = false, BCOLPERM = true;
    bf16_t* O; int ldc;
    __device__ __forceinline__ void operator()(f32x4 (&acc)[2][2][4][2], const Unit& u, int wr, int wc, int fr, int fq) const {
        const int row0 = u.pm * BM + wr * 64 + fr, col0 = u.pn * BM + wc * 64 + 8 * fq;
#pragma unroll
        for (int ai = 0; ai < 2; ++ai)
#pragma unroll
            for (int m = 0; m < 4; ++m) { bf16_t* rowp = O + (size_t)(row0 + ai * HALF + m * 16) * ldc + col0;
#pragma unroll
                for (int bj = 0; bj < 2; ++bj) { const f32x4 v0 = acc[ai][bj][m][0], v1 = acc[ai][bj][m][1];
                    u32x4 w; w.x = cvt_pk_bf16_asm(v0[0], v0[1]); w.y = cvt_pk_bf16_asm(v0[2], v0[3]); w.z = cvt_pk_bf16_asm(v1[0], v1[1]); w.w = cvt_pk_bf16_asm(v1[2], v1[3]);
                    *(u32x4*)(rowp + bj * 32) = w; } }
    }
};
struct EpiResF32 {
    static constexpr bool PERM = false, AFTER_DRAIN = false, AROWPERM = false, BCOLPERM = false;
    const float* X; float* O; int ldc;
    __device__ __forceinline__ void operator()(f32x4 (&acc)[2][2][4][2], const Unit& u, int wr, int wc, int fr, int fq) const {
        const int row0 = u.pm * BM + wr * 64 + fr, col0 = u.pn * BM + wc * 32 + 4 * fq;
#pragma unroll
        for (int ai = 0; ai < 2; ++ai)
#pragma unroll
            for (int m = 0; m < 4; ++m) { const size_t ro = (size_t)(row0 + ai * HALF + m * 16) * ldc + col0;
#pragma unroll
                for (int bj = 0; bj < 2; ++bj)
#pragma unroll
                    for (int n = 0; n < 2; ++n) { const f32x4 xv = *(const f32x4*)(X + ro + bj * HALF + n * 16);
                        *(f32x4*)(O + ro + bj * HALF + n * 16) = xv * ALPHA + acc[ai][bj][m][n]; } }
    }
};
template <bool XBF  , bool WF32  > struct EpiResLn {
    static constexpr bool PERM = true, AFTER_DRAIN = true, AROWPERM = false, BCOLPERM = false;
    const float* X; const bf16_t* XB; float* O; bf16_t* OB; const float* gam; const float* bet; float* rs; unsigned* cnt;
    __device__ __forceinline__ void operator()(f32x4 (&acc)[2][2][4][2], const Unit& u, int wr, int wc, int fr, int fq) const {
        const int row0 = u.pm * BM + wr * 64 + fr, col0 = u.pn * BM + wc * 32 + 8 * fq;
#pragma unroll
        for (int ai = 0; ai < 2; ++ai)
#pragma unroll
            for (int m = 0; m < 4; ++m) { const int row = row0 + ai * HALF + m * 16; const size_t ro = (size_t)row * DM + col0;
                float s = 0.f, q = 0.f;
#pragma unroll
                for (int bj = 0; bj < 2; ++bj)
#pragma unroll
                    for (int n = 0; n < 2; ++n) { f32x4 xv;
                        if constexpr (XBF) { const u32x2 xb2 = *(const u32x2*)(XB + ro + bj * HALF + n * 4); xv = (f32x4){bflo(xb2.x), bfhi(xb2.x), bflo(xb2.y), bfhi(xb2.y)}; }
                        else xv = *(const f32x4*)(X + ro + bj * HALF + n * 4);
                        const f32x4 z = xv * ALPHA + acc[ai][bj][m][n]; acc[ai][bj][m][n] = z;
                        s += (z[0] + z[1]) + (z[2] + z[3]); q += (z[0] * z[0] + z[1] * z[1]) + (z[2] * z[2] + z[3] * z[3]); }
                s += __shfl_xor(s, 16); s += __shfl_xor(s, 32); q += __shfl_xor(q, 16); q += __shfl_xor(q, 32);
                if (fq == 0) { (void)__hip_atomic_fetch_add(rs + 2 * row, s, __ATOMIC_RELAXED, __HIP_MEMORY_SCOPE_AGENT); (void)__hip_atomic_fetch_add(rs + 2 * row + 1, q, __ATOMIC_RELAXED, __HIP_MEMORY_SCOPE_AGENT); } }
        asm volatile("s_waitcnt vmcnt(0)" ::: "memory");
        unsigned* cp = cnt + 64 * u.pm;
        if ((threadIdx.x & 63) == 0) (void)__hip_atomic_fetch_add(cp, 1u, __ATOMIC_RELAXED, __HIP_MEMORY_SCOPE_AGENT);
        { unsigned sp = 0; while ((unsigned)__builtin_amdgcn_readfirstlane(__hip_atomic_load(cp, __ATOMIC_RELAXED, __HIP_MEMORY_SCOPE_AGENT)) < 64u) { __builtin_amdgcn_s_sleep(2); if (++sp > (1u << 22)) break; } }
        f32x4 gg[2][2], bb[2][2];
#pragma unroll
        for (int bj = 0; bj < 2; ++bj)
#pragma unroll
            for (int n = 0; n < 2; ++n) { gg[bj][n] = *(const f32x4*)(gam + col0 + bj * HALF + n * 4); bb[bj][n] = *(const f32x4*)(bet + col0 + bj * HALF + n * 4); }
#pragma unroll
        for (int ai = 0; ai < 2; ++ai)
#pragma unroll
            for (int m = 0; m < 4; ++m) { const int row = row0 + ai * HALF + m * 16; const size_t ro = (size_t)row * DM + col0;
                const float s = __hip_atomic_load(rs + 2 * row, __ATOMIC_RELAXED, __HIP_MEMORY_SCOPE_AGENT), q = __hip_atomic_load(rs + 2 * row + 1, __ATOMIC_RELAXED, __HIP_MEMORY_SCOPE_AGENT);
                const float mu = s * (1.0f / DM), rstd = rsqrtf(fmaxf(q * (1.0f / DM) - mu * mu, 0.f) + 1e-5f);
#pragma unroll
                for (int bj = 0; bj < 2; ++bj)
#pragma unroll
                    for (int n = 0; n < 2; ++n) { const f32x4 o = (acc[ai][bj][m][n] - mu) * rstd * gg[bj][n] + bb[bj][n];
                        if constexpr (WF32) *(f32x4*)(O + ro + bj * HALF + n * 4) = o;
                        if (OB) { u32x2 p; p.x = cvt_pk_bf16_asm(o[0], o[1]); p.y = cvt_pk_bf16_asm(o[2], o[3]); *(u32x2*)(OB + ro + bj * HALF + n * 4) = p; } } }
    }
};
__device__ __forceinline__ float dpp_shr1(float x) { return __builtin_bit_cast(float, __builtin_amdgcn_update_dpp(0, __builtin_bit_cast(int, x), 0x111, 0xf, 0xf, true)); }
struct EpiConvFfn {
    static constexpr bool PERM = true, AFTER_DRAIN = false, AROWPERM = true, BCOLPERM = false;
    bf16_t* act; float* halo; const float* cw; const float* cb;
    __device__ __forceinline__ void operator()(f32x4 (&acc)[2][2][4][2], const Unit& u, int wr, int wc, int fr, int fq) const {
        const int fcol = u.pn * 128 + wc * 32 + 8 * fq;
        const int rbase = u.pm * BM + wr * 128;
        {
            float* hb = halo + (size_t)(rbase >> 7) * 4 * NUP + fcol;
            if (fr == 0) {
#pragma unroll
                for (int bj = 0; bj < 2; ++bj)
#pragma unroll
                    for (int n = 0; n < 2; ++n) { *(f32x4*)(hb + (size_t)2 * NUP + bj * DFF + 4 * n) = acc[0][bj][0][n]; *(f32x4*)(hb + (size_t)3 * NUP + bj * DFF + 4 * n) = acc[0][bj][1][n]; }
            }
            if (fr == 15) {
#pragma unroll
                for (int bj = 0; bj < 2; ++bj)
#pragma unroll
                    for (int n = 0; n < 2; ++n) { *(f32x4*)(hb + bj * DFF + 4 * n) = acc[1][bj][2][n]; *(f32x4*)(hb + (size_t)1 * NUP + bj * DFF + 4 * n) = acc[1][bj][3][n]; }
            }
        }
        u32x2 pk0[8];
#pragma unroll
        for (int n = 0; n < 2; ++n) {
            f32x4 W0[2], W1[2], W2[2], Bb[2];
#pragma unroll
            for (int bj = 0; bj < 2; ++bj) { const int hc = bj * DFF + fcol + 4 * n;
                W0[bj] = *(const f32x4*)(cw + hc); W1[bj] = *(const f32x4*)(cw + NUP + hc); W2[bj] = *(const f32x4*)(cw + 2 * NUP + hc); Bb[bj] = *(const f32x4*)(cb + hc); }
            f32x4 E6[2], E7[2];
#pragma unroll
            for (int bj = 0; bj < 2; ++bj) { const f32x4 s6 = acc[1][bj][2][n], s7 = acc[1][bj][3][n];
                E6[bj][0] = dpp_shr1(s6[0]); E6[bj][1] = dpp_shr1(s6[1]); E6[bj][2] = dpp_shr1(s6[2]); E6[bj][3] = dpp_shr1(s6[3]);
                E7[bj][0] = dpp_shr1(s7[0]); E7[bj][1] = dpp_shr1(s7[1]); E7[bj][2] = dpp_shr1(s7[2]); E7[bj][3] = dpp_shr1(s7[3]); }
#pragma unroll
            for (int i = 0; i < 8; ++i) {
                f32x4 h[2];
#pragma unroll
                for (int bj = 0; bj < 2; ++bj) {
                    const f32x4 cur = acc[i >> 2][bj][i & 3][n];
                    const f32x4 p1 = (i >= 1) ? acc[(i - 1 >= 0 ? i - 1 : 0) >> 2][bj][(i - 1 >= 0 ? i - 1 : 0) & 3][n] : E7[bj];
                    const f32x4 p2 = (i >= 2) ? acc[(i - 2 >= 0 ? i - 2 : 0) >> 2][bj][(i - 2 >= 0 ? i - 2 : 0) & 3][n] : (i == 1 ? E7[bj] : E6[bj]);
                    h[bj] = W2[bj] * cur + W1[bj] * p1 + W0[bj] * p2 + Bb[bj];
                }
                const f32x4 gt = h[1], ng = gt * (-1.4426950408889634f);
                f32x4 r;
#pragma unroll
                for (int j = 0; j < 4; ++j) r[j] = __builtin_amdgcn_rcpf(1.0f + __builtin_amdgcn_exp2f(ng[j]));
                const f32x4 av = h[0] * gt * r;
                u32x2 pk; pk.x = cvt_pk_bf16_asm(av[0], av[1]); pk.y = cvt_pk_bf16_asm(av[2], av[3]);
                if (n == 0) pk0[i] = pk;
                else if (i >= 2 || fr > 0) { u32x4 w; w.x = pk0[i].x; w.y = pk0[i].y; w.z = pk.x; w.w = pk.y;
                    *(u32x4*)(act + (size_t)(rbase + 8 * fr + i) * DFF + fcol) = w; }
            }
            asm volatile("" ::: "memory");
        }
    }
};
}

template <bool UPMAP>
__device__ __forceinline__ void transpose_macro(const float* W, int ldw, int k0, int n0, bf16_t* Wt, int ldt, unsigned char* lds) {
    bf16_t* sT = (bf16_t*)lds; const int tid = threadIdx.x;
    float4 v[2][4];
#pragma unroll
    for (int i = 0; i < 2; ++i)
#pragma unroll
        for (int j = 0; j < 4; ++j) v[i][j] = *(const float4*)(W + (size_t)(k0 + (tid >> 4) + 32 * i) * ldw + n0 + 64 * j + (tid & 15) * 4);
#pragma unroll
    for (int i = 0; i < 2; ++i)
#pragma unroll
        for (int j = 0; j < 4; ++j) { const int k = (tid >> 4) + 32 * i, n = 64 * j + (tid & 15) * 4;
            sT[(n + 0) * 66 + k] = f2bf(v[i][j].x); sT[(n + 1) * 66 + k] = f2bf(v[i][j].y); sT[(n + 2) * 66 + k] = f2bf(v[i][j].z); sT[(n + 3) * 66 + k] = f2bf(v[i][j].w); }
    __syncthreads();
#pragma unroll
    for (int j = 0; j < 4; ++j) { const int n = 64 * j + (tid >> 3), ks = (tid & 7) * 8; const unsigned* p = (const unsigned*)(sT + n * 66 + ks);
        u32x4 o; o.x = p[0]; o.y = p[1]; o.z = p[2]; o.w = p[3];
        int drow = n0 + n;
        if (UPMAP) { const int f = (drow < DFF) ? drow : drow - DFF; drow = 256 * (f >> 7) + (f & 127) + ((drow < DFF) ? 0 : 128); }
        *(u32x4*)(Wt + (size_t)drow * ldt + k0 + ks) = o; }
    __syncthreads();
}
constexpr int TM_IN = 32 * 28, TM_OUT = 32 * 8, TM_UP = 32 * 44, TM_DN = 88 * 8;
__device__ __forceinline__ void phase_transposes(const Args& A, unsigned char* lds, int g0, int g1, int worker, int nworkers) {
    unsigned char* ws = A.ws;
    for (int g = g0 + worker; g < g1; g += nworkers) {
        if (g < TM_IN) { const int tk = g / 28, tn = g % 28; transpose_macro<false>(A.w_in, NIN, tk * 64, tn * 256, (bf16_t*)(ws + WS_WIN), DM, lds); }
        else if (g < TM_IN + TM_OUT) { const int h = g - TM_IN, tk = h / 8, tn = h % 8; transpose_macro<false>(A.w_out, DM, tk * 64, tn * 256, (bf16_t*)(ws + WS_WOUT), DM, lds); }
        else if (g < TM_IN + TM_OUT + TM_UP) { const int h = g - TM_IN - TM_OUT, tk = h / 44, tn = h % 44; transpose_macro<true>(A.w_up, NUP, tk * 64, tn * 256, (bf16_t*)(ws + WS_WUP), DM, lds); }
        else { const int h = g - TM_IN - TM_OUT - TM_UP, tk = h / 8, tn = h % 8; transpose_macro<false>(A.w_down, DM, tk * 64, tn * 256, (bf16_t*)(ws + WS_WDN), DFF, lds); }
    }
}
__device__ __forceinline__ void phase_prologue(const Args& A, unsigned char* lds) {
    unsigned char* ws = A.ws;
    const int lane = threadIdx.x & 63, gw = blockIdx.x * 8 + (threadIdx.x >> 6), nw = gridDim.x * 8;
    bf16_t* xb = (bf16_t*)(ws + WS_XB); float* gates = (float*)(ws + WS_GATES);
    phase_transposes(A, lds, 0, TM_IN, blockIdx.x, gridDim.x);
    for (int it = gw; it < MT / 4; it += nw) {
        const int r0 = it * 4;
        float acc[4][8];
#pragma unroll
        for (int r = 0; r < 4; ++r)
#pragma unroll
            for (int q = 0; q < 8; ++q) acc[r][q] = 0.f;
#pragma unroll 1
        for (int ih = 0; ih < 2; ++ih) {
        f32x4 xq[4][4];
#pragma unroll
        for (int i = 0; i < 4; ++i)
#pragma unroll
            for (int r = 0; r < 4; ++r) xq[i][r] = *(const f32x4*)(A.x + (size_t)(r0 + r) * DM + (ih * 4 + i) * 256 + lane * 4);
#pragma unroll
        for (int i = 0; i < 4; ++i) {
            const int kb = (ih * 4 + i) * 256 + lane * 4;
            f32x4 xv[4];
#pragma unroll
            for (int r = 0; r < 4; ++r) { xv[r] = xq[i][r];
                u32x2 o; o.x = cvt_pk_bf16(xv[r][0], xv[r][1]); o.y = cvt_pk_bf16(xv[r][2], xv[r][3]); *(u32x2*)(xb + (size_t)(r0 + r) * DM + kb) = o; }
#pragma unroll
            for (int j = 0; j < 4; ++j) {
                const f32x4* wp = (const f32x4*)(A.w_in + (size_t)(kb + j) * NIN + NP);
                const f32x4 w0 = wp[0], w1 = wp[1];
#pragma unroll
                for (int r = 0; r < 4; ++r) { const float xs = xv[r][j];
                    acc[r][0] += xs * w0[0]; acc[r][1] += xs * w0[1]; acc[r][2] += xs * w0[2]; acc[r][3] += xs * w0[3];
                    acc[r][4] += xs * w1[0]; acc[r][5] += xs * w1[1]; acc[r][6] += xs * w1[2]; acc[r][7] += xs * w1[3]; }
            }
        }
        }
#pragma unroll
        for (int r = 0; r < 4; ++r)
#pragma unroll
            for (int q = 0; q < 8; ++q) { float v = acc[r][q];
#pragma unroll
                for (int off = 32; off >= 1; off >>= 1) v += __shfl_xor(v, off);
                acc[r][q] = v; }
        if (lane == 0) {
            const f32x4 b0 = *(const f32x4*)(A.b_gates), b1 = *(const f32x4*)(A.b_gates + 4);
#pragma unroll
            for (int r = 0; r < 4; ++r) {
                *(f32x4*)(gates + (size_t)(r0 + r) * 8) = (f32x4){acc[r][0] + b0[0], acc[r][1] + b0[1], acc[r][2] + b0[2], acc[r][3] + b0[3]};
                *(f32x4*)(gates + (size_t)(r0 + r) * 8 + 4) = (f32x4){acc[r][4] + b1[0], acc[r][5] + b1[1], acc[r][6] + b1[2], acc[r][7] + b1[3]}; }
        }
    }
}

__device__ __forceinline__ void phase_yconv(const Args& A) {
    const bf16_t* proj = (const bf16_t*)(A.ws + WS_PROJ); bf16_t* y = (bf16_t*)(A.ws + WS_Y);
    for (int idx = blockIdx.x * 512 + threadIdx.x; idx < MT * 128; idx += gridDim.x * 512) {
        const int row = idx >> 7, c = (idx & 127) * 8, t = row & (SEQ - 1);
        const bf16_t* pr = proj + (size_t)row * NP + c;
        const u32x4 bv = *(const u32x4*)pr;
        float cv[8];
#pragma unroll
        for (int i = 0; i < 8; ++i) cv[i] = 0.f;
#pragma unroll
        for (int j = 0; j < 3; ++j) {
            const int dt = 2 - j;
            if (t - dt >= 0) {
                const u32x4 cc = *(const u32x4*)(pr - (size_t)dt * NP + WCONV), hh = *(const u32x4*)(pr - (size_t)dt * NP + 2 * WCONV);
                const f32x4 w0 = *(const f32x4*)(A.w_sc + j * WCONV + c), w1 = *(const f32x4*)(A.w_sc + j * WCONV + c + 4);
                const float wv[8] = {w0[0], w0[1], w0[2], w0[3], w1[0], w1[1], w1[2], w1[3]};
#pragma unroll
                for (int q = 0; q < 4; ++q) { cv[2 * q] += wv[2 * q] * bflo(cc[q]) * bflo(hh[q]); cv[2 * q + 1] += wv[2 * q + 1] * bfhi(cc[q]) * bfhi(hh[q]); }
            }
        }
        u32x4 o;
#pragma unroll
        for (int q = 0; q < 4; ++q) o[q] = cvt_pk_bf16(bflo(bv[q]) * cv[2 * q], bfhi(bv[q]) * cv[2 * q + 1]);
        *(u32x4*)(y + (size_t)row * DM + c) = o;
    }
}

__device__ __forceinline__ void phase_mlstm(const Args& A, unsigned char* lds, float* hbuf) {
    const int tid = threadIdx.x, lane = tid & 63, w = tid >> 6, g = lane >> 4, l15 = lane & 15;
    const int a = w >> 2, ti = w & 3;
    unsigned char* QS = lds; unsigned char* KS = lds + 33792; unsigned char* VT = lds + 67584; unsigned char* WVT = VT + 4608; unsigned char* CT = WVT + 4608; unsigned char* XCH = CT + 33792;
    const bf16_t* proj = (const bf16_t*)(A.ws + WS_PROJ); const float* gates = (const float*)(A.ws + WS_GATES);
    float* TBC = (float*)(lds + 131088); float* TUV = TBC + 2048; float* TCM = TUV + 2048;
    for (int item = blockIdx.x; item < 256; item += gridDim.x) {
        const int xcd = item & 7, idx = item >> 3; const int bh = xcd * 2 + (idx >> 4), es = idx & 15;
        const int b = bh >> 2, hh = bh & 3, e0 = es * 16;
        const size_t row0 = (size_t)b * SEQ;
        __syncthreads();
        for (int i = tid; i < 16896 / 4; i += 512) ((unsigned*)CT)[i] = 0u;
        for (int i = tid; i < 16 * 72; i += 512) { const int r = 16 + i / 72, ci = i % 72; ((bf16_t*)VT)[r * 72 + ci] = (r == 16) ? (bf16_t)0x3F80 : (bf16_t)0; ((bf16_t*)WVT)[r * 72 + ci] = 0; }
        f32x4 Cst[2][2];
#pragma unroll
        for (int x = 0; x < 2; ++x)
#pragma unroll
            for (int et = 0; et < 2; ++et) Cst[x][et] = (f32x4){0.f, 0.f, 0.f, 0.f};
        float m_state = 0.f;
        u32x4 qr[4], kr[4]; unsigned vr;
        const bf16_t* qbase = proj + row0 * NP + 3072 + hh * 256;
#define ML_LOAD(c) do { _Pragma("unroll") for (int i = 0; i < 4; ++i) { const int p = tid + 512 * i, r = p >> 5, c16 = p & 31; const bf16_t* rp = qbase + (size_t)((c) * 64 + r) * NP + c16 * 8; \
            qr[i] = *(const u32x4*)rp; kr[i] = *(const u32x4*)(rp + 1024); } \
            vr = *(const unsigned*)(qbase + (size_t)((c) * 64 + (tid >> 3)) * NP + 2048 + e0 + (tid & 7) * 2); } while (0)
        ML_LOAD(0);
#pragma unroll 1
        for (int cc = 4 * w; cc < 4 * w + 4; ++cc) {
            const float* gp = gates + (row0 + cc * 64 + lane) * 8 + hh; const float gi = gp[0], gf = gp[4];
            const float lf = fminf(gf, 0.f) - log1pf(__expf(-fabsf(gf)));
            float bc = lf;
#pragma unroll
            for (int off = 1; off < 64; off <<= 1) { const float t = __shfl_up(bc, off); if (lane >= off) bc += t; }
            const float uv = gi - bc;
            float cm = uv;
#pragma unroll
            for (int off = 1; off < 64; off <<= 1) { const float t = __shfl_up(cm, off); if (lane >= off) cm = fmaxf(cm, t); }
            TBC[cc * 64 + lane] = bc; TUV[cc * 64 + lane] = uv; TCM[cc * 64 + lane] = cm;
        }
        __syncthreads();
#pragma unroll 1
        for (int c = 0; c < 32; ++c) {
            const float* tbc = TBC + c * 64; const float* tuv = TUV + c * 64; const float* tcm = TCM + c * 64;
            const float g_tot = tbc[63], cm63 = tcm[63];
            const float M63 = fmaxf(m_state, cm63), decay = __expf(m_state - M63);
            const float m_old = m_state;
            m_state = g_tot + M63;
#pragma unroll
            for (int i = 0; i < 4; ++i) { const int p = tid + 512 * i, r = p >> 5, c16 = p & 31; *(u32x4*)(QS + r * 528 + c16 * 16) = qr[i]; *(u32x4*)(KS + r * 528 + c16 * 16) = kr[i]; }
            { const int s = tid >> 3, ep = tid & 7; const float wv = __expf(tuv[s] - M63);
              ((bf16_t*)VT)[(2 * ep) * 72 + s] = (bf16_t)(vr & 0xffffu); ((bf16_t*)VT)[(2 * ep + 1) * 72 + s] = (bf16_t)(vr >> 16);
              ((bf16_t*)WVT)[(2 * ep) * 72 + s] = f2bf(bflo(vr) * wv); ((bf16_t*)WVT)[(2 * ep + 1) * 72 + s] = f2bf(bfhi(vr) * wv);
              if (ep == 0) ((bf16_t*)WVT)[16 * 72 + s] = f2bf(wv); }
            if (c + 1 < 32) ML_LOAD(c + 1);
            __syncthreads();
            bf16x8 qf[8]; f32x4 S0 = (f32x4){0.f, 0.f, 0.f, 0.f}, S1 = S0;
#pragma unroll
            for (int kk = 0; kk < 8; ++kk) {
                const int ko = ((kk + 4 * a) & 7) * 64 + g * 16;
                qf[kk] = *(const bf16x8*)(QS + (16 * ti + l15) * 528 + ko);
                const bf16x8 kf0 = *(const bf16x8*)(KS + (32 * a + l15) * 528 + ko), kf1 = *(const bf16x8*)(KS + (32 * a + 16 + l15) * 528 + ko);
                S0 = __builtin_amdgcn_mfma_f32_16x16x32_bf16(kf0, qf[kk], S0, 0, 0, 0); S1 = __builtin_amdgcn_mfma_f32_16x16x32_bf16(kf1, qf[kk], S1, 0, 0, 0);
            }
            const int tcol = 16 * ti + l15;
            const float Mt = fmaxf(m_old, tcm[tcol]);
            const f32x4 u0v = *(const f32x4*)(tuv + 32 * a + 4 * g), u1v = *(const f32x4*)(tuv + 32 * a + 16 + 4 * g);
            float p[8];
#pragma unroll
            for (int r = 0; r < 4; ++r) { const int s0 = 32 * a + 4 * g + r, s1 = s0 + 16;
                p[r] = (s0 <= tcol) ? S0[r] * 0.0625f * __expf(u0v[r] - Mt) : 0.f; p[4 + r] = (s1 <= tcol) ? S1[r] * 0.0625f * __expf(u1v[r] - Mt) : 0.f; }
            u32x4 pau; pau.x = cvt_pk_bf16(p[0], p[1]); pau.y = cvt_pk_bf16(p[2], p[3]); pau.z = cvt_pk_bf16(p[4], p[5]); pau.w = cvt_pk_bf16(p[6], p[7]);
            const bf16x8 pa = __builtin_bit_cast(bf16x8, pau);
            f32x4 rr[2];
#pragma unroll
            for (int et = 0; et < 2; ++et) { const unsigned char* vp = VT + (16 * et + l15) * 144 + (32 * a + 4 * g) * 2;
                const u32x2 lo = *(const u32x2*)vp, hi = *(const u32x2*)(vp + 32);
                u32x4 vbu; vbu.x = lo.x; vbu.y = lo.y; vbu.z = hi.x; vbu.w = hi.y;
                rr[et] = __builtin_amdgcn_mfma_f32_16x16x32_bf16(pa, __builtin_bit_cast(bf16x8, vbu), (f32x4){0.f, 0.f, 0.f, 0.f}, 0, 0, 0); }
            const f32x4 cmr = *(const f32x4*)(tcm + 16 * ti + 4 * g), bcr = *(const f32x4*)(tbc + 16 * ti + 4 * g);
            {
                const unsigned char* CTc = CT + (c & 1) * 16896;
                f32x4 in0 = (f32x4){0.f, 0.f, 0.f, 0.f}, in1 = in0;
#pragma unroll
                for (int k2 = 0; k2 < 4; ++k2) {
                    const bf16x8 qa = qf[k2];
                    const bf16x8 c0 = *(const bf16x8*)(CTc + (l15) * 528 + (128 * a + 32 * k2 + 8 * g) * 2), c1 = *(const bf16x8*)(CTc + (16 + l15) * 528 + (128 * a + 32 * k2 + 8 * g) * 2);
                    in0 = __builtin_amdgcn_mfma_f32_16x16x32_bf16(qa, c0, in0, 0, 0, 0); in1 = __builtin_amdgcn_mfma_f32_16x16x32_bf16(qa, c1, in1, 0, 0, 0);
                }
#pragma unroll
                for (int r = 0; r < 4; ++r) { const float iw = __expf(m_old - fmaxf(m_old, cmr[r])) * 0.0625f; rr[0][r] += in0[r] * iw; rr[1][r] += in1[r] * iw; }
            }
            if (a == 1) { *(f32x4*)(XCH + ((ti * 2 + 0) * 64 + lane) * 16) = rr[0]; *(f32x4*)(XCH + ((ti * 2 + 1) * 64 + lane) * 16) = rr[1]; }
            {
                unsigned char* CTn = CT + ((c + 1) & 1) * 16896;
#pragma unroll
                for (int x = 0; x < 2; ++x) {
                    const int dt = 2 * w + x;
#pragma unroll
                    for (int et = 0; et < 2; ++et) Cst[x][et] *= decay;
#pragma unroll
                    for (int ks = 0; ks < 2; ++ks) {
                        const s16x4 klo = __builtin_amdgcn_ds_read_tr16_b64_v4i16((LAS s16x4*)(KS + (32 * ks + 8 * g + (l15 >> 2)) * 528 + (16 * dt + 4 * (l15 & 3)) * 2));
                        const s16x4 khi = __builtin_amdgcn_ds_read_tr16_b64_v4i16((LAS s16x4*)(KS + (32 * ks + 8 * g + 4 + (l15 >> 2)) * 528 + (16 * dt + 4 * (l15 & 3)) * 2));
                        const bf16x8 ka = {klo[0], klo[1], klo[2], klo[3], khi[0], khi[1], khi[2], khi[3]};
#pragma unroll
                        for (int et = 0; et < 2; ++et) { const bf16x8 wvb = *(const bf16x8*)(WVT + (16 * et + l15) * 144 + (32 * ks + 8 * g) * 2);
                            Cst[x][et] = __builtin_amdgcn_mfma_f32_16x16x32_bf16(ka, wvb, Cst[x][et], 0, 0, 0); }
                    }
#pragma unroll
                    for (int et = 0; et < 2; ++et) { u32x2 o; o.x = cvt_pk_bf16(Cst[x][et][0], Cst[x][et][1]); o.y = cvt_pk_bf16(Cst[x][et][2], Cst[x][et][3]);
                        *(u32x2*)(CTn + (16 * et + l15) * 528 + (16 * dt + 4 * g) * 2) = o; }
                }
            }
            __syncthreads();
            if (a == 0) {
                const f32x4 o0 = *(const f32x4*)(XCH + ((ti * 2 + 0) * 64 + lane) * 16), o1 = *(const f32x4*)(XCH + ((ti * 2 + 1) * 64 + lane) * 16);
#pragma unroll
                for (int r = 0; r < 4; ++r) {
                    const float den = __shfl(rr[1][r] + o1[r], lane & 48), fl = __expf(-(bcr[r] + fmaxf(m_old, cmr[r])));
                    const float hv = (rr[0][r] + o0[r]) * __builtin_amdgcn_rcpf(fmaxf(fabsf(den), fl));
                    hbuf[(row0 + c * 64 + 16 * ti + 4 * g + r) * 1024 + hh * 256 + e0 + l15] = hv;
                }
            }
        }
#undef ML_LOAD
    }
}

__device__ __forceinline__ void phase_headnorm(const Args& A, const float* hbuf) {
    const bf16_t* proj = (const bf16_t*)(A.ws + WS_PROJ); bf16_t* y = (bf16_t*)(A.ws + WS_Y);
    const int lane = threadIdx.x & 63, gw = blockIdx.x * 8 + (threadIdx.x >> 6), nw = gridDim.x * 8;
    f32x4 gn[4];
#pragma unroll
    for (int hh = 0; hh < 4; ++hh) gn[hh] = *(const f32x4*)(A.mh_gain + hh * 256 + lane * 4);
    for (int row = gw; row < MT; row += nw) {
        f32x4 hv[4]; u32x2 ov[4]; float s[4], q[4];
#pragma unroll
        for (int hh = 0; hh < 4; ++hh) { hv[hh] = *(const f32x4*)(hbuf + (size_t)row * 1024 + hh * 256 + lane * 4); ov[hh] = *(const u32x2*)(proj + (size_t)row * NP + 6144 + hh * 256 + lane * 4); }
#pragma unroll
        for (int hh = 0; hh < 4; ++hh) s[hh] = (hv[hh][0] + hv[hh][1]) + (hv[hh][2] + hv[hh][3]);
#pragma unroll
        for (int off = 32; off >= 1; off >>= 1)
#pragma unroll
            for (int hh = 0; hh < 4; ++hh) s[hh] += __shfl_xor(s[hh], off);
#pragma unroll
        for (int hh = 0; hh < 4; ++hh) { const float mu = s[hh] * (1.0f / 256.0f); hv[hh] = hv[hh] - mu; q[hh] = (hv[hh][0] * hv[hh][0] + hv[hh][1] * hv[hh][1]) + (hv[hh][2] * hv[hh][2] + hv[hh][3] * hv[hh][3]); }
#pragma unroll
        for (int off = 32; off >= 1; off >>= 1)
#pragma unroll
            for (int hh = 0; hh < 4; ++hh) q[hh] += __shfl_xor(q[hh], off);
#pragma unroll
        for (int hh = 0; hh < 4; ++hh) {
            const float rstd = rsqrtf(q[hh] * (1.0f / 256.0f) + 1e-6f);
            const float o0 = bflo(ov[hh].x), o1 = bfhi(ov[hh].x), o2 = bflo(ov[hh].y), o3 = bfhi(ov[hh].y);
            const float y0 = hv[hh][0] * rstd * gn[hh][0] * __builtin_amdgcn_rcpf(1.0f + __expf(-o0)), y1 = hv[hh][1] * rstd * gn[hh][1] * __builtin_amdgcn_rcpf(1.0f + __expf(-o1));
            const float y2 = hv[hh][2] * rstd * gn[hh][2] * __builtin_amdgcn_rcpf(1.0f + __expf(-o2)), y3 = hv[hh][3] * rstd * gn[hh][3] * __builtin_amdgcn_rcpf(1.0f + __expf(-o3));
            u32x2 o; o.x = cvt_pk_bf16(y0, y1); o.y = cvt_pk_bf16(y2, y3);
            *(u32x2*)(y + (size_t)row * DM + WCONV + hh * 256 + lane * 4) = o;
        }
    }
}

__device__ __forceinline__ void phase_ln(float* io, const float* gam, const float* bet, bf16_t* ob) {
    const int lane = threadIdx.x & 63, gw = blockIdx.x * 8 + (threadIdx.x >> 6), nw = gridDim.x * 8;
    for (int row = gw; row < MT; row += nw) {
        float* rp = io + (size_t)row * DM;
        f32x4 v[8]; float s = 0.f;
#pragma unroll
        for (int i = 0; i < 8; ++i) { v[i] = *(const f32x4*)(rp + i * 256 + lane * 4); s += (v[i][0] + v[i][1]) + (v[i][2] + v[i][3]); }
#pragma unroll
        for (int off = 32; off >= 1; off >>= 1) s += __shfl_xor(s, off);
        const float mu = s * (1.0f / DM);
        float q = 0.f;
#pragma unroll
        for (int i = 0; i < 8; ++i) { v[i] = v[i] - mu; q += (v[i][0] * v[i][0] + v[i][1] * v[i][1]) + (v[i][2] * v[i][2] + v[i][3] * v[i][3]); }
#pragma unroll
        for (int off = 32; off >= 1; off >>= 1) q += __shfl_xor(q, off);
        const float rstd = rsqrtf(q * (1.0f / DM) + 1e-5f);
#pragma unroll
        for (int i = 0; i < 8; ++i) { const f32x4 gg = *(const f32x4*)(gam + i * 256 + lane * 4), bb = *(const f32x4*)(bet + i * 256 + lane * 4);
            const f32x4 o = v[i] * rstd * gg + bb;
            *(f32x4*)(rp + i * 256 + lane * 4) = o;
            if (ob) { u32x2 p; p.x = cvt_pk_bf16(o[0], o[1]); p.y = cvt_pk_bf16(o[2], o[3]); *(u32x2*)(ob + (size_t)row * DM + i * 256 + lane * 4) = p; } }
    }
}

__device__ __forceinline__ void phase_fixup(const Args& A) {
    const float* halo = (const float*)(A.ws + WS_HALO); bf16_t* act = (bf16_t*)(A.ws + WS_ACT);
    for (int idx = blockIdx.x * 512 + threadIdx.x; idx < 64 * 2 * (DFF / 4); idx += gridDim.x * 512) {
        const int f = (idx % (DFF / 4)) * 4, br = idx / (DFF / 4), rr = br & 1, B = br >> 1;
        const bool first = (B & 15) == 0;
        const float* hc = halo + (size_t)B * 4 * NUP; const float* hp = hc - 4 * NUP;
        f32x4 hv[2];
#pragma unroll
        for (int bj = 0; bj < 2; ++bj) {
            const int col = bj * DFF + f;
            const f32x4 cur = *(const f32x4*)(hc + (size_t)(2 + rr) * NUP + col);
            f32x4 p1, p2; const f32x4 z = (f32x4){0.f, 0.f, 0.f, 0.f};
            if (rr == 0) { p1 = first ? z : *(const f32x4*)(hp + (size_t)1 * NUP + col); p2 = first ? z : *(const f32x4*)(hp + col); }
            else { p1 = *(const f32x4*)(hc + (size_t)2 * NUP + col); p2 = first ? z : *(const f32x4*)(hp + (size_t)1 * NUP + col); }
            const f32x4 w0 = *(const f32x4*)(A.w_fc + col), w1 = *(const f32x4*)(A.w_fc + NUP + col), w2 = *(const f32x4*)(A.w_fc + 2 * NUP + col), bb = *(const f32x4*)(A.b_fc + col);
            hv[bj] = w2 * cur + w1 * p1 + w0 * p2 + bb;
        }
        float av[4];
#pragma unroll
        for (int j = 0; j < 4; ++j) { const float gt = hv[1][j]; av[j] = hv[0][j] * gt / (1.0f + __expf(-gt)); }
        u32x2 o; o.x = cvt_pk_bf16(av[0], av[1]); o.y = cvt_pk_bf16(av[2], av[3]);
        *(u32x2*)(act + (size_t)(B * 128 + rr) * DFF + f) = o;
    }
}

__device__ __forceinline__ void phase_dump(const bf16_t* src, int ld, int c0, float* out) {
    for (size_t idx = (size_t)blockIdx.x * 512 + threadIdx.x; idx < (size_t)MT * DM; idx += (size_t)gridDim.x * 512) {
        const size_t row = idx / DM, col = idx % DM; out[idx] = bflo((unsigned)src[row * ld + c0 + col]); }
}
#ifndef DBG_STOP
#define DBG_STOP -1
#endif
#define XB_TMO      128
#define XB_XCNT(j)  (256  + 64 * (j))
#define XB_XSUB(j)  (1280 + 64 * (j))
#define XB_XGEN(j)  (2304 + 64 * (j))
#define XB_TOP      3328
#define XB_TOPGEN   3392
#define XCD_BAR_WORDS 3456
#define XB_SPIN_CAP (1u << 22)
__device__ __forceinline__ unsigned xb_ld(unsigned* p)              { return __hip_atomic_load(p, __ATOMIC_RELAXED, __HIP_MEMORY_SCOPE_AGENT); }
__device__ __forceinline__ unsigned xb_add(unsigned* p, unsigned v) { return __hip_atomic_fetch_add(p, v, __ATOMIC_RELAXED, __HIP_MEMORY_SCOPE_AGENT); }
__device__ __forceinline__ unsigned xb_xcc_id() { return (unsigned)__builtin_amdgcn_s_getreg((3 << 11) | 20) & 0xFu; }
#define XB_SPIN(cond, bar) do { unsigned _sp = 0; while (cond) { __builtin_amdgcn_s_sleep(1); \
    if ((++_sp & 255u) == 0u) { if (xb_ld(&(bar)[XB_TMO])) break; if (_sp > XB_SPIN_CAP) { atomicAdd(&(bar)[XB_TMO], 1u); break; } } } } while (0)
struct XcdBarrier { unsigned* bar; unsigned x; volatile LAS unsigned* st; };
__device__ __forceinline__ XcdBarrier xcd_barrier_post(unsigned* bar, volatile LAS unsigned* st) {
    XcdBarrier b; b.bar = bar; b.x = xb_xcc_id(); b.st = st;
    if (threadIdx.x == 0) (void)xb_add(&bar[XB_XCNT(b.x)], 1u);
    return b;
}
__device__ __forceinline__ void xcd_barrier_complete(unsigned* bar, unsigned x, unsigned& nloc, unsigned& nx) {
    const unsigned G = gridDim.x * gridDim.y * gridDim.z;
    unsigned sum, cnt, mine, sp = 0u;
    for (;;) {
        sum = 0u; cnt = 0u; mine = 0u;
#pragma unroll
        for (unsigned j = 0; j < 16; ++j) { const unsigned c = xb_ld(&bar[XB_XCNT(j)]); sum += c; cnt += (c > 0u) ? 1u : 0u; mine = (j == x) ? c : mine; }
        if (sum == G) break;
        __builtin_amdgcn_s_sleep(1);
        if ((++sp & 255u) == 0u) { if (xb_ld(&bar[XB_TMO])) break; if (sp > XB_SPIN_CAP) { atomicAdd(&bar[XB_TMO], 1u); break; } }
    }
    nloc = mine > 0u ? mine : 1u; nx = cnt > 0u ? cnt : 1u;
}
__device__ __forceinline__ void xcd_barrier(const XcdBarrier& b) {
    asm volatile("s_waitcnt vmcnt(0)" ::: "memory");
    __syncthreads();
    if (threadIdx.x == 0) {
        unsigned* bar = b.bar;
        __builtin_amdgcn_s_waitcnt(0);
        unsigned nloc = b.st[0], nx = b.st[1];
        if (nloc == 0u) { xcd_barrier_complete(bar, b.x, nloc, nx); b.st[0] = nloc; b.st[1] = nx; }
        const unsigned old = xb_add(&bar[XB_XSUB(b.x)], 1u);
        const unsigned gen = old / nloc;
        if (old + 1u == (gen + 1u) * nloc) {
            __builtin_amdgcn_fence(__ATOMIC_RELEASE, "agent");
            asm volatile("s_waitcnt vmcnt(0)" ::: "memory");
            const unsigned og = xb_add(&bar[XB_TOP], 1u);
            const unsigned tg = og / nx;
            if (og + 1u == (tg + 1u) * nx) xb_add(&bar[XB_TOPGEN], 1u);
            else XB_SPIN(xb_ld(&bar[XB_TOPGEN]) == tg, bar);
            __builtin_amdgcn_fence(__ATOMIC_ACQUIRE, "agent");
            xb_add(&bar[XB_XGEN(b.x)], 1u);
            asm volatile("s_waitcnt vmcnt(0)" ::: "memory");
        } else {
            XB_SPIN(xb_ld(&bar[XB_XGEN(b.x)]) == gen, bar);
            __builtin_amdgcn_fence(__ATOMIC_ACQUIRE, "agent");
            asm volatile("s_waitcnt vmcnt(0)" ::: "memory");
        }
    }
    __syncthreads();
}

constexpr int N_PHASES = 10;
#ifndef ONLY_PH
#define ONLY_PH -1
#endif
#define PH_ON(x) (ONLY_PH < 0 || ONLY_PH == (x))
__global__ void __launch_bounds__(512, 2) mega(Args a) {
    extern __shared__ __attribute__((aligned(16))) unsigned char lds[];
    cg::grid_group grid = cg::this_grid();
    unsigned char* ws = a.ws;
#define PH_RUN(x) (PH_ON(x) && a.ph_lo <= (x) && (x) < a.ph_hi)
#define PH_SYNC(x) do { if (a.ph_lo <= (x) && (x) + 1 < a.ph_hi) xcd_barrier(xb); } while (0)
    volatile LAS unsigned* xst = (volatile LAS unsigned*)((LAS unsigned char*)lds + 131072);
    if (threadIdx.x == 0) { xst[0] = 0u; xst[1] = 0u; }
    __syncthreads();
    const XcdBarrier xb = xcd_barrier_post((unsigned*)(ws + WS_BAR), xst);
    if (a.ph_hi > 1000) grid.sync();
#ifndef REP0
#define REP0 1
#endif
#ifndef REP2
#define REP2 1
#endif
#ifndef REP6
#define REP6 1
#endif
    if (PH_RUN(0)) for (int rep = 0; rep < REP0; ++rep) phase_prologue(a, lds);
    PH_SYNC(0);
    if (PH_RUN(1)) { pg8::Gemm g{(const bf16_t*)(ws + WS_XB), (const bf16_t*)(ws + WS_WIN), MT, NP, DM}; pg8::StaticOrder S; S.init(MT, NP, gridDim.x, blockIdx.x);
        pg8::EpiBf16 E{(bf16_t*)(ws + WS_PROJ), NP}; pg8::gemm_phase<pg8::EpiBf16, true>((LAS unsigned char*)lds, g, S, E);
        const int rem = ((MT / 256) * (NP / 256)) % (int)gridDim.x;
        if (rem == 0) phase_transposes(a, lds, TM_IN, TM_IN + TM_OUT + TM_UP, blockIdx.x, gridDim.x);
        else if ((int)blockIdx.x >= rem) phase_transposes(a, lds, TM_IN, TM_IN + TM_OUT + TM_UP, blockIdx.x - rem, gridDim.x - rem); }
    PH_SYNC(1);
    if (PH_RUN(2)) for (int rep = 0; rep < REP2; ++rep) { phase_yconv(a); phase_mlstm(a, lds, a.out); }
    PH_SYNC(2);
    if (PH_RUN(3)) phase_headnorm(a, a.out);
    PH_SYNC(3);
    if (PH_RUN(4)) { pg8::Gemm g{(const bf16_t*)(ws + WS_Y), (const bf16_t*)(ws + WS_WOUT), MT, DM, DM}; pg8::StaticOrder S; S.init(MT, DM, gridDim.x, blockIdx.x);
        if (a.fuse_ln) { pg8::EpiResLn<false, false> E{a.x, nullptr, nullptr, (bf16_t*)(ws + WS_X1B), a.ln1_g, a.ln1_b, (float*)(ws + WS_RS1), (unsigned*)(ws + WS_CNT)}; pg8::gemm_phase((LAS unsigned char*)lds, g, S, E); }
        else { pg8::EpiResF32 E{a.x, a.out, DM}; pg8::gemm_phase((LAS unsigned char*)lds, g, S, E); } }
    PH_SYNC(4);
    if (PH_RUN(5) && !a.fuse_ln) phase_ln(a.out, a.ln1_g, a.ln1_b, (bf16_t*)(ws + WS_X1B));
    if (!a.fuse_ln) PH_SYNC(5);
    if (PH_RUN(6)) { pg8::Gemm g{(const bf16_t*)(ws + WS_X1B), (const bf16_t*)(ws + WS_WUP), MT, NUP, DM}; pg8::StaticOrder S; S.init(MT, NUP, gridDim.x, blockIdx.x);
        pg8::EpiConvFfn E{(bf16_t*)(ws + WS_ACT), (float*)(ws + WS_HALO), a.w_fc, a.b_fc}; pg8::gemm_phase<pg8::EpiConvFfn, true>((LAS unsigned char*)lds, g, S, E);
        const int rem = ((MT / 256) * (NUP / 256)) % (int)gridDim.x; const int t0 = TM_IN + TM_OUT + TM_UP, t1 = t0 + TM_DN;
        if (rem == 0) phase_transposes(a, lds, t0, t1, blockIdx.x, gridDim.x);
        else if ((int)blockIdx.x >= rem) phase_transposes(a, lds, t0, t1, blockIdx.x - rem, gridDim.x - rem); }
    PH_SYNC(6);
    if (PH_RUN(7)) phase_fixup(a);
    PH_SYNC(7);
    if (PH_RUN(8)) { pg8::Gemm g{(const bf16_t*)(ws + WS_ACT), (const bf16_t*)(ws + WS_WDN), MT, DM, DFF}; pg8::StaticOrder S; S.init(MT, DM, gridDim.x, blockIdx.x);
        if (a.fuse_ln) { pg8::EpiResLn<true, true> E{nullptr, (const bf16_t*)(ws + WS_X1B), a.out, nullptr, a.ln2_g, a.ln2_b, (float*)(ws + WS_RS2), (unsigned*)(ws + WS_CNT) + 32 * 64}; pg8::gemm_phase((LAS unsigned char*)lds, g, S, E); }
        else { pg8::EpiResF32 E{a.out, a.out, DM}; pg8::gemm_phase((LAS unsigned char*)lds, g, S, E); } }
    if (!a.fuse_ln) PH_SYNC(8);
    if (PH_RUN(9) && !a.fuse_ln) phase_ln(a.out, a.ln2_g, a.ln2_b, nullptr);
    if (DBG_STOP == 1 && a.ph_lo == 101) phase_dump((const bf16_t*)(ws + WS_PROJ), NP, 3072, a.out);
    if (DBG_STOP == 3 && a.ph_lo == 103) phase_dump((const bf16_t*)(ws + WS_Y), DM, 0, a.out);
    if (DBG_STOP == 7 && a.ph_lo == 107) phase_dump((const bf16_t*)(ws + WS_ACT), DFF, 0, a.out);
}

extern "C" void kernel_launch(void* const* d_in, const int* in_sizes, int n_in, void* d_out, int out_size, void* d_ws, size_t ws_size, hipStream_t stream) {
    static int grid = 0;
    if (grid == 0) {
        if (n_in != 14 || ws_size < WS_END) { fprintf(stderr, "kernel_launch: unexpected n_in %d / ws_size %zu (need %zu)\n", n_in, ws_size, (size_t)WS_END); grid = -1; return; }
        int dev = 0, cus = 0, per_cu = 0;
        hipGetDevice(&dev); hipDeviceGetAttribute(&cus, hipDeviceAttributeMultiprocessorCount, dev);
        if (hipFuncSetAttribute((const void*)mega, hipFuncAttributeMaxDynamicSharedMemorySize, LDS_BYTES) != hipSuccess) { fprintf(stderr, "kernel_launch: hipFuncSetAttribute failed\n"); grid = -1; return; }
        if (hipOccupancyMaxActiveBlocksPerMultiprocessor(&per_cu, (const void*)mega, 512, LDS_BYTES) != hipSuccess || per_cu < 1) { fprintf(stderr, "kernel_launch: occupancy query failed (%d)\n", per_cu); (void)hipGetLastError(); per_cu = 1; }
        grid = cus * 1;
        fprintf(stderr, "kernel_launch: cus %d per_cu %d grid %d\n", cus, per_cu, grid);
    }
    if (grid < 0) return;
    if (hipMemsetAsync((char*)d_ws + WS_BAR, 0, WS_END - WS_BAR, stream)     != hipSuccess) { fprintf(stderr, "kernel_launch: memset failed\n"); return; }
    Args a{};
    a.x = (const float*)d_in[0]; a.w_in = (const float*)d_in[1]; a.b_gates = (const float*)d_in[2]; a.w_sc = (const float*)d_in[3]; a.mh_gain = (const float*)d_in[4]; a.w_out = (const float*)d_in[5];
    a.ln1_g = (const float*)d_in[6]; a.ln1_b = (const float*)d_in[7]; a.w_up = (const float*)d_in[8]; a.w_fc = (const float*)d_in[9]; a.b_fc = (const float*)d_in[10]; a.w_down = (const float*)d_in[11];
    a.ln2_g = (const float*)d_in[12]; a.ln2_b = (const float*)d_in[13];
    a.out = (float*)d_out; a.ws = (unsigned char*)d_ws;
    a.fuse_ln = (MK_SINGLE && grid == 256) ? 1 : 0;
#if MK_SINGLE
    a.ph_lo = 0; a.ph_hi = N_PHASES;
    void* args[] = {&a};
    hipError_t e = hipLaunchCooperativeKernel((const void*)mega, dim3(grid), dim3(512), args, LDS_BYTES, stream);
    if (e != hipSuccess) fprintf(stderr, "cooperative launch failed: %s (grid %d)\n", hipGetErrorString(e), grid);
#else
    for (int ph = 0; ph < N_PHASES; ++ph) { if (DBG_STOP >= 0 && ph > DBG_STOP) break; a.ph_lo = ph; a.ph_hi = ph + 1; hipLaunchKernelGGL(mega, dim3(grid), dim3(512), LDS_BYTES, stream, a); }
    if (DBG_STOP >= 0) { a.ph_lo = 100 + DBG_STOP; a.ph_hi = 101 + DBG_STOP; hipLaunchKernelGGL(mega, dim3(grid), dim3(512), LDS_BYTES, stream, a); }
#endif
}
```

```cpp
#include <hip/hip_runtime.h>
#include <hip/hip_cooperative_groups.h>
#include <cstdio>
#include <cstdint>
namespace cg = cooperative_groups;

#ifndef MK_SINGLE
#define MK_SINGLE 1
#endif

#define LAS __attribute__((address_space(3)))
typedef unsigned short bf16_t;
typedef short bf16x8 __attribute__((ext_vector_type(8)));
typedef float f32x4 __attribute__((ext_vector_type(4)));
typedef unsigned u32x4 __attribute__((ext_vector_type(4)));
typedef unsigned u32x2 __attribute__((ext_vector_type(2)));
typedef short s16x4 __attribute__((ext_vector_type(4)));

constexpr int MT = 8192, DM = 2048, SEQ = 2048, NIN = 7176, NP = 7168, DFF = 5632, NUP = 11264, WCONV = 1024;
constexpr float ALPHA = 1.189207115002721f;
constexpr size_t WS_WIN = 0;
constexpr size_t WS_WOUT = WS_WIN + (size_t)NP * DM * 2;
constexpr size_t WS_WUP = WS_WOUT + (size_t)DM * DM * 2;
constexpr size_t WS_WDN = WS_WUP + (size_t)NUP * DM * 2;
constexpr size_t WS_X1B = WS_WDN + (size_t)DM * DFF * 2;
constexpr size_t WS_GATES = WS_X1B + (size_t)MT * DM * 2;
constexpr size_t WS_C = WS_GATES + (size_t)MT * 8 * 4;
constexpr size_t WS_PROJ = WS_C;
constexpr size_t WS_Y = WS_PROJ + (size_t)MT * NP * 2;
constexpr size_t WS_XB = WS_Y + (size_t)MT * DM * 2;
constexpr size_t WS_ACT = WS_C;
constexpr size_t WS_HALO = WS_ACT + (size_t)MT * DFF * 2;
constexpr size_t WS_BAR = WS_XB + (size_t)MT * DM * 2;
constexpr size_t WS_RS1 = WS_BAR + 16384;
constexpr size_t WS_RS2 = WS_RS1 + (size_t)MT * 8;
constexpr size_t WS_CNT = WS_RS2 + (size_t)MT * 8;
constexpr size_t WS_END = WS_CNT + 2 * 32 * 256;
constexpr size_t WS_GCLO = WS_X1B, WS_GCHI = WS_XB;
constexpr size_t WS_NV = 0;
constexpr size_t WS_TAB = WS_NV + (size_t)512 * 256 * 2;
constexpr size_t WS_MST = WS_TAB + (size_t)16 * 3 * 2048 * 4;
constexpr int LDS_BYTES = 131072 + 16 + 3 * 32 * 64 * 4;

struct Args {
    const float* x; const float* w_in; const float* b_gates; const float* w_sc; const float* mh_gain; const float* w_out;
    const float* ln1_g; const float* ln1_b; const float* w_up; const float* w_fc; const float* b_fc; const float* w_down;
    const float* ln2_g; const float* ln2_b;
    float* out; unsigned char* ws; int ph_lo, ph_hi, fuse_ln, pad0;
};

typedef __bf16 bf16v2 __attribute__((ext_vector_type(2)));
typedef float f32x2 __attribute__((ext_vector_type(2)));
__device__ __forceinline__ unsigned cvt_pk_bf16(float lo, float hi) { const f32x2 v = {lo, hi}; const bf16v2 r = __builtin_convertvector(v, bf16v2); return __builtin_bit_cast(unsigned, r); }
__device__ __forceinline__ unsigned cvt_pk_bf16_asm(float lo, float hi) { unsigned r; asm volatile("v_cvt_pk_bf16_f32 %0, %1, %2" : "=v"(r) : "v"(lo), "v"(hi)); return r; }
__device__ __forceinline__ float bflo(unsigned u) { return __uint_as_float(u << 16); }
__device__ __forceinline__ float bfhi(unsigned u) { return __uint_as_float(u & 0xffff0000u); }
__device__ __forceinline__ bf16_t f2bf(float f) { unsigned u = __float_as_uint(f); u += 0x7FFFu + ((u >> 16) & 1u); return (bf16_t)(u >> 16); }

namespace pg8 {
constexpr int BM = 256, BK = 64, HALF = 128, HTB = HALF * BK * 2, STAGE_BYTES = 8 * HTB, NXCD = 8, WGM = 8;
__host__ __device__ __forceinline__ int lds_byte(int r, int c) { const int st = (r >> 4) * 2 + (c >> 5), rr = r & 15, cc = c & 31, ob = rr * 64 + cc * 2; return st * 1024 + (ob ^ (((ob >> 9) & 1) << 5)); }
__host__ __device__ __forceinline__ void stage_rc(int b, int& R, int& C) { const int st = b / 1024, sb = b % 1024, swz = sb ^ (((sb >> 9) & 1) << 5); R = (st >> 1) * 16 + swz / 64; C = (st & 1) * 32 + (swz % 64) / 2; }
__host__ __device__ __forceinline__ int perm32(int rho) { const int n = rho >> 4, i = rho & 15; return 8 * (i >> 2) + 4 * n + (i & 3); }
struct Unit { int pm, pn; };
struct Gemm { const bf16_t* A; const bf16_t* Bt; int M, N, K; };
struct StaticOrder {
    int nM, nN, nwg, G, c;
    __device__ void init(int M, int N, int G_, int c_) { nM = M / BM; nN = N / BM; nwg = nM * nN; G = G_; c = c_; }
    __device__ bool next(int i, Unit& u) const {
        const long L = (long)i * G + c; if (L >= nwg) return false;
        int wgid = (int)L; { const int q = nwg / NXCD, r = nwg % NXCD, xcd = wgid % NXCD, off = wgid / NXCD; wgid = (xcd < r ? xcd * (q + 1) : r * (q + 1) + (xcd - r) * q) + off; }
        const int nig = WGM * nN, gid = wgid / nig, fm = gid * WGM, gsz = (nM - fm) < WGM ? (nM - fm) : WGM;
        u.pm = fm + ((wgid % nig) % gsz); u.pn = (wgid % nig) / gsz; return true;
    }
};

template <class Epi, bool ALIGN_EPI = false, bool SP2 = true>
__device__ __forceinline__ void gemm_phase(LAS unsigned char* lds, const Gemm g, const StaticOrder& S, const Epi& E) {
    const int tid = threadIdx.x, wid = __builtin_amdgcn_readfirstlane(tid >> 6), lane = tid & 63, wr = wid >> 2, wc = wid & 3, fr = lane & 15, fq = lane >> 4;
    const int K = g.K, nt = K / BK;
    unsigned voffA[2], voffB[2];
#pragma unroll
    for (int i = 0; i < 2; ++i) { int R, C; stage_rc(tid * 16 + i * 8192, R, C); const int Rb = Epi::PERM ? ((R & ~31) + perm32(R & 31)) : R;
        const int Ra = Epi::AROWPERM ? (128 * (R >> 6) + 8 * (R & 15) + ((R >> 4) & 3)) : R;
        const int Rbb = Epi::BCOLPERM ? (64 * (R >> 5) + perm32(R & 31)) : Rb;
        voffA[i] = (unsigned)(Ra * K + C) * 2u; voffB[i] = (unsigned)(Rbb * K + C) * 2u; }
    const size_t kstep = (size_t)(BK * 2);
    const size_t hstep = (size_t)HALF * K * 2;
    const size_t hstepA = Epi::AROWPERM ? (size_t)4 * K * 2 : hstep;
    const size_t hstepB = Epi::BCOLPERM ? (size_t)32 * K * 2 : hstep;
    const size_t tstep = 2 * hstep;
    const unsigned ldsw = (unsigned)wid * 1024u;
    const int aoff = lds_byte(wr * 64 + fr, fq * 8), boff = lds_byte(wc * 32 + fr, fq * 8);
#define PG8_SA(b, h) (((b) * 2 + (h)) * HTB)
#define PG8_SB(b, h) ((4 + (b) * 2 + (h)) * HTB)
#define PG8_STAGE(bufoff, gbase, voff) do { _Pragma("unroll") for (int _i = 0; _i < 2; ++_i) \
        __builtin_amdgcn_global_load_lds((const unsigned*)((const char*)(gbase) + (voff)[_i]), (LAS unsigned*)(lds + (bufoff) + ldsw + _i * 8192), 16, 0, 0); } while (0)
#define PG8_LDA(dst, b, h) do { _Pragma("unroll") for (int m = 0; m < 4; ++m) _Pragma("unroll") for (int k = 0; k < 2; ++k) dst[m][k] = *(const LAS bf16x8*)(lds + PG8_SA(b, h) + aoff + m * 2048 + k * 1024); } while (0)
#define PG8_LDB(dst, b, h) do { _Pragma("unroll") for (int n = 0; n < 2; ++n) _Pragma("unroll") for (int k = 0; k < 2; ++k) dst[n][k] = *(const LAS bf16x8*)(lds + PG8_SB(b, h) + boff + n * 2048 + k * 1024); } while (0)
#define PG8_MMA(ai, bj, At, Bt) do { __builtin_amdgcn_s_setprio(1); _Pragma("unroll") for (int m = 0; m < 4; ++m) _Pragma("unroll") for (int n = 0; n < 2; ++n) _Pragma("unroll") for (int k = 0; k < 2; ++k) \
        acc[ai][bj][m][n] = __builtin_amdgcn_mfma_f32_16x16x32_bf16(Bt[n][k], At[m][k], acc[ai][bj][m][n], 0, 0, 0); __builtin_amdgcn_s_setprio(0); } while (0)
#define PG8_WAIT_V(n) asm volatile("s_waitcnt vmcnt(" #n ")" ::: "memory")
#define PG8_WAIT_L(n) asm volatile("s_waitcnt lgkmcnt(" #n ")" ::: "memory")
#define PG8_BAR __builtin_amdgcn_s_barrier()
#define PG8_SCHED __builtin_amdgcn_sched_barrier(0)
    Unit cur, nxt; int ui = 0;
    if (!S.next(0, cur)) return;
    f32x4 acc[2][2][4][2];
#pragma unroll
    for (int a = 0; a < 2; ++a)
#pragma unroll
        for (int b = 0; b < 2; ++b)
#pragma unroll
            for (int m = 0; m < 4; ++m)
#pragma unroll
                for (int n = 0; n < 2; ++n) acc[a][b][m][n] = (f32x4){0.f, 0.f, 0.f, 0.f};
    bf16x8 At[4][2], B0[2][2], B1[2][2];
    const char* cA = (const char*)g.A + (size_t)cur.pm * tstep; const char* cB = (const char*)g.Bt + (size_t)cur.pn * tstep;
    if constexpr (SP2) {
        PG8_STAGE(PG8_SB(0, 0), cB, voffB); PG8_STAGE(PG8_SB(0, 1), cB + hstepB, voffB); PG8_STAGE(PG8_SA(0, 0), cA, voffA); PG8_STAGE(PG8_SA(0, 1), cA + hstepA, voffA);
        if (wr == 1) PG8_BAR;
        PG8_WAIT_V(2); PG8_BAR;
        PG8_STAGE(PG8_SB(1, 0), cB + kstep, voffB); PG8_STAGE(PG8_SA(1, 0), cA + kstep, voffA); PG8_STAGE(PG8_SB(1, 1), cB + hstepB + kstep, voffB);
        PG8_WAIT_V(6); PG8_BAR;
    } else {
        PG8_STAGE(PG8_SB(0, 0), cB, voffB); PG8_STAGE(PG8_SA(0, 0), cA, voffA); PG8_STAGE(PG8_SB(0, 1), cB + hstepB, voffB); PG8_STAGE(PG8_SA(0, 1), cA + hstepA, voffA);
        if (wr == 1) PG8_BAR;
        PG8_WAIT_V(4); PG8_BAR;
        PG8_STAGE(PG8_SB(1, 0), cB + kstep, voffB); PG8_STAGE(PG8_SA(1, 0), cA + kstep, voffA); PG8_STAGE(PG8_SB(1, 1), cB + hstepB + kstep, voffB);
        PG8_WAIT_V(6); PG8_BAR;
    }
    for (;;) {
        const bool has_next = S.next(ui + 1, nxt);
        const char* nA = has_next ? (const char*)g.A + (size_t)nxt.pm * tstep : cA; const char* nB = has_next ? (const char*)g.Bt + (size_t)nxt.pn * tstep : cB;
        for (int t = 0; t < nt; t += 2) {
            const bool last = (t == nt - 2);
            const char* a1 = cA + (size_t)(t + 1) * kstep;
            const char* a2 = last ? nA : cA + (size_t)(t + 2) * kstep; const char* b2 = last ? nB : cB + (size_t)(t + 2) * kstep;
            const char* a3 = a2 + kstep; const char* b3 = b2 + kstep;
            if constexpr (SP2) {
            PG8_LDB(B0, 0, 0); PG8_LDB(B1, 0, 1); PG8_SCHED; PG8_LDA(At, 0, 0); PG8_STAGE(PG8_SA(1, 1), a1 + hstepA, voffA);
            PG8_WAIT_V(8); PG8_WAIT_L(0); PG8_BAR; PG8_MMA(0, 0, At, B0); PG8_MMA(0, 1, At, B1); PG8_BAR; PG8_SCHED;
            PG8_LDA(At, 0, 1); PG8_STAGE(PG8_SB(0, 0), b2, voffB); PG8_STAGE(PG8_SB(0, 1), b2 + hstepB, voffB); PG8_STAGE(PG8_SA(0, 0), a2, voffA);
            PG8_WAIT_V(8); PG8_WAIT_L(0); PG8_BAR; PG8_MMA(1, 0, At, B0); PG8_MMA(1, 1, At, B1); PG8_BAR; PG8_SCHED;
            PG8_LDB(B0, 1, 0); PG8_LDB(B1, 1, 1); PG8_SCHED; PG8_LDA(At, 1, 0); PG8_STAGE(PG8_SA(0, 1), a2 + hstepA, voffA);
            PG8_WAIT_V(8); PG8_WAIT_L(0); PG8_BAR; PG8_MMA(0, 0, At, B0); PG8_MMA(0, 1, At, B1); PG8_BAR; PG8_SCHED;
            PG8_LDA(At, 1, 1); PG8_STAGE(PG8_SB(1, 0), b3, voffB); PG8_STAGE(PG8_SB(1, 1), b3 + hstepB, voffB); PG8_STAGE(PG8_SA(1, 0), a3, voffA);
            PG8_WAIT_V(8); PG8_WAIT_L(0); PG8_BAR; PG8_MMA(1, 0, At, B0); PG8_MMA(1, 1, At, B1); PG8_BAR; PG8_SCHED;
            } else {
            PG8_LDB(B0, 0, 0); PG8_SCHED; PG8_LDA(At, 0, 0); PG8_STAGE(PG8_SA(1, 1), a1 + hstepA, voffA);
            PG8_WAIT_L(8); PG8_BAR; PG8_WAIT_L(0); PG8_MMA(0, 0, At, B0); PG8_BAR; PG8_SCHED;
            PG8_LDB(B1, 0, 1); PG8_STAGE(PG8_SB(0, 0), b2, voffB);
            PG8_BAR; PG8_WAIT_L(0); PG8_MMA(0, 1, At, B1); PG8_BAR;
            PG8_LDA(At, 0, 1); PG8_STAGE(PG8_SA(0, 0), a2, voffA);
            PG8_BAR; PG8_WAIT_L(0); PG8_MMA(1, 0, At, B0); PG8_BAR; PG8_SCHED;
            PG8_STAGE(PG8_SB(0, 1), b2 + hstepB, voffB);
            PG8_WAIT_V(6); PG8_BAR; PG8_MMA(1, 1, At, B1); PG8_BAR;
            PG8_LDB(B0, 1, 0); PG8_SCHED; PG8_LDA(At, 1, 0); PG8_STAGE(PG8_SA(0, 1), a2 + hstepA, voffA);
            PG8_WAIT_L(8); PG8_BAR; PG8_WAIT_L(0); PG8_MMA(0, 0, At, B0); PG8_BAR; PG8_SCHED;
            PG8_LDB(B1, 1, 1); PG8_STAGE(PG8_SB(1, 0), b3, voffB);
            PG8_BAR; PG8_WAIT_L(0); PG8_MMA(0, 1, At, B1); PG8_BAR;
            PG8_LDA(At, 1, 1); PG8_STAGE(PG8_SA(1, 0), a3, voffA);
            PG8_BAR; PG8_WAIT_L(0); PG8_MMA(1, 0, At, B0); PG8_BAR; PG8_SCHED;
            PG8_STAGE(PG8_SB(1, 1), b3 + hstepB, voffB);
            PG8_WAIT_V(6); PG8_BAR; PG8_MMA(1, 1, At, B1); PG8_BAR;

            }
        }
        if constexpr (ALIGN_EPI) { if (wr == 0) PG8_BAR; }
        if constexpr (!Epi::AFTER_DRAIN) E(acc, cur, wr, wc, fr, fq);
        if (!has_next) break;
#pragma unroll
        for (int a = 0; a < 2; ++a)
#pragma unroll
            for (int b = 0; b < 2; ++b)
#pragma unroll
                for (int m = 0; m < 4; ++m)
#pragma unroll
                    for (int n = 0; n < 2; ++n) acc[a][b][m][n] = (f32x4){0.f, 0.f, 0.f, 0.f};
        cur = nxt; cA = nA; cB = nB; ++ui;
        if constexpr (ALIGN_EPI) { if (wr == 1) PG8_BAR; }
    }
    PG8_WAIT_V(0);
    if constexpr (!ALIGN_EPI) { if (wr == 0) PG8_BAR; }
    PG8_BAR;
    if constexpr (Epi::AFTER_DRAIN) E(acc, cur, wr, wc, fr, fq);
#undef PG8_SA
#undef PG8_SB
#undef PG8_STAGE
#undef PG8_LDA
#undef PG8_LDB
#undef PG8_MMA
#undef PG8_WAIT_V
#undef PG8_WAIT_L
#undef PG8_BAR
#undef PG8_SCHED
}

struct EpiBf16 {
    static constexpr bool PERM = true, AFTER_DRAIN = false, AROWPERM = false, BCOLPERM = true;
    bf16_t* O; int ldc;
    __device__ __forceinline__ void operator()(f32x4 (&acc)[2][2][4][2], const Unit& u, int wr, int wc, int fr, int fq) const {
        const int row0 = u.pm * BM + wr * 64 + fr, col0 = u.pn * BM + wc * 64 + 8 * fq;
#pragma unroll
        for (int ai = 0; ai < 2; ++ai)
#pragma unroll
            for (int m = 0; m < 4; ++m) { bf16_t* rowp = O + (size_t)(row0 + ai * HALF + m * 16) * ldc + col0;
#pragma unroll
                for (int bj = 0; bj < 2; ++bj) { const f32x4 v0 = acc[ai][bj][m][0], v1 = acc[ai][bj][m][1];
                    u32x4 w; w.x = cvt_pk_bf16_asm(v0[0], v0[1]); w.y = cvt_pk_bf16_asm(v0[2], v0[3]); w.z = cvt_pk_bf16_asm(v1[0], v1[1]); w.w = cvt_pk_bf16_asm(v1[2], v1[3]);
                    *(u32x4*)(rowp + bj * 32) = w; } }
    }
};
struct EpiResF32 {
    static constexpr bool PERM = false, AFTER_DRAIN = false, AROWPERM = false, BCOLPERM = false;
    const float* X; float* O; int ldc;
    __device__ __forceinline__ void operator()(f32x4 (&acc)[2][2][4][2], const Unit& u, int wr, int wc, int fr, int fq) const {
        const int row0 = u.pm * BM + wr * 64 + fr, col0 = u.pn * BM + wc * 32 + 4 * fq;
#pragma unroll
        for (int ai = 0; ai < 2; ++ai)
#pragma unroll
            for (int m = 0; m < 4; ++m) { const size_t ro = (size_t)(row0 + ai * HALF + m * 16) * ldc + col0;
#pragma unroll
                for (int bj = 0; bj < 2; ++bj)
#pragma unroll
                    for (int n = 0; n < 2; ++n) { const f32x4 xv = *(const f32x4*)(X + ro + bj * HALF + n * 16);
                        *(f32x4*)(O + ro + bj * HALF + n * 16) = xv * ALPHA + acc[ai][bj][m][n]; } }
    }
};
template <bool XBF  , bool WF32  > struct EpiResLn {
    static constexpr bool PERM = true, AFTER_DRAIN = true, AROWPERM = false, BCOLPERM = false;
    const float* X; const bf16_t* XB; float* O; bf16_t* OB; const float* gam; const float* bet; float* rs; unsigned* cnt;
    __device__ __forceinline__ void operator()(f32x4 (&acc)[2][2][4][2], const Unit& u, int wr, int wc, int fr, int fq) const {
        const int row0 = u.pm * BM + wr * 64 + fr, col0 = u.pn * BM + wc * 32 + 8 * fq;
#pragma unroll
        for (int ai = 0; ai < 2; ++ai)
#pragma unroll
            for (int m = 0; m < 4; ++m) { const int row = row0 + ai * HALF + m * 16; const size_t ro = (size_t)row * DM + col0;
                float s = 0.f, q = 0.f;
#pragma unroll
                for (int bj = 0; bj < 2; ++bj)
#pragma unroll
                    for (int n = 0; n < 2; ++n) { f32x4 xv;
                        if constexpr (XBF) { const u32x2 xb2 = *(const u32x2*)(XB + ro + bj * HALF + n * 4); xv = (f32x4){bflo(xb2.x), bfhi(xb2.x), bflo(xb2.y), bfhi(xb2.y)}; }
                        else xv = *(const f32x4*)(X + ro + bj * HALF + n * 4);
                        const f32x4 z = xv * ALPHA + acc[ai][bj][m][n]; acc[ai][bj][m][n] = z;
                        s += (z[0] + z[1]) + (z[2] + z[3]); q += (z[0] * z[0] + z[1] * z[1]) + (z[2] * z[2] + z[3] * z[3]); }
                s += __shfl_xor(s, 16); s += __shfl_xor(s, 32); q += __shfl_xor(q, 16); q += __shfl_xor(q, 32);
                if (fq == 0) { (void)__hip_atomic_fetch_add(rs + 2 * row, s, __ATOMIC_RELAXED, __HIP_MEMORY_SCOPE_AGENT); (void)__hip_atomic_fetch_add(rs + 2 * row + 1, q, __ATOMIC_RELAXED, __HIP_MEMORY_SCOPE_AGENT); } }
        asm volatile("s_waitcnt vmcnt(0)" ::: "memory");
        unsigned* cp = cnt + 64 * u.pm;
        if ((threadIdx.x & 63) == 0) (void)__hip_atomic_fetch_add(cp, 1u, __ATOMIC_RELAXED, __HIP_MEMORY_SCOPE_AGENT);
        { unsigned sp = 0; while ((unsigned)__builtin_amdgcn_readfirstlane(__hip_atomic_load(cp, __ATOMIC_RELAXED, __HIP_MEMORY_SCOPE_AGENT)) < 64u) { __builtin_amdgcn_s_sleep(2); if (++sp > (1u << 22)) break; } }
        f32x4 gg[2][2], bb[2][2];
#pragma unroll
        for (int bj = 0; bj < 2; ++bj)
#pragma unroll
            for (int n = 0; n < 2; ++n) { gg[bj][n] = *(const f32x4*)(gam + col0 + bj * HALF + n * 4); bb[bj][n] = *(const f32x4*)(bet + col0 + bj * HALF + n * 4); }
#pragma unroll
        for (int ai = 0; ai < 2; ++ai)
#pragma unroll
            for (int m = 0; m < 4; ++m) { const int row = row0 + ai * HALF + m * 16; const size_t ro = (size_t)row * DM + col0;
                const float s = __hip_atomic_load(rs + 2 * row, __ATOMIC_RELAXED, __HIP_MEMORY_SCOPE_AGENT), q = __hip_atomic_load(rs + 2 * row + 1, __ATOMIC_RELAXED, __HIP_MEMORY_SCOPE_AGENT);
                const float mu = s * (1.0f / DM), rstd = rsqrtf(fmaxf(q * (1.0f / DM) - mu * mu, 0.f) + 1e-5f);
#pragma unroll
                for (int bj = 0; bj < 2; ++bj)
#pragma unroll
                    for (int n = 0; n < 2; ++n) { const f32x4 o = (acc[ai][bj][m][n] - mu) * rstd * gg[bj][n] + bb[bj][n];
                        if constexpr (WF32) *(f32x4*)(O + ro + bj * HALF + n * 4) = o;
                        if (OB) { u32x2 p; p.x = cvt_pk_bf16_asm(o[0], o[1]); p.y = cvt_pk_bf16_asm(o[2], o[3]); *(u32x2*)(OB + ro + bj * HALF + n * 4) = p; } } }
    }
};
__device__ __forceinline__ float dpp_shr1(float x) { return __builtin_bit_cast(float, __builtin_amdgcn_update_dpp(0, __builtin_bit_cast(int, x), 0x111, 0xf, 0xf, true)); }
struct EpiConvFfn {
    static constexpr bool PERM = true, AFTER_DRAIN = false, AROWPERM = true, BCOLPERM = false;
    bf16_t* act; float* halo; const float* cw; const float* cb;
    __device__ __forceinline__ void operator()(f32x4 (&acc)[2][2][4][2], const Unit& u, int wr, int wc, int fr, int fq) const {
        const int fcol = u.pn * 128 + wc * 32 + 8 * fq;
        const int rbase = u.pm * BM + wr * 128;
        {
            float* hb = halo + (size_t)(rbase >> 7) * 4 * NUP + fcol;
            if (fr == 0) {
#pragma unroll
                for (int bj = 0; bj < 2; ++bj)
#pragma unroll
                    for (int n = 0; n < 2; ++n) { *(f32x4*)(hb + (size_t)2 * NUP + bj * DFF + 4 * n) = acc[0][bj][0][n]; *(f32x4*)(hb + (size_t)3 * NUP + bj * DFF + 4 * n) = acc[0][bj][1][n]; }
            }
            if (fr == 15) {
#pragma unroll
                for (int bj = 0; bj < 2; ++bj)
#pragma unroll
                    for (int n = 0; n < 2; ++n) { *(f32x4*)(hb + bj * DFF + 4 * n) = acc[1][bj][2][n]; *(f32x4*)(hb + (size_t)1 * NUP + bj * DFF + 4 * n) = acc[1][bj][3][n]; }
            }
        }
        u32x2 pk0[8];
#pragma unroll
        for (int n = 0; n < 2; ++n) {
            f32x4 W0[2], W1[2], W2[2], Bb[2];
#pragma unroll
            for (int bj = 0; bj < 2; ++bj) { const int hc = bj * DFF + fcol + 4 * n;
                W0[bj] = *(const f32x4*)(cw + hc); W1[bj] = *(const f32x4*)(cw + NUP + hc); W2[bj] = *(const f32x4*)(cw + 2 * NUP + hc); Bb[bj] = *(const f32x4*)(cb + hc); }
            f32x4 E6[2], E7[2];
#pragma unroll
            for (int bj = 0; bj < 2; ++bj) { const f32x4 s6 = acc[1][bj][2][n], s7 = acc[1][bj][3][n];
                E6[bj][0] = dpp_shr1(s6[0]); E6[bj][1] = dpp_shr1(s6[1]); E6[bj][2] = dpp_shr1(s6[2]); E6[bj][3] = dpp_shr1(s6[3]);
                E7[bj][0] = dpp_shr1(s7[0]); E7[bj][1] = dpp_shr1(s7[1]); E7[bj][2] = dpp_shr1(s7[2]); E7[bj][3] = dpp_shr1(s7[3]); }
#pragma unroll
            for (int i = 0; i < 8; ++i) {
                f32x4 h[2];
#pragma unroll
                for (int bj = 0; bj < 2; ++bj) {
                    const f32x4 cur = acc[i >> 2][bj][i & 3][n];
                    const f32x4 p1 = (i >= 1) ? acc[(i - 1 >= 0 ? i - 1 : 0) >> 2][bj][(i - 1 >= 0 ? i - 1 : 0) & 3][n] : E7[bj];
                    const f32x4 p2 = (i >= 2) ? acc[(i - 2 >= 0 ? i - 2 : 0) >> 2][bj][(i - 2 >= 0 ? i - 2 : 0) & 3][n] : (i == 1 ? E7[bj] : E6[bj]);
                    h[bj] = W2[bj] * cur + W1[bj] * p1 + W0[bj] * p2 + Bb[bj];
                }
                const f32x4 gt = h[1], ng = gt * (-1.4426950408889634f);
                f32x4 r;
#pragma unroll
                for (int j = 0; j < 4; ++j) r[j] = __builtin_amdgcn_rcpf(1.0f + __builtin_amdgcn_exp2f(ng[j]));
                const f32x4 av = h[0] * gt * r;
                u32x2 pk; pk.x = cvt_pk_bf16_asm(av[0], av[1]); pk.y = cvt_pk_bf16_asm(av[2], av[3]);
                if (n == 0) pk0[i] = pk;
                else if (i >= 2 || fr > 0) { u32x4 w; w.x = pk0[i].x; w.y = pk0[i].y; w.z = pk.x; w.w = pk.y;
                    *(u32x4*)(act + (size_t)(rbase + 8 * fr + i) * DFF + fcol) = w; }
            }
            asm volatile("" ::: "memory");
        }
    }
};
}

template <bool UPMAP>
__device__ __forceinline__ void transpose_macro(const float* W, int ldw, int k0, int n0, bf16_t* Wt, int ldt, unsigned char* lds) {
    bf16_t* sT = (bf16_t*)lds; const int tid = threadIdx.x;
    float4 v[2][4];
#pragma unroll
    for (int i = 0; i < 2; ++i)
#pragma unroll
        for (int j = 0; j < 4; ++j) v[i][j] = *(const float4*)(W + (size_t)(k0 + (tid >> 4) + 32 * i) * ldw + n0 + 64 * j + (tid & 15) * 4);
#pragma unroll
    for (int i = 0; i < 2; ++i)
#pragma unroll
        for (int j = 0; j < 4; ++j) { const int k = (tid >> 4) + 32 * i, n = 64 * j + (tid & 15) * 4;
            sT[(n + 0) * 66 + k] = f2bf(v[i][j].x); sT[(n + 1) * 66 + k] = f2bf(v[i][j].y); sT[(n + 2) * 66 + k] = f2bf(v[i][j].z); sT[(n + 3) * 66 + k] = f2bf(v[i][j].w); }
    __syncthreads();
#pragma unroll
    for (int j = 0; j < 4; ++j) { const int n = 64 * j + (tid >> 3), ks = (tid & 7) * 8; const unsigned* p = (const unsigned*)(sT + n * 66 + ks);
        u32x4 o; o.x = p[0]; o.y = p[1]; o.z = p[2]; o.w = p[3];
        int drow = n0 + n;
        if (UPMAP) { const int f = (drow < DFF) ? drow : drow - DFF; drow = 256 * (f >> 7) + (f & 127) + ((drow < DFF) ? 0 : 128); }
        *(u32x4*)(Wt + (size_t)drow * ldt + k0 + ks) = o; }
    __syncthreads();
}
constexpr int TM_IN = 32 * 28, TM_OUT = 32 * 8, TM_UP = 32 * 44, TM_DN = 88 * 8;
__device__ __forceinline__ void phase_transposes(const Args& A, unsigned char* lds, int g0, int g1, int worker, int nworkers) {
    unsigned char* ws = A.ws;
    for (int g = g0 + worker; g < g1; g += nworkers) {
        if (g < TM_IN) { const int tk = g / 28, tn = g % 28; transpose_macro<false>(A.w_in, NIN, tk * 64, tn * 256, (bf16_t*)(ws + WS_WIN), DM, lds); }
        else if (g < TM_IN + TM_OUT) { const int h = g - TM_IN, tk = h / 8, tn = h % 8; transpose_macro<false>(A.w_out, DM, tk * 64, tn * 256, (bf16_t*)(ws + WS_WOUT), DM, lds); }
        else if (g < TM_IN + TM_OUT + TM_UP) { const int h = g - TM_IN - TM_OUT, tk = h / 44, tn = h % 44; transpose_macro<true>(A.w_up, NUP, tk * 64, tn * 256, (bf16_t*)(ws + WS_WUP), DM, lds); }
        else { const int h = g - TM_IN - TM_OUT - TM_UP, tk = h / 8, tn = h % 8; transpose_macro<false>(A.w_down, DM, tk * 64, tn * 256, (bf16_t*)(ws + WS_WDN), DFF, lds); }
    }
}
__device__ __forceinline__ void phase_prologue(const Args& A, unsigned char* lds) {
    unsigned char* ws = A.ws;
    const int lane = threadIdx.x & 63, gw = blockIdx.x * 8 + (threadIdx.x >> 6), nw = gridDim.x * 8;
    bf16_t* xb = (bf16_t*)(ws + WS_XB); float* gates = (float*)(ws + WS_GATES);
    phase_transposes(A, lds, 0, TM_IN, blockIdx.x, gridDim.x);
    for (int it = gw; it < MT / 4; it += nw) {
        const int r0 = it * 4;
        float acc[4][8];
#pragma unroll
        for (int r = 0; r < 4; ++r)
#pragma unroll
            for (int q = 0; q < 8; ++q) acc[r][q] = 0.f;
#pragma unroll 1
        for (int ih = 0; ih < 2; ++ih) {
        f32x4 xq[4][4];
#pragma unroll
        for (int i = 0; i < 4; ++i)
#pragma unroll
            for (int r = 0; r < 4; ++r) xq[i][r] = *(const f32x4*)(A.x + (size_t)(r0 + r) * DM + (ih * 4 + i) * 256 + lane * 4);
#pragma unroll
        for (int i = 0; i < 4; ++i) {
            const int kb = (ih * 4 + i) * 256 + lane * 4;
            f32x4 xv[4];
#pragma unroll
            for (int r = 0; r < 4; ++r) { xv[r] = xq[i][r];
                u32x2 o; o.x = cvt_pk_bf16(xv[r][0], xv[r][1]); o.y = cvt_pk_bf16(xv[r][2], xv[r][3]); *(u32x2*)(xb + (size_t)(r0 + r) * DM + kb) = o; }
#pragma unroll
            for (int j = 0; j < 4; ++j) {
                const f32x4* wp = (const f32x4*)(A.w_in + (size_t)(kb + j) * NIN + NP);
                const f32x4 w0 = wp[0], w1 = wp[1];
#pragma unroll
                for (int r = 0; r < 4; ++r) { const float xs = xv[r][j];
                    acc[r][0] += xs * w0[0]; acc[r][1] += xs * w0[1]; acc[r][2] += xs * w0[2]; acc[r][3] += xs * w0[3];
                    acc[r][4] += xs * w1[0]; acc[r][5] += xs * w1[1]; acc[r][6] += xs * w1[2]; acc[r][7] += xs * w1[3]; }
            }
        }
        }
#pragma unroll
        for (int r = 0; r < 4; ++r)
#pragma unroll
            for (int q = 0; q < 8; ++q) { float v = acc[r][q];
#pragma unroll
                for (int off = 32; off >= 1; off >>= 1) v += __shfl_xor(v, off);
                acc[r][q] = v; }
        if (lane == 0) {
            const f32x4 b0 = *(const f32x4*)(A.b_gates), b1 = *(const f32x4*)(A.b_gates + 4);
#pragma unroll
            for (int r = 0; r < 4; ++r) {
                *(f32x4*)(gates + (size_t)(r0 + r) * 8) = (f32x4){acc[r][0] + b0[0], acc[r][1] + b0[1], acc[r][2] + b0[2], acc[r][3] + b0[3]};
                *(f32x4*)(gates + (size_t)(r0 + r) * 8 + 4) = (f32x4){acc[r][4] + b1[0], acc[r][5] + b1[1], acc[r][6] + b1[2], acc[r][7] + b1[3]}; }
        }
    }
}

__device__ __forceinline__ void phase_yconv(const Args& A) {
    const bf16_t* proj = (const bf16_t*)(A.ws + WS_PROJ); bf16_t* y = (bf16_t*)(A.ws + WS_Y);
    for (int idx = blockIdx.x * 512 + threadIdx.x; idx < MT * 128; idx += gridDim.x * 512) {
        const int row = idx >> 7, c = (idx & 127) * 8, t = row & (SEQ - 1);
        const bf16_t* pr = proj + (size_t)row * NP + c;
        const u32x4 bv = *(const u32x4*)pr;
        float cv[8];
#pragma unroll
        for (int i = 0; i < 8; ++i) cv[i] = 0.f;
#pragma unroll
        for (int j = 0; j < 3; ++j) {
            const int dt = 2 - j;
            if (t - dt >= 0) {
                const u32x4 cc = *(const u32x4*)(pr - (size_t)dt * NP + WCONV), hh = *(const u32x4*)(pr - (size_t)dt * NP + 2 * WCONV);
                const f32x4 w0 = *(const f32x4*)(A.w_sc + j * WCONV + c), w1 = *(const f32x4*)(A.w_sc + j * WCONV + c + 4);
                const float wv[8] = {w0[0], w0[1], w0[2], w0[3], w1[0], w1[1], w1[2], w1[3]};
#pragma unroll
                for (int q = 0; q < 4; ++q) { cv[2 * q] += wv[2 * q] * bflo(cc[q]) * bflo(hh[q]); cv[2 * q + 1] += wv[2 * q + 1] * bfhi(cc[q]) * bfhi(hh[q]); }
            }
        }
        u32x4 o;
#pragma unroll
        for (int q = 0; q < 4; ++q) o[q] = cvt_pk_bf16(bflo(bv[q]) * cv[2 * q], bfhi(bv[q]) * cv[2 * q + 1]);
        *(u32x4*)(y + (size_t)row * DM + c) = o;
    }
}

__device__ __forceinline__ void phase_mlstm(const Args& A, unsigned char* lds, float* hbuf) {
    const int tid = threadIdx.x, lane = tid & 63, w = tid >> 6, g = lane >> 4, l15 = lane & 15;
    const int a = w >> 2, ti = w & 3;
    unsigned char* QS = lds; unsigned char* KS = lds + 33792; unsigned char* VT = lds + 67584; unsigned char* WVT = VT + 4608; unsigned char* CT = WVT + 4608; unsigned char* XCH = CT + 33792;
    const bf16_t* proj = (const bf16_t*)(A.ws + WS_PROJ); const float* gates = (const float*)(A.ws + WS_GATES);
    float* TBC = (float*)(lds + 131088); float* TUV = TBC + 2048; float* TCM = TUV + 2048;
    for (int item = blockIdx.x; item < 256; item += gridDim.x) {
        const int xcd = item & 7, idx = item >> 3; const int bh = xcd * 2 + (idx >> 4), es = idx & 15;
        const int b = bh >> 2, hh = bh & 3, e0 = es * 16;
        const size_t row0 = (size_t)b * SEQ;
        __syncthreads();
        for (int i = tid; i < 16896 / 4; i += 512) ((unsigned*)CT)[i] = 0u;
        for (int i = tid; i < 16 * 72; i += 512) { const int r = 16 + i / 72, ci = i % 72; ((bf16_t*)VT)[r * 72 + ci] = (r == 16) ? (bf16_t)0x3F80 : (bf16_t)0; ((bf16_t*)WVT)[r * 72 + ci] = 0; }
        f32x4 Cst[2][2];
#pragma unroll
        for (int x = 0; x < 2; ++x)
#pragma unroll
            for (int et = 0; et < 2; ++et) Cst[x][et] = (f32x4){0.f, 0.f, 0.f, 0.f};
        float m_state = 0.f;
        u32x4 qr[4], kr[4]; unsigned vr;
        const bf16_t* qbase = proj + row0 * NP + 3072 + hh * 256;
#define ML_LOAD(c) do { _Pragma("unroll") for (int i = 0; i < 4; ++i) { const int p = tid + 512 * i, r = p >> 5, c16 = p & 31; const bf16_t* rp = qbase + (size_t)((c) * 64 + r) * NP + c16 * 8; \
            qr[i] = *(const u32x4*)rp; kr[i] = *(const u32x4*)(rp + 1024); } \
            vr = *(const unsigned*)(qbase + (size_t)((c) * 64 + (tid >> 3)) * NP + 2048 + e0 + (tid & 7) * 2); } while (0)
        ML_LOAD(0);
#pragma unroll 1
        for (int cc = 4 * w; cc < 4 * w + 4; ++cc) {
            const float* gp = gates + (row0 + cc * 64 + lane) * 8 + hh; const float gi = gp[0], gf = gp[4];
            const float lf = fminf(gf, 0.f) - log1pf(__expf(-fabsf(gf)));
            float bc = lf;
#pragma unroll
            for (int off = 1; off < 64; off <<= 1) { const float t = __shfl_up(bc, off); if (lane >= off) bc += t; }
            const float uv = gi - bc;
            float cm = uv;
#pragma unroll
            for (int off = 1; off < 64; off <<= 1) { const float t = __shfl_up(cm, off); if (lane >= off) cm = fmaxf(cm, t); }
            TBC[cc * 64 + lane] = bc; TUV[cc * 64 + lane] = uv; TCM[cc * 64 + lane] = cm;
        }
        __syncthreads();
#pragma unroll 1
        for (int c = 0; c < 32; ++c) {
            const float* tbc = TBC + c * 64; const float* tuv = TUV + c * 64; const float* tcm = TCM + c * 64;
            const float g_tot = tbc[63], cm63 = tcm[63];
            const float M63 = fmaxf(m_state, cm63), decay = __expf(m_state - M63);
            const float m_old = m_state;
            m_state = g_tot + M63;
#pragma unroll
            for (int i = 0; i < 4; ++i) { const int p = tid + 512 * i, r = p >> 5, c16 = p & 31; *(u32x4*)(QS + r * 528 + c16 * 16) = qr[i]; *(u32x4*)(KS + r * 528 + c16 * 16) = kr[i]; }
            { const int s = tid >> 3, ep = tid & 7; const float wv = __expf(tuv[s] - M63);
              ((bf16_t*)VT)[(2 * ep) * 72 + s] = (bf16_t)(vr & 0xffffu); ((bf16_t*)VT)[(2 * ep + 1) * 72 + s] = (bf16_t)(vr >> 16);
              ((bf16_t*)WVT)[(2 * ep) * 72 + s] = f2bf(bflo(vr) * wv); ((bf16_t*)WVT)[(2 * ep + 1) * 72 + s] = f2bf(bfhi(vr) * wv);
              if (ep == 0) ((bf16_t*)WVT)[16 * 72 + s] = f2bf(wv); }
            if (c + 1 < 32) ML_LOAD(c + 1);
            __syncthreads();
            bf16x8 qf[8]; f32x4 S0 = (f32x4){0.f, 0.f, 0.f, 0.f}, S1 = S0;
#pragma unroll
            for (int kk = 0; kk < 8; ++kk) {
                const int ko = ((kk + 4 * a) & 7) * 64 + g * 16;
                qf[kk] = *(const bf16x8*)(QS + (16 * ti + l15) * 528 + ko);
                const bf16x8 kf0 = *(const bf16x8*)(KS + (32 * a + l15) * 528 + ko), kf1 = *(const bf16x8*)(KS + (32 * a + 16 + l15) * 528 + ko);
                S0 = __builtin_amdgcn_mfma_f32_16x16x32_bf16(kf0, qf[kk], S0, 0, 0, 0); S1 = __builtin_amdgcn_mfma_f32_16x16x32_bf16(kf1, qf[kk], S1, 0, 0, 0);
            }
            const int tcol = 16 * ti + l15;
            const float Mt = fmaxf(m_old, tcm[tcol]);
            const f32x4 u0v = *(const f32x4*)(tuv + 32 * a + 4 * g), u1v = *(const f32x4*)(tuv + 32 * a + 16 + 4 * g);
            float p[8];
#pragma unroll
            for (int r = 0; r < 4; ++r) { const int s0 = 32 * a + 4 * g + r, s1 = s0 + 16;
                p[r] = (s0 <= tcol) ? S0[r] * 0.0625f * __expf(u0v[r] - Mt) : 0.f; p[4 + r] = (s1 <= tcol) ? S1[r] * 0.0625f * __expf(u1v[r] - Mt) : 0.f; }
            u32x4 pau; pau.x = cvt_pk_bf16(p[0], p[1]); pau.y = cvt_pk_bf16(p[2], p[3]); pau.z = cvt_pk_bf16(p[4], p[5]); pau.w = cvt_pk_bf16(p[6], p[7]);
            const bf16x8 pa = __builtin_bit_cast(bf16x8, pau);
            f32x4 rr[2];
#pragma unroll
            for (int et = 0; et < 2; ++et) { const unsigned char* vp = VT + (16 * et + l15) * 144 + (32 * a + 4 * g) * 2;
                const u32x2 lo = *(const u32x2*)vp, hi = *(const u32x2*)(vp + 32);
                u32x4 vbu; vbu.x = lo.x; vbu.y = lo.y; vbu.z = hi.x; vbu.w = hi.y;
                rr[et] = __builtin_amdgcn_mfma_f32_16x16x32_bf16(pa, __builtin_bit_cast(bf16x8, vbu), (f32x4){0.f, 0.f, 0.f, 0.f}, 0, 0, 0); }
            const f32x4 cmr = *(const f32x4*)(tcm + 16 * ti + 4 * g), bcr = *(const f32x4*)(tbc + 16 * ti + 4 * g);
            {
                const unsigned char* CTc = CT + (c & 1) * 16896;
                f32x4 in0 = (f32x4){0.f, 0.f, 0.f, 0.f}, in1 = in0;
#pragma unroll
                for (int k2 = 0; k2 < 4; ++k2) {
                    const bf16x8 qa = qf[k2];
                    const bf16x8 c0 = *(const bf16x8*)(CTc + (l15) * 528 + (128 * a + 32 * k2 + 8 * g) * 2), c1 = *(const bf16x8*)(CTc + (16 + l15) * 528 + (128 * a + 32 * k2 + 8 * g) * 2);
                    in0 = __builtin_amdgcn_mfma_f32_16x16x32_bf16(qa, c0, in0, 0, 0, 0); in1 = __builtin_amdgcn_mfma_f32_16x16x32_bf16(qa, c1, in1, 0, 0, 0);
                }
#pragma unroll
                for (int r = 0; r < 4; ++r) { const float iw = __expf(m_old - fmaxf(m_old, cmr[r])) * 0.0625f; rr[0][r] += in0[r] * iw; rr[1][r] += in1[r] * iw; }
            }
            if (a == 1) { *(f32x4*)(XCH + ((ti * 2 + 0) * 64 + lane) * 16) = rr[0]; *(f32x4*)(XCH + ((ti * 2 + 1) * 64 + lane) * 16) = rr[1]; }
            {
                unsigned char* CTn = CT + ((c + 1) & 1) * 16896;
#pragma unroll
                for (int x = 0; x < 2; ++x) {
                    const int dt = 2 * w + x;
#pragma unroll
                    for (int et = 0; et < 2; ++et) Cst[x][et] *= decay;
#pragma unroll
                    for (int ks = 0; ks < 2; ++ks) {
                        const s16x4 klo = __builtin_amdgcn_ds_read_tr16_b64_v4i16((LAS s16x4*)(KS + (32 * ks + 8 * g + (l15 >> 2)) * 528 + (16 * dt + 4 * (l15 & 3)) * 2));
                        const s16x4 khi = __builtin_amdgcn_ds_read_tr16_b64_v4i16((LAS s16x4*)(KS + (32 * ks + 8 * g + 4 + (l15 >> 2)) * 528 + (16 * dt + 4 * (l15 & 3)) * 2));
                        const bf16x8 ka = {klo[0], klo[1], klo[2], klo[3], khi[0], khi[1], khi[2], khi[3]};
#pragma unroll
                        for (int et = 0; et < 2; ++et) { const bf16x8 wvb = *(const bf16x8*)(WVT + (16 * et + l15) * 144 + (32 * ks + 8 * g) * 2);
                            Cst[x][et] = __builtin_amdgcn_mfma_f32_16x16x32_bf16(ka, wvb, Cst[x][et], 0, 0, 0); }
                    }
#pragma unroll
                    for (int et = 0; et < 2; ++et) { u32x2 o; o.x = cvt_pk_bf16(Cst[x][et][0], Cst[x][et][1]); o.y = cvt_pk_bf16(Cst[x][et][2], Cst[x][et][3]);
                        *(u32x2*)(CTn + (16 * et + l15) * 528 + (16 * dt + 4 * g) * 2) = o; }
                }
            }
            __syncthreads();
            if (a == 0) {
                const f32x4 o0 = *(const f32x4*)(XCH + ((ti * 2 + 0) * 64 + lane) * 16), o1 = *(const f32x4*)(XCH + ((ti * 2 + 1) * 64 + lane) * 16);
#pragma unroll
                for (int r = 0; r < 4; ++r) {
                    const float den = __shfl(rr[1][r] + o1[r], lane & 48), fl = __expf(-(bcr[r] + fmaxf(m_old, cmr[r])));
                    const float hv = (rr[0][r] + o0[r]) * __builtin_amdgcn_rcpf(fmaxf(fabsf(den), fl));
                    hbuf[(row0 + c * 64 + 16 * ti + 4 * g + r) * 1024 + hh * 256 + e0 + l15] = hv;
                }
            }
        }
#undef ML_LOAD
    }
}


__device__ __forceinline__ void phase_mlstm_scan(const Args& A, unsigned char* lds) {
    const int tid = threadIdx.x, lane = tid & 63, w = tid >> 6, g = lane >> 4, l15 = lane & 15;
    unsigned char* KS = lds; unsigned char* WVT = lds + 33792;
    const bf16_t* proj = (const bf16_t*)(A.ws + WS_PROJ); const float* gates = (const float*)(A.ws + WS_GATES);
    float* TBC = (float*)(lds + 131088); float* TUV = TBC + 2048; float* TCM = TUV + 2048;
    for (int item = blockIdx.x; item < 256; item += gridDim.x) {
        const int xcd = item & 7, idx = item >> 3; const int bh = xcd * 2 + (idx >> 4), es = idx & 15;
        const int b = bh >> 2, hh = bh & 3, e0 = es * 16;
        const size_t row0 = (size_t)b * SEQ;
        __syncthreads();
        for (int i = tid; i < 15 * 72; i += 512) ((bf16_t*)WVT)[17 * 72 + i] = 0;
        f32x4 Cst[2][2];
#pragma unroll
        for (int x = 0; x < 2; ++x)
#pragma unroll
            for (int et = 0; et < 2; ++et) Cst[x][et] = (f32x4){0.f, 0.f, 0.f, 0.f};
        float m_state = 0.f;
        u32x4 kr[4]; unsigned vr;
        const bf16_t* qbase = proj + row0 * NP + 3072 + hh * 256;
#define SC_LOAD(c) do { _Pragma("unroll") for (int i = 0; i < 4; ++i) { const int p = tid + 512 * i, r = p >> 5, c16 = p & 31; kr[i] = *(const u32x4*)(qbase + (size_t)((c) * 64 + r) * NP + 1024 + c16 * 8); } \
            vr = *(const unsigned*)(qbase + (size_t)((c) * 64 + (tid >> 3)) * NP + 2048 + e0 + (tid & 7) * 2); } while (0)
        SC_LOAD(0);
#pragma unroll 1
        for (int cc = 4 * w; cc < 4 * w + 4; ++cc) {
            const float* gp = gates + (row0 + cc * 64 + lane) * 8 + hh; const float gi = gp[0], gf = gp[4];
            const float lf = fminf(gf, 0.f) - log1pf(__expf(-fabsf(gf)));
            float bc = lf;
#pragma unroll
            for (int off = 1; off < 64; off <<= 1) { const float t = __shfl_up(bc, off); if (lane >= off) bc += t; }
            const float uv = gi - bc;
            float cm = uv;
#pragma unroll
            for (int off = 1; off < 64; off <<= 1) { const float t = __shfl_up(cm, off); if (lane >= off) cm = fmaxf(cm, t); }
            TBC[cc * 64 + lane] = bc; TUV[cc * 64 + lane] = uv; TCM[cc * 64 + lane] = cm;
        }
        __syncthreads();
        if (es == 0) { float* tab = (float*)(A.ws + WS_TAB) + (size_t)bh * 3 * 2048;
            for (int i = tid; i < 2048; i += 512) { tab[i] = TBC[i]; tab[2048 + i] = TUV[i]; tab[4096 + i] = TCM[i]; } }
        unsigned char* gc = A.ws + (bh < 8 ? WS_GCLO : WS_GCHI) + (size_t)((bh & 7) * 32) * 131072;
        bf16_t* nv = (bf16_t*)(A.ws + WS_NV) + (size_t)bh * 32 * 256;
        float* mst = (float*)(A.ws + WS_MST) + bh * 32;
#pragma unroll 1
        for (int c = 0; c < 32; ++c) {
            const float* tbc = TBC + c * 64; const float* tuv = TUV + c * 64; const float* tcm = TCM + c * 64;
            const float g_tot = tbc[63], cm63 = tcm[63];
            const float M63 = fmaxf(m_state, cm63), decay = __expf(m_state - M63);
            if (es == 0 && tid == 0) mst[c] = m_state;
            m_state = g_tot + M63;
#pragma unroll
            for (int x = 0; x < 2; ++x) { const int dt = 2 * w + x;
                u32x2 o; o.x = cvt_pk_bf16(Cst[x][0][0], Cst[x][0][1]); o.y = cvt_pk_bf16(Cst[x][0][2], Cst[x][0][3]);
                *(u32x2*)(gc + (size_t)c * 131072 + (e0 + l15) * 512 + (16 * dt + 4 * g) * 2) = o;
                if (es == 0 && l15 == 0) { u32x2 n2; n2.x = cvt_pk_bf16(Cst[x][1][0], Cst[x][1][1]); n2.y = cvt_pk_bf16(Cst[x][1][2], Cst[x][1][3]); *(u32x2*)(nv + c * 256 + 16 * dt + 4 * g) = n2; } }
#pragma unroll
            for (int i = 0; i < 4; ++i) { const int p = tid + 512 * i, r = p >> 5, c16 = p & 31; *(u32x4*)(KS + r * 528 + c16 * 16) = kr[i]; }
            { const int s = tid >> 3, ep = tid & 7; const float wv = __expf(tuv[s] - M63);
              ((bf16_t*)WVT)[(2 * ep) * 72 + s] = f2bf(bflo(vr) * wv); ((bf16_t*)WVT)[(2 * ep + 1) * 72 + s] = f2bf(bfhi(vr) * wv);
              if (ep == 0) ((bf16_t*)WVT)[16 * 72 + s] = f2bf(wv); }
            if (c + 1 < 32) SC_LOAD(c + 1);
            __syncthreads();
#pragma unroll
            for (int x = 0; x < 2; ++x) {
                const int dt = 2 * w + x;
#pragma unroll
                for (int et = 0; et < 2; ++et) Cst[x][et] *= decay;
#pragma unroll
                for (int ks = 0; ks < 2; ++ks) {
                    const s16x4 klo = __builtin_amdgcn_ds_read_tr16_b64_v4i16((LAS s16x4*)(KS + (32 * ks + 8 * g + (l15 >> 2)) * 528 + (16 * dt + 4 * (l15 & 3)) * 2));
                    const s16x4 khi = __builtin_amdgcn_ds_read_tr16_b64_v4i16((LAS s16x4*)(KS + (32 * ks + 8 * g + 4 + (l15 >> 2)) * 528 + (16 * dt + 4 * (l15 & 3)) * 2));
                    const bf16x8 ka = {klo[0], klo[1], klo[2], klo[3], khi[0], khi[1], khi[2], khi[3]};
#pragma unroll
                    for (int et = 0; et < 2; ++et) { const bf16x8 wvb = *(const bf16x8*)(WVT + (16 * et + l15) * 144 + (32 * ks + 8 * g) * 2);
                        Cst[x][et] = __builtin_amdgcn_mfma_f32_16x16x32_bf16(ka, wvb, Cst[x][et], 0, 0, 0); }
                }
            }
            __syncthreads();
        }
#undef SC_LOAD
    }
}

__device__ __forceinline__ void phase_mlstm_out(const Args& A, unsigned char* lds, float* hbuf) {
    const int tid = threadIdx.x, lane = tid & 63, w = tid >> 6, g = lane >> 4, l15 = lane & 15;
    const int a = w >> 2, ti = w & 3;
    unsigned char* QS = lds; unsigned char* KS = lds + 33792; unsigned char* VS = lds + 67584; unsigned char* PI = lds + 101376;
    float* DEN = (float*)(lds + 110592); float* TB = DEN + 64;
    const bf16_t* proj = (const bf16_t*)(A.ws + WS_PROJ);
    for (int it = blockIdx.x; it < 512; it += gridDim.x) {
        const int bh = it >> 5, c = it & 31, b = bh >> 2, hh = bh & 3;
        const size_t row0 = (size_t)b * SEQ + c * 64;
        const bf16_t* qbase = proj + row0 * NP + 3072 + hh * 256;
        const unsigned char* gc = A.ws + (bh < 8 ? WS_GCLO : WS_GCHI) + (size_t)((bh & 7) * 32 + c) * 131072;
        const bf16_t* nv = (const bf16_t*)(A.ws + WS_NV) + (size_t)(bh * 32 + c) * 256;
        const float* tab = (const float*)(A.ws + WS_TAB) + (size_t)bh * 3 * 2048 + c * 64;
        const float m_c = ((const float*)(A.ws + WS_MST))[bh * 32 + c];
        __syncthreads();
        { u32x4 qv[4], kv[4], vv[4];
#pragma unroll
          for (int i = 0; i < 4; ++i) { const int p = tid + 512 * i, r = p >> 5, c16 = p & 31; const bf16_t* rp = qbase + (size_t)r * NP + c16 * 8; qv[i] = *(const u32x4*)rp; kv[i] = *(const u32x4*)(rp + 1024); vv[i] = *(const u32x4*)(rp + 2048); }
#pragma unroll
          for (int i = 0; i < 4; ++i) { const int p = tid + 512 * i, r = p >> 5, c16 = p & 31; *(u32x4*)(QS + r * 528 + c16 * 16) = qv[i]; *(u32x4*)(KS + r * 528 + c16 * 16) = kv[i]; *(u32x4*)(VS + r * 528 + c16 * 16) = vv[i]; } }
        if (tid < 192) TB[tid] = tab[(tid >> 6) * 2048 + (tid & 63)];
        __syncthreads();
        const float* tbc = TB; const float* tuv = TB + 64; const float* tcm = TB + 128;
        {
            f32x4 S0 = (f32x4){0.f, 0.f, 0.f, 0.f}, S1 = S0;
#pragma unroll
            for (int kk = 0; kk < 8; ++kk) {
                const int ko = kk * 64 + g * 16;
                const bf16x8 qf = *(const bf16x8*)(QS + (16 * ti + l15) * 528 + ko);
                const bf16x8 kf0 = *(const bf16x8*)(KS + (32 * a + l15) * 528 + ko), kf1 = *(const bf16x8*)(KS + (32 * a + 16 + l15) * 528 + ko);
                S0 = __builtin_amdgcn_mfma_f32_16x16x32_bf16(kf0, qf, S0, 0, 0, 0); S1 = __builtin_amdgcn_mfma_f32_16x16x32_bf16(kf1, qf, S1, 0, 0, 0);
            }
            const int tcol = 16 * ti + l15;
            const float Mt = fmaxf(m_c, tcm[tcol]);
            const f32x4 u0v = *(const f32x4*)(tuv + 32 * a + 4 * g), u1v = *(const f32x4*)(tuv + 32 * a + 16 + 4 * g);
            float p[8];
#pragma unroll
            for (int r = 0; r < 4; ++r) { const int s0 = 32 * a + 4 * g + r, s1 = s0 + 16;
                p[r] = (s0 <= tcol) ? S0[r] * 0.0625f * __expf(u0v[r] - Mt) : 0.f; p[4 + r] = (s1 <= tcol) ? S1[r] * 0.0625f * __expf(u1v[r] - Mt) : 0.f; }
            u32x2 plo, phi; plo.x = cvt_pk_bf16(p[0], p[1]); plo.y = cvt_pk_bf16(p[2], p[3]); phi.x = cvt_pk_bf16(p[4], p[5]); phi.y = cvt_pk_bf16(p[6], p[7]);
            *(u32x2*)(PI + tcol * 144 + (32 * a + 4 * g) * 2) = plo; *(u32x2*)(PI + tcol * 144 + (32 * a + 16 + 4 * g) * 2) = phi;
        }
        __syncthreads();
        f32x4 acc[4][2], inr[4][2];
#pragma unroll
        for (int tt = 0; tt < 4; ++tt)
#pragma unroll
            for (int x = 0; x < 2; ++x) { acc[tt][x] = (f32x4){0.f, 0.f, 0.f, 0.f}; inr[tt][x] = (f32x4){0.f, 0.f, 0.f, 0.f}; }
#pragma unroll
        for (int ks = 0; ks < 2; ++ks) {
            bf16x8 vb[2];
#pragma unroll
            for (int x = 0; x < 2; ++x) { const int et = 2 * w + x;
                const s16x4 vlo = __builtin_amdgcn_ds_read_tr16_b64_v4i16((LAS s16x4*)(VS + (32 * ks + 8 * g + (l15 >> 2)) * 528 + (16 * et + 4 * (l15 & 3)) * 2));
                const s16x4 vhi = __builtin_amdgcn_ds_read_tr16_b64_v4i16((LAS s16x4*)(VS + (32 * ks + 8 * g + 4 + (l15 >> 2)) * 528 + (16 * et + 4 * (l15 & 3)) * 2));
                vb[x] = (bf16x8){vlo[0], vlo[1], vlo[2], vlo[3], vhi[0], vhi[1], vhi[2], vhi[3]}; }
#pragma unroll
            for (int tt = 0; tt < 4; ++tt) { const bf16x8 pa = *(const bf16x8*)(PI + (16 * tt + l15) * 144 + (32 * ks + 8 * g) * 2);
                acc[tt][0] = __builtin_amdgcn_mfma_f32_16x16x32_bf16(pa, vb[0], acc[tt][0], 0, 0, 0); acc[tt][1] = __builtin_amdgcn_mfma_f32_16x16x32_bf16(pa, vb[1], acc[tt][1], 0, 0, 0); }
        }
#pragma unroll
        for (int kk = 0; kk < 8; ++kk) {
            const bf16x8 cb0 = *(const bf16x8*)(gc + (size_t)((16 * (2 * w) + l15) * 256 + 32 * kk + 8 * g) * 2), cb1 = *(const bf16x8*)(gc + (size_t)((16 * (2 * w + 1) + l15) * 256 + 32 * kk + 8 * g) * 2);
#pragma unroll
            for (int tt = 0; tt < 4; ++tt) { const bf16x8 qa = *(const bf16x8*)(QS + (16 * tt + l15) * 528 + (32 * kk + 8 * g) * 2);
                inr[tt][0] = __builtin_amdgcn_mfma_f32_16x16x32_bf16(qa, cb0, inr[tt][0], 0, 0, 0); inr[tt][1] = __builtin_amdgcn_mfma_f32_16x16x32_bf16(qa, cb1, inr[tt][1], 0, 0, 0); }
        }
        if (w < 4) {
            f32x4 di = (f32x4){0.f, 0.f, 0.f, 0.f}, dn = di;
            const unsigned one2 = (l15 == 0) ? 0x3F803F80u : 0u;
            u32x4 ou; ou.x = one2; ou.y = one2; ou.z = one2; ou.w = one2;
            const bf16x8 onesf = __builtin_bit_cast(bf16x8, ou);
#pragma unroll
            for (int ks = 0; ks < 2; ++ks) { const bf16x8 pa = *(const bf16x8*)(PI + (16 * w + l15) * 144 + (32 * ks + 8 * g) * 2); di = __builtin_amdgcn_mfma_f32_16x16x32_bf16(pa, onesf, di, 0, 0, 0); }
#pragma unroll
            for (int kk = 0; kk < 8; ++kk) { u32x4 nu = *(const u32x4*)(nv + 32 * kk + 8 * g); if (l15 != 0) nu = (u32x4){0u, 0u, 0u, 0u};
                const bf16x8 qa = *(const bf16x8*)(QS + (16 * w + l15) * 528 + (32 * kk + 8 * g) * 2);
                dn = __builtin_amdgcn_mfma_f32_16x16x32_bf16(qa, __builtin_bit_cast(bf16x8, nu), dn, 0, 0, 0); }
            if (l15 == 0) {
#pragma unroll
                for (int r = 0; r < 4; ++r) { const int t = 16 * w + 4 * g + r; const float iw = __expf(m_c - fmaxf(m_c, tcm[t])) * 0.0625f; DEN[t] = di[r] + dn[r] * iw; } }
        }
        __syncthreads();
#pragma unroll
        for (int tt = 0; tt < 4; ++tt) {
            const f32x4 cmr = *(const f32x4*)(tcm + 16 * tt + 4 * g), bcr = *(const f32x4*)(tbc + 16 * tt + 4 * g), dnr = *(const f32x4*)(DEN + 16 * tt + 4 * g);
#pragma unroll
            for (int r = 0; r < 4; ++r) {
                const float Mx = fmaxf(m_c, cmr[r]), iw = __expf(m_c - Mx) * 0.0625f, fl = __expf(-(bcr[r] + Mx));
                const float rden = __builtin_amdgcn_rcpf(fmaxf(fabsf(dnr[r]), fl));
                float* hp = hbuf + (row0 + 16 * tt + 4 * g + r) * 1024 + hh * 256 + 32 * w + l15;
                hp[0] = (acc[tt][0][r] + inr[tt][0][r] * iw) * rden; hp[16] = (acc[tt][1][r] + inr[tt][1][r] * iw) * rden;
            }
        }
    }
}

__device__ __forceinline__ void phase_headnorm(const Args& A, const float* hbuf) {
    const bf16_t* proj = (const bf16_t*)(A.ws + WS_PROJ); bf16_t* y = (bf16_t*)(A.ws + WS_Y);
    const int lane = threadIdx.x & 63, gw = blockIdx.x * 8 + (threadIdx.x >> 6), nw = gridDim.x * 8;
    f32x4 gn[4];
#pragma unroll
    for (int hh = 0; hh < 4; ++hh) gn[hh] = *(const f32x4*)(A.mh_gain + hh * 256 + lane * 4);
    for (int row = gw; row < MT; row += nw) {
        f32x4 hv[4]; u32x2 ov[4]; float s[4], q[4];
#pragma unroll
        for (int hh = 0; hh < 4; ++hh) { hv[hh] = *(const f32x4*)(hbuf + (size_t)row * 1024 + hh * 256 + lane * 4); ov[hh] = *(const u32x2*)(proj + (size_t)row * NP + 6144 + hh * 256 + lane * 4); }
#pragma unroll
        for (int hh = 0; hh < 4; ++hh) s[hh] = (hv[hh][0] + hv[hh][1]) + (hv[hh][2] + hv[hh][3]);
#pragma unroll
        for (int off = 32; off >= 1; off >>= 1)
#pragma unroll
            for (int hh = 0; hh < 4; ++hh) s[hh] += __shfl_xor(s[hh], off);
#pragma unroll
        for (int hh = 0; hh < 4; ++hh) { const float mu = s[hh] * (1.0f / 256.0f); hv[hh] = hv[hh] - mu; q[hh] = (hv[hh][0] * hv[hh][0] + hv[hh][1] * hv[hh][1]) + (hv[hh][2] * hv[hh][2] + hv[hh][3] * hv[hh][3]); }
#pragma unroll
        for (int off = 32; off >= 1; off >>= 1)
#pragma unroll
            for (int hh = 0; hh < 4; ++hh) q[hh] += __shfl_xor(q[hh], off);
#pragma unroll
        for (int hh = 0; hh < 4; ++hh) {
            const float rstd = rsqrtf(q[hh] * (1.0f / 256.0f) + 1e-6f);
            const float o0 = bflo(ov[hh].x), o1 = bfhi(ov[hh].x), o2 = bflo(ov[hh].y), o3 = bfhi(ov[hh].y);
            const float y0 = hv[hh][0] * rstd * gn[hh][0] * __builtin_amdgcn_rcpf(1.0f + __expf(-o0)), y1 = hv[hh][1] * rstd * gn[hh][1] * __builtin_amdgcn_rcpf(1.0f + __expf(-o1));
            const float y2 = hv[hh][2] * rstd * gn[hh][2] * __builtin_amdgcn_rcpf(1.0f + __expf(-o2)), y3 = hv[hh][3] * rstd * gn[hh][3] * __builtin_amdgcn_rcpf(1.0f + __expf(-o3));
            u32x2 o; o.x = cvt_pk_bf16(y0, y1); o.y = cvt_pk_bf16(y2, y3);
            *(u32x2*)(y + (size_t)row * DM + WCONV + hh * 256 + lane * 4) = o;
        }
    }
}

__device__ __forceinline__ void phase_ln(float* io, const float* gam, const float* bet, bf16_t* ob) {
    const int lane = threadIdx.x & 63, gw = blockIdx.x * 8 + (threadIdx.x >> 6), nw = gridDim.x * 8;
    for (int row = gw; row < MT; row += nw) {
        float* rp = io + (size_t)row * DM;
        f32x4 v[8]; float s = 0.f;
#pragma unroll
        for (int i = 0; i < 8; ++i) { v[i] = *(const f32x4*)(rp + i * 256 + lane * 4); s += (v[i][0] + v[i][1]) + (v[i][2] + v[i][3]); }
#pragma unroll
        for (int off = 32; off >= 1; off >>= 1) s += __shfl_xor(s, off);
        const float mu = s * (1.0f / DM);
        float q = 0.f;
#pragma unroll
        for (int i = 0; i < 8; ++i) { v[i] = v[i] - mu; q += (v[i][0] * v[i][0] + v[i][1] * v[i][1]) + (v[i][2] * v[i][2] + v[i][3] * v[i][3]); }
#pragma unroll
        for (int off = 32; off >= 1; off >>= 1) q += __shfl_xor(q, off);
        const float rstd = rsqrtf(q * (1.0f / DM) + 1e-5f);
#pragma unroll
        for (int i = 0; i < 8; ++i) { const f32x4 gg = *(const f32x4*)(gam + i * 256 + lane * 4), bb = *(const f32x4*)(bet + i * 256 + lane * 4);
            const f32x4 o = v[i] * rstd * gg + bb;
            *(f32x4*)(rp + i * 256 + lane * 4) = o;
            if (ob) { u32x2 p; p.x = cvt_pk_bf16(o[0], o[1]); p.y = cvt_pk_bf16(o[2], o[3]); *(u32x2*)(ob + (size_t)row * DM + i * 256 + lane * 4) = p; } }
    }
}

__device__ __forceinline__ void phase_fixup(const Args& A) {
    const float* halo = (const float*)(A.ws + WS_HALO); bf16_t* act = (bf16_t*)(A.ws + WS_ACT);
    for (int idx = blockIdx.x * 512 + threadIdx.x; idx < 64 * 2 * (DFF / 4); idx += gridDim.x * 512) {
        const int f = (idx % (DFF / 4)) * 4, br = idx / (DFF / 4), rr = br & 1, B = br >> 1;
        const bool first = (B & 15) == 0;
        const float* hc = halo + (size_t)B * 4 * NUP; const float* hp = hc - 4 * NUP;
        f32x4 hv[2];
#pragma unroll
        for (int bj = 0; bj < 2; ++bj) {
            const int col = bj * DFF + f;
            const f32x4 cur = *(const f32x4*)(hc + (size_t)(2 + rr) * NUP + col);
            f32x4 p1, p2; const f32x4 z = (f32x4){0.f, 0.f, 0.f, 0.f};
            if (rr == 0) { p1 = first ? z : *(const f32x4*)(hp + (size_t)1 * NUP + col); p2 = first ? z : *(const f32x4*)(hp + col); }
            else { p1 = *(const f32x4*)(hc + (size_t)2 * NUP + col); p2 = first ? z : *(const f32x4*)(hp + (size_t)1 * NUP + col); }
            const f32x4 w0 = *(const f32x4*)(A.w_fc + col), w1 = *(const f32x4*)(A.w_fc + NUP + col), w2 = *(const f32x4*)(A.w_fc + 2 * NUP + col), bb = *(const f32x4*)(A.b_fc + col);
            hv[bj] = w2 * cur + w1 * p1 + w0 * p2 + bb;
        }
        float av[4];
#pragma unroll
        for (int j = 0; j < 4; ++j) { const float gt = hv[1][j]; av[j] = hv[0][j] * gt / (1.0f + __expf(-gt)); }
        u32x2 o; o.x = cvt_pk_bf16(av[0], av[1]); o.y = cvt_pk_bf16(av[2], av[3]);
        *(u32x2*)(act + (size_t)(B * 128 + rr) * DFF + f) = o;
    }
}

__device__ __forceinline__ void phase_dump(const bf16_t* src, int ld, int c0, float* out) {
    for (size_t idx = (size_t)blockIdx.x * 512 + threadIdx.x; idx < (size_t)MT * DM; idx += (size_t)gridDim.x * 512) {
        const size_t row = idx / DM, col = idx % DM; out[idx] = bflo((unsigned)src[row * ld + c0 + col]); }
}
#ifndef DBG_STOP
#define DBG_STOP -1
#endif
#define XB_TMO      128
#define XB_XCNT(j)  (256  + 64 * (j))
#define XB_XSUB(j)  (1280 + 64 * (j))
#define XB_XGEN(j)  (2304 + 64 * (j))
#define XB_TOP      3328
#define XB_TOPGEN   3392
#define XCD_BAR_WORDS 3456
#define XB_SPIN_CAP (1u << 22)
__device__ __forceinline__ unsigned xb_ld(unsigned* p)              { return __hip_atomic_load(p, __ATOMIC_RELAXED, __HIP_MEMORY_SCOPE_AGENT); }
__device__ __forceinline__ unsigned xb_add(unsigned* p, unsigned v) { return __hip_atomic_fetch_add(p, v, __ATOMIC_RELAXED, __HIP_MEMORY_SCOPE_AGENT); }
__device__ __forceinline__ unsigned xb_xcc_id() { return (unsigned)__builtin_amdgcn_s_getreg((3 << 11) | 20) & 0xFu; }
#define XB_SPIN(cond, bar) do { unsigned _sp = 0; while (cond) { __builtin_amdgcn_s_sleep(1); \
    if ((++_sp & 255u) == 0u) { if (xb_ld(&(bar)[XB_TMO])) break; if (_sp > XB_SPIN_CAP) { atomicAdd(&(bar)[XB_TMO], 1u); break; } } } } while (0)
struct XcdBarrier { unsigned* bar; unsigned x; volatile LAS unsigned* st; };
__device__ __forceinline__ XcdBarrier xcd_barrier_post(unsigned* bar, volatile LAS unsigned* st) {
    XcdBarrier b; b.bar = bar; b.x = xb_xcc_id(); b.st = st;
    if (threadIdx.x == 0) (void)xb_add(&bar[XB_XCNT(b.x)], 1u);
    return b;
}
__device__ __forceinline__ void xcd_barrier_complete(unsigned* bar, unsigned x, unsigned& nloc, unsigned& nx) {
    const unsigned G = gridDim.x * gridDim.y * gridDim.z;
    unsigned sum, cnt, mine, sp = 0u;
    for (;;) {
        sum = 0u; cnt = 0u; mine = 0u;
#pragma unroll
        for (unsigned j = 0; j < 16; ++j) { const unsigned c = xb_ld(&bar[XB_XCNT(j)]); sum += c; cnt += (c > 0u) ? 1u : 0u; mine = (j == x) ? c : mine; }
        if (sum == G) break;
        __builtin_amdgcn_s_sleep(1);
        if ((++sp & 255u) == 0u) { if (xb_ld(&bar[XB_TMO])) break; if (sp > XB_SPIN_CAP) { atomicAdd(&bar[XB_TMO], 1u); break; } }
    }
    nloc = mine > 0u ? mine : 1u; nx = cnt > 0u ? cnt : 1u;
}
__device__ __forceinline__ void xcd_barrier(const XcdBarrier& b) {
    asm volatile("s_waitcnt vmcnt(0)" ::: "memory");
    __syncthreads();
    if (threadIdx.x == 0) {
        unsigned* bar = b.bar;
        __builtin_amdgcn_s_waitcnt(0);
        unsigned nloc = b.st[0], nx = b.st[1];
        if (nloc == 0u) { xcd_barrier_complete(bar, b.x, nloc, nx); b.st[0] = nloc; b.st[1] = nx; }
        const unsigned old = xb_add(&bar[XB_XSUB(b.x)], 1u);
        const unsigned gen = old / nloc;
        if (old + 1u == (gen + 1u) * nloc) {
            __builtin_amdgcn_fence(__ATOMIC_RELEASE, "agent");
            asm volatile("s_waitcnt vmcnt(0)" ::: "memory");
            const unsigned og = xb_add(&bar[XB_TOP], 1u);
            const unsigned tg = og / nx;
            if (og + 1u == (tg + 1u) * nx) xb_add(&bar[XB_TOPGEN], 1u);
            else XB_SPIN(xb_ld(&bar[XB_TOPGEN]) == tg, bar);
            __builtin_amdgcn_fence(__ATOMIC_ACQUIRE, "agent");
            xb_add(&bar[XB_XGEN(b.x)], 1u);
            asm volatile("s_waitcnt vmcnt(0)" ::: "memory");
        } else {
            XB_SPIN(xb_ld(&bar[XB_XGEN(b.x)]) == gen, bar);
            __builtin_amdgcn_fence(__ATOMIC_ACQUIRE, "agent");
            asm volatile("s_waitcnt vmcnt(0)" ::: "memory");
        }
    }
    __syncthreads();
}

constexpr int N_PHASES = 10;
#ifndef ONLY_PH
#define ONLY_PH -1
#endif
#define PH_ON(x) (ONLY_PH < 0 || ONLY_PH == (x))
__global__ void __launch_bounds__(512, 2) mega(Args a) {
    extern __shared__ __attribute__((aligned(16))) unsigned char lds[];
    cg::grid_group grid = cg::this_grid();
    unsigned char* ws = a.ws;
#define PH_RUN(x) (PH_ON(x) && a.ph_lo <= (x) && (x) < a.ph_hi)
#define PH_SYNC(x) do { if (a.ph_lo <= (x) && (x) + 1 < a.ph_hi) xcd_barrier(xb); } while (0)
    volatile LAS unsigned* xst = (volatile LAS unsigned*)((LAS unsigned char*)lds + 131072);
    if (threadIdx.x == 0) { xst[0] = 0u; xst[1] = 0u; }
    __syncthreads();
    const XcdBarrier xb = xcd_barrier_post((unsigned*)(ws + WS_BAR), xst);
    if (a.ph_hi > 1000) grid.sync();
#ifndef REP0
#define REP0 1
#endif
#ifndef REP2
#define REP2 1
#endif
#ifndef REP6
#define REP6 1
#endif
    if (PH_RUN(0)) for (int rep = 0; rep < REP0; ++rep) phase_prologue(a, lds);
    PH_SYNC(0);
    if (PH_RUN(1)) { pg8::Gemm g{(const bf16_t*)(ws + WS_XB), (const bf16_t*)(ws + WS_WIN), MT, NP, DM}; pg8::StaticOrder S; S.init(MT, NP, gridDim.x, blockIdx.x);
        pg8::EpiBf16 E{(bf16_t*)(ws + WS_PROJ), NP}; pg8::gemm_phase<pg8::EpiBf16, true>((LAS unsigned char*)lds, g, S, E);
        const int rem = ((MT / 256) * (NP / 256)) % (int)gridDim.x;
        if (rem == 0) phase_transposes(a, lds, TM_IN, TM_IN + TM_OUT + TM_UP, blockIdx.x, gridDim.x);
        else if ((int)blockIdx.x >= rem) phase_transposes(a, lds, TM_IN, TM_IN + TM_OUT + TM_UP, blockIdx.x - rem, gridDim.x - rem); }
    PH_SYNC(1);
    if (PH_RUN(2)) {
        phase_yconv(a);
        if (a.fuse_ln) { phase_mlstm_scan(a, lds); xcd_barrier(xb); phase_mlstm_out(a, lds, a.out); }
        else phase_mlstm(a, lds, a.out); }
    PH_SYNC(2);
    if (PH_RUN(3)) phase_headnorm(a, a.out);
    PH_SYNC(3);
    if (PH_RUN(4)) { pg8::Gemm g{(const bf16_t*)(ws + WS_Y), (const bf16_t*)(ws + WS_WOUT), MT, DM, DM}; pg8::StaticOrder S; S.init(MT, DM, gridDim.x, blockIdx.x);
        if (a.fuse_ln) { pg8::EpiResLn<false, false> E{a.x, nullptr, nullptr, (bf16_t*)(ws + WS_X1B), a.ln1_g, a.ln1_b, (float*)(ws + WS_RS1), (unsigned*)(ws + WS_CNT)}; pg8::gemm_phase((LAS unsigned char*)lds, g, S, E); }
        else { pg8::EpiResF32 E{a.x, a.out, DM}; pg8::gemm_phase((LAS unsigned char*)lds, g, S, E); } }
    PH_SYNC(4);
    if (PH_RUN(5) && !a.fuse_ln) phase_ln(a.out, a.ln1_g, a.ln1_b, (bf16_t*)(ws + WS_X1B));
    if (!a.fuse_ln) PH_SYNC(5);
    if (PH_RUN(6)) { pg8::Gemm g{(const bf16_t*)(ws + WS_X1B), (const bf16_t*)(ws + WS_WUP), MT, NUP, DM}; pg8::StaticOrder S; S.init(MT, NUP, gridDim.x, blockIdx.x);
        pg8::EpiConvFfn E{(bf16_t*)(ws + WS_ACT), (float*)(ws + WS_HALO), a.w_fc, a.b_fc}; pg8::gemm_phase<pg8::EpiConvFfn, true>((LAS unsigned char*)lds, g, S, E);
        const int rem = ((MT / 256) * (NUP / 256)) % (int)gridDim.x; const int t0 = TM_IN + TM_OUT + TM_UP, t1 = t0 + TM_DN;
        if (rem == 0) phase_transposes(a, lds, t0, t1, blockIdx.x, gridDim.x);
        else if ((int)blockIdx.x >= rem) phase_transposes(a, lds, t0, t1, blockIdx.x - rem, gridDim.x - rem); }
    PH_SYNC(6);
    if (PH_RUN(7)) phase_fixup(a);
    PH_SYNC(7);
    if (PH_RUN(8)) { pg8::Gemm g{(const bf16_t*)(ws + WS_ACT), (const bf16_t*)(ws + WS_WDN), MT, DM, DFF}; pg8::StaticOrder S; S.init(MT, DM, gridDim.x, blockIdx.x);
        if (a.fuse_ln) { pg8::EpiResLn<true, true> E{nullptr, (const bf16_t*)(ws + WS_X1B), a.out, nullptr, a.ln2_g, a.ln2_b, (float*)(ws + WS_RS2), (unsigned*)(ws + WS_CNT) + 32 * 64}; pg8::gemm_phase((LAS unsigned char*)lds, g, S, E); }
        else { pg8::EpiResF32 E{a.out, a.out, DM}; pg8::gemm_phase((LAS unsigned char*)lds, g, S, E); } }
    if (!a.fuse_ln) PH_SYNC(8);
    if (PH_RUN(9) && !a.fuse_ln) phase_ln(a.out, a.ln2_g, a.ln2_b, nullptr);
    if (DBG_STOP == 1 && a.ph_lo == 101) phase_dump((const bf16_t*)(ws + WS_PROJ), NP, 3072, a.out);
    if (DBG_STOP == 3 && a.ph_lo == 103) phase_dump((const bf16_t*)(ws + WS_Y), DM, 0, a.out);
    if (DBG_STOP == 7 && a.ph_lo == 107) phase_dump((const bf16_t*)(ws + WS_ACT), DFF, 0, a.out);
}

extern "C" void kernel_launch(void* const* d_in, const int* in_sizes, int n_in, void* d_out, int out_size, void* d_ws, size_t ws_size, hipStream_t stream) {
    static int grid = 0;
    if (grid == 0) {
        if (n_in != 14 || ws_size < WS_END) { fprintf(stderr, "kernel_launch: unexpected n_in %d / ws_size %zu (need %zu)\n", n_in, ws_size, (size_t)WS_END); grid = -1; return; }
        int dev = 0, cus = 0, per_cu = 0;
        hipGetDevice(&dev); hipDeviceGetAttribute(&cus, hipDeviceAttributeMultiprocessorCount, dev);
        if (hipFuncSetAttribute((const void*)mega, hipFuncAttributeMaxDynamicSharedMemorySize, LDS_BYTES) != hipSuccess) { fprintf(stderr, "kernel_launch: hipFuncSetAttribute failed\n"); grid = -1; return; }
        if (hipOccupancyMaxActiveBlocksPerMultiprocessor(&per_cu, (const void*)mega, 512, LDS_BYTES) != hipSuccess || per_cu < 1) { fprintf(stderr, "kernel_launch: occupancy query failed (%d)\n", per_cu); (void)hipGetLastError(); per_cu = 1; }
        grid = cus * 1;
        fprintf(stderr, "kernel_launch: cus %d per_cu %d grid %d\n", cus, per_cu, grid);
    }
    if (grid < 0) return;
    if (hipMemsetAsync((char*)d_ws + WS_BAR, 0, WS_END - WS_BAR, stream)     != hipSuccess) { fprintf(stderr, "kernel_launch: memset failed\n"); return; }
    Args a{};
    a.x = (const float*)d_in[0]; a.w_in = (const float*)d_in[1]; a.b_gates = (const float*)d_in[2]; a.w_sc = (const float*)d_in[3]; a.mh_gain = (const float*)d_in[4]; a.w_out = (const float*)d_in[5];
    a.ln1_g = (const float*)d_in[6]; a.ln1_b = (const float*)d_in[7]; a.w_up = (const float*)d_in[8]; a.w_fc = (const float*)d_in[9]; a.b_fc = (const float*)d_in[10]; a.w_down = (const float*)d_in[11];
    a.ln2_g = (const float*)d_in[12]; a.ln2_b = (const float*)d_in[13];
    a.out = (float*)d_out; a.ws = (unsigned char*)d_ws;
    a.fuse_ln = (MK_SINGLE && grid == 256) ? 1 : 0;
#if MK_SINGLE
    a.ph_lo = 0; a.ph_hi = N_PHASES;
    void* args[] = {&a};
    hipError_t e = hipLaunchCooperativeKernel((const void*)mega, dim3(grid), dim3(512), args, LDS_BYTES, stream);
    if (e != hipSuccess) fprintf(stderr, "cooperative launch failed: %s (grid %d)\n", hipGetErrorString(e), grid);
#else
    for (int ph = 0; ph < N_PHASES; ++ph) { if (DBG_STOP >= 0 && ph > DBG_STOP) break; a.ph_lo = ph; a.ph_hi = ph + 1; hipLaunchKernelGGL(mega, dim3(grid), dim3(512), LDS_BYTES, stream, a); }
    if (DBG_STOP >= 0) { a.ph_lo = 100 + DBG_STOP; a.ph_hi = 101 + DBG_STOP; hipLaunchKernelGGL(mega, dim3(grid), dim3(512), LDS_BYTES, stream, a); }
#endif
}
```

```cpp
#include <hip/hip_runtime.h>
#include <hip/hip_cooperative_groups.h>
#include <cstdio>
#include <cstdint>
namespace cg = cooperative_groups;

#ifndef MK_SINGLE
#define MK_SINGLE 1
#endif

#define LAS __attribute__((address_space(3)))
typedef unsigned short bf16_t;
typedef short bf16x8 __attribute__((ext_vector_type(8)));
typedef float f32x4 __attribute__((ext_vector_type(4)));
typedef unsigned u32x4 __attribute__((ext_vector_type(4)));
typedef unsigned u32x2 __attribute__((ext_vector_type(2)));
typedef short s16x4 __attribute__((ext_vector_type(4)));

constexpr int MT = 8192, DM = 2048, SEQ = 2048, NIN = 7176, NP = 7168, DFF = 5632, NUP = 11264, WCONV = 1024;
constexpr float ALPHA = 1.189207115002721f;
constexpr size_t WS_WIN = 0;
constexpr size_t WS_WOUT = WS_WIN + (size_t)NP * DM * 2;
constexpr size_t WS_WUP = WS_WOUT + (size_t)DM * DM * 2;
constexpr size_t WS_WDN = WS_WUP + (size_t)NUP * DM * 2;
constexpr size_t WS_X1B = WS_WDN + (size_t)DM * DFF * 2;
constexpr size_t WS_GATES = WS_X1B + (size_t)MT * DM * 2;
constexpr size_t WS_C = WS_GATES + (size_t)MT * 8 * 4;
constexpr size_t WS_PROJ = WS_C;
constexpr size_t WS_Y = WS_PROJ + (size_t)MT * NP * 2;
constexpr size_t WS_XB = WS_Y + (size_t)MT * DM * 2;
constexpr size_t WS_ACT = WS_C;
constexpr size_t WS_HALO = WS_ACT + (size_t)MT * DFF * 2;
constexpr size_t WS_BAR = WS_XB + (size_t)MT * DM * 2;
constexpr size_t WS_RS1 = WS_BAR + 16384;
constexpr size_t WS_RS2 = WS_RS1 + (size_t)MT * 8;
constexpr size_t WS_CNT = WS_RS2 + (size_t)MT * 8;
constexpr size_t WS_END = WS_CNT + 2 * 32 * 256;
constexpr size_t WS_GCLO = WS_X1B, WS_GCHI = WS_XB;
constexpr size_t WS_NV = 0;
constexpr size_t WS_TAB = WS_NV + (size_t)512 * 256 * 2;
constexpr size_t WS_MST = WS_TAB + (size_t)16 * 3 * 2048 * 4;
constexpr int LDS_BYTES = 131072 + 16 + 3 * 32 * 64 * 4;

struct Args {
    const float* x; const float* w_in; const float* b_gates; const float* w_sc; const float* mh_gain; const float* w_out;
    const float* ln1_g; const float* ln1_b; const float* w_up; const float* w_fc; const float* b_fc; const float* w_down;
    const float* ln2_g; const float* ln2_b;
    float* out; unsigned char* ws; int ph_lo, ph_hi, fuse_ln, pad0;
};

typedef __bf16 bf16v2 __attribute__((ext_vector_type(2)));
typedef float f32x2 __attribute__((ext_vector_type(2)));
__device__ __forceinline__ unsigned cvt_pk_bf16(float lo, float hi) { const f32x2 v = {lo, hi}; const bf16v2 r = __builtin_convertvector(v, bf16v2); return __builtin_bit_cast(unsigned, r); }
__device__ __forceinline__ unsigned cvt_pk_bf16_asm(float lo, float hi) { unsigned r; asm volatile("v_cvt_pk_bf16_f32 %0, %1, %2" : "=v"(r) : "v"(lo), "v"(hi)); return r; }
__device__ __forceinline__ float bflo(unsigned u) { return __uint_as_float(u << 16); }
__device__ __forceinline__ float bfhi(unsigned u) { return __uint_as_float(u & 0xffff0000u); }
__device__ __forceinline__ bf16_t f2bf(float f) { unsigned u = __float_as_uint(f); u += 0x7FFFu + ((u >> 16) & 1u); return (bf16_t)(u >> 16); }

namespace pg8 {
constexpr int BM = 256, BK = 64, HALF = 128, HTB = HALF * BK * 2, STAGE_BYTES = 8 * HTB, NXCD = 8, WGM = 8;
__host__ __device__ __forceinline__ int lds_byte(int r, int c) { const int st = (r >> 4) * 2 + (c >> 5), rr = r & 15, cc = c & 31, ob = rr * 64 + cc * 2; return st * 1024 + (ob ^ (((ob >> 9) & 1) << 5)); }
__host__ __device__ __forceinline__ void stage_rc(int b, int& R, int& C) { const int st = b / 1024, sb = b % 1024, swz = sb ^ (((sb >> 9) & 1) << 5); R = (st >> 1) * 16 + swz / 64; C = (st & 1) * 32 + (swz % 64) / 2; }
__host__ __device__ __forceinline__ int perm32(int rho) { const int n = rho >> 4, i = rho & 15; return 8 * (i >> 2) + 4 * n + (i & 3); }
struct Unit { int pm, pn; };
struct Gemm { const bf16_t* A; const bf16_t* Bt; int M, N, K; };
struct StaticOrder {
    int nM, nN, nwg, G, c;
    __device__ void init(int M, int N, int G_, int c_) { nM = M / BM; nN = N / BM; nwg = nM * nN; G = G_; c = c_; }
    __device__ bool next(int i, Unit& u) const {
        const long L = (long)i * G + c; if (L >= nwg) return false;
        int wgid = (int)L; { const int q = nwg / NXCD, r = nwg % NXCD, xcd = wgid % NXCD, off = wgid / NXCD; wgid = (xcd < r ? xcd * (q + 1) : r * (q + 1) + (xcd - r) * q) + off; }
        const int nig = WGM * nN, gid = wgid / nig, fm = gid * WGM, gsz = (nM - fm) < WGM ? (nM - fm) : WGM;
        u.pm = fm + ((wgid % nig) % gsz); u.pn = (wgid % nig) / gsz; return true;
    }
};

template <class Epi, bool ALIGN_EPI = false, bool SP2 = true>
__device__ __forceinline__ void gemm_phase(LAS unsigned char* lds, const Gemm g, const StaticOrder& S, const Epi& E) {
    const int tid = threadIdx.x, wid = __builtin_amdgcn_readfirstlane(tid >> 6), lane = tid & 63, wr = wid >> 2, wc = wid & 3, fr = lane & 15, fq = lane >> 4;
    const int K = g.K, nt = K / BK;
    unsigned voffA[2], voffB[2];
#pragma unroll
    for (int i = 0; i < 2; ++i) { int R, C; stage_rc(tid * 16 + i * 8192, R, C); const int Rb = Epi::PERM ? ((R & ~31) + perm32(R & 31)) : R;
        const int Ra = Epi::AROWPERM ? (128 * (R >> 6) + 8 * (R & 15) + ((R >> 4) & 3)) : R;
        const int Rbb = Epi::BCOLPERM ? (64 * (R >> 5) + perm32(R & 31)) : Rb;
        voffA[i] = (unsigned)(Ra * K + C) * 2u; voffB[i] = (unsigned)(Rbb * K + C) * 2u; }
    const size_t kstep = (size_t)(BK * 2);
    const size_t hstep = (size_t)HALF * K * 2;
    const size_t hstepA = Epi::AROWPERM ? (size_t)4 * K * 2 : hstep;
    const size_t hstepB = Epi::BCOLPERM ? (size_t)32 * K * 2 : hstep;
    const size_t tstep = 2 * hstep;
    const unsigned ldsw = (unsigned)wid * 1024u;
    const int aoff = lds_byte(wr * 64 + fr, fq * 8), boff = lds_byte(wc * 32 + fr, fq * 8);
#define PG8_SA(b, h) (((b) * 2 + (h)) * HTB)
#define PG8_SB(b, h) ((4 + (b) * 2 + (h)) * HTB)
#define PG8_STAGE(bufoff, gbase, voff) do { _Pragma("unroll") for (int _i = 0; _i < 2; ++_i) \
        __builtin_amdgcn_global_load_lds((const unsigned*)((const char*)(gbase) + (voff)[_i]), (LAS unsigned*)(lds + (bufoff) + ldsw + _i * 8192), 16, 0, 0); } while (0)
#define PG8_LDA(dst, b, h) do { _Pragma("unroll") for (int m = 0; m < 4; ++m) _Pragma("unroll") for (int k = 0; k < 2; ++k) dst[m][k] = *(const LAS bf16x8*)(lds + PG8_SA(b, h) + aoff + m * 2048 + k * 1024); } while (0)
#define PG8_LDB(dst, b, h) do { _Pragma("unroll") for (int n = 0; n < 2; ++n) _Pragma("unroll") for (int k = 0; k < 2; ++k) dst[n][k] = *(const LAS bf16x8*)(lds + PG8_SB(b, h) + boff + n * 2048 + k * 1024); } while (0)
#define PG8_MMA(ai, bj, At, Bt) do { __builtin_amdgcn_s_setprio(1); _Pragma("unroll") for (int m = 0; m < 4; ++m) _Pragma("unroll") for (int n = 0; n < 2; ++n) _Pragma("unroll") for (int k = 0; k < 2; ++k) \
        acc[ai][bj][m][n] = __builtin_amdgcn_mfma_f32_16x16x32_bf16(Bt[n][k], At[m][k], acc[ai][bj][m][n], 0, 0, 0); __builtin_amdgcn_s_setprio(0); } while (0)
#define PG8_WAIT_V(n) asm volatile("s_waitcnt vmcnt(" #n ")" ::: "memory")
#define PG8_WAIT_L(n) asm volatile("s_waitcnt lgkmcnt(" #n ")" ::: "memory")
#define PG8_BAR __builtin_amdgcn_s_barrier()
#define PG8_SCHED __builtin_amdgcn_sched_barrier(0)
    Unit cur, nxt; int ui = 0;
    if (!S.next(0, cur)) return;
    f32x4 acc[2][2][4][2];
#pragma unroll
    for (int a = 0; a < 2; ++a)
#pragma unroll
        for (int b = 0; b < 2; ++b)
#pragma unroll
            for (int m = 0; m < 4; ++m)
#pragma unroll
                for (int n = 0; n < 2; ++n) acc[a][b][m][n] = (f32x4){0.f, 0.f, 0.f, 0.f};
    bf16x8 At[4][2], B0[2][2], B1[2][2];
    const char* cA = (const char*)g.A + (size_t)cur.pm * tstep; const char* cB = (const char*)g.Bt + (size_t)cur.pn * tstep;
    if constexpr (SP2) {
        PG8_STAGE(PG8_SB(0, 0), cB, voffB); PG8_STAGE(PG8_SB(0, 1), cB + hstepB, voffB); PG8_STAGE(PG8_SA(0, 0), cA, voffA); PG8_STAGE(PG8_SA(0, 1), cA + hstepA, voffA);
        if (wr == 1) PG8_BAR;
        PG8_WAIT_V(2); PG8_BAR;
        PG8_STAGE(PG8_SB(1, 0), cB + kstep, voffB); PG8_STAGE(PG8_SA(1, 0), cA + kstep, voffA); PG8_STAGE(PG8_SB(1, 1), cB + hstepB + kstep, voffB);
        PG8_WAIT_V(6); PG8_BAR;
    } else {
        PG8_STAGE(PG8_SB(0, 0), cB, voffB); PG8_STAGE(PG8_SA(0, 0), cA, voffA); PG8_STAGE(PG8_SB(0, 1), cB + hstepB, voffB); PG8_STAGE(PG8_SA(0, 1), cA + hstepA, voffA);
        if (wr == 1) PG8_BAR;
        PG8_WAIT_V(4); PG8_BAR;
        PG8_STAGE(PG8_SB(1, 0), cB + kstep, voffB); PG8_STAGE(PG8_SA(1, 0), cA + kstep, voffA); PG8_STAGE(PG8_SB(1, 1), cB + hstepB + kstep, voffB);
        PG8_WAIT_V(6); PG8_BAR;
    }
    for (;;) {
        const bool has_next = S.next(ui + 1, nxt);
        const char* nA = has_next ? (const char*)g.A + (size_t)nxt.pm * tstep : cA; const char* nB = has_next ? (const char*)g.Bt + (size_t)nxt.pn * tstep : cB;
        for (int t = 0; t < nt; t += 2) {
            const bool last = (t == nt - 2);
            const char* a1 = cA + (size_t)(t + 1) * kstep;
            const char* a2 = last ? nA : cA + (size_t)(t + 2) * kstep; const char* b2 = last ? nB : cB + (size_t)(t + 2) * kstep;
            const char* a3 = a2 + kstep; const char* b3 = b2 + kstep;
            if constexpr (SP2) {
            PG8_LDB(B0, 0, 0); PG8_LDB(B1, 0, 1); PG8_SCHED; PG8_LDA(At, 0, 0); PG8_STAGE(PG8_SA(1, 1), a1 + hstepA, voffA);
            PG8_WAIT_V(8); PG8_WAIT_L(0); PG8_BAR; PG8_MMA(0, 0, At, B0); PG8_MMA(0, 1, At, B1); PG8_BAR; PG8_SCHED;
            PG8_LDA(At, 0, 1); PG8_STAGE(PG8_SB(0, 0), b2, voffB); PG8_STAGE(PG8_SB(0, 1), b2 + hstepB, voffB); PG8_STAGE(PG8_SA(0, 0), a2, voffA);
            PG8_WAIT_V(8); PG8_WAIT_L(0); PG8_BAR; PG8_MMA(1, 0, At, B0); PG8_MMA(1, 1, At, B1); PG8_BAR; PG8_SCHED;
            PG8_LDB(B0, 1, 0); PG8_LDB(B1, 1, 1); PG8_SCHED; PG8_LDA(At, 1, 0); PG8_STAGE(PG8_SA(0, 1), a2 + hstepA, voffA);
            PG8_WAIT_V(8); PG8_WAIT_L(0); PG8_BAR; PG8_MMA(0, 0, At, B0); PG8_MMA(0, 1, At, B1); PG8_BAR; PG8_SCHED;
            PG8_LDA(At, 1, 1); PG8_STAGE(PG8_SB(1, 0), b3, voffB); PG8_STAGE(PG8_SB(1, 1), b3 + hstepB, voffB); PG8_STAGE(PG8_SA(1, 0), a3, voffA);
            PG8_WAIT_V(8); PG8_WAIT_L(0); PG8_BAR; PG8_MMA(1, 0, At, B0); PG8_MMA(1, 1, At, B1); PG8_BAR; PG8_SCHED;
            } else {
            PG8_LDB(B0, 0, 0); PG8_SCHED; PG8_LDA(At, 0, 0); PG8_STAGE(PG8_SA(1, 1), a1 + hstepA, voffA);
            PG8_WAIT_L(8); PG8_BAR; PG8_WAIT_L(0); PG8_MMA(0, 0, At, B0); PG8_BAR; PG8_SCHED;
            PG8_LDB(B1, 0, 1); PG8_STAGE(PG8_SB(0, 0), b2, voffB);
            PG8_BAR; PG8_WAIT_L(0); PG8_MMA(0, 1, At, B1); PG8_BAR;
            PG8_LDA(At, 0, 1); PG8_STAGE(PG8_SA(0, 0), a2, voffA);
            PG8_BAR; PG8_WAIT_L(0); PG8_MMA(1, 0, At, B0); PG8_BAR; PG8_SCHED;
            PG8_STAGE(PG8_SB(0, 1), b2 + hstepB, voffB);
            PG8_WAIT_V(6); PG8_BAR; PG8_MMA(1, 1, At, B1); PG8_BAR;
            PG8_LDB(B0, 1, 0); PG8_SCHED; PG8_LDA(At, 1, 0); PG8_STAGE(PG8_SA(0, 1), a2 + hstepA, voffA);
            PG8_WAIT_L(8); PG8_BAR; PG8_WAIT_L(0); PG8_MMA(0, 0, At, B0); PG8_BAR; PG8_SCHED;
            PG8_LDB(B1, 1, 1); PG8_STAGE(PG8_SB(1, 0), b3, voffB);
            PG8_BAR; PG8_WAIT_L(0); PG8_MMA(0, 1, At, B1); PG8_BAR;
            PG8_LDA(At, 1, 1); PG8_STAGE(PG8_SA(1, 0), a3, voffA);
            PG8_BAR; PG8_WAIT_L(0); PG8_MMA(1, 0, At, B0); PG8_BAR; PG8_SCHED;
            PG8_STAGE(PG8_SB(1, 1), b3 + hstepB, voffB);
            PG8_WAIT_V(6); PG8_BAR; PG8_MMA(1, 1, At, B1); PG8_BAR;

            }
        }
        if constexpr (ALIGN_EPI) { if (wr == 0) PG8_BAR; }
        if constexpr (!Epi::AFTER_DRAIN) E(acc, cur, wr, wc, fr, fq);
        if (!has_next) break;
#pragma unroll
        for (int a = 0; a < 2; ++a)
#pragma unroll
            for (int b = 0; b < 2; ++b)
#pragma unroll
                for (int m = 0; m < 4; ++m)
#pragma unroll
                    for (int n = 0; n < 2; ++n) acc[a][b][m][n] = (f32x4){0.f, 0.f, 0.f, 0.f};
        cur = nxt; cA = nA; cB = nB; ++ui;
        if constexpr (ALIGN_EPI) { if (wr == 1) PG8_BAR; }
    }
    PG8_WAIT_V(0);
    if constexpr (!ALIGN_EPI) { if (wr == 0) PG8_BAR; }
    PG8_BAR;
    if constexpr (Epi::AFTER_DRAIN) E(acc, cur, wr, wc, fr, fq);
#undef PG8_SA
#undef PG8_SB
#undef PG8_STAGE
#undef PG8_LDA
#undef PG8_LDB
#undef PG8_MMA
#undef PG8_WAIT_V
#undef PG8_WAIT_L
#undef PG8_BAR
#undef PG8_SCHED
}

struct EpiBf16 {
    static constexpr bool PERM = true, AFTER_DRAIN = false, AROWPERM = false, BCOLPERM = true;
    bf16_t* O; int ldc;
    __device__ __forceinline__ void operator()(f32x4 (&acc)[2][2][4][2], const Unit& u, int wr, int wc, int fr, int fq) const {
        const int row0 = u.pm * BM + wr * 64 + fr, col0 = u.pn * BM + wc * 64 + 8 * fq;
#pragma unroll
        for (int ai = 0; ai < 2; ++ai)
#pragma unroll
            for (int m = 0; m < 4; ++m) { bf16_t* rowp = O + (size_t)(row0 + ai * HALF + m * 16) * ldc + col0;
#pragma unroll
                for (int bj = 0; bj < 2; ++bj) { const f32x4 v0 = acc[ai][bj][m][0], v1 = acc[ai][bj][m][1];
                    u32x4 w; w.x = cvt_pk_bf16_asm(v0[0], v0[1]); w.y = cvt_pk_bf16_asm(v0[2], v0[3]); w.z = cvt_pk_bf16_asm(v1[0], v1[1]); w.w = cvt_pk_bf16_asm(v1[2], v1[3]);
                    *(u32x4*)(rowp + bj * 32) = w; } }
    }
};
struct EpiResF32 {
    static constexpr bool PERM = false, AFTER_DRAIN = false, AROWPERM = false, BCOLPERM = false;
    const float* X; float* O; int ldc;
    __device__ __forceinline__ void operator()(f32x4 (&acc)[2][2][4][2], const Unit& u, int wr, int wc, int fr, int fq) const {
        const int row0 = u.pm * BM + wr * 64 + fr, col0 = u.pn * BM + wc * 32 + 4 * fq;
#pragma unroll
        for (int ai = 0; ai < 2; ++ai)
#pragma unroll
            for (int m = 0; m < 4; ++m) { const size_t ro = (size_t)(row0 + ai * HALF + m * 16) * ldc + col0;
#pragma unroll
                for (int bj = 0; bj < 2; ++bj)
#pragma unroll
                    for (int n = 0; n < 2; ++n) { const f32x4 xv = *(const f32x4*)(X + ro + bj * HALF + n * 16);
                        *(f32x4*)(O + ro + bj * HALF + n * 16) = xv * ALPHA + acc[ai][bj][m][n]; } }
    }
};
template <bool XBF  , bool WF32  > struct EpiResLn {
    static constexpr bool PERM = true, AFTER_DRAIN = true, AROWPERM = false, BCOLPERM = false;
    const float* X; const bf16_t* XB; float* O; bf16_t* OB; const float* gam; const float* bet; float* rs; unsigned* cnt;
    __device__ __forceinline__ void operator()(f32x4 (&acc)[2][2][4][2], const Unit& u, int wr, int wc, int fr, int fq) const {
        const int row0 = u.pm * BM + wr * 64 + fr, col0 = u.pn * BM + wc * 32 + 8 * fq;
#pragma unroll
        for (int ai = 0; ai < 2; ++ai)
#pragma unroll
            for (int m = 0; m < 4; ++m) { const int row = row0 + ai * HALF + m * 16; const size_t ro = (size_t)row * DM + col0;
                float s = 0.f, q = 0.f;
#pragma unroll
                for (int bj = 0; bj < 2; ++bj)
#pragma unroll
                    for (int n = 0; n < 2; ++n) { f32x4 xv;
                        if constexpr (XBF) { const u32x2 xb2 = *(const u32x2*)(XB + ro + bj * HALF + n * 4); xv = (f32x4){bflo(xb2.x), bfhi(xb2.x), bflo(xb2.y), bfhi(xb2.y)}; }
                        else xv = *(const f32x4*)(X + ro + bj * HALF + n * 4);
                        const f32x4 z = xv * ALPHA + acc[ai][bj][m][n]; acc[ai][bj][m][n] = z;
                        s += (z[0] + z[1]) + (z[2] + z[3]); q += (z[0] * z[0] + z[1] * z[1]) + (z[2] * z[2] + z[3] * z[3]); }
                s += __shfl_xor(s, 16); s += __shfl_xor(s, 32); q += __shfl_xor(q, 16); q += __shfl_xor(q, 32);
                if (fq == 0) { (void)__hip_atomic_fetch_add(rs + 2 * row, s, __ATOMIC_RELAXED, __HIP_MEMORY_SCOPE_AGENT); (void)__hip_atomic_fetch_add(rs + 2 * row + 1, q, __ATOMIC_RELAXED, __HIP_MEMORY_SCOPE_AGENT); } }
        asm volatile("s_waitcnt vmcnt(0)" ::: "memory");
        unsigned* cp = cnt + 64 * u.pm;
        if ((threadIdx.x & 63) == 0) (void)__hip_atomic_fetch_add(cp, 1u, __ATOMIC_RELAXED, __HIP_MEMORY_SCOPE_AGENT);
        { unsigned sp = 0; while ((unsigned)__builtin_amdgcn_readfirstlane(__hip_atomic_load(cp, __ATOMIC_RELAXED, __HIP_MEMORY_SCOPE_AGENT)) < 64u) { __builtin_amdgcn_s_sleep(2); if (++sp > (1u << 22)) break; } }
        f32x4 gg[2][2], bb[2][2];
#pragma unroll
        for (int bj = 0; bj < 2; ++bj)
#pragma unroll
            for (int n = 0; n < 2; ++n) { gg[bj][n] = *(const f32x4*)(gam + col0 + bj * HALF + n * 4); bb[bj][n] = *(const f32x4*)(bet + col0 + bj * HALF + n * 4); }
#pragma unroll
        for (int ai = 0; ai < 2; ++ai)
#pragma unroll
            for (int m = 0; m < 4; ++m) { const int row = row0 + ai * HALF + m * 16; const size_t ro = (size_t)row * DM + col0;
                const float s = __hip_atomic_load(rs + 2 * row, __ATOMIC_RELAXED, __HIP_MEMORY_SCOPE_AGENT), q = __hip_atomic_load(rs + 2 * row + 1, __ATOMIC_RELAXED, __HIP_MEMORY_SCOPE_AGENT);
                const float mu = s * (1.0f / DM), rstd = rsqrtf(fmaxf(q * (1.0f / DM) - mu * mu, 0.f) + 1e-5f);
#pragma unroll
                for (int bj = 0; bj < 2; ++bj)
#pragma unroll
                    for (int n = 0; n < 2; ++n) { const f32x4 o = (acc[ai][bj][m][n] - mu) * rstd * gg[bj][n] + bb[bj][n];
                        if constexpr (WF32) *(f32x4*)(O + ro + bj * HALF + n * 4) = o;
                        if (OB) { u32x2 p; p.x = cvt_pk_bf16_asm(o[0], o[1]); p.y = cvt_pk_bf16_asm(o[2], o[3]); *(u32x2*)(OB + ro + bj * HALF + n * 4) = p; } } }
    }
};
__device__ __forceinline__ float dpp_shr1(float x) { return __builtin_bit_cast(float, __builtin_amdgcn_update_dpp(0, __builtin_bit_cast(int, x), 0x111, 0xf, 0xf, true)); }
struct EpiConvFfn {
    static constexpr bool PERM = true, AFTER_DRAIN = false, AROWPERM = true, BCOLPERM = false;
    bf16_t* act; float* halo; const float* cw; const float* cb;
    __device__ __forceinline__ void operator()(f32x4 (&acc)[2][2][4][2], const Unit& u, int wr, int wc, int fr, int fq) const {
        const int fcol = u.pn * 128 + wc * 32 + 8 * fq;
        const int rbase = u.pm * BM + wr * 128;
        {
            float* hb = halo + (size_t)(rbase >> 7) * 4 * NUP + fcol;
            if (fr == 0) {
#pragma unroll
                for (int bj = 0; bj < 2; ++bj)
#pragma unroll
                    for (int n = 0; n < 2; ++n) { *(f32x4*)(hb + (size_t)2 * NUP + bj * DFF + 4 * n) = acc[0][bj][0][n]; *(f32x4*)(hb + (size_t)3 * NUP + bj * DFF + 4 * n) = acc[0][bj][1][n]; }
            }
            if (fr == 15) {
#pragma unroll
                for (int bj = 0; bj < 2; ++bj)
#pragma unroll
                    for (int n = 0; n < 2; ++n) { *(f32x4*)(hb + bj * DFF + 4 * n) = acc[1][bj][2][n]; *(f32x4*)(hb + (size_t)1 * NUP + bj * DFF + 4 * n) = acc[1][bj][3][n]; }
            }
        }
        u32x2 pk0[8];
#pragma unroll
        for (int n = 0; n < 2; ++n) {
            f32x4 W0[2], W1[2], W2[2], Bb[2];
#pragma unroll
            for (int bj = 0; bj < 2; ++bj) { const int hc = bj * DFF + fcol + 4 * n;
                W0[bj] = *(const f32x4*)(cw + hc); W1[bj] = *(const f32x4*)(cw + NUP + hc); W2[bj] = *(const f32x4*)(cw + 2 * NUP + hc); Bb[bj] = *(const f32x4*)(cb + hc); }
            f32x4 E6[2], E7[2];
#pragma unroll
            for (int bj = 0; bj < 2; ++bj) { const f32x4 s6 = acc[1][bj][2][n], s7 = acc[1][bj][3][n];
                E6[bj][0] = dpp_shr1(s6[0]); E6[bj][1] = dpp_shr1(s6[1]); E6[bj][2] = dpp_shr1(s6[2]); E6[bj][3] = dpp_shr1(s6[3]);
                E7[bj][0] = dpp_shr1(s7[0]); E7[bj][1] = dpp_shr1(s7[1]); E7[bj][2] = dpp_shr1(s7[2]); E7[bj][3] = dpp_shr1(s7[3]); }
#pragma unroll
            for (int i = 0; i < 8; ++i) {
                f32x4 h[2];
#pragma unroll
                for (int bj = 0; bj < 2; ++bj) {
                    const f32x4 cur = acc[i >> 2][bj][i & 3][n];
                    const f32x4 p1 = (i >= 1) ? acc[(i - 1 >= 0 ? i - 1 : 0) >> 2][bj][(i - 1 >= 0 ? i - 1 : 0) & 3][n] : E7[bj];
                    const f32x4 p2 = (i >= 2) ? acc[(i - 2 >= 0 ? i - 2 : 0) >> 2][bj][(i - 2 >= 0 ? i - 2 : 0) & 3][n] : (i == 1 ? E7[bj] : E6[bj]);
                    h[bj] = W2[bj] * cur + W1[bj] * p1 + W0[bj] * p2 + Bb[bj];
                }
                const f32x4 gt = h[1], ng = gt * (-1.4426950408889634f);
                f32x4 r;
#pragma unroll
                for (int j = 0; j < 4; ++j) r[j] = __builtin_amdgcn_rcpf(1.0f + __builtin_amdgcn_exp2f(ng[j]));
                const f32x4 av = h[0] * gt * r;
                u32x2 pk; pk.x = cvt_pk_bf16_asm(av[0], av[1]); pk.y = cvt_pk_bf16_asm(av[2], av[3]);
                if (n == 0) pk0[i] = pk;
                else if (i >= 2 || fr > 0) { u32x4 w; w.x = pk0[i].x; w.y = pk0[i].y; w.z = pk.x; w.w = pk.y;
                    *(u32x4*)(act + (size_t)(rbase + 8 * fr + i) * DFF + fcol) = w; }
            }
            asm volatile("" ::: "memory");
        }
    }
};
}

template <bool UPMAP>
__device__ __forceinline__ void transpose_macro(const float* W, int ldw, int k0, int n0, bf16_t* Wt, int ldt, unsigned char* lds) {
    bf16_t* sT = (bf16_t*)lds; const int tid = threadIdx.x;
    float4 v[2][4];
#pragma unroll
    for (int i = 0; i < 2; ++i)
#pragma unroll
        for (int j = 0; j < 4; ++j) v[i][j] = *(const float4*)(W + (size_t)(k0 + (tid >> 4) + 32 * i) * ldw + n0 + 64 * j + (tid & 15) * 4);
#pragma unroll
    for (int i = 0; i < 2; ++i)
#pragma unroll
        for (int j = 0; j < 4; ++j) { const int k = (tid >> 4) + 32 * i, n = 64 * j + (tid & 15) * 4;
            sT[(n + 0) * 66 + k] = f2bf(v[i][j].x); sT[(n + 1) * 66 + k] = f2bf(v[i][j].y); sT[(n + 2) * 66 + k] = f2bf(v[i][j].z); sT[(n + 3) * 66 + k] = f2bf(v[i][j].w); }
    __syncthreads();
#pragma unroll
    for (int j = 0; j < 4; ++j) { const int n = 64 * j + (tid >> 3), ks = (tid & 7) * 8; const unsigned* p = (const unsigned*)(sT + n * 66 + ks);
        u32x4 o; o.x = p[0]; o.y = p[1]; o.z = p[2]; o.w = p[3];
        int drow = n0 + n;
        if (UPMAP) { const int f = (drow < DFF) ? drow : drow - DFF; drow = 256 * (f >> 7) + (f & 127) + ((drow < DFF) ? 0 : 128); }
        *(u32x4*)(Wt + (size_t)drow * ldt + k0 + ks) = o; }
    __syncthreads();
}
constexpr int TM_IN = 32 * 28, TM_OUT = 32 * 8, TM_UP = 32 * 44, TM_DN = 88 * 8;
__device__ __forceinline__ void phase_transposes(const Args& A, unsigned char* lds, int g0, int g1, int worker, int nworkers) {
    unsigned char* ws = A.ws;
    for (int g = g0 + worker; g < g1; g += nworkers) {
        if (g < TM_IN) { const int tk = g / 28, tn = g % 28; transpose_macro<false>(A.w_in, NIN, tk * 64, tn * 256, (bf16_t*)(ws + WS_WIN), DM, lds); }
        else if (g < TM_IN + TM_OUT) { const int h = g - TM_IN, tk = h / 8, tn = h % 8; transpose_macro<false>(A.w_out, DM, tk * 64, tn * 256, (bf16_t*)(ws + WS_WOUT), DM, lds); }
        else if (g < TM_IN + TM_OUT + TM_UP) { const int h = g - TM_IN - TM_OUT, tk = h / 44, tn = h % 44; transpose_macro<true>(A.w_up, NUP, tk * 64, tn * 256, (bf16_t*)(ws + WS_WUP), DM, lds); }
        else { const int h = g - TM_IN - TM_OUT - TM_UP, tk = h / 8, tn = h % 8; transpose_macro<false>(A.w_down, DM, tk * 64, tn * 256, (bf16_t*)(ws + WS_WDN), DFF, lds); }
    }
}
__device__ __forceinline__ void phase_prologue(const Args& A, unsigned char* lds) {
    unsigned char* ws = A.ws;
    const int lane = threadIdx.x & 63, gw = blockIdx.x * 8 + (threadIdx.x >> 6), nw = gridDim.x * 8;
    bf16_t* xb = (bf16_t*)(ws + WS_XB); float* gates = (float*)(ws + WS_GATES);
    phase_transposes(A, lds, 0, TM_IN, blockIdx.x, gridDim.x);
    for (int it = gw; it < MT / 4; it += nw) {
        const int r0 = it * 4;
        float acc[4][8];
#pragma unroll
        for (int r = 0; r < 4; ++r)
#pragma unroll
            for (int q = 0; q < 8; ++q) acc[r][q] = 0.f;
#pragma unroll 1
        for (int ih = 0; ih < 2; ++ih) {
        f32x4 xq[4][4];
#pragma unroll
        for (int i = 0; i < 4; ++i)
#pragma unroll
            for (int r = 0; r < 4; ++r) xq[i][r] = *(const f32x4*)(A.x + (size_t)(r0 + r) * DM + (ih * 4 + i) * 256 + lane * 4);
#pragma unroll
        for (int i = 0; i < 4; ++i) {
            const int kb = (ih * 4 + i) * 256 + lane * 4;
            f32x4 xv[4];
#pragma unroll
            for (int r = 0; r < 4; ++r) { xv[r] = xq[i][r];
                u32x2 o; o.x = cvt_pk_bf16(xv[r][0], xv[r][1]); o.y = cvt_pk_bf16(xv[r][2], xv[r][3]); *(u32x2*)(xb + (size_t)(r0 + r) * DM + kb) = o; }
#pragma unroll
            for (int j = 0; j < 4; ++j) {
                const f32x4* wp = (const f32x4*)(A.w_in + (size_t)(kb + j) * NIN + NP);
                const f32x4 w0 = wp[0], w1 = wp[1];
#pragma unroll
                for (int r = 0; r < 4; ++r) { const float xs = xv[r][j];
                    acc[r][0] += xs * w0[0]; acc[r][1] += xs * w0[1]; acc[r][2] += xs * w0[2]; acc[r][3] += xs * w0[3];
                    acc[r][4] += xs * w1[0]; acc[r][5] += xs * w1[1]; acc[r][6] += xs * w1[2]; acc[r][7] += xs * w1[3]; }
            }
        }
        }
#pragma unroll
        for (int r = 0; r < 4; ++r)
#pragma unroll
            for (int q = 0; q < 8; ++q) { float v = acc[r][q];
#pragma unroll
                for (int off = 32; off >= 1; off >>= 1) v += __shfl_xor(v, off);
                acc[r][q] = v; }
        if (lane == 0) {
            const f32x4 b0 = *(const f32x4*)(A.b_gates), b1 = *(const f32x4*)(A.b_gates + 4);
#pragma unroll
            for (int r = 0; r < 4; ++r) {
                *(f32x4*)(gates + (size_t)(r0 + r) * 8) = (f32x4){acc[r][0] + b0[0], acc[r][1] + b0[1], acc[r][2] + b0[2], acc[r][3] + b0[3]};
                *(f32x4*)(gates + (size_t)(r0 + r) * 8 + 4) = (f32x4){acc[r][4] + b1[0], acc[r][5] + b1[1], acc[r][6] + b1[2], acc[r][7] + b1[3]}; }
        }
    }
}

__device__ __forceinline__ void phase_yconv(const Args& A) {
    const bf16_t* proj = (const bf16_t*)(A.ws + WS_PROJ); bf16_t* y = (bf16_t*)(A.ws + WS_Y);
    for (int idx = blockIdx.x * 512 + threadIdx.x; idx < MT * 128; idx += gridDim.x * 512) {
        const int row = idx >> 7, c = (idx & 127) * 8, t = row & (SEQ - 1);
        const bf16_t* pr = proj + (size_t)row * NP + c;
        const u32x4 bv = *(const u32x4*)pr;
        float cv[8];
#pragma unroll
        for (int i = 0; i < 8; ++i) cv[i] = 0.f;
#pragma unroll
        for (int j = 0; j < 3; ++j) {
            const int dt = 2 - j;
            if (t - dt >= 0) {
                const u32x4 cc = *(const u32x4*)(pr - (size_t)dt * NP + WCONV), hh = *(const u32x4*)(pr - (size_t)dt * NP + 2 * WCONV);
                const f32x4 w0 = *(const f32x4*)(A.w_sc + j * WCONV + c), w1 = *(const f32x4*)(A.w_sc + j * WCONV + c + 4);
                const float wv[8] = {w0[0], w0[1], w0[2], w0[3], w1[0], w1[1], w1[2], w1[3]};
#pragma unroll
                for (int q = 0; q < 4; ++q) { cv[2 * q] += wv[2 * q] * bflo(cc[q]) * bflo(hh[q]); cv[2 * q + 1] += wv[2 * q + 1] * bfhi(cc[q]) * bfhi(hh[q]); }
            }
        }
        u32x4 o;
#pragma unroll
        for (int q = 0; q < 4; ++q) o[q] = cvt_pk_bf16(bflo(bv[q]) * cv[2 * q], bfhi(bv[q]) * cv[2 * q + 1]);
        *(u32x4*)(y + (size_t)row * DM + c) = o;
    }
}

__device__ __forceinline__ void phase_mlstm(const Args& A, unsigned char* lds, float* hbuf) {
    const int tid = threadIdx.x, lane = tid & 63, w = tid >> 6, g = lane >> 4, l15 = lane & 15;
    const int a = w >> 2, ti = w & 3;
    unsigned char* QS = lds; unsigned char* KS = lds + 33792; unsigned char* VT = lds + 67584; unsigned char* WVT = VT + 4608; unsigned char* CT = WVT + 4608; unsigned char* XCH = CT + 33792;
    const bf16_t* proj = (const bf16_t*)(A.ws + WS_PROJ); const float* gates = (const float*)(A.ws + WS_GATES);
    float* TBC = (float*)(lds + 131088); float* TUV = TBC + 2048; float* TCM = TUV + 2048;
    for (int item = blockIdx.x; item < 256; item += gridDim.x) {
        const int xcd = item & 7, idx = item >> 3; const int bh = xcd * 2 + (idx >> 4), es = idx & 15;
        const int b = bh >> 2, hh = bh & 3, e0 = es * 16;
        const size_t row0 = (size_t)b * SEQ;
        __syncthreads();
        for (int i = tid; i < 16896 / 4; i += 512) ((unsigned*)CT)[i] = 0u;
        for (int i = tid; i < 16 * 72; i += 512) { const int r = 16 + i / 72, ci = i % 72; ((bf16_t*)VT)[r * 72 + ci] = (r == 16) ? (bf16_t)0x3F80 : (bf16_t)0; ((bf16_t*)WVT)[r * 72 + ci] = 0; }
        f32x4 Cst[2][2];
#pragma unroll
        for (int x = 0; x < 2; ++x)
#pragma unroll
            for (int et = 0; et < 2; ++et) Cst[x][et] = (f32x4){0.f, 0.f, 0.f, 0.f};
        float m_state = 0.f;
        u32x4 qr[4], kr[4]; unsigned vr;
        const bf16_t* qbase = proj + row0 * NP + 3072 + hh * 256;
#define ML_LOAD(c) do { _Pragma("unroll") for (int i = 0; i < 4; ++i) { const int p = tid + 512 * i, r = p >> 5, c16 = p & 31; const bf16_t* rp = qbase + (size_t)((c) * 64 + r) * NP + c16 * 8; \
            qr[i] = *(const u32x4*)rp; kr[i] = *(const u32x4*)(rp + 1024); } \
            vr = *(const unsigned*)(qbase + (size_t)((c) * 64 + (tid >> 3)) * NP + 2048 + e0 + (tid & 7) * 2); } while (0)
        ML_LOAD(0);
#pragma unroll 1
        for (int cc = 4 * w; cc < 4 * w + 4; ++cc) {
            const float* gp = gates + (row0 + cc * 64 + lane) * 8 + hh; const float gi = gp[0], gf = gp[4];
            const float lf = fminf(gf, 0.f) - log1pf(__expf(-fabsf(gf)));
            float bc = lf;
#pragma unroll
            for (int off = 1; off < 64; off <<= 1) { const float t = __shfl_up(bc, off); if (lane >= off) bc += t; }
            const float uv = gi - bc;
            float cm = uv;
#pragma unroll
            for (int off = 1; off < 64; off <<= 1) { const float t = __shfl_up(cm, off); if (lane >= off) cm = fmaxf(cm, t); }
            TBC[cc * 64 + lane] = bc; TUV[cc * 64 + lane] = uv; TCM[cc * 64 + lane] = cm;
        }
        __syncthreads();
#pragma unroll 1
        for (int c = 0; c < 32; ++c) {
            const float* tbc = TBC + c * 64; const float* tuv = TUV + c * 64; const float* tcm = TCM + c * 64;
            const float g_tot = tbc[63], cm63 = tcm[63];
            const float M63 = fmaxf(m_state, cm63), decay = __expf(m_state - M63);
            const float m_old = m_state;
            m_state = g_tot + M63;
#pragma unroll
            for (int i = 0; i < 4; ++i) { const int p = tid + 512 * i, r = p >> 5, c16 = p & 31; *(u32x4*)(QS + r * 528 + c16 * 16) = qr[i]; *(u32x4*)(KS + r * 528 + c16 * 16) = kr[i]; }
            { const int s = tid >> 3, ep = tid & 7; const float wv = __expf(tuv[s] - M63);
              ((bf16_t*)VT)[(2 * ep) * 72 + s] = (bf16_t)(vr & 0xffffu); ((bf16_t*)VT)[(2 * ep + 1) * 72 + s] = (bf16_t)(vr >> 16);
              ((bf16_t*)WVT)[(2 * ep) * 72 + s] = f2bf(bflo(vr) * wv); ((bf16_t*)WVT)[(2 * ep + 1) * 72 + s] = f2bf(bfhi(vr) * wv);
              if (ep == 0) ((bf16_t*)WVT)[16 * 72 + s] = f2bf(wv); }
            if (c + 1 < 32) ML_LOAD(c + 1);
            __syncthreads();
            bf16x8 qf[8]; f32x4 S0 = (f32x4){0.f, 0.f, 0.f, 0.f}, S1 = S0;
#pragma unroll
            for (int kk = 0; kk < 8; ++kk) {
                const int ko = ((kk + 4 * a) & 7) * 64 + g * 16;
                qf[kk] = *(const bf16x8*)(QS + (16 * ti + l15) * 528 + ko);
                const bf16x8 kf0 = *(const bf16x8*)(KS + (32 * a + l15) * 528 + ko), kf1 = *(const bf16x8*)(KS + (32 * a + 16 + l15) * 528 + ko);
                S0 = __builtin_amdgcn_mfma_f32_16x16x32_bf16(kf0, qf[kk], S0, 0, 0, 0); S1 = __builtin_amdgcn_mfma_f32_16x16x32_bf16(kf1, qf[kk], S1, 0, 0, 0);
            }
            const int tcol = 16 * ti + l15;
            const float Mt = fmaxf(m_old, tcm[tcol]);
            const f32x4 u0v = *(const f32x4*)(tuv + 32 * a + 4 * g), u1v = *(const f32x4*)(tuv + 32 * a + 16 + 4 * g);
            float p[8];
#pragma unroll
            for (int r = 0; r < 4; ++r) { const int s0 = 32 * a + 4 * g + r, s1 = s0 + 16;
                p[r] = (s0 <= tcol) ? S0[r] * 0.0625f * __expf(u0v[r] - Mt) : 0.f; p[4 + r] = (s1 <= tcol) ? S1[r] * 0.0625f * __expf(u1v[r] - Mt) : 0.f; }
            u32x4 pau; pau.x = cvt_pk_bf16(p[0], p[1]); pau.y = cvt_pk_bf16(p[2], p[3]); pau.z = cvt_pk_bf16(p[4], p[5]); pau.w = cvt_pk_bf16(p[6], p[7]);
            const bf16x8 pa = __builtin_bit_cast(bf16x8, pau);
            f32x4 rr[2];
#pragma unroll
            for (int et = 0; et < 2; ++et) { const unsigned char* vp = VT + (16 * et + l15) * 144 + (32 * a + 4 * g) * 2;
                const u32x2 lo = *(const u32x2*)vp, hi = *(const u32x2*)(vp + 32);
                u32x4 vbu; vbu.x = lo.x; vbu.y = lo.y; vbu.z = hi.x; vbu.w = hi.y;
                rr[et] = __builtin_amdgcn_mfma_f32_16x16x32_bf16(pa, __builtin_bit_cast(bf16x8, vbu), (f32x4){0.f, 0.f, 0.f, 0.f}, 0, 0, 0); }
            const f32x4 cmr = *(const f32x4*)(tcm + 16 * ti + 4 * g), bcr = *(const f32x4*)(tbc + 16 * ti + 4 * g);
            {
                const unsigned char* CTc = CT + (c & 1) * 16896;
                f32x4 in0 = (f32x4){0.f, 0.f, 0.f, 0.f}, in1 = in0;
#pragma unroll
                for (int k2 = 0; k2 < 4; ++k2) {
                    const bf16x8 qa = qf[k2];
                    const bf16x8 c0 = *(const bf16x8*)(CTc + (l15) * 528 + (128 * a + 32 * k2 + 8 * g) * 2), c1 = *(const bf16x8*)(CTc + (16 + l15) * 528 + (128 * a + 32 * k2 + 8 * g) * 2);
                    in0 = __builtin_amdgcn_mfma_f32_16x16x32_bf16(qa, c0, in0, 0, 0, 0); in1 = __builtin_amdgcn_mfma_f32_16x16x32_bf16(qa, c1, in1, 0, 0, 0);
                }
#pragma unroll
                for (int r = 0; r < 4; ++r) { const float iw = __expf(m_old - fmaxf(m_old, cmr[r])) * 0.0625f; rr[0][r] += in0[r] * iw; rr[1][r] += in1[r] * iw; }
            }
            if (a == 1) { *(f32x4*)(XCH + ((ti * 2 + 0) * 64 + lane) * 16) = rr[0]; *(f32x4*)(XCH + ((ti * 2 + 1) * 64 + lane) * 16) = rr[1]; }
            {
                unsigned char* CTn = CT + ((c + 1) & 1) * 16896;
#pragma unroll
                for (int x = 0; x < 2; ++x) {
                    const int dt = 2 * w + x;
#pragma unroll
                    for (int et = 0; et < 2; ++et) Cst[x][et] *= decay;
#pragma unroll
                    for (int ks = 0; ks < 2; ++ks) {
                        const s16x4 klo = __builtin_amdgcn_ds_read_tr16_b64_v4i16((LAS s16x4*)(KS + (32 * ks + 8 * g + (l15 >> 2)) * 528 + (16 * dt + 4 * (l15 & 3)) * 2));
                        const s16x4 khi = __builtin_amdgcn_ds_read_tr16_b64_v4i16((LAS s16x4*)(KS + (32 * ks + 8 * g + 4 + (l15 >> 2)) * 528 + (16 * dt + 4 * (l15 & 3)) * 2));
                        const bf16x8 ka = {klo[0], klo[1], klo[2], klo[3], khi[0], khi[1], khi[2], khi[3]};
#pragma unroll
                        for (int et = 0; et < 2; ++et) { const bf16x8 wvb = *(const bf16x8*)(WVT + (16 * et + l15) * 144 + (32 * ks + 8 * g) * 2);
                            Cst[x][et] = __builtin_amdgcn_mfma_f32_16x16x32_bf16(ka, wvb, Cst[x][et], 0, 0, 0); }
                    }
#pragma unroll
                    for (int et = 0; et < 2; ++et) { u32x2 o; o.x = cvt_pk_bf16(Cst[x][et][0], Cst[x][et][1]); o.y = cvt_pk_bf16(Cst[x][et][2], Cst[x][et][3]);
                        *(u32x2*)(CTn + (16 * et + l15) * 528 + (16 * dt + 4 * g) * 2) = o; }
                }
            }
            __syncthreads();
            if (a == 0) {
                const f32x4 o0 = *(const f32x4*)(XCH + ((ti * 2 + 0) * 64 + lane) * 16), o1 = *(const f32x4*)(XCH + ((ti * 2 + 1) * 64 + lane) * 16);
#pragma unroll
                for (int r = 0; r < 4; ++r) {
                    const float den = __shfl(rr[1][r] + o1[r], lane & 48), fl = __expf(-(bcr[r] + fmaxf(m_old, cmr[r])));
                    const float hv = (rr[0][r] + o0[r]) * __builtin_amdgcn_rcpf(fmaxf(fabsf(den), fl));
                    hbuf[(row0 + c * 64 + 16 * ti + 4 * g + r) * 1024 + hh * 256 + e0 + l15] = hv;
                }
            }
        }
#undef ML_LOAD
    }
}


__device__ __forceinline__ void phase_mlstm_scan(const Args& A, unsigned char* lds) {
    const int tid = threadIdx.x, lane = tid & 63, w = tid >> 6, g = lane >> 4, l15 = lane & 15;
    unsigned char* KSB = lds; unsigned char* WVB = lds + 2 * 33792;
    const bf16_t* proj = (const bf16_t*)(A.ws + WS_PROJ); const float* gates = (const float*)(A.ws + WS_GATES);
    float* TBC = (float*)(lds + 131088); float* TUV = TBC + 2048; float* TCM = TUV + 2048;
    for (int item = blockIdx.x; item < 256; item += gridDim.x) {
        const int xcd = item & 7, idx = item >> 3; const int bh = xcd * 2 + (idx >> 4), es = idx & 15;
        const int b = bh >> 2, hh = bh & 3, e0 = es * 16;
        const size_t row0 = (size_t)b * SEQ;
        __syncthreads();
        for (int i = tid; i < 15 * 72; i += 512) { ((bf16_t*)WVB)[17 * 72 + i] = 0; ((bf16_t*)(WVB + 4608))[17 * 72 + i] = 0; }
        f32x4 Cst[2][2];
#pragma unroll
        for (int x = 0; x < 2; ++x)
#pragma unroll
            for (int et = 0; et < 2; ++et) Cst[x][et] = (f32x4){0.f, 0.f, 0.f, 0.f};
        float m_state = 0.f;
        u32x4 kA[4], kB[4], kC[4], kD[4]; unsigned vA, vB, vC, vD;
        const bf16_t* qbase = proj + row0 * NP + 3072 + hh * 256;
#define SC_LOAD(c, KR, VR) do { _Pragma("unroll") for (int i = 0; i < 4; ++i) { const int p = tid + 512 * i, r = p >> 5, c16 = p & 31; KR[i] = *(const u32x4*)(qbase + (size_t)((c) * 64 + r) * NP + 1024 + c16 * 8); } \
            VR = *(const unsigned*)(qbase + (size_t)((c) * 64 + (tid >> 3)) * NP + 2048 + e0 + (tid & 7) * 2); } while (0)
        SC_LOAD(0, kA, vA); SC_LOAD(1, kB, vB); SC_LOAD(2, kC, vC);
#pragma unroll 1
        for (int cc = 4 * w; cc < 4 * w + 4; ++cc) {
            const float* gp = gates + (row0 + cc * 64 + lane) * 8 + hh; const float gi = gp[0], gf = gp[4];
            const float lf = fminf(gf, 0.f) - log1pf(__expf(-fabsf(gf)));
            float bc = lf;
#pragma unroll
            for (int off = 1; off < 64; off <<= 1) { const float t = __shfl_up(bc, off); if (lane >= off) bc += t; }
            const float uv = gi - bc;
            float cm = uv;
#pragma unroll
            for (int off = 1; off < 64; off <<= 1) { const float t = __shfl_up(cm, off); if (lane >= off) cm = fmaxf(cm, t); }
            TBC[cc * 64 + lane] = bc; TUV[cc * 64 + lane] = uv; TCM[cc * 64 + lane] = cm;
        }
        __syncthreads();
        if (es == 0) { float* tab = (float*)(A.ws + WS_TAB) + (size_t)bh * 3 * 2048;
            for (int i = tid; i < 2048; i += 512) { tab[i] = TBC[i]; tab[2048 + i] = TUV[i]; tab[4096 + i] = TCM[i]; } }
        unsigned char* gc = A.ws + (bh < 8 ? WS_GCLO : WS_GCHI) + (size_t)((bh & 7) * 32) * 131072;
        bf16_t* nv = (bf16_t*)(A.ws + WS_NV) + (size_t)bh * 32 * 256;
        float* mst = (float*)(A.ws + WS_MST) + bh * 32;
#define SC_STEP(c, KU, VU, KL, VL) do { \
            const float* tbc = TBC + (c) * 64; const float* tuv = TUV + (c) * 64; const float* tcm = TCM + (c) * 64; \
            unsigned char* KS = KSB + ((c) & 1) * 33792; unsigned char* WVT = WVB + ((c) & 1) * 4608; \
            const float g_tot = tbc[63], cm63 = tcm[63]; \
            const float M63 = fmaxf(m_state, cm63), decay = __expf(m_state - M63); \
            if (es == 0 && tid == 0) mst[(c)] = m_state; \
            m_state = g_tot + M63; \
            _Pragma("unroll") for (int i = 0; i < 4; ++i) { const int p = tid + 512 * i, r = p >> 5, c16 = p & 31; *(u32x4*)(KS + r * 528 + c16 * 16) = KU[i]; } \
            { const int s = tid >> 3, ep = tid & 7; const float wv = __expf(tuv[s] - M63); \
              ((bf16_t*)WVT)[(2 * ep) * 72 + s] = f2bf(bflo(VU) * wv); ((bf16_t*)WVT)[(2 * ep + 1) * 72 + s] = f2bf(bfhi(VU) * wv); \
              if (ep == 0) ((bf16_t*)WVT)[16 * 72 + s] = f2bf(wv); } \
            if ((c) + 3 < 32) SC_LOAD((c) + 3, KL, VL); \
            _Pragma("unroll") for (int x = 0; x < 2; ++x) { const int dt = 2 * w + x; \
                u32x2 o; o.x = cvt_pk_bf16(Cst[x][0][0], Cst[x][0][1]); o.y = cvt_pk_bf16(Cst[x][0][2], Cst[x][0][3]); \
                *(u32x2*)(gc + (size_t)(c) * 131072 + (e0 + l15) * 512 + (16 * dt + 4 * g) * 2) = o; \
                if (es == 0 && l15 == 0) { u32x2 n2; n2.x = cvt_pk_bf16(Cst[x][1][0], Cst[x][1][1]); n2.y = cvt_pk_bf16(Cst[x][1][2], Cst[x][1][3]); *(u32x2*)(nv + (c) * 256 + 16 * dt + 4 * g) = n2; } } \
            __syncthreads(); \
            _Pragma("unroll") for (int x = 0; x < 2; ++x) { const int dt = 2 * w + x; \
                _Pragma("unroll") for (int et = 0; et < 2; ++et) Cst[x][et] *= decay; \
                _Pragma("unroll") for (int ks = 0; ks < 2; ++ks) { \
                    const s16x4 klo = __builtin_amdgcn_ds_read_tr16_b64_v4i16((LAS s16x4*)(KS + (32 * ks + 8 * g + (l15 >> 2)) * 528 + (16 * dt + 4 * (l15 & 3)) * 2)); \
                    const s16x4 khi = __builtin_amdgcn_ds_read_tr16_b64_v4i16((LAS s16x4*)(KS + (32 * ks + 8 * g + 4 + (l15 >> 2)) * 528 + (16 * dt + 4 * (l15 & 3)) * 2)); \
                    const bf16x8 ka = {klo[0], klo[1], klo[2], klo[3], khi[0], khi[1], khi[2], khi[3]}; \
                    _Pragma("unroll") for (int et = 0; et < 2; ++et) { const bf16x8 wvb = *(const bf16x8*)(WVT + (16 * et + l15) * 144 + (32 * ks + 8 * g) * 2); \
                        Cst[x][et] = __builtin_amdgcn_mfma_f32_16x16x32_bf16(ka, wvb, Cst[x][et], 0, 0, 0); } } } \
        } while (0)
#pragma unroll 1
        for (int c4 = 0; c4 < 32; c4 += 4) {
            SC_STEP(c4 + 0, kA, vA, kD, vD);
            SC_STEP(c4 + 1, kB, vB, kA, vA);
            SC_STEP(c4 + 2, kC, vC, kB, vB);
            SC_STEP(c4 + 3, kD, vD, kC, vC);
        }
#undef SC_STEP
#undef SC_LOAD
    }
}

__device__ __forceinline__ void phase_mlstm_out(const Args& A, unsigned char* lds, float* hbuf) {
    const int tid = threadIdx.x, lane = tid & 63, w = tid >> 6, g = lane >> 4, l15 = lane & 15;
    const int a = w >> 2, ti = w & 3;
    unsigned char* QS = lds; unsigned char* KS = lds + 33792; unsigned char* VS = lds + 67584; unsigned char* PI = lds + 101376;
    float* DEN = (float*)(lds + 110592); float* TB = DEN + 64;
    float* HT = (float*)lds;
    const bf16_t* proj = (const bf16_t*)(A.ws + WS_PROJ);
    for (int it = blockIdx.x; it < 512; it += gridDim.x) {
        const int bh = it >> 5, c = it & 31, b = bh >> 2, hh = bh & 3;
        const size_t row0 = (size_t)b * SEQ + c * 64;
        const bf16_t* qbase = proj + row0 * NP + 3072 + hh * 256;
        const unsigned char* gc = A.ws + (bh < 8 ? WS_GCLO : WS_GCHI) + (size_t)((bh & 7) * 32 + c) * 131072;
        const bf16_t* nv = (const bf16_t*)(A.ws + WS_NV) + (size_t)(bh * 32 + c) * 256;
        const float* tab = (const float*)(A.ws + WS_TAB) + (size_t)bh * 3 * 2048 + c * 64;
        const float m_c = ((const float*)(A.ws + WS_MST))[bh * 32 + c];
        __syncthreads();
        { u32x4 qv[4], kv[4], vv[4];
#pragma unroll
          for (int i = 0; i < 4; ++i) { const int p = tid + 512 * i, r = p >> 5, c16 = p & 31; const bf16_t* rp = qbase + (size_t)r * NP + c16 * 8; qv[i] = *(const u32x4*)rp; kv[i] = *(const u32x4*)(rp + 1024); vv[i] = *(const u32x4*)(rp + 2048); }
#pragma unroll
          for (int i = 0; i < 4; ++i) { const int p = tid + 512 * i, r = p >> 5, c16 = p & 31; *(u32x4*)(QS + r * 528 + c16 * 16) = qv[i]; *(u32x4*)(KS + r * 528 + c16 * 16) = kv[i]; *(u32x4*)(VS + r * 528 + c16 * 16) = vv[i]; } }
        if (tid < 192) TB[tid] = tab[(tid >> 6) * 2048 + (tid & 63)];
        __syncthreads();
        const float* tbc = TB; const float* tuv = TB + 64; const float* tcm = TB + 128;
        {
            f32x4 S0 = (f32x4){0.f, 0.f, 0.f, 0.f}, S1 = S0;
#pragma unroll
            for (int kk = 0; kk < 8; ++kk) {
                const int ko = kk * 64 + g * 16;
                const bf16x8 qf = *(const bf16x8*)(QS + (16 * ti + l15) * 528 + ko);
                const bf16x8 kf0 = *(const bf16x8*)(KS + (32 * a + l15) * 528 + ko), kf1 = *(const bf16x8*)(KS + (32 * a + 16 + l15) * 528 + ko);
                S0 = __builtin_amdgcn_mfma_f32_16x16x32_bf16(kf0, qf, S0, 0, 0, 0); S1 = __builtin_amdgcn_mfma_f32_16x16x32_bf16(kf1, qf, S1, 0, 0, 0);
            }
            const int tcol = 16 * ti + l15;
            const float Mt = fmaxf(m_c, tcm[tcol]);
            const f32x4 u0v = *(const f32x4*)(tuv + 32 * a + 4 * g), u1v = *(const f32x4*)(tuv + 32 * a + 16 + 4 * g);
            float p[8];
#pragma unroll
            for (int r = 0; r < 4; ++r) { const int s0 = 32 * a + 4 * g + r, s1 = s0 + 16;
                p[r] = (s0 <= tcol) ? S0[r] * 0.0625f * __expf(u0v[r] - Mt) : 0.f; p[4 + r] = (s1 <= tcol) ? S1[r] * 0.0625f * __expf(u1v[r] - Mt) : 0.f; }
            u32x2 plo, phi; plo.x = cvt_pk_bf16(p[0], p[1]); plo.y = cvt_pk_bf16(p[2], p[3]); phi.x = cvt_pk_bf16(p[4], p[5]); phi.y = cvt_pk_bf16(p[6], p[7]);
            *(u32x2*)(PI + tcol * 144 + (32 * a + 4 * g) * 2) = plo; *(u32x2*)(PI + tcol * 144 + (32 * a + 16 + 4 * g) * 2) = phi;
        }
        __syncthreads();
        f32x4 acc[4][2], inr[4][2];
#pragma unroll
        for (int tt = 0; tt < 4; ++tt)
#pragma unroll
            for (int x = 0; x < 2; ++x) { acc[tt][x] = (f32x4){0.f, 0.f, 0.f, 0.f}; inr[tt][x] = (f32x4){0.f, 0.f, 0.f, 0.f}; }
#pragma unroll
        for (int ks = 0; ks < 2; ++ks) {
            bf16x8 vb[2];
#pragma unroll
            for (int x = 0; x < 2; ++x) { const int et = 2 * w + x;
                const s16x4 vlo = __builtin_amdgcn_ds_read_tr16_b64_v4i16((LAS s16x4*)(VS + (32 * ks + 8 * g + (l15 >> 2)) * 528 + (16 * et + 4 * (l15 & 3)) * 2));
                const s16x4 vhi = __builtin_amdgcn_ds_read_tr16_b64_v4i16((LAS s16x4*)(VS + (32 * ks + 8 * g + 4 + (l15 >> 2)) * 528 + (16 * et + 4 * (l15 & 3)) * 2));
                vb[x] = (bf16x8){vlo[0], vlo[1], vlo[2], vlo[3], vhi[0], vhi[1], vhi[2], vhi[3]}; }
#pragma unroll
            for (int tt = 0; tt < 4; ++tt) { const bf16x8 pa = *(const bf16x8*)(PI + (16 * tt + l15) * 144 + (32 * ks + 8 * g) * 2);
                acc[tt][0] = __builtin_amdgcn_mfma_f32_16x16x32_bf16(pa, vb[0], acc[tt][0], 0, 0, 0); acc[tt][1] = __builtin_amdgcn_mfma_f32_16x16x32_bf16(pa, vb[1], acc[tt][1], 0, 0, 0); }
        }
#pragma unroll
        for (int kk = 0; kk < 8; ++kk) {
            const bf16x8 cb0 = *(const bf16x8*)(gc + (size_t)((16 * (2 * w) + l15) * 256 + 32 * kk + 8 * g) * 2), cb1 = *(const bf16x8*)(gc + (size_t)((16 * (2 * w + 1) + l15) * 256 + 32 * kk + 8 * g) * 2);
#pragma unroll
            for (int tt = 0; tt < 4; ++tt) { const bf16x8 qa = *(const bf16x8*)(QS + (16 * tt + l15) * 528 + (32 * kk + 8 * g) * 2);
                inr[tt][0] = __builtin_amdgcn_mfma_f32_16x16x32_bf16(qa, cb0, inr[tt][0], 0, 0, 0); inr[tt][1] = __builtin_amdgcn_mfma_f32_16x16x32_bf16(qa, cb1, inr[tt][1], 0, 0, 0); }
        }
        if (w < 4) {
            f32x4 di = (f32x4){0.f, 0.f, 0.f, 0.f}, dn = di;
            const unsigned one2 = (l15 == 0) ? 0x3F803F80u : 0u;
            u32x4 ou; ou.x = one2; ou.y = one2; ou.z = one2; ou.w = one2;
            const bf16x8 onesf = __builtin_bit_cast(bf16x8, ou);
#pragma unroll
            for (int ks = 0; ks < 2; ++ks) { const bf16x8 pa = *(const bf16x8*)(PI + (16 * w + l15) * 144 + (32 * ks + 8 * g) * 2); di = __builtin_amdgcn_mfma_f32_16x16x32_bf16(pa, onesf, di, 0, 0, 0); }
#pragma unroll
            for (int kk = 0; kk < 8; ++kk) { u32x4 nu = *(const u32x4*)(nv + 32 * kk + 8 * g); if (l15 != 0) nu = (u32x4){0u, 0u, 0u, 0u};
                const bf16x8 qa = *(const bf16x8*)(QS + (16 * w + l15) * 528 + (32 * kk + 8 * g) * 2);
                dn = __builtin_amdgcn_mfma_f32_16x16x32_bf16(qa, __builtin_bit_cast(bf16x8, nu), dn, 0, 0, 0); }
            if (l15 == 0) {
#pragma unroll
                for (int r = 0; r < 4; ++r) { const int t = 16 * w + 4 * g + r; const float iw = __expf(m_c - fmaxf(m_c, tcm[t])) * 0.0625f; DEN[t] = di[r] + dn[r] * iw; } }
        }
        __syncthreads();
#pragma unroll
        for (int tt = 0; tt < 4; ++tt) {
            const f32x4 cmr = *(const f32x4*)(tcm + 16 * tt + 4 * g), bcr = *(const f32x4*)(tbc + 16 * tt + 4 * g), dnr = *(const f32x4*)(DEN + 16 * tt + 4 * g);
#pragma unroll
            for (int r = 0; r < 4; ++r) {
                const float Mx = fmaxf(m_c, cmr[r]), iw = __expf(m_c - Mx) * 0.0625f, fl = __expf(-(bcr[r] + Mx));
                const float rden = __builtin_amdgcn_rcpf(fmaxf(fabsf(dnr[r]), fl));
                float* hp = HT + (16 * tt + 4 * g + r) * 260 + 32 * w + l15;
                hp[0] = (acc[tt][0][r] + inr[tt][0][r] * iw) * rden; hp[16] = (acc[tt][1][r] + inr[tt][1][r] * iw) * rden;
            }
        }
        __syncthreads();
        {
            const f32x4 gn = *(const f32x4*)(A.mh_gain + hh * 256 + lane * 4);
            bf16_t* y = (bf16_t*)(A.ws + WS_Y);
#pragma unroll
            for (int hb = 0; hb < 2; ++hb) {
                f32x4 hv[4]; u32x2 ov[4]; float sm[4], sq[4];
#pragma unroll
                for (int i = 0; i < 4; ++i) { const int rl = 8 * w + 4 * hb + i; hv[i] = *(const f32x4*)(HT + rl * 260 + lane * 4); ov[i] = *(const u32x2*)(proj + (row0 + rl) * NP + 6144 + hh * 256 + lane * 4); }
#pragma unroll
                for (int i = 0; i < 4; ++i) sm[i] = (hv[i][0] + hv[i][1]) + (hv[i][2] + hv[i][3]);
#pragma unroll
                for (int off = 32; off >= 1; off >>= 1)
#pragma unroll
                    for (int i = 0; i < 4; ++i) sm[i] += __shfl_xor(sm[i], off);
#pragma unroll
                for (int i = 0; i < 4; ++i) { const float mu = sm[i] * (1.0f / 256.0f); hv[i] = hv[i] - mu; sq[i] = (hv[i][0] * hv[i][0] + hv[i][1] * hv[i][1]) + (hv[i][2] * hv[i][2] + hv[i][3] * hv[i][3]); }
#pragma unroll
                for (int off = 32; off >= 1; off >>= 1)
#pragma unroll
                    for (int i = 0; i < 4; ++i) sq[i] += __shfl_xor(sq[i], off);
#pragma unroll
                for (int i = 0; i < 4; ++i) { const int rl = 8 * w + 4 * hb + i;
                    const float rstd = rsqrtf(sq[i] * (1.0f / 256.0f) + 1e-6f);
                    const float o0 = bflo(ov[i].x), o1 = bfhi(ov[i].x), o2 = bflo(ov[i].y), o3 = bfhi(ov[i].y);
                    const float y0 = hv[i][0] * rstd * gn[0] * __builtin_amdgcn_rcpf(1.0f + __expf(-o0)), y1 = hv[i][1] * rstd * gn[1] * __builtin_amdgcn_rcpf(1.0f + __expf(-o1));
                    const float y2 = hv[i][2] * rstd * gn[2] * __builtin_amdgcn_rcpf(1.0f + __expf(-o2)), y3 = hv[i][3] * rstd * gn[3] * __builtin_amdgcn_rcpf(1.0f + __expf(-o3));
                    u32x2 o; o.x = cvt_pk_bf16(y0, y1); o.y = cvt_pk_bf16(y2, y3);
                    *(u32x2*)(y + (row0 + rl) * DM + WCONV + hh * 256 + lane * 4) = o; }
            }
        }
    }
}

__device__ __forceinline__ void phase_headnorm(const Args& A, const float* hbuf) {
    const bf16_t* proj = (const bf16_t*)(A.ws + WS_PROJ); bf16_t* y = (bf16_t*)(A.ws + WS_Y);
    const int lane = threadIdx.x & 63, gw = blockIdx.x * 8 + (threadIdx.x >> 6), nw = gridDim.x * 8;
    f32x4 gn[4];
#pragma unroll
    for (int hh = 0; hh < 4; ++hh) gn[hh] = *(const f32x4*)(A.mh_gain + hh * 256 + lane * 4);
    for (int row = gw; row < MT; row += nw) {
        f32x4 hv[4]; u32x2 ov[4]; float s[4], q[4];
#pragma unroll
        for (int hh = 0; hh < 4; ++hh) { hv[hh] = *(const f32x4*)(hbuf + (size_t)row * 1024 + hh * 256 + lane * 4); ov[hh] = *(const u32x2*)(proj + (size_t)row * NP + 6144 + hh * 256 + lane * 4); }
#pragma unroll
        for (int hh = 0; hh < 4; ++hh) s[hh] = (hv[hh][0] + hv[hh][1]) + (hv[hh][2] + hv[hh][3]);
#pragma unroll
        for (int off = 32; off >= 1; off >>= 1)
#pragma unroll
            for (int hh = 0; hh < 4; ++hh) s[hh] += __shfl_xor(s[hh], off);
#pragma unroll
        for (int hh = 0; hh < 4; ++hh) { const float mu = s[hh] * (1.0f / 256.0f); hv[hh] = hv[hh] - mu; q[hh] = (hv[hh][0] * hv[hh][0] + hv[hh][1] * hv[hh][1]) + (hv[hh][2] * hv[hh][2] + hv[hh][3] * hv[hh][3]); }
#pragma unroll
        for (int off = 32; off >= 1; off >>= 1)
#pragma unroll
            for (int hh = 0; hh < 4; ++hh) q[hh] += __shfl_xor(q[hh], off);
#pragma unroll
        for (int hh = 0; hh < 4; ++hh) {
            const float rstd = rsqrtf(q[hh] * (1.0f / 256.0f) + 1e-6f);
            const float o0 = bflo(ov[hh].x), o1 = bfhi(ov[hh].x), o2 = bflo(ov[hh].y), o3 = bfhi(ov[hh].y);
            const float y0 = hv[hh][0] * rstd * gn[hh][0] * __builtin_amdgcn_rcpf(1.0f + __expf(-o0)), y1 = hv[hh][1] * rstd * gn[hh][1] * __builtin_amdgcn_rcpf(1.0f + __expf(-o1));
            const float y2 = hv[hh][2] * rstd * gn[hh][2] * __builtin_amdgcn_rcpf(1.0f + __expf(-o2)), y3 = hv[hh][3] * rstd * gn[hh][3] * __builtin_amdgcn_rcpf(1.0f + __expf(-o3));
            u32x2 o; o.x = cvt_pk_bf16(y0, y1); o.y = cvt_pk_bf16(y2, y3);
            *(u32x2*)(y + (size_t)row * DM + WCONV + hh * 256 + lane * 4) = o;
        }
    }
}

__device__ __forceinline__ void phase_ln(float* io, const float* gam, const float* bet, bf16_t* ob) {
    const int lane = threadIdx.x & 63, gw = blockIdx.x * 8 + (threadIdx.x >> 6), nw = gridDim.x * 8;
    for (int row = gw; row < MT; row += nw) {
        float* rp = io + (size_t)row * DM;
        f32x4 v[8]; float s = 0.f;
#pragma unroll
        for (int i = 0; i < 8; ++i) { v[i] = *(const f32x4*)(rp + i * 256 + lane * 4); s += (v[i][0] + v[i][1]) + (v[i][2] + v[i][3]); }
#pragma unroll
        for (int off = 32; off >= 1; off >>= 1) s += __shfl_xor(s, off);
        const float mu = s * (1.0f / DM);
        float q = 0.f;
#pragma unroll
        for (int i = 0; i < 8; ++i) { v[i] = v[i] - mu; q += (v[i][0] * v[i][0] + v[i][1] * v[i][1]) + (v[i][2] * v[i][2] + v[i][3] * v[i][3]); }
#pragma unroll
        for (int off = 32; off >= 1; off >>= 1) q += __shfl_xor(q, off);
        const float rstd = rsqrtf(q * (1.0f / DM) + 1e-5f);
#pragma unroll
        for (int i = 0; i < 8; ++i) { const f32x4 gg = *(const f32x4*)(gam + i * 256 + lane * 4), bb = *(const f32x4*)(bet + i * 256 + lane * 4);
            const f32x4 o = v[i] * rstd * gg + bb;
            *(f32x4*)(rp + i * 256 + lane * 4) = o;
            if (ob) { u32x2 p; p.x = cvt_pk_bf16(o[0], o[1]); p.y = cvt_pk_bf16(o[2], o[3]); *(u32x2*)(ob + (size_t)row * DM + i * 256 + lane * 4) = p; } }
    }
}

__device__ __forceinline__ void phase_fixup(const Args& A) {
    const float* halo = (const float*)(A.ws + WS_HALO); bf16_t* act = (bf16_t*)(A.ws + WS_ACT);
    for (int idx = blockIdx.x * 512 + threadIdx.x; idx < 64 * 2 * (DFF / 4); idx += gridDim.x * 512) {
        const int f = (idx % (DFF / 4)) * 4, br = idx / (DFF / 4), rr = br & 1, B = br >> 1;
        const bool first = (B & 15) == 0;
        const float* hc = halo + (size_t)B * 4 * NUP; const float* hp = hc - 4 * NUP;
        f32x4 hv[2];
#pragma unroll
        for (int bj = 0; bj < 2; ++bj) {
            const int col = bj * DFF + f;
            const f32x4 cur = *(const f32x4*)(hc + (size_t)(2 + rr) * NUP + col);
            f32x4 p1, p2; const f32x4 z = (f32x4){0.f, 0.f, 0.f, 0.f};
            if (rr == 0) { p1 = first ? z : *(const f32x4*)(hp + (size_t)1 * NUP + col); p2 = first ? z : *(const f32x4*)(hp + col); }
            else { p1 = *(const f32x4*)(hc + (size_t)2 * NUP + col); p2 = first ? z : *(const f32x4*)(hp + (size_t)1 * NUP + col); }
            const f32x4 w0 = *(const f32x4*)(A.w_fc + col), w1 = *(const f32x4*)(A.w_fc + NUP + col), w2 = *(const f32x4*)(A.w_fc + 2 * NUP + col), bb = *(const f32x4*)(A.b_fc + col);
            hv[bj] = w2 * cur + w1 * p1 + w0 * p2 + bb;
        }
        float av[4];
#pragma unroll
        for (int j = 0; j < 4; ++j) { const float gt = hv[1][j]; av[j] = hv[0][j] * gt / (1.0f + __expf(-gt)); }
        u32x2 o; o.x = cvt_pk_bf16(av[0], av[1]); o.y = cvt_pk_bf16(av[2], av[3]);
        *(u32x2*)(act + (size_t)(B * 128 + rr) * DFF + f) = o;
    }
}

__device__ __forceinline__ void phase_dump(const bf16_t* src, int ld, int c0, float* out) {
    for (size_t idx = (size_t)blockIdx.x * 512 + threadIdx.x; idx < (size_t)MT * DM; idx += (size_t)gridDim.x * 512) {
        const size_t row = idx / DM, col = idx % DM; out[idx] = bflo((unsigned)src[row * ld + c0 + col]); }
}
#ifndef DBG_STOP
#define DBG_STOP -1
#endif
#define XB_TMO      128
#define XB_XCNT(j)  (256  + 64 * (j))
#define XB_XSUB(j)  (1280 + 64 * (j))
#define XB_XGEN(j)  (2304 + 64 * (j))
#define XB_TOP      3328
#define XB_TOPGEN   3392
#define XCD_BAR_WORDS 3456
#define XB_SPIN_CAP (1u << 22)
__device__ __forceinline__ unsigned xb_ld(unsigned* p)              { return __hip_atomic_load(p, __ATOMIC_RELAXED, __HIP_MEMORY_SCOPE_AGENT); }
__device__ __forceinline__ unsigned xb_add(unsigned* p, unsigned v) { return __hip_atomic_fetch_add(p, v, __ATOMIC_RELAXED, __HIP_MEMORY_SCOPE_AGENT); }
__device__ __forceinline__ unsigned xb_xcc_id() { return (unsigned)__builtin_amdgcn_s_getreg((3 << 11) | 20) & 0xFu; }
#define XB_SPIN(cond, bar) do { unsigned _sp = 0; while (cond) { __builtin_amdgcn_s_sleep(1); \
    if ((++_sp & 255u) == 0u) { if (xb_ld(&(bar)[XB_TMO])) break; if (_sp > XB_SPIN_CAP) { atomicAdd(&(bar)[XB_TMO], 1u); break; } } } } while (0)
struct XcdBarrier { unsigned* bar; unsigned x; volatile LAS unsigned* st; };
__device__ __forceinline__ XcdBarrier xcd_barrier_post(unsigned* bar, volatile LAS unsigned* st) {
    XcdBarrier b; b.bar = bar; b.x = xb_xcc_id(); b.st = st;
    if (threadIdx.x == 0) (void)xb_add(&bar[XB_XCNT(b.x)], 1u);
    return b;
}
__device__ __forceinline__ void xcd_barrier_complete(unsigned* bar, unsigned x, unsigned& nloc, unsigned& nx) {
    const unsigned G = gridDim.x * gridDim.y * gridDim.z;
    unsigned sum, cnt, mine, sp = 0u;
    for (;;) {
        sum = 0u; cnt = 0u; mine = 0u;
#pragma unroll
        for (unsigned j = 0; j < 16; ++j) { const unsigned c = xb_ld(&bar[XB_XCNT(j)]); sum += c; cnt += (c > 0u) ? 1u : 0u; mine = (j == x) ? c : mine; }
        if (sum == G) break;
        __builtin_amdgcn_s_sleep(1);
        if ((++sp & 255u) == 0u) { if (xb_ld(&bar[XB_TMO])) break; if (sp > XB_SPIN_CAP) { atomicAdd(&bar[XB_TMO], 1u); break; } }
    }
    nloc = mine > 0u ? mine : 1u; nx = cnt > 0u ? cnt : 1u;
}
__device__ __forceinline__ void xcd_barrier(const XcdBarrier& b) {
    asm volatile("s_waitcnt vmcnt(0)" ::: "memory");
    __syncthreads();
    if (threadIdx.x == 0) {
        unsigned* bar = b.bar;
        __builtin_amdgcn_s_waitcnt(0);
        unsigned nloc = b.st[0], nx = b.st[1];
        if (nloc == 0u) { xcd_barrier_complete(bar, b.x, nloc, nx); b.st[0] = nloc; b.st[1] = nx; }
        const unsigned old = xb_add(&bar[XB_XSUB(b.x)], 1u);
        const unsigned gen = old / nloc;
        if (old + 1u == (gen + 1u) * nloc) {
            __builtin_amdgcn_fence(__ATOMIC_RELEASE, "agent");
            asm volatile("s_waitcnt vmcnt(0)" ::: "memory");
            const unsigned og = xb_add(&bar[XB_TOP], 1u);
            const unsigned tg = og / nx;
            if (og + 1u == (tg + 1u) * nx) xb_add(&bar[XB_TOPGEN], 1u);
            else XB_SPIN(xb_ld(&bar[XB_TOPGEN]) == tg, bar);
            __builtin_amdgcn_fence(__ATOMIC_ACQUIRE, "agent");
            xb_add(&bar[XB_XGEN(b.x)], 1u);
            asm volatile("s_waitcnt vmcnt(0)" ::: "memory");
        } else {
            XB_SPIN(xb_ld(&bar[XB_XGEN(b.x)]) == gen, bar);
            __builtin_amdgcn_fence(__ATOMIC_ACQUIRE, "agent");
            asm volatile("s_waitcnt vmcnt(0)" ::: "memory");
        }
    }
    __syncthreads();
}

constexpr int N_PHASES = 10;
#ifndef ONLY_PH
#define ONLY_PH -1
#endif
#define PH_ON(x) (ONLY_PH < 0 || ONLY_PH == (x))
__global__ void __launch_bounds__(512, 2) mega(Args a) {
    extern __shared__ __attribute__((aligned(16))) unsigned char lds[];
    cg::grid_group grid = cg::this_grid();
    unsigned char* ws = a.ws;
#define PH_RUN(x) (PH_ON(x) && a.ph_lo <= (x) && (x) < a.ph_hi)
#define PH_SYNC(x) do { if (a.ph_lo <= (x) && (x) + 1 < a.ph_hi) xcd_barrier(xb); } while (0)
    volatile LAS unsigned* xst = (volatile LAS unsigned*)((LAS unsigned char*)lds + 131072);
    if (threadIdx.x == 0) { xst[0] = 0u; xst[1] = 0u; }
    __syncthreads();
    const XcdBarrier xb = xcd_barrier_post((unsigned*)(ws + WS_BAR), xst);
    if (a.ph_hi > 1000) grid.sync();
#ifndef REP0
#define REP0 1
#endif
#ifndef REP2
#define REP2 1
#endif
#ifndef REP6
#define REP6 1
#endif
    if (PH_RUN(0)) for (int rep = 0; rep < REP0; ++rep) phase_prologue(a, lds);
    PH_SYNC(0);
    if (PH_RUN(1)) { pg8::Gemm g{(const bf16_t*)(ws + WS_XB), (const bf16_t*)(ws + WS_WIN), MT, NP, DM}; pg8::StaticOrder S; S.init(MT, NP, gridDim.x, blockIdx.x);
        pg8::EpiBf16 E{(bf16_t*)(ws + WS_PROJ), NP}; pg8::gemm_phase<pg8::EpiBf16, true>((LAS unsigned char*)lds, g, S, E);
        const int rem = ((MT / 256) * (NP / 256)) % (int)gridDim.x;
        if (rem == 0) phase_transposes(a, lds, TM_IN, TM_IN + TM_OUT + TM_UP, blockIdx.x, gridDim.x);
        else if ((int)blockIdx.x >= rem) phase_transposes(a, lds, TM_IN, TM_IN + TM_OUT + TM_UP, blockIdx.x - rem, gridDim.x - rem); }
    PH_SYNC(1);
    if (PH_RUN(2)) {
        phase_yconv(a);
        if (a.fuse_ln) { phase_mlstm_scan(a, lds); xcd_barrier(xb); phase_mlstm_out(a, lds, a.out); }
        else phase_mlstm(a, lds, a.out); }
    PH_SYNC(2);
    if (PH_RUN(3) && !a.fuse_ln) phase_headnorm(a, a.out);
    if (!a.fuse_ln) PH_SYNC(3);
    if (PH_RUN(4)) { pg8::Gemm g{(const bf16_t*)(ws + WS_Y), (const bf16_t*)(ws + WS_WOUT), MT, DM, DM}; pg8::StaticOrder S; S.init(MT, DM, gridDim.x, blockIdx.x);
        if (a.fuse_ln) { pg8::EpiResLn<false, false> E{a.x, nullptr, nullptr, (bf16_t*)(ws + WS_X1B), a.ln1_g, a.ln1_b, (float*)(ws + WS_RS1), (unsigned*)(ws + WS_CNT)}; pg8::gemm_phase((LAS unsigned char*)lds, g, S, E); }
        else { pg8::EpiResF32 E{a.x, a.out, DM}; pg8::gemm_phase((LAS unsigned char*)lds, g, S, E); } }
    PH_SYNC(4);
    if (PH_RUN(5) && !a.fuse_ln) phase_ln(a.out, a.ln1_g, a.ln1_b, (bf16_t*)(ws + WS_X1B));
    if (!a.fuse_ln) PH_SYNC(5);
    if (PH_RUN(6)) { pg8::Gemm g{(const bf16_t*)(ws + WS_X1B), (const bf16_t*)(ws + WS_WUP), MT, NUP, DM}; pg8::StaticOrder S; S.init(MT, NUP, gridDim.x, blockIdx.x);
        pg8::EpiConvFfn E{(bf16_t*)(ws + WS_ACT), (float*)(ws + WS_HALO), a.w_fc, a.b_fc}; pg8::gemm_phase<pg8::EpiConvFfn, true>((LAS unsigned char*)lds, g, S, E);
        const int rem = ((MT / 256) * (NUP / 256)) % (int)gridDim.x; const int t0 = TM_IN + TM_OUT + TM_UP, t1 = t0 + TM_DN;
        if (rem == 0) phase_transposes(a, lds, t0, t1, blockIdx.x, gridDim.x);
        else if ((int)blockIdx.x >= rem) phase_transposes(a, lds, t0, t1, blockIdx.x - rem, gridDim.x - rem); }
    PH_SYNC(6);
    if (PH_RUN(7)) phase_fixup(a);
    PH_SYNC(7);
    if (PH_RUN(8)) { pg8::Gemm g{(const bf16_t*)(ws + WS_ACT), (const bf16_t*)(ws + WS_WDN), MT, DM, DFF}; pg8::StaticOrder S; S.init(MT, DM, gridDim.x, blockIdx.x);
        if (a.fuse_ln) { pg8::EpiResLn<true, true> E{nullptr, (const bf16_t*)(ws + WS_X1B), a.out, nullptr, a.ln2_g, a.ln2_b, (float*)(ws + WS_RS2), (unsigned*)(ws + WS_CNT) + 32 * 64}; pg8::gemm_phase((LAS unsigned char*)lds, g, S, E); }
        else { pg8::EpiResF32 E{a.out, a.out, DM}; pg8::gemm_phase((LAS unsigned char*)lds, g, S, E); } }
    if (!a.fuse_ln) PH_SYNC(8);
    if (PH_RUN(9) && !a.fuse_ln) phase_ln(a.out, a.ln2_g, a.ln2_b, nullptr);
    if (DBG_STOP == 1 && a.ph_lo == 101) phase_dump((const bf16_t*)(ws + WS_PROJ), NP, 3072, a.out);
    if (DBG_STOP == 3 && a.ph_lo == 103) phase_dump((const bf16_t*)(ws + WS_Y), DM, 0, a.out);
    if (DBG_STOP == 7 && a.ph_lo == 107) phase_dump((const bf16_t*)(ws + WS_ACT), DFF, 0, a.out);
}

extern "C" void kernel_launch(void* const* d_in, const int* in_sizes, int n_in, void* d_out, int out_size, void* d_ws, size_t ws_size, hipStream_t stream) {
    static int grid = 0;
    if (grid == 0) {
        if (n_in != 14 || ws_size < WS_END) { fprintf(stderr, "kernel_launch: unexpected n_in %d / ws_size %zu (need %zu)\n", n_in, ws_size, (size_t)WS_END); grid = -1; return; }
        int dev = 0, cus = 0, per_cu = 0;
        hipGetDevice(&dev); hipDeviceGetAttribute(&cus, hipDeviceAttributeMultiprocessorCount, dev);
        if (hipFuncSetAttribute((const void*)mega, hipFuncAttributeMaxDynamicSharedMemorySize, LDS_BYTES) != hipSuccess) { fprintf(stderr, "kernel_launch: hipFuncSetAttribute failed\n"); grid = -1; return; }
        if (hipOccupancyMaxActiveBlocksPerMultiprocessor(&per_cu, (const void*)mega, 512, LDS_BYTES) != hipSuccess || per_cu < 1) { fprintf(stderr, "kernel_launch: occupancy query failed (%d)\n", per_cu); (void)hipGetLastError(); per_cu = 1; }
        grid = cus * 1;
        fprintf(stderr, "kernel_launch: cus %d per_cu %d grid %d\n", cus, per_cu, grid);
    }
    if (grid < 0) return;
    if (hipMemsetAsync((char*)d_ws + WS_BAR, 0, WS_END - WS_BAR, stream)     != hipSuccess) { fprintf(stderr, "kernel_launch: memset failed\n"); return; }
    Args a{};
    a.x = (const float*)d_in[0]; a.w_in = (const float*)d_in[1]; a.b_gates = (const float*)d_in[2]; a.w_sc = (const float*)d_in[3]; a.mh_gain = (const float*)d_in[4]; a.w_out = (const float*)d_in[5];
    a.ln1_g = (const float*)d_in[6]; a.ln1_b = (const float*)d_in[7]; a.w_up = (const float*)d_in[8]; a.w_fc = (const float*)d_in[9]; a.b_fc = (const float*)d_in[10]; a.w_down = (const float*)d_in[11];
    a.ln2_g = (const float*)d_in[12]; a.ln2_b = (const float*)d_in[13];
    a.out = (float*)d_out; a.ws = (unsigned char*)d_ws;
    a.fuse_ln = (MK_SINGLE && grid == 256) ? 1 : 0;
#if MK_SINGLE
    a.ph_lo = 0; a.ph_hi = N_PHASES;
    void* args[] = {&a};
    hipError_t e = hipLaunchCooperativeKernel((const void*)mega, dim3(grid), dim3(512), args, LDS_BYTES, stream);
    if (e != hipSuccess) fprintf(stderr, "cooperative launch failed: %s (grid %d)\n", hipGetErrorString(e), grid);
#else
    for (int ph = 0; ph < N_PHASES; ++ph) { if (DBG_STOP >= 0 && ph > DBG_STOP) break; a.ph_lo = ph; a.ph_hi = ph + 1; hipLaunchKernelGGL(mega, dim3(grid), dim3(512), LDS_BYTES, stream, a); }
    if (DBG_STOP >= 0) { a.ph_lo = 100 + DBG_STOP; a.ph_hi = 101 + DBG_STOP; hipLaunchKernelGGL(mega, dim3(grid), dim3(512), LDS_BYTES, stream, a); }
#endif
}
```

```cpp
#include <hip/hip_runtime.h>
#include <hip/hip_cooperative_groups.h>
#include <cstdio>
#include <cstdint>
namespace cg = cooperative_groups;

#ifndef MK_SINGLE
#define MK_SINGLE 1
#endif

#define LAS __attribute__((address_space(3)))
typedef unsigned short bf16_t;
typedef short bf16x8 __attribute__((ext_vector_type(8)));
typedef float f32x4 __attribute__((ext_vector_type(4)));
typedef unsigned u32x4 __attribute__((ext_vector_type(4)));
typedef unsigned u32x2 __attribute__((ext_vector_type(2)));
typedef short s16x4 __attribute__((ext_vector_type(4)));

constexpr int MT = 8192, DM = 2048, SEQ = 2048, NIN = 7176, NP = 7168, DFF = 5632, NUP = 11264, WCONV = 1024;
constexpr float ALPHA = 1.189207115002721f;
constexpr size_t WS_WIN = 0;
constexpr size_t WS_WOUT = WS_WIN + (size_t)NP * DM * 2;
constexpr size_t WS_WUP = WS_WOUT + (size_t)DM * DM * 2;
constexpr size_t WS_WDN = WS_WUP + (size_t)NUP * DM * 2;
constexpr size_t WS_X1B = WS_WDN + (size_t)DM * DFF * 2;
constexpr size_t WS_GATES = WS_X1B + (size_t)MT * DM * 2;
constexpr size_t WS_C = WS_GATES + (size_t)MT * 8 * 4;
constexpr size_t WS_PROJ = WS_C;
constexpr size_t WS_Y = WS_PROJ + (size_t)MT * NP * 2;
constexpr size_t WS_XB = WS_Y + (size_t)MT * DM * 2;
constexpr size_t WS_ACT = WS_C;
constexpr size_t WS_HALO = WS_ACT + (size_t)MT * DFF * 2;
constexpr size_t WS_BAR = WS_XB + (size_t)MT * DM * 2;
constexpr size_t WS_RS1 = WS_BAR + 16384;
constexpr size_t WS_RS2 = WS_RS1 + (size_t)MT * 8;
constexpr size_t WS_CNT = WS_RS2 + (size_t)MT * 8;
constexpr size_t WS_END = WS_CNT + 2 * 32 * 256;
constexpr size_t WS_GCLO = WS_X1B, WS_GCHI = WS_XB;
constexpr size_t WS_NV = 0;
constexpr size_t WS_TAB = WS_NV + (size_t)512 * 256 * 2;
constexpr size_t WS_MST = WS_TAB + (size_t)16 * 3 * 2048 * 4;
constexpr int LDS_BYTES = 131072 + 16 + 3 * 32 * 64 * 4;

struct Args {
    const float* x; const float* w_in; const float* b_gates; const float* w_sc; const float* mh_gain; const float* w_out;
    const float* ln1_g; const float* ln1_b; const float* w_up; const float* w_fc; const float* b_fc; const float* w_down;
    const float* ln2_g; const float* ln2_b;
    float* out; unsigned char* ws; int ph_lo, ph_hi, fuse_ln, pad0;
};

typedef __bf16 bf16v2 __attribute__((ext_vector_type(2)));
typedef float f32x2 __attribute__((ext_vector_type(2)));
__device__ __forceinline__ unsigned cvt_pk_bf16(float lo, float hi) { const f32x2 v = {lo, hi}; const bf16v2 r = __builtin_convertvector(v, bf16v2); return __builtin_bit_cast(unsigned, r); }
__device__ __forceinline__ unsigned cvt_pk_bf16_asm(float lo, float hi) { unsigned r; asm volatile("v_cvt_pk_bf16_f32 %0, %1, %2" : "=v"(r) : "v"(lo), "v"(hi)); return r; }
__device__ __forceinline__ float bflo(unsigned u) { return __uint_as_float(u << 16); }
__device__ __forceinline__ float bfhi(unsigned u) { return __uint_as_float(u & 0xffff0000u); }
__device__ __forceinline__ bf16_t f2bf(float f) { unsigned u = __float_as_uint(f); u += 0x7FFFu + ((u >> 16) & 1u); return (bf16_t)(u >> 16); }

namespace pg8 {
constexpr int BM = 256, BK = 64, HALF = 128, HTB = HALF * BK * 2, STAGE_BYTES = 8 * HTB, NXCD = 8, WGM = 8;
__host__ __device__ __forceinline__ int lds_byte(int r, int c) { const int st = (r >> 4) * 2 + (c >> 5), rr = r & 15, cc = c & 31, ob = rr * 64 + cc * 2; return st * 1024 + (ob ^ (((ob >> 9) & 1) << 5)); }
__host__ __device__ __forceinline__ void stage_rc(int b, int& R, int& C) { const int st = b / 1024, sb = b % 1024, swz = sb ^ (((sb >> 9) & 1) << 5); R = (st >> 1) * 16 + swz / 64; C = (st & 1) * 32 + (swz % 64) / 2; }
__host__ __device__ __forceinline__ int perm32(int rho) { const int n = rho >> 4, i = rho & 15; return 8 * (i >> 2) + 4 * n + (i & 3); }
struct Unit { int pm, pn; };
struct Gemm { const bf16_t* A; const bf16_t* Bt; int M, N, K; };
struct StaticOrder {
    int nM, nN, nwg, G, c;
    __device__ void init(int M, int N, int G_, int c_) { nM = M / BM; nN = N / BM; nwg = nM * nN; G = G_; c = c_; }
    __device__ bool next(int i, Unit& u) const {
        const long L = (long)i * G + c; if (L >= nwg) return false;
        int wgid = (int)L; { const int q = nwg / NXCD, r = nwg % NXCD, xcd = wgid % NXCD, off = wgid / NXCD; wgid = (xcd < r ? xcd * (q + 1) : r * (q + 1) + (xcd - r) * q) + off; }
        const int nig = WGM * nN, gid = wgid / nig, fm = gid * WGM, gsz = (nM - fm) < WGM ? (nM - fm) : WGM;
        u.pm = fm + ((wgid % nig) % gsz); u.pn = (wgid % nig) / gsz; return true;
    }
};

template <class Epi, bool ALIGN_EPI = false, bool SP2 = true>
__device__ __forceinline__ void gemm_phase(LAS unsigned char* lds, const Gemm g, const StaticOrder& S, const Epi& E) {
    const int tid = threadIdx.x, wid = __builtin_amdgcn_readfirstlane(tid >> 6), lane = tid & 63, wr = wid >> 2, wc = wid & 3, fr = lane & 15, fq = lane >> 4;
    const int K = g.K, nt = K / BK;
    unsigned voffA[2], voffB[2];
#pragma unroll
    for (int i = 0; i < 2; ++i) { int R, C; stage_rc(tid * 16 + i * 8192, R, C); const int Rb = Epi::PERM ? ((R & ~31) + perm32(R & 31)) : R;
        const int Ra = Epi::AROWPERM ? (128 * (R >> 6) + 8 * (R & 15) + ((R >> 4) & 3)) : R;
        const int Rbb = Epi::BCOLPERM ? (64 * (R >> 5) + perm32(R & 31)) : Rb;
        voffA[i] = (unsigned)(Ra * K + C) * 2u; voffB[i] = (unsigned)(Rbb * K + C) * 2u; }
    const size_t kstep = (size_t)(BK * 2);
    const size_t hstep = (size_t)HALF * K * 2;
    const size_t hstepA = Epi::AROWPERM ? (size_t)4 * K * 2 : hstep;
    const size_t hstepB = Epi::BCOLPERM ? (size_t)32 * K * 2 : hstep;
    const size_t tstep = 2 * hstep;
    const unsigned ldsw = (unsigned)wid * 1024u;
    const int aoff = lds_byte(wr * 64 + fr, fq * 8), boff = lds_byte(wc * 32 + fr, fq * 8);
#define PG8_SA(b, h) (((b) * 2 + (h)) * HTB)
#define PG8_SB(b, h) ((4 + (b) * 2 + (h)) * HTB)
#define PG8_STAGE(bufoff, gbase, voff) do { _Pragma("unroll") for (int _i = 0; _i < 2; ++_i) \
        __builtin_amdgcn_global_load_lds((const unsigned*)((const char*)(gbase) + (voff)[_i]), (LAS unsigned*)(lds + (bufoff) + ldsw + _i * 8192), 16, 0, 0); } while (0)
#define PG8_LDA(dst, b, h) do { _Pragma("unroll") for (int m = 0; m < 4; ++m) _Pragma("unroll") for (int k = 0; k < 2; ++k) dst[m][k] = *(const LAS bf16x8*)(lds + PG8_SA(b, h) + aoff + m * 2048 + k * 1024); } while (0)
#define PG8_LDB(dst, b, h) do { _Pragma("unroll") for (int n = 0; n < 2; ++n) _Pragma("unroll") for (int k = 0; k < 2; ++k) dst[n][k] = *(const LAS bf16x8*)(lds + PG8_SB(b, h) + boff + n * 2048 + k * 1024); } while (0)
#define PG8_MMA(ai, bj, At, Bt) do { __builtin_amdgcn_s_setprio(1); _Pragma("unroll") for (int m = 0; m < 4; ++m) _Pragma("unroll") for (int n = 0; n < 2; ++n) _Pragma("unroll") for (int k = 0; k < 2; ++k) \
        acc[ai][bj][m][n] = __builtin_amdgcn_mfma_f32_16x16x32_bf16(Bt[n][k], At[m][k], acc[ai][bj][m][n], 0, 0, 0); __builtin_amdgcn_s_setprio(0); } while (0)
#define PG8_WAIT_V(n) asm volatile("s_waitcnt vmcnt(" #n ")" ::: "memory")
#define PG8_WAIT_L(n) asm volatile("s_waitcnt lgkmcnt(" #n ")" ::: "memory")
#define PG8_BAR __builtin_amdgcn_s_barrier()
#define PG8_SCHED __builtin_amdgcn_sched_barrier(0)
    Unit cur, nxt; int ui = 0;
    if (!S.next(0, cur)) return;
    f32x4 acc[2][2][4][2];
#pragma unroll
    for (int a = 0; a < 2; ++a)
#pragma unroll
        for (int b = 0; b < 2; ++b)
#pragma unroll
            for (int m = 0; m < 4; ++m)
#pragma unroll
                for (int n = 0; n < 2; ++n) acc[a][b][m][n] = (f32x4){0.f, 0.f, 0.f, 0.f};
    bf16x8 At[4][2], B0[2][2], B1[2][2];
    const char* cA = (const char*)g.A + (size_t)cur.pm * tstep; const char* cB = (const char*)g.Bt + (size_t)cur.pn * tstep;
    if constexpr (SP2) {
        PG8_STAGE(PG8_SB(0, 0), cB, voffB); PG8_STAGE(PG8_SB(0, 1), cB + hstepB, voffB); PG8_STAGE(PG8_SA(0, 0), cA, voffA); PG8_STAGE(PG8_SA(0, 1), cA + hstepA, voffA);
        if (wr == 1) PG8_BAR;
        PG8_WAIT_V(2); PG8_BAR;
        PG8_STAGE(PG8_SB(1, 0), cB + kstep, voffB); PG8_STAGE(PG8_SA(1, 0), cA + kstep, voffA); PG8_STAGE(PG8_SB(1, 1), cB + hstepB + kstep, voffB);
        PG8_WAIT_V(6); PG8_BAR;
    } else {
        PG8_STAGE(PG8_SB(0, 0), cB, voffB); PG8_STAGE(PG8_SA(0, 0), cA, voffA); PG8_STAGE(PG8_SB(0, 1), cB + hstepB, voffB); PG8_STAGE(PG8_SA(0, 1), cA + hstepA, voffA);
        if (wr == 1) PG8_BAR;
        PG8_WAIT_V(4); PG8_BAR;
        PG8_STAGE(PG8_SB(1, 0), cB + kstep, voffB); PG8_STAGE(PG8_SA(1, 0), cA + kstep, voffA); PG8_STAGE(PG8_SB(1, 1), cB + hstepB + kstep, voffB);
        PG8_WAIT_V(6); PG8_BAR;
    }
    for (;;) {
        const bool has_next = S.next(ui + 1, nxt);
        const char* nA = has_next ? (const char*)g.A + (size_t)nxt.pm * tstep : cA; const char* nB = has_next ? (const char*)g.Bt + (size_t)nxt.pn * tstep : cB;
        for (int t = 0; t < nt; t += 2) {
            const bool last = (t == nt - 2);
            const char* a1 = cA + (size_t)(t + 1) * kstep;
            const char* a2 = last ? nA : cA + (size_t)(t + 2) * kstep; const char* b2 = last ? nB : cB + (size_t)(t + 2) * kstep;
            const char* a3 = a2 + kstep; const char* b3 = b2 + kstep;
            if constexpr (SP2) {
            PG8_LDB(B0, 0, 0); PG8_LDB(B1, 0, 1); PG8_SCHED; PG8_LDA(At, 0, 0); PG8_STAGE(PG8_SA(1, 1), a1 + hstepA, voffA);
            PG8_WAIT_V(8); PG8_WAIT_L(0); PG8_BAR; PG8_MMA(0, 0, At, B0); PG8_MMA(0, 1, At, B1); PG8_BAR; PG8_SCHED;
            PG8_LDA(At, 0, 1); PG8_STAGE(PG8_SB(0, 0), b2, voffB); PG8_STAGE(PG8_SB(0, 1), b2 + hstepB, voffB); PG8_STAGE(PG8_SA(0, 0), a2, voffA);
            PG8_WAIT_V(8); PG8_WAIT_L(0); PG8_BAR; PG8_MMA(1, 0, At, B0); PG8_MMA(1, 1, At, B1); PG8_BAR; PG8_SCHED;
            PG8_LDB(B0, 1, 0); PG8_LDB(B1, 1, 1); PG8_SCHED; PG8_LDA(At, 1, 0); PG8_STAGE(PG8_SA(0, 1), a2 + hstepA, voffA);
            PG8_WAIT_V(8); PG8_WAIT_L(0); PG8_BAR; PG8_MMA(0, 0, At, B0); PG8_MMA(0, 1, At, B1); PG8_BAR; PG8_SCHED;
            PG8_LDA(At, 1, 1); PG8_STAGE(PG8_SB(1, 0), b3, voffB); PG8_STAGE(PG8_SB(1, 1), b3 + hstepB, voffB); PG8_STAGE(PG8_SA(1, 0), a3, voffA);
            PG8_WAIT_V(8); PG8_WAIT_L(0); PG8_BAR; PG8_MMA(1, 0, At, B0); PG8_MMA(1, 1, At, B1); PG8_BAR; PG8_SCHED;
            } else {
            PG8_LDB(B0, 0, 0); PG8_SCHED; PG8_LDA(At, 0, 0); PG8_STAGE(PG8_SA(1, 1), a1 + hstepA, voffA);
            PG8_WAIT_L(8); PG8_BAR; PG8_WAIT_L(0); PG8_MMA(0, 0, At, B0); PG8_BAR; PG8_SCHED;
            PG8_LDB(B1, 0, 1); PG8_STAGE(PG8_SB(0, 0), b2, voffB);
            PG8_BAR; PG8_WAIT_L(0); PG8_MMA(0, 1, At, B1); PG8_BAR;
            PG8_LDA(At, 0, 1); PG8_STAGE(PG8_SA(0, 0), a2, voffA);
            PG8_BAR; PG8_WAIT_L(0); PG8_MMA(1, 0, At, B0); PG8_BAR; PG8_SCHED;
            PG8_STAGE(PG8_SB(0, 1), b2 + hstepB, voffB);
            PG8_WAIT_V(6); PG8_BAR; PG8_MMA(1, 1, At, B1); PG8_BAR;
            PG8_LDB(B0, 1, 0); PG8_SCHED; PG8_LDA(At, 1, 0); PG8_STAGE(PG8_SA(0, 1), a2 + hstepA, voffA);
            PG8_WAIT_L(8); PG8_BAR; PG8_WAIT_L(0); PG8_MMA(0, 0, At, B0); PG8_BAR; PG8_SCHED;
            PG8_LDB(B1, 1, 1); PG8_STAGE(PG8_SB(1, 0), b3, voffB);
            PG8_BAR; PG8_WAIT_L(0); PG8_MMA(0, 1, At, B1); PG8_BAR;
            PG8_LDA(At, 1, 1); PG8_STAGE(PG8_SA(1, 0), a3, voffA);
            PG8_BAR; PG8_WAIT_L(0); PG8_MMA(1, 0, At, B0); PG8_BAR; PG8_SCHED;
            PG8_STAGE(PG8_SB(1, 1), b3 + hstepB, voffB);
            PG8_WAIT_V(6); PG8_BAR; PG8_MMA(1, 1, At, B1); PG8_BAR;

            }
        }
        if constexpr (ALIGN_EPI) { if (wr == 0) PG8_BAR; }
        if constexpr (!Epi::AFTER_DRAIN) E(acc, cur, wr, wc, fr, fq);
        if (!has_next) break;
#pragma unroll
        for (int a = 0; a < 2; ++a)
#pragma unroll
            for (int b = 0; b < 2; ++b)
#pragma unroll
                for (int m = 0; m < 4; ++m)
#pragma unroll
                    for (int n = 0; n < 2; ++n) acc[a][b][m][n] = (f32x4){0.f, 0.f, 0.f, 0.f};
        cur = nxt; cA = nA; cB = nB; ++ui;
        if constexpr (ALIGN_EPI) { if (wr == 1) PG8_BAR; }
    }
    PG8_WAIT_V(0);
    if constexpr (!ALIGN_EPI) { if (wr == 0) PG8_BAR; }
    PG8_BAR;
    if constexpr (Epi::AFTER_DRAIN) E(acc, cur, wr, wc, fr, fq);
#undef PG8_SA
#undef PG8_SB
#undef PG8_STAGE
#undef PG8_LDA
#undef PG8_LDB
#undef PG8_MMA
#undef PG8_WAIT_V
#undef PG8_WAIT_L
#undef PG8_BAR
#undef PG8_SCHED
}

struct EpiBf16 {
    static constexpr bool PERM = true, AFTER_DRAIN = false, AROWPERM = false, BCOLPERM = true;
    bf16_t* O; int ldc;
    __device__ __forceinline__ void operator()(f32x4 (&acc)[2][2][4][2], const Unit& u, int wr, int wc, int fr, int fq) const {
        const int row0 = u.pm * BM + wr * 64 + fr, col0 = u.pn * BM + wc * 64 + 8 * fq;
#pragma unroll
        for (int ai = 0; ai < 2; ++ai)
#pragma unroll
            for (int m = 0; m < 4; ++m) { bf16_t* rowp = O + (size_t)(row0 + ai * HALF + m * 16) * ldc + col0;
#pragma unroll
                for (int bj = 0; bj < 2; ++bj) { const f32x4 v0 = acc[ai][bj][m][0], v1 = acc[ai][bj][m][1];
                    u32x4 w; w.x = cvt_pk_bf16_asm(v0[0], v0[1]); w.y = cvt_pk_bf16_asm(v0[2], v0[3]); w.z = cvt_pk_bf16_asm(v1[0], v1[1]); w.w = cvt_pk_bf16_asm(v1[2], v1[3]);
                    *(u32x4*)(rowp + bj * 32) = w; } }
    }
};
struct EpiResF32 {
    static constexpr bool PERM = false, AFTER_DRAIN = false, AROWPERM = false, BCOLPERM = false;
    const float* X; float* O; int ldc;
    __device__ __forceinline__ void operator()(f32x4 (&acc)[2][2][4][2], const Unit& u, int wr, int wc, int fr, int fq) const {
        const int row0 = u.pm * BM + wr * 64 + fr, col0 = u.pn * BM + wc * 32 + 4 * fq;
#pragma unroll
        for (int ai = 0; ai < 2; ++ai)
#pragma unroll
            for (int m = 0; m < 4; ++m) { const size_t ro = (size_t)(row0 + ai * HALF + m * 16) * ldc + col0;
#pragma unroll
                for (int bj = 0; bj < 2; ++bj)
#pragma unroll
                    for (int n = 0; n < 2; ++n) { const f32x4 xv = *(const f32x4*)(X + ro + bj * HALF + n * 16);
                        *(f32x4*)(O + ro + bj * HALF + n * 16) = xv * ALPHA + acc[ai][bj][m][n]; } }
    }
};
template <bool XBF  , bool WF32  > struct EpiResLn {
    static constexpr bool PERM = true, AFTER_DRAIN = true, AROWPERM = false, BCOLPERM = false;
    const float* X; const bf16_t* XB; float* O; bf16_t* OB; const float* gam; const float* bet; float* rs; unsigned* cnt;
    __device__ __forceinline__ void operator()(f32x4 (&acc)[2][2][4][2], const Unit& u, int wr, int wc, int fr, int fq) const {
        const int row0 = u.pm * BM + wr * 64 + fr, col0 = u.pn * BM + wc * 32 + 8 * fq;
#pragma unroll
        for (int ai = 0; ai < 2; ++ai)
#pragma unroll
            for (int m = 0; m < 4; ++m) { const int row = row0 + ai * HALF + m * 16; const size_t ro = (size_t)row * DM + col0;
                float s = 0.f, q = 0.f;
#pragma unroll
                for (int bj = 0; bj < 2; ++bj)
#pragma unroll
                    for (int n = 0; n < 2; ++n) { f32x4 xv;
                        if constexpr (XBF) { const u32x2 xb2 = *(const u32x2*)(XB + ro + bj * HALF + n * 4); xv = (f32x4){bflo(xb2.x), bfhi(xb2.x), bflo(xb2.y), bfhi(xb2.y)}; }
                        else xv = *(const f32x4*)(X + ro + bj * HALF + n * 4);
                        const f32x4 z = xv * ALPHA + acc[ai][bj][m][n]; acc[ai][bj][m][n] = z;
                        s += (z[0] + z[1]) + (z[2] + z[3]); q += (z[0] * z[0] + z[1] * z[1]) + (z[2] * z[2] + z[3] * z[3]); }
                s += __shfl_xor(s, 16); s += __shfl_xor(s, 32); q += __shfl_xor(q, 16); q += __shfl_xor(q, 32);
                if (fq == 0) { (void)__hip_atomic_fetch_add(rs + 2 * row, s, __ATOMIC_RELAXED, __HIP_MEMORY_SCOPE_AGENT); (void)__hip_atomic_fetch_add(rs + 2 * row + 1, q, __ATOMIC_RELAXED, __HIP_MEMORY_SCOPE_AGENT); } }
        asm volatile("s_waitcnt vmcnt(0)" ::: "memory");
        unsigned* cp = cnt + 64 * u.pm;
        if ((threadIdx.x & 63) == 0) (void)__hip_atomic_fetch_add(cp, 1u, __ATOMIC_RELAXED, __HIP_MEMORY_SCOPE_AGENT);
        { unsigned sp = 0; while ((unsigned)__builtin_amdgcn_readfirstlane(__hip_atomic_load(cp, __ATOMIC_RELAXED, __HIP_MEMORY_SCOPE_AGENT)) < 64u) { __builtin_amdgcn_s_sleep(2); if (++sp > (1u << 22)) break; } }
        f32x4 gg[2][2], bb[2][2];
#pragma unroll
        for (int bj = 0; bj < 2; ++bj)
#pragma unroll
            for (int n = 0; n < 2; ++n) { gg[bj][n] = *(const f32x4*)(gam + col0 + bj * HALF + n * 4); bb[bj][n] = *(const f32x4*)(bet + col0 + bj * HALF + n * 4); }
#pragma unroll
        for (int ai = 0; ai < 2; ++ai)
#pragma unroll
            for (int m = 0; m < 4; ++m) { const int row = row0 + ai * HALF + m * 16; const size_t ro = (size_t)row * DM + col0;
                const float s = __hip_atomic_load(rs + 2 * row, __ATOMIC_RELAXED, __HIP_MEMORY_SCOPE_AGENT), q = __hip_atomic_load(rs + 2 * row + 1, __ATOMIC_RELAXED, __HIP_MEMORY_SCOPE_AGENT);
                const float mu = s * (1.0f / DM), rstd = rsqrtf(fmaxf(q * (1.0f / DM) - mu * mu, 0.f) + 1e-5f);
#pragma unroll
                for (int bj = 0; bj < 2; ++bj)
#pragma unroll
                    for (int n = 0; n < 2; ++n) { const f32x4 o = (acc[ai][bj][m][n] - mu) * rstd * gg[bj][n] + bb[bj][n];
                        if constexpr (WF32) *(f32x4*)(O + ro + bj * HALF + n * 4) = o;
                        if (OB) { u32x2 p; p.x = cvt_pk_bf16_asm(o[0], o[1]); p.y = cvt_pk_bf16_asm(o[2], o[3]); *(u32x2*)(OB + ro + bj * HALF + n * 4) = p; } } }
    }
};
__device__ __forceinline__ float dpp_shr1(float x) { return __builtin_bit_cast(float, __builtin_amdgcn_update_dpp(0, __builtin_bit_cast(int, x), 0x111, 0xf, 0xf, true)); }
struct EpiConvFfn {
    static constexpr bool PERM = true, AFTER_DRAIN = false, AROWPERM = true, BCOLPERM = false;
    bf16_t* act; float* halo; const float* cw; const float* cb;
    __device__ __forceinline__ void operator()(f32x4 (&acc)[2][2][4][2], const Unit& u, int wr, int wc, int fr, int fq) const {
        const int fcol = u.pn * 128 + wc * 32 + 8 * fq;
        const int rbase = u.pm * BM + wr * 128;
        {
            float* hb = halo + (size_t)(rbase >> 7) * 4 * NUP + fcol;
            if (fr == 0) {
#pragma unroll
                for (int bj = 0; bj < 2; ++bj)
#pragma unroll
                    for (int n = 0; n < 2; ++n) { *(f32x4*)(hb + (size_t)2 * NUP + bj * DFF + 4 * n) = acc[0][bj][0][n]; *(f32x4*)(hb + (size_t)3 * NUP + bj * DFF + 4 * n) = acc[0][bj][1][n]; }
            }
            if (fr == 15) {
#pragma unroll
                for (int bj = 0; bj < 2; ++bj)
#pragma unroll
                    for (int n = 0; n < 2; ++n) { *(f32x4*)(hb + bj * DFF + 4 * n) = acc[1][bj][2][n]; *(f32x4*)(hb + (size_t)1 * NUP + bj * DFF + 4 * n) = acc[1][bj][3][n]; }
            }
        }
        u32x2 pk0[8];
#pragma unroll
        for (int n = 0; n < 2; ++n) {
            f32x4 W0[2], W1[2], W2[2], Bb[2];
#pragma unroll
            for (int bj = 0; bj < 2; ++bj) { const int hc = bj * DFF + fcol + 4 * n;
                W0[bj] = *(const f32x4*)(cw + hc); W1[bj] = *(const f32x4*)(cw + NUP + hc); W2[bj] = *(const f32x4*)(cw + 2 * NUP + hc); Bb[bj] = *(const f32x4*)(cb + hc); }
            f32x4 E6[2], E7[2];
#pragma unroll
            for (int bj = 0; bj < 2; ++bj) { const f32x4 s6 = acc[1][bj][2][n], s7 = acc[1][bj][3][n];
                E6[bj][0] = dpp_shr1(s6[0]); E6[bj][1] = dpp_shr1(s6[1]); E6[bj][2] = dpp_shr1(s6[2]); E6[bj][3] = dpp_shr1(s6[3]);
                E7[bj][0] = dpp_shr1(s7[0]); E7[bj][1] = dpp_shr1(s7[1]); E7[bj][2] = dpp_shr1(s7[2]); E7[bj][3] = dpp_shr1(s7[3]); }
#pragma unroll
            for (int i = 0; i < 8; ++i) {
                f32x4 h[2];
#pragma unroll
                for (int bj = 0; bj < 2; ++bj) {
                    const f32x4 cur = acc[i >> 2][bj][i & 3][n];
                    const f32x4 p1 = (i >= 1) ? acc[(i - 1 >= 0 ? i - 1 : 0) >> 2][bj][(i - 1 >= 0 ? i - 1 : 0) & 3][n] : E7[bj];
                    const f32x4 p2 = (i >= 2) ? acc[(i - 2 >= 0 ? i - 2 : 0) >> 2][bj][(i - 2 >= 0 ? i - 2 : 0) & 3][n] : (i == 1 ? E7[bj] : E6[bj]);
                    h[bj] = W2[bj] * cur + W1[bj] * p1 + W0[bj] * p2 + Bb[bj];
                }
                const f32x4 gt = h[1], ng = gt * (-1.4426950408889634f);
                f32x4 r;
#pragma unroll
                for (int j = 0; j < 4; ++j) r[j] = __builtin_amdgcn_rcpf(1.0f + __builtin_amdgcn_exp2f(ng[j]));
                const f32x4 av = h[0] * gt * r;
                u32x2 pk; pk.x = cvt_pk_bf16_asm(av[0], av[1]); pk.y = cvt_pk_bf16_asm(av[2], av[3]);
                if (n == 0) pk0[i] = pk;
                else if (i >= 2 || fr > 0) { u32x4 w; w.x = pk0[i].x; w.y = pk0[i].y; w.z = pk.x; w.w = pk.y;
                    *(u32x4*)(act + (size_t)(rbase + 8 * fr + i) * DFF + fcol) = w; }
            }
            asm volatile("" ::: "memory");
        }
    }
};
}

template <bool UPMAP>
__device__ __forceinline__ void transpose_macro(const float* W, int ldw, int k0, int n0, bf16_t* Wt, int ldt, unsigned char* lds) {
    bf16_t* sT = (bf16_t*)lds; const int tid = threadIdx.x;
    float4 v[2][4];
#pragma unroll
    for (int i = 0; i < 2; ++i)
#pragma unroll
        for (int j = 0; j < 4; ++j) v[i][j] = *(const float4*)(W + (size_t)(k0 + (tid >> 4) + 32 * i) * ldw + n0 + 64 * j + (tid & 15) * 4);
#pragma unroll
    for (int i = 0; i < 2; ++i)
#pragma unroll
        for (int j = 0; j < 4; ++j) { const int k = (tid >> 4) + 32 * i, n = 64 * j + (tid & 15) * 4;
            sT[(n + 0) * 66 + k] = f2bf(v[i][j].x); sT[(n + 1) * 66 + k] = f2bf(v[i][j].y); sT[(n + 2) * 66 + k] = f2bf(v[i][j].z); sT[(n + 3) * 66 + k] = f2bf(v[i][j].w); }
    __syncthreads();
#pragma unroll
    for (int j = 0; j < 4; ++j) { const int n = 64 * j + (tid >> 3), ks = (tid & 7) * 8; const unsigned* p = (const unsigned*)(sT + n * 66 + ks);
        u32x4 o; o.x = p[0]; o.y = p[1]; o.z = p[2]; o.w = p[3];
        int drow = n0 + n;
        if (UPMAP) { const int f = (drow < DFF) ? drow : drow - DFF; drow = 256 * (f >> 7) + (f & 127) + ((drow < DFF) ? 0 : 128); }
        *(u32x4*)(Wt + (size_t)drow * ldt + k0 + ks) = o; }
    __syncthreads();
}
constexpr int TM_IN = 32 * 28, TM_OUT = 32 * 8, TM_UP = 32 * 44, TM_DN = 88 * 8;
__device__ __forceinline__ void phase_transposes(const Args& A, unsigned char* lds, int g0, int g1, int worker, int nworkers) {
    unsigned char* ws = A.ws;
    for (int g = g0 + worker; g < g1; g += nworkers) {
        if (g < TM_IN) { const int tk = g / 28, tn = g % 28; transpose_macro<false>(A.w_in, NIN, tk * 64, tn * 256, (bf16_t*)(ws + WS_WIN), DM, lds); }
        else if (g < TM_IN + TM_OUT) { const int h = g - TM_IN, tk = h / 8, tn = h % 8; transpose_macro<false>(A.w_out, DM, tk * 64, tn * 256, (bf16_t*)(ws + WS_WOUT), DM, lds); }
        else if (g < TM_IN + TM_OUT + TM_UP) { const int h = g - TM_IN - TM_OUT, tk = h / 44, tn = h % 44; transpose_macro<true>(A.w_up, NUP, tk * 64, tn * 256, (bf16_t*)(ws + WS_WUP), DM, lds); }
        else { const int h = g - TM_IN - TM_OUT - TM_UP, tk = h / 8, tn = h % 8; transpose_macro<false>(A.w_down, DM, tk * 64, tn * 256, (bf16_t*)(ws + WS_WDN), DFF, lds); }
    }
}
__device__ __forceinline__ void phase_prologue(const Args& A, unsigned char* lds) {
    unsigned char* ws = A.ws;
    const int lane = threadIdx.x & 63, gw = blockIdx.x * 8 + (threadIdx.x >> 6), nw = gridDim.x * 8;
    bf16_t* xb = (bf16_t*)(ws + WS_XB); float* gates = (float*)(ws + WS_GATES);
    phase_transposes(A, lds, 0, TM_IN, blockIdx.x, gridDim.x);
    for (int it = gw; it < MT / 4; it += nw) {
        const int r0 = it * 4;
        float acc[4][8];
#pragma unroll
        for (int r = 0; r < 4; ++r)
#pragma unroll
            for (int q = 0; q < 8; ++q) acc[r][q] = 0.f;
#pragma unroll 1
        for (int ih = 0; ih < 2; ++ih) {
        f32x4 xq[4][4];
#pragma unroll
        for (int i = 0; i < 4; ++i)
#pragma unroll
            for (int r = 0; r < 4; ++r) xq[i][r] = *(const f32x4*)(A.x + (size_t)(r0 + r) * DM + (ih * 4 + i) * 256 + lane * 4);
#pragma unroll
        for (int i = 0; i < 4; ++i) {
            const int kb = (ih * 4 + i) * 256 + lane * 4;
            f32x4 xv[4];
#pragma unroll
            for (int r = 0; r < 4; ++r) { xv[r] = xq[i][r];
                u32x2 o; o.x = cvt_pk_bf16(xv[r][0], xv[r][1]); o.y = cvt_pk_bf16(xv[r][2], xv[r][3]); *(u32x2*)(xb + (size_t)(r0 + r) * DM + kb) = o; }
#pragma unroll
            for (int j = 0; j < 4; ++j) {
                const f32x4* wp = (const f32x4*)(A.w_in + (size_t)(kb + j) * NIN + NP);
                const f32x4 w0 = wp[0], w1 = wp[1];
#pragma unroll
                for (int r = 0; r < 4; ++r) { const float xs = xv[r][j];
                    acc[r][0] += xs * w0[0]; acc[r][1] += xs * w0[1]; acc[r][2] += xs * w0[2]; acc[r][3] += xs * w0[3];
                    acc[r][4] += xs * w1[0]; acc[r][5] += xs * w1[1]; acc[r][6] += xs * w1[2]; acc[r][7] += xs * w1[3]; }
            }
        }
        }
#pragma unroll
        for (int r = 0; r < 4; ++r)
#pragma unroll
            for (int q = 0; q < 8; ++q) { float v = acc[r][q];
#pragma unroll
                for (int off = 32; off >= 1; off >>= 1) v += __shfl_xor(v, off);
                acc[r][q] = v; }
        if (lane == 0) {
            const f32x4 b0 = *(const f32x4*)(A.b_gates), b1 = *(const f32x4*)(A.b_gates + 4);
#pragma unroll
            for (int r = 0; r < 4; ++r) {
                *(f32x4*)(gates + (size_t)(r0 + r) * 8) = (f32x4){acc[r][0] + b0[0], acc[r][1] + b0[1], acc[r][2] + b0[2], acc[r][3] + b0[3]};
                *(f32x4*)(gates + (size_t)(r0 + r) * 8 + 4) = (f32x4){acc[r][4] + b1[0], acc[r][5] + b1[1], acc[r][6] + b1[2], acc[r][7] + b1[3]}; }
        }
    }
}

__device__ __forceinline__ void phase_yconv(const Args& A) {
    const bf16_t* proj = (const bf16_t*)(A.ws + WS_PROJ); bf16_t* y = (bf16_t*)(A.ws + WS_Y);
    for (int idx = blockIdx.x * 512 + threadIdx.x; idx < MT * 128; idx += gridDim.x * 512) {
        const int row = idx >> 7, c = (idx & 127) * 8, t = row & (SEQ - 1);
        const bf16_t* pr = proj + (size_t)row * NP + c;
        const u32x4 bv = *(const u32x4*)pr;
        float cv[8];
#pragma unroll
        for (int i = 0; i < 8; ++i) cv[i] = 0.f;
#pragma unroll
        for (int j = 0; j < 3; ++j) {
            const int dt = 2 - j;
            if (t - dt >= 0) {
                const u32x4 cc = *(const u32x4*)(pr - (size_t)dt * NP + WCONV), hh = *(const u32x4*)(pr - (size_t)dt * NP + 2 * WCONV);
                const f32x4 w0 = *(const f32x4*)(A.w_sc + j * WCONV + c), w1 = *(const f32x4*)(A.w_sc + j * WCONV + c + 4);
                const float wv[8] = {w0[0], w0[1], w0[2], w0[3], w1[0], w1[1], w1[2], w1[3]};
#pragma unroll
                for (int q = 0; q < 4; ++q) { cv[2 * q] += wv[2 * q] * bflo(cc[q]) * bflo(hh[q]); cv[2 * q + 1] += wv[2 * q + 1] * bfhi(cc[q]) * bfhi(hh[q]); }
            }
        }
        u32x4 o;
#pragma unroll
        for (int q = 0; q < 4; ++q) o[q] = cvt_pk_bf16(bflo(bv[q]) * cv[2 * q], bfhi(bv[q]) * cv[2 * q + 1]);
        *(u32x4*)(y + (size_t)row * DM + c) = o;
    }
}

__device__ __forceinline__ void phase_mlstm(const Args& A, unsigned char* lds, float* hbuf) {
    const int tid = threadIdx.x, lane = tid & 63, w = tid >> 6, g = lane >> 4, l15 = lane & 15;
    const int a = w >> 2, ti = w & 3;
    unsigned char* QS = lds; unsigned char* KS = lds + 33792; unsigned char* VT = lds + 67584; unsigned char* WVT = VT + 4608; unsigned char* CT = WVT + 4608; unsigned char* XCH = CT + 33792;
    const bf16_t* proj = (const bf16_t*)(A.ws + WS_PROJ); const float* gates = (const float*)(A.ws + WS_GATES);
    float* TBC = (float*)(lds + 131088); float* TUV = TBC + 2048; float* TCM = TUV + 2048;
    for (int item = blockIdx.x; item < 256; item += gridDim.x) {
        const int xcd = item & 7, idx = item >> 3; const int bh = xcd * 2 + (idx >> 4), es = idx & 15;
        const int b = bh >> 2, hh = bh & 3, e0 = es * 16;
        const size_t row0 = (size_t)b * SEQ;
        __syncthreads();
        for (int i = tid; i < 16896 / 4; i += 512) ((unsigned*)CT)[i] = 0u;
        for (int i = tid; i < 16 * 72; i += 512) { const int r = 16 + i / 72, ci = i % 72; ((bf16_t*)VT)[r * 72 + ci] = (r == 16) ? (bf16_t)0x3F80 : (bf16_t)0; ((bf16_t*)WVT)[r * 72 + ci] = 0; }
        f32x4 Cst[2][2];
#pragma unroll
        for (int x = 0; x < 2; ++x)
#pragma unroll
            for (int et = 0; et < 2; ++et) Cst[x][et] = (f32x4){0.f, 0.f, 0.f, 0.f};
        float m_state = 0.f;
        u32x4 qr[4], kr[4]; unsigned vr;
        const bf16_t* qbase = proj + row0 * NP + 3072 + hh * 256;
#define ML_LOAD(c) do { _Pragma("unroll") for (int i = 0; i < 4; ++i) { const int p = tid + 512 * i, r = p >> 5, c16 = p & 31; const bf16_t* rp = qbase + (size_t)((c) * 64 + r) * NP + c16 * 8; \
            qr[i] = *(const u32x4*)rp; kr[i] = *(const u32x4*)(rp + 1024); } \
            vr = *(const unsigned*)(qbase + (size_t)((c) * 64 + (tid >> 3)) * NP + 2048 + e0 + (tid & 7) * 2); } while (0)
        ML_LOAD(0);
#pragma unroll 1
        for (int cc = 4 * w; cc < 4 * w + 4; ++cc) {
            const float* gp = gates + (row0 + cc * 64 + lane) * 8 + hh; const float gi = gp[0], gf = gp[4];
            const float lf = fminf(gf, 0.f) - log1pf(__expf(-fabsf(gf)));
            float bc = lf;
#pragma unroll
            for (int off = 1; off < 64; off <<= 1) { const float t = __shfl_up(bc, off); if (lane >= off) bc += t; }
            const float uv = gi - bc;
            float cm = uv;
#pragma unroll
            for (int off = 1; off < 64; off <<= 1) { const float t = __shfl_up(cm, off); if (lane >= off) cm = fmaxf(cm, t); }
            TBC[cc * 64 + lane] = bc; TUV[cc * 64 + lane] = uv; TCM[cc * 64 + lane] = cm;
        }
        __syncthreads();
#pragma unroll 1
        for (int c = 0; c < 32; ++c) {
            const float* tbc = TBC + c * 64; const float* tuv = TUV + c * 64; const float* tcm = TCM + c * 64;
            const float g_tot = tbc[63], cm63 = tcm[63];
            const float M63 = fmaxf(m_state, cm63), decay = __expf(m_state - M63);
            const float m_old = m_state;
            m_state = g_tot + M63;
#pragma unroll
            for (int i = 0; i < 4; ++i) { const int p = tid + 512 * i, r = p >> 5, c16 = p & 31; *(u32x4*)(QS + r * 528 + c16 * 16) = qr[i]; *(u32x4*)(KS + r * 528 + c16 * 16) = kr[i]; }
            { const int s = tid >> 3, ep = tid & 7; const float wv = __expf(tuv[s] - M63);
              ((bf16_t*)VT)[(2 * ep) * 72 + s] = (bf16_t)(vr & 0xffffu); ((bf16_t*)VT)[(2 * ep + 1) * 72 + s] = (bf16_t)(vr >> 16);
              ((bf16_t*)WVT)[(2 * ep) * 72 + s] = f2bf(bflo(vr) * wv); ((bf16_t*)WVT)[(2 * ep + 1) * 72 + s] = f2bf(bfhi(vr) * wv);
              if (ep == 0) ((bf16_t*)WVT)[16 * 72 + s] = f2bf(wv); }
            if (c + 1 < 32) ML_LOAD(c + 1);
            __syncthreads();
            bf16x8 qf[8]; f32x4 S0 = (f32x4){0.f, 0.f, 0.f, 0.f}, S1 = S0;
#pragma unroll
            for (int kk = 0; kk < 8; ++kk) {
                const int ko = ((kk + 4 * a) & 7) * 64 + g * 16;
                qf[kk] = *(const bf16x8*)(QS + (16 * ti + l15) * 528 + ko);
                const bf16x8 kf0 = *(const bf16x8*)(KS + (32 * a + l15) * 528 + ko), kf1 = *(const bf16x8*)(KS + (32 * a + 16 + l15) * 528 + ko);
                S0 = __builtin_amdgcn_mfma_f32_16x16x32_bf16(kf0, qf[kk], S0, 0, 0, 0); S1 = __builtin_amdgcn_mfma_f32_16x16x32_bf16(kf1, qf[kk], S1, 0, 0, 0);
            }
            const int tcol = 16 * ti + l15;
            const float Mt = fmaxf(m_old, tcm[tcol]);
            const f32x4 u0v = *(const f32x4*)(tuv + 32 * a + 4 * g), u1v = *(const f32x4*)(tuv + 32 * a + 16 + 4 * g);
            float p[8];
#pragma unroll
            for (int r = 0; r < 4; ++r) { const int s0 = 32 * a + 4 * g + r, s1 = s0 + 16;
                p[r] = (s0 <= tcol) ? S0[r] * 0.0625f * __expf(u0v[r] - Mt) : 0.f; p[4 + r] = (s1 <= tcol) ? S1[r] * 0.0625f * __expf(u1v[r] - Mt) : 0.f; }
            u32x4 pau; pau.x = cvt_pk_bf16(p[0], p[1]); pau.y = cvt_pk_bf16(p[2], p[3]); pau.z = cvt_pk_bf16(p[4], p[5]); pau.w = cvt_pk_bf16(p[6], p[7]);
            const bf16x8 pa = __builtin_bit_cast(bf16x8, pau);
            f32x4 rr[2];
#pragma unroll
            for (int et = 0; et < 2; ++et) { const unsigned char* vp = VT + (16 * et + l15) * 144 + (32 * a + 4 * g) * 2;
                const u32x2 lo = *(const u32x2*)vp, hi = *(const u32x2*)(vp + 32);
                u32x4 vbu; vbu.x = lo.x; vbu.y = lo.y; vbu.z = hi.x; vbu.w = hi.y;
                rr[et] = __builtin_amdgcn_mfma_f32_16x16x32_bf16(pa, __builtin_bit_cast(bf16x8, vbu), (f32x4){0.f, 0.f, 0.f, 0.f}, 0, 0, 0); }
            const f32x4 cmr = *(const f32x4*)(tcm + 16 * ti + 4 * g), bcr = *(const f32x4*)(tbc + 16 * ti + 4 * g);
            {
                const unsigned char* CTc = CT + (c & 1) * 16896;
                f32x4 in0 = (f32x4){0.f, 0.f, 0.f, 0.f}, in1 = in0;
#pragma unroll
                for (int k2 = 0; k2 < 4; ++k2) {
                    const bf16x8 qa = qf[k2];
                    const bf16x8 c0 = *(const bf16x8*)(CTc + (l15) * 528 + (128 * a + 32 * k2 + 8 * g) * 2), c1 = *(const bf16x8*)(CTc + (16 + l15) * 528 + (128 * a + 32 * k2 + 8 * g) * 2);
                    in0 = __builtin_amdgcn_mfma_f32_16x16x32_bf16(qa, c0, in0, 0, 0, 0); in1 = __builtin_amdgcn_mfma_f32_16x16x32_bf16(qa, c1, in1, 0, 0, 0);
                }
#pragma unroll
                for (int r = 0; r < 4; ++r) { const float iw = __expf(m_old - fmaxf(m_old, cmr[r])) * 0.0625f; rr[0][r] += in0[r] * iw; rr[1][r] += in1[r] * iw; }
            }
            if (a == 1) { *(f32x4*)(XCH + ((ti * 2 + 0) * 64 + lane) * 16) = rr[0]; *(f32x4*)(XCH + ((ti * 2 + 1) * 64 + lane) * 16) = rr[1]; }
            {
                unsigned char* CTn = CT + ((c + 1) & 1) * 16896;
#pragma unroll
                for (int x = 0; x < 2; ++x) {
                    const int dt = 2 * w + x;
#pragma unroll
                    for (int et = 0; et < 2; ++et) Cst[x][et] *= decay;
#pragma unroll
                    for (int ks = 0; ks < 2; ++ks) {
                        const s16x4 klo = __builtin_amdgcn_ds_read_tr16_b64_v4i16((LAS s16x4*)(KS + (32 * ks + 8 * g + (l15 >> 2)) * 528 + (16 * dt + 4 * (l15 & 3)) * 2));
                        const s16x4 khi = __builtin_amdgcn_ds_read_tr16_b64_v4i16((LAS s16x4*)(KS + (32 * ks + 8 * g + 4 + (l15 >> 2)) * 528 + (16 * dt + 4 * (l15 & 3)) * 2));
                        const bf16x8 ka = {klo[0], klo[1], klo[2], klo[3], khi[0], khi[1], khi[2], khi[3]};
#pragma unroll
                        for (int et = 0; et < 2; ++et) { const bf16x8 wvb = *(const bf16x8*)(WVT + (16 * et + l15) * 144 + (32 * ks + 8 * g) * 2);
                            Cst[x][et] = __builtin_amdgcn_mfma_f32_16x16x32_bf16(ka, wvb, Cst[x][et], 0, 0, 0); }
                    }
#pragma unroll
                    for (int et = 0; et < 2; ++et) { u32x2 o; o.x = cvt_pk_bf16(Cst[x][et][0], Cst[x][et][1]); o.y = cvt_pk_bf16(Cst[x][et][2], Cst[x][et][3]);
                        *(u32x2*)(CTn + (16 * et + l15) * 528 + (16 * dt + 4 * g) * 2) = o; }
                }
            }
            __syncthreads();
            if (a == 0) {
                const f32x4 o0 = *(const f32x4*)(XCH + ((ti * 2 + 0) * 64 + lane) * 16), o1 = *(const f32x4*)(XCH + ((ti * 2 + 1) * 64 + lane) * 16);
#pragma unroll
                for (int r = 0; r < 4; ++r) {
                    const float den = __shfl(rr[1][r] + o1[r], lane & 48), fl = __expf(-(bcr[r] + fmaxf(m_old, cmr[r])));
                    const float hv = (rr[0][r] + o0[r]) * __builtin_amdgcn_rcpf(fmaxf(fabsf(den), fl));
                    hbuf[(row0 + c * 64 + 16 * ti + 4 * g + r) * 1024 + hh * 256 + e0 + l15] = hv;
                }
            }
        }
#undef ML_LOAD
    }
}


__device__ __forceinline__ void phase_mlstm_scan(const Args& A, unsigned char* lds) {
    const int tid = threadIdx.x, lane = tid & 63, w = tid >> 6, g = lane >> 4, l15 = lane & 15;
    unsigned char* KSB = lds; unsigned char* WVB = lds + 2 * 33792;
    const bf16_t* proj = (const bf16_t*)(A.ws + WS_PROJ); const float* gates = (const float*)(A.ws + WS_GATES);
    float* TBC = (float*)(lds + 131088); float* TUV = TBC + 2048; float* TCM = TUV + 2048;
    for (int item = blockIdx.x; item < 256; item += gridDim.x) {
        const int xcd = item & 7, idx = item >> 3; const int bh = xcd * 2 + (idx >> 4), es = idx & 15;
        const int b = bh >> 2, hh = bh & 3, e0 = es * 16;
        const size_t row0 = (size_t)b * SEQ;
        __syncthreads();
        for (int i = tid; i < 15 * 72; i += 512) { ((bf16_t*)WVB)[17 * 72 + i] = 0; ((bf16_t*)(WVB + 4608))[17 * 72 + i] = 0; }
        f32x4 Cst[2][2];
#pragma unroll
        for (int x = 0; x < 2; ++x)
#pragma unroll
            for (int et = 0; et < 2; ++et) Cst[x][et] = (f32x4){0.f, 0.f, 0.f, 0.f};
        float m_state = 0.f;
        u32x4 kA[4], kB[4], kC[4], kD[4]; unsigned vA, vB, vC, vD;
        const bf16_t* qbase = proj + row0 * NP + 3072 + hh * 256;
#define SC_LOAD(c, KR, VR) do { _Pragma("unroll") for (int i = 0; i < 4; ++i) { const int p = tid + 512 * i, r = p >> 5, c16 = p & 31; KR[i] = *(const u32x4*)(qbase + (size_t)((c) * 64 + r) * NP + 1024 + c16 * 8); } \
            VR = *(const unsigned*)(qbase + (size_t)((c) * 64 + (tid >> 3)) * NP + 2048 + e0 + (tid & 7) * 2); } while (0)
        SC_LOAD(0, kA, vA); SC_LOAD(1, kB, vB); SC_LOAD(2, kC, vC);
#pragma unroll 1
        for (int cc = 4 * w; cc < 4 * w + 4; ++cc) {
            const float* gp = gates + (row0 + cc * 64 + lane) * 8 + hh; const float gi = gp[0], gf = gp[4];
            const float lf = fminf(gf, 0.f) - log1pf(__expf(-fabsf(gf)));
            float bc = lf;
#pragma unroll
            for (int off = 1; off < 64; off <<= 1) { const float t = __shfl_up(bc, off); if (lane >= off) bc += t; }
            const float uv = gi - bc;
            float cm = uv;
#pragma unroll
            for (int off = 1; off < 64; off <<= 1) { const float t = __shfl_up(cm, off); if (lane >= off) cm = fmaxf(cm, t); }
            TBC[cc * 64 + lane] = bc; TUV[cc * 64 + lane] = uv; TCM[cc * 64 + lane] = cm;
        }
        __syncthreads();
        if (es == 0) { float* tab = (float*)(A.ws + WS_TAB) + (size_t)bh * 3 * 2048;
            for (int i = tid; i < 2048; i += 512) { tab[i] = TBC[i]; tab[2048 + i] = TUV[i]; tab[4096 + i] = TCM[i]; } }
        unsigned char* gc = A.ws + (bh < 8 ? WS_GCLO : WS_GCHI) + (size_t)((bh & 7) * 32) * 131072;
        bf16_t* nv = (bf16_t*)(A.ws + WS_NV) + (size_t)bh * 32 * 256;
        float* mst = (float*)(A.ws + WS_MST) + bh * 32;
#define SC_STEP(c, KU, VU, KL, VL) do { \
            const float* tbc = TBC + (c) * 64; const float* tuv = TUV + (c) * 64; const float* tcm = TCM + (c) * 64; \
            unsigned char* KS = KSB + ((c) & 1) * 33792; unsigned char* WVT = WVB + ((c) & 1) * 4608; \
            const float g_tot = tbc[63], cm63 = tcm[63]; \
            const float M63 = fmaxf(m_state, cm63), decay = __expf(m_state - M63); \
            if (es == 0 && tid == 0) mst[(c)] = m_state; \
            m_state = g_tot + M63; \
            _Pragma("unroll") for (int i = 0; i < 4; ++i) { const int p = tid + 512 * i, r = p >> 5, c16 = p & 31; *(u32x4*)(KS + r * 528 + c16 * 16) = KU[i]; } \
            { const int s = tid >> 3, ep = tid & 7; const float wv = __expf(tuv[s] - M63); \
              ((bf16_t*)WVT)[(2 * ep) * 72 + s] = f2bf(bflo(VU) * wv); ((bf16_t*)WVT)[(2 * ep + 1) * 72 + s] = f2bf(bfhi(VU) * wv); \
              if (ep == 0) ((bf16_t*)WVT)[16 * 72 + s] = f2bf(wv); } \
            if ((c) + 3 < 32) SC_LOAD((c) + 3, KL, VL); \
            _Pragma("unroll") for (int x = 0; x < 2; ++x) { const int dt = 2 * w + x; \
                u32x2 o; o.x = cvt_pk_bf16(Cst[x][0][0], Cst[x][0][1]); o.y = cvt_pk_bf16(Cst[x][0][2], Cst[x][0][3]); \
                *(u32x2*)(gc + (size_t)(c) * 131072 + (e0 + l15) * 512 + (16 * dt + 4 * g) * 2) = o; \
                if (es == 0 && l15 == 0) { u32x2 n2; n2.x = cvt_pk_bf16(Cst[x][1][0], Cst[x][1][1]); n2.y = cvt_pk_bf16(Cst[x][1][2], Cst[x][1][3]); *(u32x2*)(nv + (c) * 256 + 16 * dt + 4 * g) = n2; } } \
            __syncthreads(); \
            _Pragma("unroll") for (int x = 0; x < 2; ++x) { const int dt = 2 * w + x; \
                _Pragma("unroll") for (int et = 0; et < 2; ++et) Cst[x][et] *= decay; \
                _Pragma("unroll") for (int ks = 0; ks < 2; ++ks) { \
                    const s16x4 klo = __builtin_amdgcn_ds_read_tr16_b64_v4i16((LAS s16x4*)(KS + (32 * ks + 8 * g + (l15 >> 2)) * 528 + (16 * dt + 4 * (l15 & 3)) * 2)); \
                    const s16x4 khi = __builtin_amdgcn_ds_read_tr16_b64_v4i16((LAS s16x4*)(KS + (32 * ks + 8 * g + 4 + (l15 >> 2)) * 528 + (16 * dt + 4 * (l15 & 3)) * 2)); \
                    const bf16x8 ka = {klo[0], klo[1], klo[2], klo[3], khi[0], khi[1], khi[2], khi[3]}; \
                    _Pragma("unroll") for (int et = 0; et < 2; ++et) { const bf16x8 wvb = *(const bf16x8*)(WVT + (16 * et + l15) * 144 + (32 * ks + 8 * g) * 2); \
                        Cst[x][et] = __builtin_amdgcn_mfma_f32_16x16x32_bf16(ka, wvb, Cst[x][et], 0, 0, 0); } } } \
        } while (0)
#pragma unroll 1
        for (int c4 = 0; c4 < 32; c4 += 4) {
            SC_STEP(c4 + 0, kA, vA, kD, vD);
            SC_STEP(c4 + 1, kB, vB, kA, vA);
            SC_STEP(c4 + 2, kC, vC, kB, vB);
            SC_STEP(c4 + 3, kD, vD, kC, vC);
        }
#undef SC_STEP
#undef SC_LOAD
    }
}

__device__ __forceinline__ void phase_mlstm_out(const Args& A, unsigned char* lds, float* hbuf) {
    const int tid = threadIdx.x, lane = tid & 63, w = tid >> 6, g = lane >> 4, l15 = lane & 15;
    const int a = w >> 2, ti = w & 3;
    unsigned char* QS = lds; unsigned char* KS = lds + 33792; unsigned char* VS = lds + 67584; unsigned char* PI = lds + 101376;
    float* DEN = (float*)(lds + 110592); float* TB = DEN + 64;
    float* HT = (float*)lds;
    const bf16_t* proj = (const bf16_t*)(A.ws + WS_PROJ);
    for (int it = blockIdx.x; it < 512; it += gridDim.x) {
        const int bh = it >> 5, c = it & 31, b = bh >> 2, hh = bh & 3;
        const size_t row0 = (size_t)b * SEQ + c * 64;
        const bf16_t* qbase = proj + row0 * NP + 3072 + hh * 256;
        const unsigned char* gc = A.ws + (bh < 8 ? WS_GCLO : WS_GCHI) + (size_t)((bh & 7) * 32 + c) * 131072;
        const bf16_t* nv = (const bf16_t*)(A.ws + WS_NV) + (size_t)(bh * 32 + c) * 256;
        const float* tab = (const float*)(A.ws + WS_TAB) + (size_t)bh * 3 * 2048 + c * 64;
        const float m_c = ((const float*)(A.ws + WS_MST))[bh * 32 + c];
        __syncthreads();
        { u32x4 qv[4], kv[4], vv[4];
#pragma unroll
          for (int i = 0; i < 4; ++i) { const int p = tid + 512 * i, r = p >> 5, c16 = p & 31; const bf16_t* rp = qbase + (size_t)r * NP + c16 * 8; qv[i] = *(const u32x4*)rp; kv[i] = *(const u32x4*)(rp + 1024); vv[i] = *(const u32x4*)(rp + 2048); }
#pragma unroll
          for (int i = 0; i < 4; ++i) { const int p = tid + 512 * i, r = p >> 5, c16 = p & 31; *(u32x4*)(QS + r * 528 + c16 * 16) = qv[i]; *(u32x4*)(KS + r * 528 + c16 * 16) = kv[i]; *(u32x4*)(VS + r * 528 + c16 * 16) = vv[i]; } }
        if (tid < 192) TB[tid] = tab[(tid >> 6) * 2048 + (tid & 63)];
        __syncthreads();
        const float* tbc = TB; const float* tuv = TB + 64; const float* tcm = TB + 128;
        {
            f32x4 S0 = (f32x4){0.f, 0.f, 0.f, 0.f}, S1 = S0;
#pragma unroll
            for (int kk = 0; kk < 8; ++kk) {
                const int ko = kk * 64 + g * 16;
                const bf16x8 qf = *(const bf16x8*)(QS + (16 * ti + l15) * 528 + ko);
                const bf16x8 kf0 = *(const bf16x8*)(KS + (32 * a + l15) * 528 + ko), kf1 = *(const bf16x8*)(KS + (32 * a + 16 + l15) * 528 + ko);
                S0 = __builtin_amdgcn_mfma_f32_16x16x32_bf16(kf0, qf, S0, 0, 0, 0); S1 = __builtin_amdgcn_mfma_f32_16x16x32_bf16(kf1, qf, S1, 0, 0, 0);
            }
            const int tcol = 16 * ti + l15;
            const float Mt = fmaxf(m_c, tcm[tcol]);
            const f32x4 u0v = *(const f32x4*)(tuv + 32 * a + 4 * g), u1v = *(const f32x4*)(tuv + 32 * a + 16 + 4 * g);
            float p[8];
#pragma unroll
            for (int r = 0; r < 4; ++r) { const int s0 = 32 * a + 4 * g + r, s1 = s0 + 16;
                p[r] = (s0 <= tcol) ? S0[r] * 0.0625f * __expf(u0v[r] - Mt) : 0.f; p[4 + r] = (s1 <= tcol) ? S1[r] * 0.0625f * __expf(u1v[r] - Mt) : 0.f; }
            u32x2 plo, phi; plo.x = cvt_pk_bf16(p[0], p[1]); plo.y = cvt_pk_bf16(p[2], p[3]); phi.x = cvt_pk_bf16(p[4], p[5]); phi.y = cvt_pk_bf16(p[6], p[7]);
            *(u32x2*)(PI + tcol * 144 + (32 * a + 4 * g) * 2) = plo; *(u32x2*)(PI + tcol * 144 + (32 * a + 16 + 4 * g) * 2) = phi;
        }
        __syncthreads();
        f32x4 acc[4][2], inr[4][2];
#pragma unroll
        for (int tt = 0; tt < 4; ++tt)
#pragma unroll
            for (int x = 0; x < 2; ++x) { acc[tt][x] = (f32x4){0.f, 0.f, 0.f, 0.f}; inr[tt][x] = (f32x4){0.f, 0.f, 0.f, 0.f}; }
#pragma unroll
        for (int ks = 0; ks < 2; ++ks) {
            bf16x8 vb[2];
#pragma unroll
            for (int x = 0; x < 2; ++x) { const int et = 2 * w + x;
                const s16x4 vlo = __builtin_amdgcn_ds_read_tr16_b64_v4i16((LAS s16x4*)(VS + (32 * ks + 8 * g + (l15 >> 2)) * 528 + (16 * et + 4 * (l15 & 3)) * 2));
                const s16x4 vhi = __builtin_amdgcn_ds_read_tr16_b64_v4i16((LAS s16x4*)(VS + (32 * ks + 8 * g + 4 + (l15 >> 2)) * 528 + (16 * et + 4 * (l15 & 3)) * 2));
                vb[x] = (bf16x8){vlo[0], vlo[1], vlo[2], vlo[3], vhi[0], vhi[1], vhi[2], vhi[3]}; }
#pragma unroll
            for (int tt = 0; tt < 4; ++tt) { const bf16x8 pa = *(const bf16x8*)(PI + (16 * tt + l15) * 144 + (32 * ks + 8 * g) * 2);
                acc[tt][0] = __builtin_amdgcn_mfma_f32_16x16x32_bf16(pa, vb[0], acc[tt][0], 0, 0, 0); acc[tt][1] = __builtin_amdgcn_mfma_f32_16x16x32_bf16(pa, vb[1], acc[tt][1], 0, 0, 0); }
        }
#pragma unroll
        for (int kk = 0; kk < 8; ++kk) {
            const bf16x8 cb0 = *(const bf16x8*)(gc + (size_t)((16 * (2 * w) + l15) * 256 + 32 * kk + 8 * g) * 2), cb1 = *(const bf16x8*)(gc + (size_t)((16 * (2 * w + 1) + l15) * 256 + 32 * kk + 8 * g) * 2);
#pragma unroll
            for (int tt = 0; tt < 4; ++tt) { const bf16x8 qa = *(const bf16x8*)(QS + (16 * tt + l15) * 528 + (32 * kk + 8 * g) * 2);
                inr[tt][0] = __builtin_amdgcn_mfma_f32_16x16x32_bf16(qa, cb0, inr[tt][0], 0, 0, 0); inr[tt][1] = __builtin_amdgcn_mfma_f32_16x16x32_bf16(qa, cb1, inr[tt][1], 0, 0, 0); }
        }
        if (w < 4) {
            f32x4 di = (f32x4){0.f, 0.f, 0.f, 0.f}, dn = di;
            const unsigned one2 = (l15 == 0) ? 0x3F803F80u : 0u;
            u32x4 ou; ou.x = one2; ou.y = one2; ou.z = one2; ou.w = one2;
            const bf16x8 onesf = __builtin_bit_cast(bf16x8, ou);
#pragma unroll
            for (int ks = 0; ks < 2; ++ks) { const bf16x8 pa = *(const bf16x8*)(PI + (16 * w + l15) * 144 + (32 * ks + 8 * g) * 2); di = __builtin_amdgcn_mfma_f32_16x16x32_bf16(pa, onesf, di, 0, 0, 0); }
#pragma unroll
            for (int kk = 0; kk < 8; ++kk) { u32x4 nu = *(const u32x4*)(nv + 32 * kk + 8 * g); if (l15 != 0) nu = (u32x4){0u, 0u, 0u, 0u};
                const bf16x8 qa = *(const bf16x8*)(QS + (16 * w + l15) * 528 + (32 * kk + 8 * g) * 2);
                dn = __builtin_amdgcn_mfma_f32_16x16x32_bf16(qa, __builtin_bit_cast(bf16x8, nu), dn, 0, 0, 0); }
            if (l15 == 0) {
#pragma unroll
                for (int r = 0; r < 4; ++r) { const int t = 16 * w + 4 * g + r; const float iw = __expf(m_c - fmaxf(m_c, tcm[t])) * 0.0625f; DEN[t] = di[r] + dn[r] * iw; } }
        }
        __syncthreads();
#pragma unroll
        for (int tt = 0; tt < 4; ++tt) {
            const f32x4 cmr = *(const f32x4*)(tcm + 16 * tt + 4 * g), bcr = *(const f32x4*)(tbc + 16 * tt + 4 * g), dnr = *(const f32x4*)(DEN + 16 * tt + 4 * g);
#pragma unroll
            for (int r = 0; r < 4; ++r) {
                const float Mx = fmaxf(m_c, cmr[r]), iw = __expf(m_c - Mx) * 0.0625f, fl = __expf(-(bcr[r] + Mx));
                const float rden = __builtin_amdgcn_rcpf(fmaxf(fabsf(dnr[r]), fl));
                float* hp = HT + (16 * tt + 4 * g + r) * 260 + 32 * w + l15;
                hp[0] = (acc[tt][0][r] + inr[tt][0][r] * iw) * rden; hp[16] = (acc[tt][1][r] + inr[tt][1][r] * iw) * rden;
            }
        }
        __syncthreads();
        {
            const f32x4 gn = *(const f32x4*)(A.mh_gain + hh * 256 + lane * 4);
            bf16_t* y = (bf16_t*)(A.ws + WS_Y);
#pragma unroll
            for (int hb = 0; hb < 2; ++hb) {
                u32x4 yb[2], ycc[2][3], yhh[2][3]; int yro[2], ych[2];
#pragma unroll
                for (int j = 0; j < 2; ++j) { const int yi = tid + 512 * (2 * hb + j); const int rl = yi >> 5; ych[j] = hh * 256 + (yi & 31) * 8; yro[j] = rl;
                    const int yt = c * 64 + rl; const bf16_t* pr = proj + (row0 + rl) * NP + ych[j]; yb[j] = *(const u32x4*)pr;
#pragma unroll
                    for (int q = 0; q < 3; ++q) { const int dt = 2 - q; const bool ok = yt - dt >= 0;
                        ycc[j][q] = ok ? *(const u32x4*)(pr - (size_t)dt * NP + WCONV) : (u32x4){0u, 0u, 0u, 0u}; yhh[j][q] = ok ? *(const u32x4*)(pr - (size_t)dt * NP + 2 * WCONV) : (u32x4){0u, 0u, 0u, 0u}; } }
                f32x4 hv[4]; u32x2 ov[4]; float sm[4], sq[4];
#pragma unroll
                for (int i = 0; i < 4; ++i) { const int rl = 8 * w + 4 * hb + i; hv[i] = *(const f32x4*)(HT + rl * 260 + lane * 4); ov[i] = *(const u32x2*)(proj + (row0 + rl) * NP + 6144 + hh * 256 + lane * 4); }
#pragma unroll
                for (int i = 0; i < 4; ++i) sm[i] = (hv[i][0] + hv[i][1]) + (hv[i][2] + hv[i][3]);
#pragma unroll
                for (int off = 32; off >= 1; off >>= 1)
#pragma unroll
                    for (int i = 0; i < 4; ++i) sm[i] += __shfl_xor(sm[i], off);
#pragma unroll
                for (int i = 0; i < 4; ++i) { const float mu = sm[i] * (1.0f / 256.0f); hv[i] = hv[i] - mu; sq[i] = (hv[i][0] * hv[i][0] + hv[i][1] * hv[i][1]) + (hv[i][2] * hv[i][2] + hv[i][3] * hv[i][3]); }
#pragma unroll
                for (int off = 32; off >= 1; off >>= 1)
#pragma unroll
                    for (int i = 0; i < 4; ++i) sq[i] += __shfl_xor(sq[i], off);
#pragma unroll
                for (int i = 0; i < 4; ++i) { const int rl = 8 * w + 4 * hb + i;
                    const float rstd = rsqrtf(sq[i] * (1.0f / 256.0f) + 1e-6f);
                    const float o0 = bflo(ov[i].x), o1 = bfhi(ov[i].x), o2 = bflo(ov[i].y), o3 = bfhi(ov[i].y);
                    const float y0 = hv[i][0] * rstd * gn[0] * __builtin_amdgcn_rcpf(1.0f + __expf(-o0)), y1 = hv[i][1] * rstd * gn[1] * __builtin_amdgcn_rcpf(1.0f + __expf(-o1));
                    const float y2 = hv[i][2] * rstd * gn[2] * __builtin_amdgcn_rcpf(1.0f + __expf(-o2)), y3 = hv[i][3] * rstd * gn[3] * __builtin_amdgcn_rcpf(1.0f + __expf(-o3));
                    u32x2 o; o.x = cvt_pk_bf16(y0, y1); o.y = cvt_pk_bf16(y2, y3);
                    *(u32x2*)(y + (row0 + rl) * DM + WCONV + hh * 256 + lane * 4) = o; }
#pragma unroll
                for (int j = 0; j < 2; ++j) {
                    float cv[8];
#pragma unroll
                    for (int i = 0; i < 8; ++i) cv[i] = 0.f;
#pragma unroll
                    for (int q = 0; q < 3; ++q) { const f32x4 w0 = *(const f32x4*)(A.w_sc + q * WCONV + ych[j]), w1 = *(const f32x4*)(A.w_sc + q * WCONV + ych[j] + 4);
                        const float wv8[8] = {w0[0], w0[1], w0[2], w0[3], w1[0], w1[1], w1[2], w1[3]};
#pragma unroll
                        for (int i = 0; i < 4; ++i) { const unsigned cq = ycc[j][q][i], hq = yhh[j][q][i]; cv[2 * i] += wv8[2 * i] * bflo(cq) * bflo(hq); cv[2 * i + 1] += wv8[2 * i + 1] * bfhi(cq) * bfhi(hq); } }
                    u32x4 o;
#pragma unroll
                    for (int i = 0; i < 4; ++i) { const unsigned bq = yb[j][i]; o[i] = cvt_pk_bf16(bflo(bq) * cv[2 * i], bfhi(bq) * cv[2 * i + 1]); }
                    *(u32x4*)(y + (row0 + yro[j]) * DM + ych[j]) = o;
                }
            }
        }
    }
}

__device__ __forceinline__ void phase_headnorm(const Args& A, const float* hbuf) {
    const bf16_t* proj = (const bf16_t*)(A.ws + WS_PROJ); bf16_t* y = (bf16_t*)(A.ws + WS_Y);
    const int lane = threadIdx.x & 63, gw = blockIdx.x * 8 + (threadIdx.x >> 6), nw = gridDim.x * 8;
    f32x4 gn[4];
#pragma unroll
    for (int hh = 0; hh < 4; ++hh) gn[hh] = *(const f32x4*)(A.mh_gain + hh * 256 + lane * 4);
    for (int row = gw; row < MT; row += nw) {
        f32x4 hv[4]; u32x2 ov[4]; float s[4], q[4];
#pragma unroll
        for (int hh = 0; hh < 4; ++hh) { hv[hh] = *(const f32x4*)(hbuf + (size_t)row * 1024 + hh * 256 + lane * 4); ov[hh] = *(const u32x2*)(proj + (size_t)row * NP + 6144 + hh * 256 + lane * 4); }
#pragma unroll
        for (int hh = 0; hh < 4; ++hh) s[hh] = (hv[hh][0] + hv[hh][1]) + (hv[hh][2] + hv[hh][3]);
#pragma unroll
        for (int off = 32; off >= 1; off >>= 1)
#pragma unroll
            for (int hh = 0; hh < 4; ++hh) s[hh] += __shfl_xor(s[hh], off);
#pragma unroll
        for (int hh = 0; hh < 4; ++hh) { const float mu = s[hh] * (1.0f / 256.0f); hv[hh] = hv[hh] - mu; q[hh] = (hv[hh][0] * hv[hh][0] + hv[hh][1] * hv[hh][1]) + (hv[hh][2] * hv[hh][2] + hv[hh][3] * hv[hh][3]); }
#pragma unroll
        for (int off = 32; off >= 1; off >>= 1)
#pragma unroll
            for (int hh = 0; hh < 4; ++hh) q[hh] += __shfl_xor(q[hh], off);
#pragma unroll
        for (int hh = 0; hh < 4; ++hh) {
            const float rstd = rsqrtf(q[hh] * (1.0f / 256.0f) + 1e-6f);
            const float o0 = bflo(ov[hh].x), o1 = bfhi(ov[hh].x), o2 = bflo(ov[hh].y), o3 = bfhi(ov[hh].y);
            const float y0 = hv[hh][0] * rstd * gn[hh][0] * __builtin_amdgcn_rcpf(1.0f + __expf(-o0)), y1 = hv[hh][1] * rstd * gn[hh][1] * __builtin_amdgcn_rcpf(1.0f + __expf(-o1));
            const float y2 = hv[hh][2] * rstd * gn[hh][2] * __builtin_amdgcn_rcpf(1.0f + __expf(-o2)), y3 = hv[hh][3] * rstd * gn[hh][3] * __builtin_amdgcn_rcpf(1.0f + __expf(-o3));
            u32x2 o; o.x = cvt_pk_bf16(y0, y1); o.y = cvt_pk_bf16(y2, y3);
            *(u32x2*)(y + (size_t)row * DM + WCONV + hh * 256 + lane * 4) = o;
        }
    }
}

__device__ __forceinline__ void phase_ln(float* io, const float* gam, const float* bet, bf16_t* ob) {
    const int lane = threadIdx.x & 63, gw = blockIdx.x * 8 + (threadIdx.x >> 6), nw = gridDim.x * 8;
    for (int row = gw; row < MT; row += nw) {
        float* rp = io + (size_t)row * DM;
        f32x4 v[8]; float s = 0.f;
#pragma unroll
        for (int i = 0; i < 8; ++i) { v[i] = *(const f32x4*)(rp + i * 256 + lane * 4); s += (v[i][0] + v[i][1]) + (v[i][2] + v[i][3]); }
#pragma unroll
        for (int off = 32; off >= 1; off >>= 1) s += __shfl_xor(s, off);
        const float mu = s * (1.0f / DM);
        float q = 0.f;
#pragma unroll
        for (int i = 0; i < 8; ++i) { v[i] = v[i] - mu; q += (v[i][0] * v[i][0] + v[i][1] * v[i][1]) + (v[i][2] * v[i][2] + v[i][3] * v[i][3]); }
#pragma unroll
        for (int off = 32; off >= 1; off >>= 1) q += __shfl_xor(q, off);
        const float rstd = rsqrtf(q * (1.0f / DM) + 1e-5f);
#pragma unroll
        for (int i = 0; i < 8; ++i) { const f32x4 gg = *(const f32x4*)(gam + i * 256 + lane * 4), bb = *(const f32x4*)(bet + i * 256 + lane * 4);
            const f32x4 o = v[i] * rstd * gg + bb;
            *(f32x4*)(rp + i * 256 + lane * 4) = o;
            if (ob) { u32x2 p; p.x = cvt_pk_bf16(o[0], o[1]); p.y = cvt_pk_bf16(o[2], o[3]); *(u32x2*)(ob + (size_t)row * DM + i * 256 + lane * 4) = p; } }
    }
}

__device__ __forceinline__ void phase_fixup(const Args& A) {
    const float* halo = (const float*)(A.ws + WS_HALO); bf16_t* act = (bf16_t*)(A.ws + WS_ACT);
    for (int idx = blockIdx.x * 512 + threadIdx.x; idx < 64 * 2 * (DFF / 4); idx += gridDim.x * 512) {
        const int f = (idx % (DFF / 4)) * 4, br = idx / (DFF / 4), rr = br & 1, B = br >> 1;
        const bool first = (B & 15) == 0;
        const float* hc = halo + (size_t)B * 4 * NUP; const float* hp = hc - 4 * NUP;
        f32x4 hv[2];
#pragma unroll
        for (int bj = 0; bj < 2; ++bj) {
            const int col = bj * DFF + f;
            const f32x4 cur = *(const f32x4*)(hc + (size_t)(2 + rr) * NUP + col);
            f32x4 p1, p2; const f32x4 z = (f32x4){0.f, 0.f, 0.f, 0.f};
            if (rr == 0) { p1 = first ? z : *(const f32x4*)(hp + (size_t)1 * NUP + col); p2 = first ? z : *(const f32x4*)(hp + col); }
            else { p1 = *(const f32x4*)(hc + (size_t)2 * NUP + col); p2 = first ? z : *(const f32x4*)(hp + (size_t)1 * NUP + col); }
            const f32x4 w0 = *(const f32x4*)(A.w_fc + col), w1 = *(const f32x4*)(A.w_fc + NUP + col), w2 = *(const f32x4*)(A.w_fc + 2 * NUP + col), bb = *(const f32x4*)(A.b_fc + col);
            hv[bj] = w2 * cur + w1 * p1 + w0 * p2 + bb;
        }
        float av[4];
#pragma unroll
        for (int j = 0; j < 4; ++j) { const float gt = hv[1][j]; av[j] = hv[0][j] * gt / (1.0f + __expf(-gt)); }
        u32x2 o; o.x = cvt_pk_bf16(av[0], av[1]); o.y = cvt_pk_bf16(av[2], av[3]);
        *(u32x2*)(act + (size_t)(B * 128 + rr) * DFF + f) = o;
    }
}

__device__ __forceinline__ void phase_dump(const bf16_t* src, int ld, int c0, float* out) {
    for (size_t idx = (size_t)blockIdx.x * 512 + threadIdx.x; idx < (size_t)MT * DM; idx += (size_t)gridDim.x * 512) {
        const size_t row = idx / DM, col = idx % DM; out[idx] = bflo((unsigned)src[row * ld + c0 + col]); }
}
#ifndef DBG_STOP
#define DBG_STOP -1
#endif
#define XB_TMO      128
#define XB_XCNT(j)  (256  + 64 * (j))
#define XB_XSUB(j)  (1280 + 64 * (j))
#define XB_XGEN(j)  (2304 + 64 * (j))
#define XB_TOP      3328
#define XB_TOPGEN   3392
#define XCD_BAR_WORDS 3456
#define XB_SPIN_CAP (1u << 22)
__device__ __forceinline__ unsigned xb_ld(unsigned* p)              { return __hip_atomic_load(p, __ATOMIC_RELAXED, __HIP_MEMORY_SCOPE_AGENT); }
__device__ __forceinline__ unsigned xb_add(unsigned* p, unsigned v) { return __hip_atomic_fetch_add(p, v, __ATOMIC_RELAXED, __HIP_MEMORY_SCOPE_AGENT); }
__device__ __forceinline__ unsigned xb_xcc_id() { return (unsigned)__builtin_amdgcn_s_getreg((3 << 11) | 20) & 0xFu; }
#define XB_SPIN(cond, bar) do { unsigned _sp = 0; while (cond) { __builtin_amdgcn_s_sleep(1); \
    if ((++_sp & 255u) == 0u) { if (xb_ld(&(bar)[XB_TMO])) break; if (_sp > XB_SPIN_CAP) { atomicAdd(&(bar)[XB_TMO], 1u); break; } } } } while (0)
struct XcdBarrier { unsigned* bar; unsigned x; volatile LAS unsigned* st; };
__device__ __forceinline__ XcdBarrier xcd_barrier_post(unsigned* bar, volatile LAS unsigned* st) {
    XcdBarrier b; b.bar = bar; b.x = xb_xcc_id(); b.st = st;
    if (threadIdx.x == 0) (void)xb_add(&bar[XB_XCNT(b.x)], 1u);
    return b;
}
__device__ __forceinline__ void xcd_barrier_complete(unsigned* bar, unsigned x, unsigned& nloc, unsigned& nx) {
    const unsigned G = gridDim.x * gridDim.y * gridDim.z;
    unsigned sum, cnt, mine, sp = 0u;
    for (;;) {
        sum = 0u; cnt = 0u; mine = 0u;
#pragma unroll
        for (unsigned j = 0; j < 16; ++j) { const unsigned c = xb_ld(&bar[XB_XCNT(j)]); sum += c; cnt += (c > 0u) ? 1u : 0u; mine = (j == x) ? c : mine; }
        if (sum == G) break;
        __builtin_amdgcn_s_sleep(1);
        if ((++sp & 255u) == 0u) { if (xb_ld(&bar[XB_TMO])) break; if (sp > XB_SPIN_CAP) { atomicAdd(&bar[XB_TMO], 1u); break; } }
    }
    nloc = mine > 0u ? mine : 1u; nx = cnt > 0u ? cnt : 1u;
}
__device__ __forceinline__ void xcd_barrier(const XcdBarrier& b) {
    asm volatile("s_waitcnt vmcnt(0)" ::: "memory");
    __syncthreads();
    if (threadIdx.x == 0) {
        unsigned* bar = b.bar;
        __builtin_amdgcn_s_waitcnt(0);
        unsigned nloc = b.st[0], nx = b.st[1];
        if (nloc == 0u) { xcd_barrier_complete(bar, b.x, nloc, nx); b.st[0] = nloc; b.st[1] = nx; }
        const unsigned old = xb_add(&bar[XB_XSUB(b.x)], 1u);
        const unsigned gen = old / nloc;
        if (old + 1u == (gen + 1u) * nloc) {
            __builtin_amdgcn_fence(__ATOMIC_RELEASE, "agent");
            asm volatile("s_waitcnt vmcnt(0)" ::: "memory");
            const unsigned og = xb_add(&bar[XB_TOP], 1u);
            const unsigned tg = og / nx;
            if (og + 1u == (tg + 1u) * nx) xb_add(&bar[XB_TOPGEN], 1u);
            else XB_SPIN(xb_ld(&bar[XB_TOPGEN]) == tg, bar);
            __builtin_amdgcn_fence(__ATOMIC_ACQUIRE, "agent");
            xb_add(&bar[XB_XGEN(b.x)], 1u);
            asm volatile("s_waitcnt vmcnt(0)" ::: "memory");
        } else {
            XB_SPIN(xb_ld(&bar[XB_XGEN(b.x)]) == gen, bar);
            __builtin_amdgcn_fence(__ATOMIC_ACQUIRE, "agent");
            asm volatile("s_waitcnt vmcnt(0)" ::: "memory");
        }
    }
    __syncthreads();
}

constexpr int N_PHASES = 10;
#ifndef ONLY_PH
#define ONLY_PH -1
#endif
#define PH_ON(x) (ONLY_PH < 0 || ONLY_PH == (x))
__global__ void __launch_bounds__(512, 2) mega(Args a) {
    extern __shared__ __attribute__((aligned(16))) unsigned char lds[];
    cg::grid_group grid = cg::this_grid();
    unsigned char* ws = a.ws;
#define PH_RUN(x) (PH_ON(x) && a.ph_lo <= (x) && (x) < a.ph_hi)
#define PH_SYNC(x) do { if (a.ph_lo <= (x) && (x) + 1 < a.ph_hi) xcd_barrier(xb); } while (0)
    volatile LAS unsigned* xst = (volatile LAS unsigned*)((LAS unsigned char*)lds + 131072);
    if (threadIdx.x == 0) { xst[0] = 0u; xst[1] = 0u; }
    __syncthreads();
    const XcdBarrier xb = xcd_barrier_post((unsigned*)(ws + WS_BAR), xst);
    if (a.ph_hi > 1000) grid.sync();
#ifndef REP0
#define REP0 1
#endif
#ifndef REP2
#define REP2 1
#endif
#ifndef REP6
#define REP6 1
#endif
    if (PH_RUN(0)) for (int rep = 0; rep < REP0; ++rep) phase_prologue(a, lds);
    PH_SYNC(0);
    if (PH_RUN(1)) { pg8::Gemm g{(const bf16_t*)(ws + WS_XB), (const bf16_t*)(ws + WS_WIN), MT, NP, DM}; pg8::StaticOrder S; S.init(MT, NP, gridDim.x, blockIdx.x);
        pg8::EpiBf16 E{(bf16_t*)(ws + WS_PROJ), NP}; pg8::gemm_phase<pg8::EpiBf16, true>((LAS unsigned char*)lds, g, S, E);
        const int rem = ((MT / 256) * (NP / 256)) % (int)gridDim.x;
        if (rem == 0) phase_transposes(a, lds, TM_IN, TM_IN + TM_OUT + TM_UP, blockIdx.x, gridDim.x);
        else if ((int)blockIdx.x >= rem) phase_transposes(a, lds, TM_IN, TM_IN + TM_OUT + TM_UP, blockIdx.x - rem, gridDim.x - rem); }
    PH_SYNC(1);
    if (PH_RUN(2)) {
        if (!a.fuse_ln) phase_yconv(a);
        if (a.fuse_ln) { phase_mlstm_scan(a, lds); xcd_barrier(xb); phase_mlstm_out(a, lds, a.out); }
        else phase_mlstm(a, lds, a.out); }
    PH_SYNC(2);
    if (PH_RUN(3) && !a.fuse_ln) phase_headnorm(a, a.out);
    if (!a.fuse_ln) PH_SYNC(3);
    if (PH_RUN(4)) { pg8::Gemm g{(const bf16_t*)(ws + WS_Y), (const bf16_t*)(ws + WS_WOUT), MT, DM, DM}; pg8::StaticOrder S; S.init(MT, DM, gridDim.x, blockIdx.x);
        if (a.fuse_ln) { pg8::EpiResLn<false, false> E{a.x, nullptr, nullptr, (bf16_t*)(ws + WS_X1B), a.ln1_g, a.ln1_b, (float*)(ws + WS_RS1), (unsigned*)(ws + WS_CNT)}; pg8::gemm_phase((LAS unsigned char*)lds, g, S, E); }
        else { pg8::EpiResF32 E{a.x, a.out, DM}; pg8::gemm_phase((LAS unsigned char*)lds, g, S, E); } }
    PH_SYNC(4);
    if (PH_RUN(5) && !a.fuse_ln) phase_ln(a.out, a.ln1_g, a.ln1_b, (bf16_t*)(ws + WS_X1B));
    if (!a.fuse_ln) PH_SYNC(5);
    if (PH_RUN(6)) { pg8::Gemm g{(const bf16_t*)(ws + WS_X1B), (const bf16_t*)(ws + WS_WUP), MT, NUP, DM}; pg8::StaticOrder S; S.init(MT, NUP, gridDim.x, blockIdx.x);
        pg8::EpiConvFfn E{(bf16_t*)(ws + WS_ACT), (float*)(ws + WS_HALO), a.w_fc, a.b_fc}; pg8::gemm_phase<pg8::EpiConvFfn, true>((LAS unsigned char*)lds, g, S, E);
        const int rem = ((MT / 256) * (NUP / 256)) % (int)gridDim.x; const int t0 = TM_IN + TM_OUT + TM_UP, t1 = t0 + TM_DN;
        if (rem == 0) phase_transposes(a, lds, t0, t1, blockIdx.x, gridDim.x);
        else if ((int)blockIdx.x >= rem) phase_transposes(a, lds, t0, t1, blockIdx.x - rem, gridDim.x - rem); }
    PH_SYNC(6);
    if (PH_RUN(7)) phase_fixup(a);
    PH_SYNC(7);
    if (PH_RUN(8)) { pg8::Gemm g{(const bf16_t*)(ws + WS_ACT), (const bf16_t*)(ws + WS_WDN), MT, DM, DFF}; pg8::StaticOrder S; S.init(MT, DM, gridDim.x, blockIdx.x);
        if (a.fuse_ln) { pg8::EpiResLn<true, true> E{nullptr, (const bf16_t*)(ws + WS_X1B), a.out, nullptr, a.ln2_g, a.ln2_b, (float*)(ws + WS_RS2), (unsigned*)(ws + WS_CNT) + 32 * 64}; pg8::gemm_phase((LAS unsigned char*)lds, g, S, E); }
        else { pg8::EpiResF32 E{a.out, a.out, DM}; pg8::gemm_phase((LAS unsigned char*)lds, g, S, E); } }
    if (!a.fuse_ln) PH_SYNC(8);
    if (PH_RUN(9) && !a.fuse_ln) phase_ln(a.out, a.ln2_g, a.ln2_b, nullptr);
    if (DBG_STOP == 1 && a.ph_lo == 101) phase_dump((const bf16_t*)(ws + WS_PROJ), NP, 3072, a.out);
    if (DBG_STOP == 3 && a.ph_lo == 103) phase_dump((const bf16_t*)(ws + WS_Y), DM, 0, a.out);
    if (DBG_STOP == 7 && a.ph_lo == 107) phase_dump((const bf16_t*)(ws + WS_ACT), DFF, 0, a.out);
}

extern "C" void kernel_launch(void* const* d_in, const int* in_sizes, int n_in, void* d_out, int out_size, void* d_ws, size_t ws_size, hipStream_t stream) {
    static int grid = 0;
    if (grid == 0) {
        if (n_in != 14 || ws_size < WS_END) { fprintf(stderr, "kernel_launch: unexpected n_in %d / ws_size %zu (need %zu)\n", n_in, ws_size, (size_t)WS_END); grid = -1; return; }
        int dev = 0, cus = 0, per_cu = 0;
        hipGetDevice(&dev); hipDeviceGetAttribute(&cus, hipDeviceAttributeMultiprocessorCount, dev);
        if (hipFuncSetAttribute((const void*)mega, hipFuncAttributeMaxDynamicSharedMemorySize, LDS_BYTES) != hipSuccess) { fprintf(stderr, "kernel_launch: hipFuncSetAttribute failed\n"); grid = -1; return; }
        if (hipOccupancyMaxActiveBlocksPerMultiprocessor(&per_cu, (const void*)mega, 512, LDS_BYTES) != hipSuccess || per_cu < 1) { fprintf(stderr, "kernel_launch: occupancy query failed (%d)\n", per_cu); (void)hipGetLastError(); per_cu = 1; }
        grid = cus * 1;
        fprintf(stderr, "kernel_launch: cus %d per_cu %d grid %d\n", cus, per_cu, grid);
    }
    if (grid < 0) return;
    if (hipMemsetAsync((char*)d_ws + WS_BAR, 0, WS_END - WS_BAR, stream)     != hipSuccess) { fprintf(stderr, "kernel_launch: memset failed\n"); return; }
    Args a{};
    a.x = (const float*)d_in[0]; a.w_in = (const float*)d_in[1]; a.b_gates = (const float*)d_in[2]; a.w_sc = (const float*)d_in[3]; a.mh_gain = (const float*)d_in[4]; a.w_out = (const float*)d_in[5];
    a.ln1_g = (const float*)d_in[6]; a.ln1_b = (const float*)d_in[7]; a.w_up = (const float*)d_in[8]; a.w_fc = (const float*)d_in[9]; a.b_fc = (const float*)d_in[10]; a.w_down = (const float*)d_in[11];
    a.ln2_g = (const float*)d_in[12]; a.ln2_b = (const float*)d_in[13];
    a.out = (float*)d_out; a.ws = (unsigned char*)d_ws;
    a.fuse_ln = (MK_SINGLE && grid == 256) ? 1 : 0;
#if MK_SINGLE
    a.ph_lo = 0; a.ph_hi = N_PHASES;
    void* args[] = {&a};
    hipError_t e = hipLaunchCooperativeKernel((const void*)mega, dim3(grid), dim3(512), args, LDS_BYTES, stream);
    if (e != hipSuccess) fprintf(stderr, "cooperative launch failed: %s (grid %d)\n", hipGetErrorString(e), grid);
#else
    for (int ph = 0; ph < N_PHASES; ++ph) { if (DBG_STOP >= 0 && ph > DBG_STOP) break; a.ph_lo = ph; a.ph_hi = ph + 1; hipLaunchKernelGGL(mega, dim3(grid), dim3(512), LDS_BYTES, stream, a); }
    if (DBG_STOP >= 0) { a.ph_lo = 100 + DBG_STOP; a.ph_hi = 101 + DBG_STOP; hipLaunchKernelGGL(mega, dim3(grid), dim3(512), LDS_BYTES, stream, a); }
#endif
}
```
